# Optimizing an MI355X kernel written in HIP

```python
import math
import jax
import jax.numpy as jnp
from jax import lax
import numpy as np

D_MODEL = 2048
BATCH = 4
SEQ = 2048
DEPTH = 4

GRID_W = 64
CTX_LEN = 256
N_MIXERS = 4
REPEATS = DEPTH // N_MIXERS
DN_ALPHA = (2 * DEPTH) ** 0.25
DN_BETA = (8 * DEPTH) ** -0.25
LN_EPS = 1e-5
N_MOD = 6

D_FF = 5632
FFN_CONV = 3

RW_HEAD = 64
RW_HEADS = D_MODEL // RW_HEAD
RW_DECAY_LORA = 96
RW_ICLR_LORA = 64
RW_GATE_LORA = 256
RW_DECAY_SCALE = 0.606531
RW_GN_EPS = 64e-5

DA_HEAD = 128
DA_HEADS = D_MODEL // (2 * DA_HEAD)
DA_QBLOCK = 128
ROPE_BASE = 10000.0
ROPE_FREQS = DA_HEAD // 4

HG_EXPAND = 128
HG_HEADS = D_MODEL // HG_EXPAND
HG_HEAD_V = D_MODEL // HG_HEADS
HG_CHUNK = 64

LR_WIDTH = D_MODEL
LR_BLOCKS = 8
LR_BS = LR_WIDTH // LR_BLOCKS
LR_CONV = 4
LR_C = 8.0

kernel_name = 'hybrid_interleaved_diffusion_backbone'


def layer_norm(x, g, b):
    xf = x.astype(jnp.float32)
    mu = jnp.mean(xf, -1, keepdims=True)
    var = jnp.mean(jnp.square(xf - mu), -1, keepdims=True)
    return ((xf - mu) * lax.rsqrt(var + LN_EPS)).astype(x.dtype) * g + b


def rms_norm(x, g, eps):
    xf = x.astype(jnp.float32)
    return (xf * lax.rsqrt(jnp.mean(jnp.square(xf), -1, keepdims=True) + eps)).astype(x.dtype) * g


def split_apply(fn_ctx, fn_lat, z, n_ctx):
    if n_ctx == 0:
        return fn_lat(z)
    return jnp.concatenate([fn_ctx(z[:, :n_ctx]), fn_lat(z[:, n_ctx:])], axis=1)


def seg_flip(t, n_ctx):
    return jnp.concatenate([jnp.flip(t[:, :n_ctx], 1), jnp.flip(t[:, n_ctx:], 1)], axis=1)


def dwconv_centred(x, w, b):
    k_w, n = w.shape[0], x.shape[1]
    xp = jnp.pad(x, ((0, 0), ((k_w - 1) // 2, k_w // 2), (0, 0)))
    return b + sum(xp[:, j:j + n] * w[j] for j in range(k_w))


def centred_shift_delta(x):
    xp = jnp.pad(x, ((0, 0), (1, 1), (0, 0)))
    return 0.5 * (xp[:, :-2] + xp[:, 2:]) - x


def ada_modulate(z, n_ctx, m_ctx, m_lat, j):
    mod = lambda m: (lambda s: s * (1 + m[:, None, j + 1]) + m[:, None, j])
    return split_apply(mod(m_ctx), mod(m_lat), z, n_ctx)


def ada_gate(y, n_ctx, m_ctx, m_lat, j):
    gate = lambda m: (lambda s: s * m[:, None, j])
    return split_apply(gate(m_ctx), gate(m_lat), y, n_ctx)


def prefix_axial_rope(n_ctx, n_lat):
    n_rows = n_lat // GRID_W
    row = jnp.repeat(jnp.arange(n_rows, dtype=jnp.float32), GRID_W)
    col = jnp.tile(jnp.arange(GRID_W, dtype=jnp.float32), n_rows)
    inv_freq = ROPE_BASE ** (-jnp.arange(ROPE_FREQS, dtype=jnp.float32) / ROPE_FREQS)
    ang_r, ang_c = row[:, None] * inv_freq, col[:, None] * inv_freq
    ang = jnp.concatenate([ang_r, ang_r, ang_c, ang_c], axis=-1)
    ang = jnp.concatenate([jnp.zeros((n_ctx, DA_HEAD), jnp.float32), ang], axis=0)
    return jnp.cos(ang), jnp.sin(ang)


def rotate_quarters(t):
    qa, qb, qc, qd = jnp.split(t, 4, axis=-1)
    return jnp.concatenate([-qb, qa, -qd, qc], axis=-1)


def rwkv7_scan(r, w, k, v, kk, a):
    def step(S, inp):
        r_t, w_t, k_t, v_t, kk_t, a_t = inp
        sa = jnp.einsum('ghij,ghj->ghi', S, kk_t)
        S = (S * w_t[:, :, None, :] - sa[..., None] * (kk_t * a_t)[:, :, None, :]
             + v_t[..., None] * k_t[:, :, None, :])
        return S, jnp.einsum('ghij,ghj->ghi', S, r_t)
    S0 = jnp.zeros(r.shape[1:] + (r.shape[-1],), r.dtype)
    return lax.scan(step, S0, (r, w, k, v, kk, a))[1]


def gla_chunked(q, k, v, logf):
    g_, n, h_, dk = q.shape
    dv = v.shape[-1]
    nc = n // HG_CHUNK
    blk = lambda t: jnp.moveaxis(t.reshape(g_, nc, HG_CHUNK, h_, t.shape[-1]), 1, 0)
    q, k, v = blk(q), blk(k), blk(v)
    b = jnp.cumsum(blk(logf).astype(jnp.float32), axis=2)
    b_end = b[:, :, -1:]
    qd = q * jnp.exp(b)
    kd = k * jnp.exp(-b)
    ke = k * jnp.exp(b_end - b)
    causal = jnp.tril(jnp.ones((HG_CHUNK, HG_CHUNK), bool))
    att = jnp.where(causal, jnp.einsum('ngthk,ngshk->nghts', qd, kd), 0.0)
    o_intra = jnp.einsum('nghts,ngshv->ngthv', att, v.astype(att.dtype))

    def step(S, inp):
        qd_n, ke_n, v_n, dec_n = inp
        o_n = jnp.einsum('gthk,ghkv->gthv', qd_n, S)
        S = dec_n[..., None] * S + jnp.einsum('gshk,gshv->ghkv', ke_n, v_n)
        return S, o_n
    S0 = jnp.zeros((g_, h_, dk, dv), qd.dtype)
    _, o_inter = lax.scan(step, S0, (qd, ke, v.astype(qd.dtype), jnp.exp(b_end[:, :, 0])))
    o = o_intra + o_inter
    return jnp.moveaxis(o, 0, 1).reshape(g_, n, h_, dv)


def rwkv7_mixer(h, n_ctx, drop_ctx, mu, w_rkv, w0, w1, w2, a0, a1, a2, g1, g2, k_k, k_a, r_k,
                gn_g, gn_b, w_o):
    bsz, n, _ = h.shape
    dt = h.dtype
    dx = split_apply(centred_shift_delta, centred_shift_delta, h, n_ctx)
    xs = h[None] + dx[None] * mu[:, None, None, :]
    r, k, v = jnp.einsum('nbld,nde->nble', xs[:3], w_rkv)
    w_log = w0[:, None, None] + jnp.einsum('nblr,nrd->nbld', jnp.tanh(jnp.einsum('bld,ndr->nblr', xs[3], w1)), w2)
    decay = jnp.exp(-RW_DECAY_SCALE * jax.nn.sigmoid(w_log))
    iclr = jax.nn.sigmoid(a0[:, None, None] + jnp.einsum('nblr,nrd->nbld', jnp.einsum('bld,ndr->nblr', xs[4], a1), a2))
    g = jax.nn.sigmoid(xs[5] @ g1) @ g2
    kk = (k * k_k).reshape(bsz, n, RW_HEADS, RW_HEAD)
    kk = kk * lax.rsqrt(jnp.sum(jnp.square(kk.astype(jnp.float32)), -1, keepdims=True) + 1e-12).astype(kk.dtype)
    kk = kk.reshape(bsz, n, D_MODEL)
    k_dir = k[None] * (1 + (iclr - 1) * k_a)

    def dirs(t_f, t_b):
        t = jnp.concatenate([t_f, seg_flip(t_b, n_ctx)], axis=0).astype(dt)
        return jnp.moveaxis(t.reshape(t.shape[:2] + (RW_HEADS, RW_HEAD)), 1, 0)
    y = rwkv7_scan(dirs(r, r), dirs(decay[0], decay[1]), dirs(k_dir[0], k_dir[1]),
                   dirs(v, v), dirs(kk, kk), dirs(iclr[0], iclr[1]))
    y = jnp.moveaxis(y, 0, 1)
    y = y[:bsz] + seg_flip(y[bsz:], n_ctx)
    heads = lambda t: t.reshape(t.shape[:2] + (RW_HEADS, RW_HEAD))
    rh, vh = heads(r), heads(v)
    bonus = jnp.sum(rh * heads(k_dir[0] + k_dir[1]) * r_k, -1, keepdims=True) * vh
    if drop_ctx:
        y, bonus, g = y[:, n_ctx:], bonus[:, n_ctx:], g[:, n_ctx:]
    yf = y.astype(jnp.float32)
    mean = jnp.mean(yf, -1, keepdims=True)
    var = jnp.mean(jnp.square(yf - mean), -1, keepdims=True)
    yn = ((yf - mean) * lax.rsqrt(var + RW_GN_EPS)).astype(dt)
    yn = yn.reshape(yn.shape[:2] + (D_MODEL,)) * gn_g + gn_b
    out = (yn + bonus.reshape(yn.shape)) * g
    return out @ w_o


def diff_attention_mixer(h, n_ctx, drop_ctx, layer_idx, rope_cos, rope_sin, w_qkv, lam_vec, sub_g, w_o):
    bsz, n, _ = h.shape
    q, k, v = jnp.split(h @ w_qkv, 3, axis=-1)
    cos, sin = rope_cos[:, None].astype(h.dtype), rope_sin[:, None].astype(h.dtype)
    rope = lambda t: t * cos + rotate_quarters(t) * sin
    q = rope(q.reshape(bsz, n, 2 * DA_HEADS, DA_HEAD)).reshape(bsz, n, DA_HEADS, 2, DA_HEAD)
    k = rope(k.reshape(bsz, n, 2 * DA_HEADS, DA_HEAD)).reshape(bsz, n, DA_HEADS, 2, DA_HEAD)
    v = v.reshape(bsz, n, DA_HEADS, 2 * DA_HEAD)
    lam_init = 0.8 - 0.6 * math.exp(-0.3 * layer_idx)
    lv = lam_vec.astype(jnp.float32)
    lam = jnp.exp(jnp.sum(lv[0] * lv[1])) - jnp.exp(jnp.sum(lv[2] * lv[3])) + lam_init

    def attend(qb, kb, vb):
        s = jnp.einsum('bqhmd,bkhmd->bhmqk', qb, kb).astype(jnp.float32) * (DA_HEAD ** -0.5)
        p = jax.nn.softmax(s, axis=-1)
        p = p[:, :, 0] - lam * p[:, :, 1]
        return jnp.einsum('bhqk,bkhe->bqhe', p.astype(vb.dtype), vb)

    q_lat = q[:, n_ctx:]
    n_blk = q_lat.shape[1] // DA_QBLOCK
    qb = jnp.moveaxis(q_lat.reshape(bsz, n_blk, DA_QBLOCK, DA_HEADS, 2, DA_HEAD), 1, 0)
    o = lax.map(lambda blk: attend(blk, k, v), qb)
    o = jnp.moveaxis(o, 0, 1).reshape(bsz, n - n_ctx, DA_HEADS, 2 * DA_HEAD)
    if not drop_ctx:
        o = jnp.concatenate([attend(q[:, :n_ctx], k[:, :n_ctx], v[:, :n_ctx]), o], axis=1)
    o = rms_norm(o, sub_g, 1e-5) * (1 - lam_init)
    return o.reshape(o.shape[:2] + (D_MODEL,)) @ w_o


def hgrn2_mixer(h, n_ctx, drop_ctx, layer_idx, w_in, lower, norm_g, w_o):
    bsz, n, _ = h.shape
    q, i_in, g_out, f_fwd, f_bwd = jnp.split(h @ w_in, 5, axis=-1)
    lb = jnp.cumsum(jax.nn.softmax(lower.astype(jnp.float32), axis=1), axis=1)
    lb = (lb - lb[:, :1])[:, layer_idx]
    f = lb[:, None, None] + (1.0 - lb[:, None, None]) * jax.nn.sigmoid(jnp.stack([f_fwd, f_bwd]).astype(jnp.float32))
    heads_k = lambda t: t.reshape(t.shape[:-1] + (HG_HEADS, HG_EXPAND))
    heads_v = lambda t: t.reshape(t.shape[:-1] + (HG_HEADS, HG_HEAD_V))
    both = lambda t_f, t_b: jnp.concatenate([t_f, seg_flip(t_b, n_ctx)], axis=0)
    qh, vh, fh = heads_k(jax.nn.silu(q)), heads_v(i_in), heads_k(f)
    o = gla_chunked(both(qh, qh), both(1.0 - fh[0], 1.0 - fh[1]), both(vh, vh),
                    both(jnp.log(fh[0]), jnp.log(fh[1])))
    o = o[:bsz] + seg_flip(o[bsz:], n_ctx)
    gh = heads_v(g_out)
    if drop_ctx:
        o, gh = o[:, n_ctx:], gh[:, n_ctx:]
    o = rms_norm(o, norm_g, 1e-5).astype(h.dtype) * jax.nn.silu(gh)
    return o.reshape(o.shape[:2] + (D_MODEL,)) @ w_o


def rglru_mixer(h, n_ctx, drop_ctx, w_in, conv_w, conv_b, w_gate, b_gate, lam, w_o):
    bsz, n, _ = h.shape
    gate_branch, xb = jnp.split(h @ w_in, 2, axis=-1)
    conv = lambda s: dwconv_centred(s, conv_w, conv_b)
    xb = split_apply(conv, conv, xb, n_ctx)
    gates = jnp.einsum('blni,dgnij->dgblnj', xb.reshape(bsz, n, LR_BLOCKS, LR_BS), w_gate)
    gates = jax.nn.sigmoid(gates.reshape(2, 2, bsz, n, LR_WIDTH) + b_gate[:, :, None, None])
    rec_gate, in_gate = gates[:, 0], gates[:, 1]
    log_a = -LR_C * rec_gate * jax.nn.softplus(-lam)[:, None, None]
    a = jnp.exp(log_a)
    u = jnp.sqrt(-jnp.expm1(2.0 * log_a)) * in_gate * xb[None]
    both = lambda t: jnp.concatenate([t[0], seg_flip(t[1], n_ctx)], axis=0)
    combine = lambda p, q: (p[0] * q[0], q[0] * p[1] + q[1])
    _, hs = lax.associative_scan(combine, (both(a), both(u)), axis=1)
    y = hs[:bsz] + seg_flip(hs[bsz:], n_ctx)
    if drop_ctx:
        y, gate_branch = y[:, n_ctx:], gate_branch[:, n_ctx:]
    return (y * jax.nn.gelu(gate_branch)) @ w_o


def conv_ffn(h, n_ctx, w_up, conv_w, conv_b, w_down):
    conv = lambda s: dwconv_centred(s, conv_w, conv_b)
    u = split_apply(conv, conv, h @ w_up, n_ctx)
    gate, val = jnp.split(u, 2, axis=-1)
    return (jax.nn.silu(gate) * val) @ w_down


def setup_inputs(seed: int = 0) -> dict:
    key = jax.random.key(seed)
    ks = iter(jax.random.split(key, 48))
    f32 = jnp.float32
    D, R, W = D_MODEL, REPEATS, LR_WIDTH

    def nrm(shape, scale):
        return scale * jax.random.normal(next(ks), shape, f32)

    inp = {}
    inp['x'] = nrm((BATCH, SEQ, D), 1.0)
    inp['c'] = nrm((BATCH, D), 1.0)
    inp['ctx'] = nrm((BATCH, CTX_LEN, D), 1.0)
    inp['c_ctx'] = nrm((D,), 1.0)
    inp['ada_w'] = nrm((DEPTH, D, N_MOD * D), 0.5 * D ** -0.5)
    inp['ada_b'] = nrm((DEPTH, N_MOD * D), 0.02)
    inp['ln_g'] = 1.0 + nrm((DEPTH, 2, D), 0.02)
    inp['ln_b'] = nrm((DEPTH, 2, D), 0.02)
    inp['ffn_w_up'] = nrm((DEPTH, D, 2 * D_FF), D ** -0.5)
    inp['ffn_conv_w'] = nrm((DEPTH, FFN_CONV, 2 * D_FF), FFN_CONV ** -0.5)
    inp['ffn_conv_b'] = nrm((DEPTH, 2 * D_FF), 0.02)
    inp['ffn_w_down'] = nrm((DEPTH, D_FF, D), DN_BETA * D_FF ** -0.5)
    inp['rw_mu'] = jax.random.uniform(next(ks), (R, 6, D), f32)
    inp['rw_w_rkv'] = nrm((R, 3, D, D), D ** -0.5)
    inp['rw_w0'] = nrm((R, 2, D), 0.5)
    inp['rw_w1'] = nrm((R, 2, D, RW_DECAY_LORA), D ** -0.5)
    inp['rw_w2'] = nrm((R, 2, RW_DECAY_LORA, D), RW_DECAY_LORA ** -0.5)
    inp['rw_a0'] = nrm((R, 2, D), 0.5)
    inp['rw_a1'] = nrm((R, 2, D, RW_ICLR_LORA), D ** -0.5)
    inp['rw_a2'] = nrm((R, 2, RW_ICLR_LORA, D), RW_ICLR_LORA ** -0.5)
    inp['rw_g1'] = nrm((R, D, RW_GATE_LORA), D ** -0.5)
    inp['rw_g2'] = nrm((R, RW_GATE_LORA, D), RW_GATE_LORA ** -0.5)
    inp['rw_k_k'] = 1.0 + nrm((R, D), 0.1)
    inp['rw_k_a'] = 1.0 + nrm((R, D), 0.1)
    inp['rw_r_k'] = nrm((R, RW_HEADS, RW_HEAD), 0.1)
    inp['rw_gn_g'] = 1.0 + nrm((R, D), 0.02)
    inp['rw_gn_b'] = nrm((R, D), 0.02)
    inp['rw_w_o'] = nrm((R, D, D), DN_BETA * D ** -0.5)
    inp['da_w_qkv'] = nrm((R, D, 3 * D), D ** -0.5)
    inp['da_lambda'] = nrm((R, 4, DA_HEAD), 0.1)
    inp['da_sub_g'] = 1.0 + nrm((R, 2 * DA_HEAD), 0.02)
    inp['da_w_o'] = nrm((R, D, D), DN_BETA * D ** -0.5)
    inp['hg_w_in'] = nrm((R, D, 5 * D), D ** -0.5)
    inp['hg_lower'] = nrm((2, DEPTH, D), 0.1)
    inp['hg_norm_g'] = 1.0 + nrm((R, HG_HEAD_V), 0.02)
    inp['hg_w_o'] = nrm((R, D, D), DN_BETA * D ** -0.5)
    inp['lr_w_in'] = nrm((R, D, 2 * W), D ** -0.5)
    inp['lr_conv_w'] = nrm((R, LR_CONV, W), LR_CONV ** -0.5)
    inp['lr_conv_b'] = nrm((R, W), 0.02)
    inp['lr_w_gate'] = nrm((R, 2, 2, LR_BLOCKS, LR_BS, LR_BS), LR_BS ** -0.5)
    inp['lr_b_gate'] = nrm((R, 2, 2, W), 0.02)
    a_init = jax.random.uniform(next(ks), (R, 2, W), f32, 0.9, 0.999)
    inp['lr_lambda'] = jnp.log(a_init) - jnp.log1p(-a_init)
    inp['lr_w_o'] = nrm((R, W, D), DN_BETA * W ** -0.5)
    return inp


def reference(x, c, ctx, c_ctx, ada_w, ada_b, ln_g, ln_b, ffn_w_up, ffn_conv_w, ffn_conv_b, ffn_w_down,
              rw_mu, rw_w_rkv, rw_w0, rw_w1, rw_w2, rw_a0, rw_a1, rw_a2, rw_g1, rw_g2, rw_k_k, rw_k_a,
              rw_r_k, rw_gn_g, rw_gn_b, rw_w_o, da_w_qkv, da_lambda, da_sub_g, da_w_o,
              hg_w_in, hg_lower, hg_norm_g, hg_w_o, lr_w_in, lr_conv_w, lr_conv_b, lr_w_gate, lr_b_gate,
              lr_lambda, lr_w_o):
    n_ctx = ctx.shape[1]
    rope_cos, rope_sin = prefix_axial_rope(n_ctx, x.shape[1])
    z = jnp.concatenate([ctx, x], axis=1)
    silu_c = jax.nn.silu(c)
    silu_cc = jax.nn.silu(c_ctx)[None]
    for i in range(DEPTH):
        rep, kind, last = i // N_MIXERS, i % N_MIXERS, i == DEPTH - 1
        m_lat = (silu_c @ ada_w[i] + ada_b[i]).reshape(-1, N_MOD, D_MODEL)
        m_ctx = (silu_cc @ ada_w[i] + ada_b[i]).reshape(1, N_MOD, D_MODEL)
        h = ada_modulate(z, n_ctx, m_ctx, m_lat, 0)
        if kind == 0:
            y = rwkv7_mixer(h, n_ctx, last, rw_mu[rep], rw_w_rkv[rep], rw_w0[rep], rw_w1[rep], rw_w2[rep],
                            rw_a0[rep], rw_a1[rep], rw_a2[rep], rw_g1[rep], rw_g2[rep], rw_k_k[rep],
                            rw_k_a[rep], rw_r_k[rep], rw_gn_g[rep], rw_gn_b[rep], rw_w_o[rep])
        elif kind == 1:
            y = diff_attention_mixer(h, n_ctx, last, i, rope_cos, rope_sin, da_w_qkv[rep], da_lambda[rep],
                                     da_sub_g[rep], da_w_o[rep])
        elif kind == 2:
            y = hgrn2_mixer(h, n_ctx, last, i, hg_w_in[rep], hg_lower, hg_norm_g[rep], hg_w_o[rep])
        else:
            y = rglru_mixer(h, n_ctx, last, lr_w_in[rep], lr_conv_w[rep], lr_conv_b[rep], lr_w_gate[rep],
                            lr_b_gate[rep], lr_lambda[rep], lr_w_o[rep])
        if last:
            z, n_ctx = z[:, n_ctx:], 0
        z = layer_norm(DN_ALPHA * z + ada_gate(y, n_ctx, m_ctx, m_lat, 2), ln_g[i, 0], ln_b[i, 0])
        h = ada_modulate(z, n_ctx, m_ctx, m_lat, 3)
        y = conv_ffn(h, n_ctx, ffn_w_up[i], ffn_conv_w[i], ffn_conv_b[i], ffn_w_down[i])
        z = layer_norm(DN_ALPHA * z + ada_gate(y, n_ctx, m_ctx, m_lat, 5), ln_g[i, 1], ln_b[i, 1])
    return z[:, n_ctx:]
```

```cpp
#include <hip/hip_runtime.h>
#include <cstdio>
#include <cstdint>

namespace pg8 {
#define PG8_LAS __attribute__((address_space(3)))
typedef unsigned short bf16_t;
typedef short bf16x8 __attribute__((ext_vector_type(8)));
typedef float f32x4 __attribute__((ext_vector_type(4)));
typedef float f32x2 __attribute__((ext_vector_type(2)));
typedef unsigned u32x4 __attribute__((ext_vector_type(4)));
typedef unsigned u32x2 __attribute__((ext_vector_type(2)));
constexpr int BM = 256, BK = 64, HALF = 128, HTB = HALF * BK * 2  , STAGE_BYTES = 8 * HTB, NXCD = 8, WGM = 8;

__host__ __device__ __forceinline__ int lds_byte(int r, int c) { const int st = (r >> 4) * 2 + (c >> 5), rr = r & 15, cc = c & 31, ob = rr * 64 + cc * 2; return st * 1024 + (ob ^ (((ob >> 9) & 1) << 5)); }
__host__ __device__ __forceinline__ void stage_rc(int b, int& R, int& C) { const int st = b / 1024, sb = b % 1024, swz = sb ^ (((sb >> 9) & 1) << 5); R = (st >> 1) * 16 + swz / 64; C = (st & 1) * 32 + (swz % 64) / 2; }
__host__ __device__ __forceinline__ int perm32(int rho) { const int n = rho >> 4, i = rho & 15; return 8 * (i >> 2) + 4 * n + (i & 3); }

struct Unit { int pm, pn; unsigned aoff, boff; int half; };
struct Gemm { const bf16_t* A; const bf16_t* Bt; int lda, ldb, K; };

template <int nM, int nN> struct TileOrder {
    static constexpr int nwg = nM * nN;
    int G, c;
    __device__ void init(int G_, int c_) { G = G_; c = c_; }
    __device__ __forceinline__ bool tile(int i, int& pm, int& pn) const { return tileL(i * G + c, pm, pn); }
    static __device__ __forceinline__ bool tileL(int L, int& pm, int& pn) {
        if (L >= nwg) return false;
        int wgid = L; { constexpr int q = nwg / NXCD, r = nwg % NXCD; const int xcd = wgid % NXCD, off = wgid / NXCD; wgid = (xcd < r ? xcd * (q + 1) : r * (q + 1) + (xcd - r) * q) + off; }
        constexpr int nig = WGM * nN; const int gid = wgid / nig, fm = gid * WGM, gsz = (nM - fm) < WGM ? (nM - fm) : WGM;
        pm = fm + ((wgid % nig) % gsz); pn = (wgid % nig) / gsz; return true;
    }
};

typedef __bf16 bf16x2_hw __attribute__((ext_vector_type(2)));
__device__ __forceinline__ unsigned cvt_pk_bf16(float lo, float hi) { const f32x2 v = {lo, hi}; const bf16x2_hw b = __builtin_convertvector(v, bf16x2_hw); return __builtin_bit_cast(unsigned, b); }

template <class Epi, class Sched, int LDA, int LDB, int KK, bool ALIGN_EPI = false, bool SP2 = false, int HM = 0>
__device__ __forceinline__ void gemm_phase(PG8_LAS unsigned char* lds, const bf16_t* gA, const bf16_t* gBt, const Sched& S, const Epi& E) {
    int tid_ = threadIdx.x; asm volatile("" : "+v"(tid_));
    const int tid = tid_, wid = __builtin_amdgcn_readfirstlane(tid >> 6), lane = tid & 63, wr = wid >> 2, wc = wid & 3, fr = lane & 15, fq = lane >> 4;
    constexpr int nt = KK / BK;
    unsigned voffA[2], voffB[2];
#pragma unroll
    for (int i = 0; i < 2; ++i) { int R, C; stage_rc(tid * 16 + i * 8192, R, C); const int Rb = Epi::PERM ? ((R & ~31) + perm32(R & 31)) : R;
        const int Ra = Epi::PERMA ? ((R & ~63) + 4 * (R & 15) + ((R & 63) >> 4)) : R;
        voffA[i] = (unsigned)(Ra * LDA + C) * 2u; voffB[i] = (unsigned)(Rb * LDB + C) * 2u; }
    constexpr size_t kstep = (size_t)(BK * 2);
    constexpr size_t hstepA = (size_t)HALF * LDA * 2, hstepB = (size_t)HALF * LDB * 2;
    const unsigned ldsw = (unsigned)wid * 1024u;
    const int aoff = lds_byte(wr * 64 + fr, fq * 8), boff = lds_byte(wc * 32 + fr, fq * 8);
#define PG8_SA(b, h) (((b) * 2 + (h)) * HTB)
#define PG8_SB(b, h) ((4 + (b) * 2 + (h)) * HTB)
#define PG8_STAGE(bufoff, gbase, voff) do { _Pragma("unroll") for (int _i = 0; _i < 2; ++_i) \
        __builtin_amdgcn_global_load_lds((const unsigned*)((const char*)(gbase) + (voff)[_i]), (PG8_LAS unsigned*)(lds + (bufoff) + ldsw + _i * 8192), 16, 0, 0); } while (0)
#define PG8_LDA(dst, b, h) do { _Pragma("unroll") for (int m = 0; m < 4; ++m) _Pragma("unroll") for (int k = 0; k < 2; ++k) dst[m][k] = *(const PG8_LAS bf16x8*)(lds + PG8_SA(b, h) + aoff + m * 2048 + k * 1024); } while (0)
#define PG8_LDB(dst, b, h) do { _Pragma("unroll") for (int n = 0; n < 2; ++n) _Pragma("unroll") for (int k = 0; k < 2; ++k) dst[n][k] = *(const PG8_LAS bf16x8*)(lds + PG8_SB(b, h) + boff + n * 2048 + k * 1024); } while (0)
#define PG8_MMA(ai, bj, At, Bt) do { __builtin_amdgcn_s_setprio(1); _Pragma("unroll") for (int m = 0; m < 4; ++m) _Pragma("unroll") for (int n = 0; n < 2; ++n) _Pragma("unroll") for (int k = 0; k < 2; ++k) \
        acc[ai][bj][m][n] = __builtin_amdgcn_mfma_f32_16x16x32_bf16(Bt[n][k], At[m][k], acc[ai][bj][m][n], 0, 0, 0); __builtin_amdgcn_s_setprio(0); } while (0)
#define PG8_WAIT_V(n) asm volatile("s_waitcnt vmcnt(" #n ")" ::: "memory")
#define PG8_WAIT_L(n) asm volatile("s_waitcnt lgkmcnt(" #n ")" ::: "memory")
#define PG8_BAR __builtin_amdgcn_s_barrier()
#define PG8_SCHED __builtin_amdgcn_sched_barrier(0)
    Unit cur, nxt; int ui = 0;
    if (!S.next(0, cur)) return;
    f32x4 acc[2][2][4][2];
#pragma unroll
    for (int a = 0; a < 2; ++a)
#pragma unroll
        for (int b = 0; b < 2; ++b)
#pragma unroll
            for (int m = 0; m < 4; ++m)
#pragma unroll
                for (int n = 0; n < 2; ++n) acc[a][b][m][n] = (f32x4){0.f, 0.f, 0.f, 0.f};
    bf16x8 At[4][2], B0[2][2], B1[2][2];
    const char* cA = (const char*)gA + cur.aoff; const char* cB = (const char*)gBt + cur.boff;
    if (HM == 1 || (HM == 2 && cur.half >= 0)) {
        PG8_STAGE(PG8_SB(0, 0), cB, voffB); PG8_STAGE(PG8_SB(0, 1), cB + hstepB, voffB); PG8_STAGE(PG8_SA(0, 0), cA, voffA);
        if (wr == 1) PG8_BAR;
        PG8_WAIT_V(0); PG8_BAR;
        PG8_STAGE(PG8_SB(1, 0), cB + kstep, voffB); PG8_STAGE(PG8_SA(1, 0), cA + kstep, voffA); PG8_STAGE(PG8_SB(1, 1), cB + hstepB + kstep, voffB);
        PG8_WAIT_V(6); PG8_BAR;
    } else if constexpr (SP2) {
        PG8_STAGE(PG8_SB(0, 0), cB, voffB); PG8_STAGE(PG8_SB(0, 1), cB + hstepB, voffB); PG8_STAGE(PG8_SA(0, 0), cA, voffA); PG8_STAGE(PG8_SA(0, 1), cA + hstepA, voffA);
        if (wr == 1) PG8_BAR;
        PG8_WAIT_V(2); PG8_BAR;
        PG8_STAGE(PG8_SB(1, 0), cB + kstep, voffB); PG8_STAGE(PG8_SA(1, 0), cA + kstep, voffA); PG8_STAGE(PG8_SB(1, 1), cB + hstepB + kstep, voffB);
        PG8_WAIT_V(6); PG8_BAR;
    } else {
        PG8_STAGE(PG8_SB(0, 0), cB, voffB); PG8_STAGE(PG8_SA(0, 0), cA, voffA); PG8_STAGE(PG8_SB(0, 1), cB + hstepB, voffB); PG8_STAGE(PG8_SA(0, 1), cA + hstepA, voffA);
        if (wr == 1) PG8_BAR;
        PG8_WAIT_V(4); PG8_BAR;
        PG8_STAGE(PG8_SB(1, 0), cB + kstep, voffB); PG8_STAGE(PG8_SA(1, 0), cA + kstep, voffA); PG8_STAGE(PG8_SB(1, 1), cB + hstepB + kstep, voffB);
        PG8_WAIT_V(6); PG8_BAR;
    }
    for (;;) {
        const bool has_next = S.next(ui + 1, nxt);
        const char* nA = has_next ? (const char*)gA + nxt.aoff : cA; const char* nB = has_next ? (const char*)gBt + nxt.boff : cB;
#define PG8_KT_ADDR const bool last = (t == nt - 2); const char* a1 = cA + (size_t)(t + 1) * kstep; \
            const char* a2 = last ? nA : cA + (size_t)(t + 2) * kstep; const char* b2 = last ? nB : cB + (size_t)(t + 2) * kstep; const char* a3 = a2 + kstep; const char* b3 = b2 + kstep;
        if (HM == 1 || (HM == 2 && cur.half >= 0)) {
#pragma unroll 1
          for (int t = 0; t < nt; t += 2) { PG8_KT_ADDR
            PG8_LDB(B0, 0, 0); PG8_LDB(B1, 0, 1); PG8_SCHED; PG8_LDA(At, 0, 0);
            PG8_WAIT_V(6); PG8_WAIT_L(0); PG8_BAR; PG8_MMA(0, 0, At, B0); PG8_MMA(0, 1, At, B1); PG8_BAR; PG8_SCHED;
            PG8_STAGE(PG8_SB(0, 0), b2, voffB); PG8_STAGE(PG8_SB(0, 1), b2 + hstepB, voffB); PG8_STAGE(PG8_SA(0, 0), a2, voffA);
            PG8_WAIT_V(6); PG8_BAR; PG8_BAR; PG8_SCHED;
            PG8_LDB(B0, 1, 0); PG8_LDB(B1, 1, 1); PG8_SCHED; PG8_LDA(At, 1, 0);
            PG8_WAIT_V(6); PG8_WAIT_L(0); PG8_BAR; PG8_MMA(0, 0, At, B0); PG8_MMA(0, 1, At, B1); PG8_BAR; PG8_SCHED;
            PG8_STAGE(PG8_SB(1, 0), b3, voffB); PG8_STAGE(PG8_SB(1, 1), b3 + hstepB, voffB); PG8_STAGE(PG8_SA(1, 0), a3, voffA);
            PG8_WAIT_V(6); PG8_BAR; PG8_BAR; PG8_SCHED;
            (void)a1;
          }
        } else {
#pragma unroll 1
          for (int t = 0; t < nt; t += 2) { PG8_KT_ADDR
            if constexpr (SP2) {
            PG8_LDB(B0, 0, 0); PG8_LDB(B1, 0, 1); PG8_SCHED; PG8_LDA(At, 0, 0); PG8_STAGE(PG8_SA(1, 1), a1 + hstepA, voffA);
            PG8_WAIT_V(8); PG8_WAIT_L(0); PG8_BAR; PG8_MMA(0, 0, At, B0); PG8_MMA(0, 1, At, B1); PG8_BAR; PG8_SCHED;
            PG8_LDA(At, 0, 1); PG8_STAGE(PG8_SB(0, 0), b2, voffB); PG8_STAGE(PG8_SB(0, 1), b2 + hstepB, voffB); PG8_STAGE(PG8_SA(0, 0), a2, voffA);
            PG8_WAIT_V(8); PG8_WAIT_L(0); PG8_BAR; PG8_MMA(1, 0, At, B0); PG8_MMA(1, 1, At, B1); PG8_BAR; PG8_SCHED;
            PG8_LDB(B0, 1, 0); PG8_LDB(B1, 1, 1); PG8_SCHED; PG8_LDA(At, 1, 0); PG8_STAGE(PG8_SA(0, 1), a2 + hstepA, voffA);
            PG8_WAIT_V(8); PG8_WAIT_L(0); PG8_BAR; PG8_MMA(0, 0, At, B0); PG8_MMA(0, 1, At, B1); PG8_BAR; PG8_SCHED;
            PG8_LDA(At, 1, 1); PG8_STAGE(PG8_SB(1, 0), b3, voffB); PG8_STAGE(PG8_SB(1, 1), b3 + hstepB, voffB); PG8_STAGE(PG8_SA(1, 0), a3, voffA);
            PG8_WAIT_V(8); PG8_WAIT_L(0); PG8_BAR; PG8_MMA(1, 0, At, B0); PG8_MMA(1, 1, At, B1); PG8_BAR; PG8_SCHED;
            } else {
            PG8_LDB(B0, 0, 0); PG8_SCHED; PG8_LDA(At, 0, 0); PG8_STAGE(PG8_SA(1, 1), a1 + hstepA, voffA);
            PG8_WAIT_L(8); PG8_BAR; PG8_WAIT_L(0); PG8_MMA(0, 0, At, B0); PG8_BAR; PG8_SCHED;
            PG8_LDB(B1, 0, 1); PG8_STAGE(PG8_SB(0, 0), b2, voffB);
            PG8_BAR; PG8_WAIT_L(0); PG8_MMA(0, 1, At, B1); PG8_BAR;
            PG8_LDA(At, 0, 1); PG8_STAGE(PG8_SA(0, 0), a2, voffA);
            PG8_BAR; PG8_WAIT_L(0); PG8_MMA(1, 0, At, B0); PG8_BAR; PG8_SCHED;
            PG8_STAGE(PG8_SB(0, 1), b2 + hstepB, voffB);
            PG8_WAIT_V(6); PG8_BAR; PG8_MMA(1, 1, At, B1); PG8_BAR;
            PG8_LDB(B0, 1, 0); PG8_SCHED; PG8_LDA(At, 1, 0); PG8_STAGE(PG8_SA(0, 1), a2 + hstepA, voffA);
            PG8_WAIT_L(8); PG8_BAR; PG8_WAIT_L(0); PG8_MMA(0, 0, At, B0); PG8_BAR; PG8_SCHED;
            PG8_LDB(B1, 1, 1); PG8_STAGE(PG8_SB(1, 0), b3, voffB);
            PG8_BAR; PG8_WAIT_L(0); PG8_MMA(0, 1, At, B1); PG8_BAR;
            PG8_LDA(At, 1, 1); PG8_STAGE(PG8_SA(1, 0), a3, voffA);
            PG8_BAR; PG8_WAIT_L(0); PG8_MMA(1, 0, At, B0); PG8_BAR; PG8_SCHED;
            PG8_STAGE(PG8_SB(1, 1), b3 + hstepB, voffB);
            PG8_WAIT_V(6); PG8_BAR; PG8_MMA(1, 1, At, B1); PG8_BAR;
            }
          }
        }
#undef PG8_KT_ADDR
        if constexpr (ALIGN_EPI) { if (wr == 0) PG8_BAR; }
        E(acc, cur, wr, wc, fr, fq);
        if (!has_next) break;
#pragma unroll
        for (int a = 0; a < 2; ++a)
#pragma unroll
            for (int b = 0; b < 2; ++b)
#pragma unroll
                for (int m = 0; m < 4; ++m)
#pragma unroll
                    for (int n = 0; n < 2; ++n) acc[a][b][m][n] = (f32x4){0.f, 0.f, 0.f, 0.f};
        cur = nxt; cA = nA; cB = nB; ++ui;
        if constexpr (ALIGN_EPI) { if (wr == 1) PG8_BAR; }
    }
    PG8_WAIT_V(0);
    if constexpr (!ALIGN_EPI) { if (wr == 0) PG8_BAR; }
    PG8_BAR;
#undef PG8_SA
#undef PG8_SB
#undef PG8_STAGE
#undef PG8_LDA
#undef PG8_LDB
#undef PG8_MMA
#undef PG8_WAIT_V
#undef PG8_WAIT_L
#undef PG8_BAR
#undef PG8_SCHED
}
}
#include <hip/hip_bf16.h>
#include <cmath>
namespace att {
using bf16 = __hip_bfloat16;
constexpr int   D = 128, NW = 8, QBLK = 32, KVBLK = 64;
constexpr float SCALE = 0.088388347648318440f;
constexpr float THR = 8.f;
constexpr int SDEPTH = 2;
constexpr int LDQ = 6144, LDK = 6144, LDO = 4096;
constexpr size_t SHM_V = KVBLK * D * 2, SHM_K = KVBLK * D * 2, SHM_ATTN = 2 * SHM_V + 2 * SHM_K + NW * 64 * 4;
using bf16x8 = __attribute__((ext_vector_type(8))) short;
using s16x4  = __attribute__((ext_vector_type(4))) short;
using f32x16 = __attribute__((ext_vector_type(16))) float;
using f32x8  = __attribute__((ext_vector_type(8))) float;
using u32x4  = __attribute__((ext_vector_type(4))) unsigned;
#define KSWZ(row, colB) ((row) * 256 + ((colB) ^ (((row) & 7) << 4)))
#define SBAR() __builtin_amdgcn_sched_barrier(0)
__device__ __forceinline__ int crow(int r, int hi) { return (r & 3) + 8 * (r >> 2) + 4 * hi; }
__device__ __forceinline__ unsigned cvtpk(float lo, float hi) {
  unsigned r; asm volatile("v_cvt_pk_bf16_f32 %0, %1, %2" : "=v"(r) : "v"(lo), "v"(hi)); return r;
}
template <typename TIn> struct Stage;
template <> struct Stage<bf16>  { using T = bf16x8;
  __device__ static __forceinline__ T ld8(const bf16* p) { return *reinterpret_cast<const bf16x8*>(p); }
  __device__ static __forceinline__ bf16x8 tobf(T x) { return x; } };
template <> struct Stage<float> { using T = f32x8;
  __device__ static __forceinline__ T ld8(const float* p) { return *reinterpret_cast<const f32x8*>(p); }
  __device__ static __forceinline__ bf16x8 tobf(T x) {
    u32x4 w = {cvtpk(x[0], x[1]), cvtpk(x[2], x[3]), cvtpk(x[4], x[5]), cvtpk(x[6], x[7])}; return *reinterpret_cast<bf16x8*>(&w); } };

__device__ __forceinline__ void partialSM(f32x16& p0, f32x16& p1, float& m_reg, float& mn, float& alpha) {
  constexpr float C = SCALE * 1.4426950408889634f;
  float pmax = p0[0]; for (int r = 1; r < 16; ++r) pmax = fmaxf(pmax, p0[r]); for (int r = 0; r < 16; ++r) pmax = fmaxf(pmax, p1[r]);
  { auto rr = __builtin_amdgcn_permlane32_swap(__float_as_uint(pmax), __float_as_uint(pmax), false, false);
    pmax = fmaxf(__uint_as_float(rr[0]), __uint_as_float(rr[1])); }
  if (__builtin_expect(__all(pmax - m_reg <= THR / SCALE), 1)) { mn = m_reg; alpha = 1.f; }
  else { mn = fmaxf(m_reg, pmax); alpha = __builtin_amdgcn_exp2f((m_reg - mn) * C); m_reg = mn; }
  float mnC = -mn * C;
  for (int r = 0; r < 16; ++r) p0[r] = fmaf(p0[r], C, mnC); for (int r = 0; r < 16; ++r) p1[r] = fmaf(p1[r], C, mnC);
  for (int r = 0; r < 16; ++r) p0[r] = __builtin_amdgcn_exp2f(p0[r]);
}
__device__ __forceinline__ void finishSM(f32x16& p0, f32x16& p1, float alpha, float& l_reg, bf16x8& pa0, bf16x8& pa1, bf16x8& pa2, bf16x8& pa3) {
  for (int r = 0; r < 16; ++r) p1[r] = __builtin_amdgcn_exp2f(p1[r]);
  float ps = 0; for (int r = 0; r < 16; ++r) ps += p0[r]; for (int r = 0; r < 16; ++r) ps += p1[r];
  { auto rr = __builtin_amdgcn_permlane32_swap(__float_as_uint(ps), __float_as_uint(ps), false, false);
    ps = __uint_as_float(rr[0]) + __uint_as_float(rr[1]); }
  l_reg = l_reg * alpha + ps;
#define PK4(P, BASE, OUT) do { unsigned a0 = cvtpk(P[BASE + 0], P[BASE + 1]), a1 = cvtpk(P[BASE + 2], P[BASE + 3]);   \
    unsigned b0 = cvtpk(P[BASE + 4], P[BASE + 5]), b1 = cvtpk(P[BASE + 6], P[BASE + 7]);                              \
    auto r0 = __builtin_amdgcn_permlane32_swap(a0, b0, false, false); auto r1 = __builtin_amdgcn_permlane32_swap(a1, b1, false, false); \
    u32x4 w = {r0[0], r1[0], r0[1], r1[1]}; OUT = *reinterpret_cast<bf16x8*>(&w); } while (0)
  PK4(p0, 0, pa0); PK4(p0, 8, pa1); PK4(p1, 0, pa2); PK4(p1, 8, pa3);
#undef PK4
}
__device__ __forceinline__ void qkt(f32x16& p0, f32x16& p1, const bf16* Ks, const bf16x8* qr, int r32, int hi) {
  p0 = f32x16{}; p1 = f32x16{};
  for (int d0 = 0; d0 < 8; ++d0) { int cb = (d0 * 16 + hi * 8) * 2;
    bf16x8 b0 = *reinterpret_cast<const bf16x8*>((const char*)Ks + KSWZ(r32, cb));
    bf16x8 b1 = *reinterpret_cast<const bf16x8*>((const char*)Ks + KSWZ(32 + r32, cb));
    p0 = __builtin_amdgcn_mfma_f32_32x32x16_bf16(b0, qr[d0], p0, 0, 0, 0);
    p1 = __builtin_amdgcn_mfma_f32_32x32x16_bf16(b1, qr[d0], p1, 0, 0, 0); }
}
__device__ __forceinline__ int v_st(int k, int c) { const int kk = (k & ~0xC) | ((k & 4) << 1) | ((k & 8) >> 1); return ((kk >> 3) * 4 + (c >> 5)) * 512 + ((kk & 7) * 32 + (c & 31)) * 2; }
__device__ __forceinline__ int v_rd_base(int lane) { return ((lane & 3) << 3) | (((lane >> 2) & 3) << 6) | (((lane >> 4) & 1) << 5) | (((lane >> 5) & 1) << 8); }
constexpr int v_rd_off(int d0, int ks, int half) { return d0 * 512 + ks * 4096 + half * 2048; }
template <int OFF> __device__ __forceinline__ s16x4 tr_read(int vb) {
  s16x4 r; asm volatile("ds_read_b64_tr_b16 %0, %1 offset:%2" : "=&v"(r) : "v"(vb), "i"(OFF) : "memory"); return r;
}
template <int D0> __device__ __forceinline__ void pv_one(f32x16& od, int vb, bf16x8 pa0, bf16x8 pa1, bf16x8 pa2, bf16x8 pa3) {
  const s16x4 l0 = tr_read<v_rd_off(D0, 0, 0)>(vb), h0 = tr_read<v_rd_off(D0, 0, 1)>(vb), l1 = tr_read<v_rd_off(D0, 1, 0)>(vb), h1 = tr_read<v_rd_off(D0, 1, 1)>(vb);
  const s16x4 l2 = tr_read<v_rd_off(D0, 2, 0)>(vb), h2 = tr_read<v_rd_off(D0, 2, 1)>(vb), l3 = tr_read<v_rd_off(D0, 3, 0)>(vb), h3 = tr_read<v_rd_off(D0, 3, 1)>(vb);
  asm volatile("s_waitcnt lgkmcnt(0)" ::: "memory"); SBAR();
#define PK(L, H) (bf16x8){L[0], L[1], L[2], L[3], H[0], H[1], H[2], H[3]}
  od = __builtin_amdgcn_mfma_f32_32x32x16_bf16(pa0, PK(l0, h0), od, 0, 0, 0);
  od = __builtin_amdgcn_mfma_f32_32x32x16_bf16(pa1, PK(l1, h1), od, 0, 0, 0);
  od = __builtin_amdgcn_mfma_f32_32x32x16_bf16(pa2, PK(l2, h2), od, 0, 0, 0);
  od = __builtin_amdgcn_mfma_f32_32x32x16_bf16(pa3, PK(l3, h3), od, 0, 0, 0);
#undef PK
}
__device__ __forceinline__ void pv_d0(f32x16* o, int vb, bf16x8 pa0, bf16x8 pa1, bf16x8 pa2, bf16x8 pa3) {
  pv_one<0>(o[0], vb, pa0, pa1, pa2, pa3); pv_one<1>(o[1], vb, pa0, pa1, pa2, pa3); pv_one<2>(o[2], vb, pa0, pa1, pa2, pa3); pv_one<3>(o[3], vb, pa0, pa1, pa2, pa3);
}

template <typename TQ>
__device__ __forceinline__ void attn_dense_body(const TQ* __restrict__ Qb, const bf16* __restrict__ Kh, const bf16* __restrict__ Vh,
                                                unsigned short* __restrict__ Ob, int seq, char* lds) {
  using St = Stage<bf16>; using SQ = Stage<TQ>;
  int tid_ = threadIdx.x; asm volatile("" : "+v"(tid_)); const int tid = tid_, wid = tid >> 6, lane = tid & 63, r32 = lane & 31, hi = lane >> 5;
  bf16* V_lds = (bf16*)lds; bf16* K_lds = (bf16*)(lds + 2 * SHM_V);
  float* ws = (float*)(lds + 2 * SHM_V + 2 * SHM_K) + wid * 64; float* li_l = ws; float* al_l = ws + 32;
  float m_reg = -1e30f, l_reg = 0; f32x16 o[4] = {}; bf16x8 qr[8];
  const TQ* Qw = Qb + (long)(wid * QBLK + r32) * LDQ + hi * 8;
#pragma unroll
  for (int d0 = 0; d0 < 8; ++d0) qr[d0] = SQ::tobf(SQ::ld8(Qw + d0 * 16));
  const int sr = tid >> 4, sc = (tid & 15) * 8, vst0 = v_st(sr, sc), vst1 = v_st(32 + sr, sc);
  const int vb0 = (int)(uintptr_t)V_lds + v_rd_base(lane);
  struct { typename St::T vs0, vs1, ks0, ks1; } sr_[SDEPTH];
#define SLOAD(i, k0) do { sr_[i].vs0 = St::ld8(&Vh[(long)((k0) + sr) * LDK + sc]); sr_[i].vs1 = St::ld8(&Vh[(long)((k0) + 32 + sr) * LDK + sc]); \
    sr_[i].ks0 = St::ld8(&Kh[(long)((k0) + sr) * LDK + sc]); sr_[i].ks1 = St::ld8(&Kh[(long)((k0) + 32 + sr) * LDK + sc]); } while (0)
#define SWRITE(b, i) do { *(bf16x8*)((char*)V_lds + (b) * SHM_V + vst0) = St::tobf(sr_[i].vs0);          \
    *(bf16x8*)((char*)V_lds + (b) * SHM_V + vst1) = St::tobf(sr_[i].vs1); int kc = sc * 2;               \
    *(bf16x8*)((char*)K_lds + (b) * SHM_K + KSWZ(sr, kc)) = St::tobf(sr_[i].ks0);                       \
    *(bf16x8*)((char*)K_lds + (b) * SHM_K + KSWZ(32 + sr, kc)) = St::tobf(sr_[i].ks1); } while (0)
#define SWAIT() do { if constexpr (SDEPTH == 2) asm volatile("s_waitcnt vmcnt(4)" ::: "memory"); else asm volatile("s_waitcnt vmcnt(0)" ::: "memory"); } while (0)
#define RESC(a) do { if (__any((a) < 1.f)) { if (hi == 0) al_l[r32] = (a); asm volatile("s_waitcnt lgkmcnt(0)" ::: "memory"); \
    for (int d = 0; d < 4; ++d) for (int r = 0; r < 16; ++r) o[d][r] *= al_l[crow(r, hi)]; } } while (0)
  f32x16 pA0, pA1, pB0, pB1; float mnA, mnB, alA, alB; bf16x8 pa0, pa1, pa2, pa3; const int NT = seq / KVBLK;
  constexpr int SE = 0, SO = SDEPTH - 1;
  SLOAD(SE, 0); asm volatile("s_waitcnt vmcnt(0)" ::: "memory"); SWRITE(0, SE); __syncthreads();
  qkt(pA0, pA1, K_lds, qr, r32, hi); partialSM(pA0, pA1, m_reg, mnA, alA);
  SLOAD(SO, KVBLK); if constexpr (SDEPTH == 2) { if (2 < NT) SLOAD(SE, 2 * KVBLK); }
  SWAIT(); SWRITE(1, SO); __syncthreads();
  for (int j = 1; j + 1 < NT; j += 2) {
    SBAR(); qkt(pB0, pB1, (bf16*)((char*)K_lds + SHM_K), qr, r32, hi);
    finishSM(pA0, pA1, alA, l_reg, pa0, pa1, pa2, pa3); SBAR();
    SLOAD(SO, (j + SDEPTH) * KVBLK); SBAR();
    pv_d0(o, vb0, pa0, pa1, pa2, pa3); partialSM(pB0, pB1, m_reg, mnB, alB);
    __syncthreads(); SWAIT(); SWRITE(0, SE);
    RESC(alB); __syncthreads();
    SBAR(); qkt(pA0, pA1, K_lds, qr, r32, hi);
    finishSM(pB0, pB1, alB, l_reg, pa0, pa1, pa2, pa3); SBAR();
    if (SDEPTH == 1 || j + 3 < NT) SLOAD(SE, (j + 1 + SDEPTH) * KVBLK); SBAR();
    pv_d0(o, vb0 + (int)SHM_V, pa0, pa1, pa2, pa3); partialSM(pA0, pA1, m_reg, mnA, alA);
    __syncthreads(); SWAIT(); SWRITE(1, SO);
    RESC(alA); __syncthreads();
  }
  SBAR(); qkt(pB0, pB1, (bf16*)((char*)K_lds + SHM_K), qr, r32, hi);
  finishSM(pA0, pA1, alA, l_reg, pa0, pa1, pa2, pa3); SBAR();
  pv_d0(o, vb0, pa0, pa1, pa2, pa3); partialSM(pB0, pB1, m_reg, mnB, alB);
  __syncthreads(); RESC(alB);
  finishSM(pB0, pB1, alB, l_reg, pa0, pa1, pa2, pa3); SBAR();
  pv_d0(o, vb0 + (int)SHM_V, pa0, pa1, pa2, pa3);
  if (hi == 0) li_l[r32] = l_reg; asm volatile("s_waitcnt lgkmcnt(0)" ::: "memory");
  float rli[16];
#pragma unroll
  for (int r = 0; r < 16; ++r) rli[r] = __builtin_amdgcn_rcpf(li_l[crow(r, hi)]);
  unsigned short* Ow = Ob + (long)(wid * QBLK) * LDO;
#pragma unroll
  for (int r = 0; r < 16; ++r) { int orow = crow(r, hi);
    for (int d0 = 0; d0 < 4; ++d0) Ow[(long)orow * LDO + d0 * 32 + r32] = (unsigned short)(pg8::cvt_pk_bf16(o[d0][r] * rli[r], 0.f) & 0xffffu); }
#undef SLOAD
#undef SWRITE
#undef SWAIT
#undef RESC
}
}
constexpr int DM = 2048, NB = 4, SEQ = 2048, NCTX = 256, LTOK = 2304, NTOK = NB * LTOK  , NLAT = NB * SEQ  ;
constexpr int DFF = 5632, DFF2 = 2 * DFF;
constexpr int NLAYER = 4, NMOD = 6;
constexpr float DN_ALPHA = 1.6817928305074290f;
constexpr float LN_EPS = 1e-5f;
constexpr int NWAVES = 8;
#ifndef MK_N_LAUNCHES
#define MK_N_LAUNCHES 1
#endif

constexpr size_t MiB = 1u << 20;
constexpr size_t al256(size_t x) { return (x + 255) / 256 * 256; }
constexpr size_t WS_CTL = 0;
constexpr size_t WS_MOD = 1 * MiB;
constexpr size_t ZERO_BYTES = 2 * MiB;
constexpr size_t WS_ROPE = 2 * MiB;
constexpr size_t WS_LB = WS_ROPE + al256((size_t)LTOK * 64 * 2 * 4);
constexpr size_t WS_STAT = WS_LB + 64 * 1024;
constexpr size_t WS_ZS = WS_STAT + 80 * 1024;
constexpr size_t WS_W0 = 4 * MiB;
static_assert(WS_ZS + (size_t)NTOK * 4 <= WS_W0, "small tables fit below the weight copies");
constexpr size_t WS_WA = WS_W0;
constexpr size_t WS_WL2 = WS_WA + (size_t)6912 * 2048 * 2;
constexpr size_t WS_WO = WS_WL2 + (size_t)10240 * 256 * 2;
constexpr size_t WS_WQKV = WS_WO + (size_t)4 * 2048 * 2048 * 2;
constexpr size_t WS_WHG = WS_WQKV + (size_t)6144 * 2048 * 2;
constexpr size_t WS_WLR = WS_WHG + (size_t)10240 * 2048 * 2;
constexpr size_t WS_WGATE = WS_WLR + (size_t)4096 * 2048 * 2;
constexpr size_t WS_WUP = WS_WGATE + (size_t)32 * 256 * 256 * 2;
constexpr size_t WS_WDN = WS_WUP + (size_t)4 * DFF2 * 2048 * 2;
constexpr size_t WS_WEND = WS_WDN + (size_t)4 * 2048 * DFF * 2;
constexpr size_t WS_Z = al256(WS_WEND);
constexpr size_t WS_PRE = WS_Z + (size_t)NTOK * DM * 4;
constexpr size_t WS_H = WS_PRE + (size_t)NTOK * DM * 4;
constexpr size_t WS_OUTB = WS_H + (size_t)NTOK * DM * 2;
constexpr size_t WS_POOL = WS_OUTB + (size_t)NTOK * DM * 2;
constexpr size_t SLOT = (size_t)NTOK * DM * 2;
constexpr size_t WS_U = WS_POOL;
constexpr size_t WS_ACT = WS_U + (size_t)NTOK * DFF2 * 2;
constexpr size_t WS_UB = WS_U + (size_t)32 * MiB;
constexpr size_t WS_RKV = WS_POOL;
constexpr size_t L0_R = WS_RKV, L0_K = WS_RKV + SLOT, L0_DEC0 = WS_RKV + 2 * SLOT, L0_DEC1 = WS_RKV + 3 * SLOT, L0_IC0 = WS_RKV + 4 * SLOT, L0_IC1 = WS_RKV + 5 * SLOT, L0_V = WS_RKV + 6 * SLOT, L0_G = WS_RKV + 7 * SLOT;
constexpr size_t L0_YS = WS_RKV;
constexpr size_t L0_HID = WS_RKV + 8 * SLOT;
constexpr size_t L0_BONUS = L0_HID + (size_t)3 * NTOK * 256 * 2;
constexpr size_t L0_SCAL = L0_BONUS + (size_t)NTOK * 32 * 4;
constexpr size_t L0_XS = al256(L0_SCAL + (size_t)256 * LTOK * 2 * 4);
constexpr size_t L0_VEC = L0_XS;
constexpr size_t L0_END = L0_VEC + (size_t)256 * LTOK * 6 * 64 * 2;
constexpr size_t L1_QKV = WS_POOL;
constexpr size_t L1_O = L1_QKV + (size_t)NTOK * 6144 * 2;
constexpr size_t L2_HGO = WS_POOL;
constexpr size_t L2_OG = L2_HGO + (size_t)NTOK * 10240 * 2;
constexpr size_t L3_IN = WS_POOL;
constexpr size_t L3_XB = L3_IN + 2 * SLOT;
constexpr size_t L3_LOGA = L3_XB + SLOT;
constexpr size_t L3_UU = L3_LOGA + 2 * SLOT;
constexpr size_t L3_YS = L3_UU + 2 * SLOT;
constexpr size_t WS_END = L0_END;
static_assert(WS_ACT + (size_t)NTOK * DFF * 2 <= WS_END && L3_YS + 4 * SLOT <= WS_END && L2_OG + 4 * SLOT <= WS_END && L1_O + (size_t)NTOK * 4096 * 4 <= WS_END, "pool");
static_assert(WS_END <= (size_t)1536 * MiB, "d_ws map must fit 4 x the largest input");

constexpr int CW_BAR = 4096;
constexpr int RING_OFF = 0, RING_BYTES = 131072;
constexpr int LDSCTL_OFF = RING_BYTES, MISC_OFF = LDSCTL_OFF + 320;
constexpr int LDS_BYTES = 147456;

#define GAS __attribute__((address_space(1)))
#define LAS __attribute__((address_space(3)))
typedef unsigned short bf16;
typedef unsigned v4u __attribute__((ext_vector_type(4)));
typedef unsigned v2u __attribute__((ext_vector_type(2)));
typedef float f32x4 __attribute__((ext_vector_type(4)));
typedef float f32x2 __attribute__((ext_vector_type(2)));
typedef short bf16x8 __attribute__((ext_vector_type(8)));
typedef GAS unsigned gu32;
#define RLX_AGENT __ATOMIC_RELAXED, __HIP_MEMORY_SCOPE_AGENT
#define LDS_WAIT() asm volatile("s_waitcnt lgkmcnt(0)" ::: "memory")
#define VM_WAIT() asm volatile("s_waitcnt vmcnt(0)" ::: "memory")
#define LDS_BARRIER() do { asm volatile("s_waitcnt lgkmcnt(0)" ::: "memory"); __builtin_amdgcn_s_barrier(); asm volatile("" ::: "memory"); } while (0)
__device__ __forceinline__ unsigned pk2(float lo, float hi) { return pg8::cvt_pk_bf16(lo, hi); }
__device__ __forceinline__ float bflo(unsigned w) { return __uint_as_float(w << 16); }
__device__ __forceinline__ float bfhi(unsigned w) { return __uint_as_float(w & 0xffff0000u); }
__device__ __forceinline__ float bf2f(bf16 x) { return __uint_as_float(((unsigned)x) << 16); }
__device__ __forceinline__ bf16 f2bf(float f) { return (bf16)(pk2(f, 0.f) & 0xffffu); }
__device__ __forceinline__ int vzero() { int z; asm volatile("v_mov_b32 %0, 0" : "=v"(z)); return z; }
__device__ __forceinline__ float sigmoidf_(float x) { return __builtin_amdgcn_rcpf(1.f + __expf(-x)); }
__device__ __forceinline__ float siluf_(float x) { return x * sigmoidf_(x); }
__device__ __forceinline__ float tanhf_(float x) { const float e = __expf(2.f * x); return 1.f - 2.f * __builtin_amdgcn_rcpf(e + 1.f); }
__device__ __forceinline__ float gelu_tanh_(float x) { const float u = 0.7978845608028654f * (x + 0.044715f * x * x * x); return 0.5f * x * (1.f + tanhf_(u)); }

#define XB_TMO      128
#define XB_XCNT(j)  (256  + 64 * (j))
#define XB_XSUB(j)  (1280 + 64 * (j))
#define XB_XGEN(j)  (2304 + 64 * (j))
#define XB_TOP      3328
#define XB_TOPGEN   3392
#define XCD_BAR_WORDS 3456
#define XB_SPIN_CAP (1u << 18)
__device__ __forceinline__ unsigned xb_ld(unsigned* p)              { return __hip_atomic_load(p, __ATOMIC_RELAXED, __HIP_MEMORY_SCOPE_AGENT); }
__device__ __forceinline__ unsigned xb_add(unsigned* p, unsigned v) { return __hip_atomic_fetch_add(p, v, __ATOMIC_RELAXED, __HIP_MEMORY_SCOPE_AGENT); }
__device__ __forceinline__ unsigned xb_xcc_id() { return (unsigned)__builtin_amdgcn_s_getreg((3 << 11) | 20) & 0xFu; }
#define XB_SPIN(cond, bar) do { unsigned _sp = 0; while (cond) { __builtin_amdgcn_s_sleep(1); \
    if ((++_sp & 255u) == 0u) { if (xb_ld(&(bar)[XB_TMO])) break; if (_sp > XB_SPIN_CAP) { atomicAdd(&(bar)[XB_TMO], 1u); break; } } } } while (0)
struct XcdBarrier { unsigned* bar; unsigned x; volatile LAS unsigned* st; };
__device__ __forceinline__ XcdBarrier xcd_barrier_post(unsigned* bar, volatile LAS unsigned* st) {
    XcdBarrier b; b.bar = bar; b.x = xb_xcc_id(); b.st = st;
    if (threadIdx.x == 0) (void)xb_add(&bar[XB_XCNT(b.x)], 1u);
    return b;
}
__device__ __forceinline__ void xcd_barrier_complete(unsigned* bar, unsigned x, unsigned& nloc, unsigned& nx) {
    const unsigned G = gridDim.x * gridDim.y * gridDim.z;
    unsigned sum, cnt, mine, sp = 0u;
    for (;;) {
        sum = 0u; cnt = 0u; mine = 0u;
#pragma unroll
        for (unsigned j = 0; j < 16; ++j) { const unsigned c = xb_ld(&bar[XB_XCNT(j)]); sum += c; cnt += (c > 0u) ? 1u : 0u; mine = (j == x) ? c : mine; }
        if (sum == G) break;
        __builtin_amdgcn_s_sleep(1);
        if ((++sp & 255u) == 0u) { if (xb_ld(&bar[XB_TMO])) break; if (sp > XB_SPIN_CAP) { atomicAdd(&bar[XB_TMO], 1u); break; } }
    }
    nloc = mine > 0u ? mine : 1u; nx = cnt > 0u ? cnt : 1u;
}
__device__ __forceinline__ void xcd_barrier(const XcdBarrier& b) {
    asm volatile("s_waitcnt vmcnt(0)" ::: "memory");
    __syncthreads();
    if (threadIdx.x == 0) {
        unsigned* bar = b.bar;
        __builtin_amdgcn_s_waitcnt(0);
        unsigned nloc = b.st[0], nx = b.st[1];
        if (nloc == 0u) { xcd_barrier_complete(bar, b.x, nloc, nx); b.st[0] = nloc; b.st[1] = nx; }
        const unsigned old = xb_add(&bar[XB_XSUB(b.x)], 1u);
        const unsigned gen = old / nloc;
        if (old + 1u == (gen + 1u) * nloc) {
            __builtin_amdgcn_fence(__ATOMIC_RELEASE, "agent");
            asm volatile("s_waitcnt vmcnt(0)" ::: "memory");
            const unsigned og = xb_add(&bar[XB_TOP], 1u);
            const unsigned tg = og / nx;
            if (og + 1u == (tg + 1u) * nx) xb_add(&bar[XB_TOPGEN], 1u);
            else XB_SPIN(xb_ld(&bar[XB_TOPGEN]) == tg, bar);
            __builtin_amdgcn_fence(__ATOMIC_ACQUIRE, "agent");
            xb_add(&bar[XB_XGEN(b.x)], 1u);
            asm volatile("s_waitcnt vmcnt(0)" ::: "memory");
        } else {
            XB_SPIN(xb_ld(&bar[XB_XGEN(b.x)]) == gen, bar);
            __builtin_amdgcn_fence(__ATOMIC_ACQUIRE, "agent");
            asm volatile("s_waitcnt vmcnt(0)" ::: "memory");
        }
    }
    __syncthreads();
}

#define CAS __attribute__((address_space(4)))
__device__ __forceinline__ const void* ldarg(int k) { const CAS char* ka = (const CAS char*)__builtin_amdgcn_kernarg_segment_ptr(); return *(const void* const volatile CAS*)(ka + 8 * k); }
#define INP(k) ((const float*)ldarg(k))
__device__ __forceinline__ float wave_max(float v) {
#pragma unroll
    for (int o = 1; o < 64; o <<= 1) v = fmaxf(v, __shfl_xor(v, o));
    return v;
}
__device__ __forceinline__ float wave_sum(float v) {
#pragma unroll
    for (int o = 1; o < 64; o <<= 1) v += __shfl_xor(v, o);
    return v;
}
struct Frame {
    LAS unsigned char* lds;
    volatile LAS unsigned* MISC;
    gu32* ctl;
    int tid, lane, wave;
    int vcu, G, bx;
    unsigned char* ws;
};
#define GW(F) ((F).vcu * NWAVES + (F).wave)
#define NGW(F) ((F).G * NWAVES)
struct ItemIter { int base, step, lim; };
__device__ __forceinline__ ItemIter item_iter(const Frame& F, int N) {
    ItemIter I;
    I.base = GW(F); I.step = NGW(F); I.lim = N;
    return I;
}

__device__ __forceinline__ void transpose_item(const float* W, int ldw, int Ksrc, int koff, int dstK, int N, bf16* WT, int row_off, LAS float* scr, int item, int lane) {
    const int nblk = N / 32, kb = item / nblk, nb = item % nblk, k0 = 64 * kb, n0 = 32 * nb;
    float tv[32];
#pragma unroll
    for (int i = 0; i < 32; ++i) { const int kk = 2 * i + (lane >> 5); const int ks = k0 + kk - koff;
        tv[i] = 0.f; if (ks >= 0 && ks < Ksrc) tv[i] = W[(size_t)ks * ldw + n0 + (lane & 31)]; }
#pragma unroll
    for (int i = 0; i < 32; ++i) scr[(2 * i + (lane >> 5)) * 33 + (lane & 31)] = tv[i];
    LDS_WAIT(); asm volatile("" ::: "memory");
    const int c = lane & 7;
#pragma unroll
    for (int j = 0; j < 4; ++j) { const int n = (lane >> 3) + 8 * j; const LAS float* s = scr + (8 * c) * 33 + n;
        v4u o; o.x = pk2(s[0 * 33], s[1 * 33]); o.y = pk2(s[2 * 33], s[3 * 33]); o.z = pk2(s[4 * 33], s[5 * 33]); o.w = pk2(s[6 * 33], s[7 * 33]);
        *(GAS v4u*)(WT + (size_t)(row_off + n0 + n) * dstK + k0 + 8 * c) = o; }
    LDS_WAIT(); asm volatile("" ::: "memory");
}
#define TR_RUN(W, ldw, Ksrc, koff, dstK, N, WT, row_off) do { const int _n = ((dstK) / 64) * ((N) / 32); \
    for (int _it = (gw + NGWv - (int)(tr_base % NGWv)) % NGWv; _it < _n; _it += NGWv) transpose_item((W), (ldw), (Ksrc), (koff), (dstK), (N), (WT), (row_off), scr, _it, F.lane); \
    tr_base += _n; } while (0)

__device__ __forceinline__ void p0_prologue(Frame& F) {
    LAS float* scr = (LAS float*)(F.lds + RING_OFF + F.wave * 16384);
    const int gw = GW(F), NGWv = NGW(F);
    unsigned char* ws = F.ws;
    long tr_base = 0;
#if defined(PROBE_MASK) && ((PROBE_MASK >> 10) & 1)
    for (int prep_ = 0; prep_ < 2; ++prep_) {
#else
    {
#endif
    bf16* WA = (bf16*)(ws + WS_WA);
    for (int n = 0; n < 3; ++n) TR_RUN(INP(13) + (size_t)n * DM * DM, DM, DM, 0, DM, DM, WA, n * DM);
    for (int d = 0; d < 2; ++d) TR_RUN(INP(15) + (size_t)d * DM * 96, 96, DM, 0, DM, 96, WA, 6144 + d * 96);
    for (int d = 0; d < 2; ++d) TR_RUN(INP(18) + (size_t)d * DM * 64, 64, DM, 0, DM, 64, WA, 6144 + 256 + d * 64);
    TR_RUN(INP(20), 256, DM, 0, DM, 256, WA, 6144 + 512);
    {
        const size_t nvec = (size_t)(64 + 128) * DM / 8;
        for (size_t i = (size_t)gw * 64 + F.lane; i < nvec; i += (size_t)NGWv * 64) {
            const size_t e = i * 8; const size_t row = e / DM, col = e % DM; const size_t r = row < 64 ? 6144 + 192 + row : 6144 + 256 + 128 + (row - 64);
            *(GAS v4u*)(WA + r * DM + col) = (v4u){0u, 0u, 0u, 0u}; }
    }
    bf16* WL2 = (bf16*)(ws + WS_WL2);
    for (int d = 0; d < 2; ++d) TR_RUN(INP(16) + (size_t)d * 96 * DM, DM, 96, d * 96, 256, DM, WL2, d * DM);
    for (int d = 0; d < 2; ++d) TR_RUN(INP(19) + (size_t)d * 64 * DM, DM, 64, d * 64, 256, DM, WL2, (2 + d) * DM);
    TR_RUN(INP(21), DM, 256, 0, 256, DM, WL2, 4 * DM);
    bf16* WO = (bf16*)(ws + WS_WO);
    TR_RUN(INP(27), DM, DM, 0, DM, DM, WO, 0); TR_RUN(INP(31), DM, DM, 0, DM, DM, WO, DM); TR_RUN(INP(35), DM, DM, 0, DM, DM, WO, 2 * DM); TR_RUN(INP(42), DM, DM, 0, DM, DM, WO, 3 * DM);
    {
        bf16* WQ = (bf16*)(ws + WS_WQKV); const float* Wsrc = INP(28);
        const int nkb = DM / 64, nit = nkb * 128;
        for (int it = (gw + NGWv - (int)(tr_base % NGWv)) % NGWv; it < nit; it += NGWv) { const int kb = it / 128, cb = it % 128; const int tile = cb >> 3, hl = (cb & 7) >> 2, qtr = cb & 3;
            const int db = tile * 8 + (qtr & 1) * 4 + hl * 2 + (qtr >> 1);
            transpose_item(Wsrc + cb * 32, 3 * DM, DM, 0, DM, 32, WQ, db * 32, scr, kb, F.lane); }
        tr_base += nit;
        TR_RUN(Wsrc + 2 * DM, 3 * DM, DM, 0, DM, DM, WQ, 2 * DM);
    }
    TR_RUN(INP(32), 5 * DM, DM, 0, DM, 5 * DM, (bf16*)(ws + WS_WHG), 0);
    TR_RUN(INP(36), 2 * DM, DM, 0, DM, 2 * DM, (bf16*)(ws + WS_WLR), 0);
    {
        bf16* WG = (bf16*)(ws + WS_WGATE);
        for (int q = 0; q < 64; ++q) { const int d = q >> 5, g = (q >> 4) & 1, n = (q >> 1) & 7, hf = q & 1;
            TR_RUN(INP(39) + ((size_t)((d * 2 + g) * 8 + n) * 256) * 256 + hf * 128, 256, 256, 0, 256, 128, WG, ((d * 8 + n) * 2 + hf) * 256 + g * 128); }
    }
    {
        const int nit = (DM / 64) * 352;
        for (int l = 0; l < NLAYER; ++l) { const float* Wsrc = INP(8) + (size_t)l * DM * DFF2;
            for (int it = (gw + NGWv - (int)(tr_base % NGWv)) % NGWv; it < nit; it += NGWv) { const int kb = it / 352, cb = it % 352; const int bj = cb / 176, rem = cb % 176;
                const int db = (rem >> 2) * 8 + bj * 4 + (rem & 3);
                transpose_item(Wsrc + cb * 32, DFF2, DM, 0, DM, 32, (bf16*)(ws + WS_WUP), l * DFF2 + db * 32, scr, kb, F.lane); }
            tr_base += nit; }
    }
    for (int l = 0; l < NLAYER; ++l) TR_RUN(INP(11) + (size_t)l * DFF * DM, DM, DFF, 0, DFF, DM, (bf16*)(ws + WS_WDN), l * DM);
    }
    { float* RT = (float*)(ws + WS_ROPE);
      for (int i = gw * 64 + F.lane; i < LTOK * 64; i += NGWv * 64) { const int t = i >> 6, f = i & 63; float ang = 0.f;
          if (t >= NCTX) { const int p = t - NCTX; const float pos = (float)((f < 32) ? (p >> 6) : (p & 63)); const float invf = powf(10000.0f, -(float)(f & 31) / 32.0f); ang = pos * invf; }
          RT[2 * i] = cosf(ang); RT[2 * i + 1] = sinf(ang); } }
    { float* LB = (float*)(ws + WS_LB); const float* lower = INP(33);
      for (int i = gw * 64 + F.lane; i < 2 * DM; i += NGWv * 64) { const int d = i / DM, c = i % DM; float v[4], mx = -1e30f;
          for (int l = 0; l < 4; ++l) { v[l] = lower[(size_t)(d * 4 + l) * DM + c]; mx = fmaxf(mx, v[l]); }
          float s = 0.f; for (int l = 0; l < 4; ++l) { v[l] = expf(v[l] - mx); s += v[l]; }
          LB[i] = (v[1] + v[2]) / s; } }
    {
        __syncthreads();
        LAS float* cv = (LAS float*)(F.lds + RING_OFF);
        LAS float* red = (LAS float*)(F.lds + RING_OFF + 5 * DM * 4);
        { f32x4 xv[5];
#pragma unroll
          for (int r = 0; r < 5; ++r) xv[r] = ((const GAS f32x4*)((r < 4) ? INP(1) + r * DM : INP(3)))[F.tid];
#pragma unroll
          for (int r = 0; r < 5; ++r) { f32x4 o; o.x = xv[r].x / (1.f + expf(-xv[r].x)); o.y = xv[r].y / (1.f + expf(-xv[r].y)); o.z = xv[r].z / (1.f + expf(-xv[r].z)); o.w = xv[r].w / (1.f + expf(-xv[r].w));
              ((LAS f32x4*)cv)[r * (DM / 4) + F.tid] = o; } }
        __syncthreads();
        float* MOD = (float*)(ws + WS_MOD);
        const int NIT = NLAYER * 96 * 2;
        for (int it = F.vcu; it < NIT; it += F.G) {
            const int l = it / 192, rem = it % 192, cb = rem >> 1, kh = rem & 1;
            const float* Wl = INP(4) + (size_t)l * DM * (NMOD * DM) + cb * 128 + 2 * F.lane;
            const int kbeg = kh * 1024 + F.wave * 128;
            float a0[5], a1[5];
#pragma unroll
            for (int r = 0; r < 5; ++r) { a0[r] = 0.f; a1[r] = 0.f; }
#pragma unroll 4
            for (int kk = 0; kk < 128; ++kk) { const int k = kbeg + kk; const f32x2 w = *(const f32x2*)(Wl + (size_t)k * (NMOD * DM));
#pragma unroll
                for (int r = 0; r < 5; ++r) { const float c = cv[r * DM + k]; a0[r] += c * w.x; a1[r] += c * w.y; } }
#pragma unroll
            for (int r = 0; r < 5; ++r) { red[(F.wave * 5 + r) * 128 + 2 * F.lane] = a0[r]; red[(F.wave * 5 + r) * 128 + 2 * F.lane + 1] = a1[r]; }
            __syncthreads();
            for (int o = F.tid; o < 5 * 128; o += NWAVES * 64) { const int r = o / 128, c = o % 128; float s = 0.f;
#pragma unroll
                for (int w = 0; w < 8; ++w) s += red[(w * 5 + r) * 128 + c];
                const int n = cb * 128 + c; if (kh == 0) s += INP(5)[(size_t)l * NMOD * DM + n];
                atomicAdd(MOD + ((size_t)(l * 5 + r) * NMOD * DM + n), s); }
            __syncthreads();
        }
    }
}

__device__ __forceinline__ const float* mod_ptr(const unsigned char* ws, int layer, int bsel, int j) { return (const float*)(ws + WS_MOD) + ((size_t)((layer * 5 + bsel) * NMOD + j)) * DM; }

template <int MODE, bool LAT, int NM, int NN, int LDA, int LDB> struct Sched {
    pg8::TileOrder<NM, NN> T;
    static constexpr unsigned a_tile = 256u * LDA * 2u, b_tile = 256u * LDB * 2u;
    __device__ void init(int G, int c) { T.init(G, c); }
    __device__ __forceinline__ bool next(int i, pg8::Unit& u) const {
        int pm, pn; if (!T.tile(i, pm, pn)) return false;
        if (LAT) pm = (pm >> 3) * 9 + 1 + (pm & 7);
        u.pm = pm; u.pn = pn; u.half = -1;
        if (MODE == 0) { u.aoff = (unsigned)pm * a_tile; u.boff = (unsigned)pn * b_tile; }
        else if (MODE == 1) { const int grp = pn < 24 ? (pn >> 3) : (pn - 21); u.aoff = ((unsigned)grp * 36u + pm) * a_tile; u.boff = (unsigned)pn * b_tile; }
        else if (MODE == 2) { const int g = pn >> 3, hg = (g == 4) ? 2 : (g >> 1); u.aoff = ((unsigned)hg * 36u + pm) * a_tile; u.boff = (unsigned)pn * b_tile; }
        else { const int n = (pn >> 1) & 7; u.aoff = (unsigned)pm * a_tile + (unsigned)n * 512u; u.boff = (unsigned)pn * b_tile; }
        return true;
    }
};
template <int SPLIT, int KSUB, int LDA, int LDB> struct SchedSplit {
    int G, c;
    __device__ void init(int G_, int c_) { G = G_; c = c_; }
    __device__ __forceinline__ bool next(int i, pg8::Unit& u) const {
        const int L = i * G + c; if (L >= 32 * SPLIT) return false;
        const int tile = L / SPLIT, ks = L % SPLIT; const int pm = 32 + (tile & 3), pn = tile >> 2;
        u.pm = pm; u.pn = pn | (ks << 8); u.half = -1;
        u.aoff = (unsigned)pm * (256u * LDA * 2u) + (unsigned)ks * (KSUB * 2u); u.boff = (unsigned)pn * (256u * LDB * 2u) + (unsigned)ks * (KSUB * 2u);
        return true;
    }
};

template <int SPLIT, int KSUB, int LDA, int LDB> struct SchedSplitHalf {
    int G, c;
    __device__ void init(int G_, int c_) { G = G_; c = c_; }
    __device__ __forceinline__ bool next(int i, pg8::Unit& u) const {
        const int L = i * G + c; if (L >= 64 * SPLIT) return false;
        const int h = L & 1, Lq = L >> 1; const int tile = Lq / SPLIT, ks = Lq % SPLIT; const int pm = 32 + (tile & 3), pn = tile >> 2;
        u.pm = pm; u.pn = pn | (ks << 8); u.half = h;
        u.aoff = (unsigned)pm * (256u * LDA * 2u) + (unsigned)h * (128u * LDA * 2u) + (unsigned)ks * (KSUB * 2u); u.boff = (unsigned)pn * (256u * LDB * 2u) + (unsigned)ks * (KSUB * 2u);
        return true;
    }
};
template <bool LAT, int NM, int NN, int LMAX, int LDA, int LDB> struct SchedHead {
    int G, c;
    __device__ void init(int G_, int c_) { G = G_; c = c_; }
    __device__ __forceinline__ bool next(int i, pg8::Unit& u) const {
        const int L = i * G + c; if (L >= LMAX) return false;
        int pm, pn; pg8::TileOrder<NM, NN>::tileL(L, pm, pn);
        if (LAT) pm = (pm >> 3) * 9 + 1 + (pm & 7);
        u.pm = pm; u.pn = pn; u.half = -1; u.aoff = (unsigned)pm * (256u * LDA * 2u); u.boff = (unsigned)pn * (256u * LDB * 2u);
        return true;
    }
};
template <bool LAT, int NM, int NN, int LMAX, int NT, int LDA, int LDB> struct SchedHT {
    int G, c;
    __device__ void init(int G_, int c_) { G = G_; c = c_; }
    __device__ __forceinline__ bool next(int i, pg8::Unit& u) const {
        const int L = i * G + c; if (L >= LMAX + 2 * NT) return false;
        const bool whole = L < LMAX; const int Lp = L - LMAX; const int h = whole ? 0 : (Lp & 1);
        int pm, pn; pg8::TileOrder<NM, NN>::tileL(whole ? L : LMAX + (Lp >> 1), pm, pn);
        if (LAT) pm = (pm >> 3) * 9 + 1 + (pm & 7);
        u.pm = pm; u.pn = pn; u.half = whole ? -1 : h; u.aoff = (unsigned)pm * (256u * LDA * 2u) + (unsigned)h * (128u * LDA * 2u); u.boff = (unsigned)pn * (256u * LDB * 2u);
        return true;
    }
};
template <bool LAT, int NM, int NN, int L0, int NT, int LDA, int LDB> struct SchedTailHalf {
    int G, c;
    __device__ void init(int G_, int c_) { G = G_; c = c_; }
    __device__ __forceinline__ bool next(int i, pg8::Unit& u) const {
        const int Lp = i * G + c; if (Lp >= 2 * NT) return false;
        const int tu = Lp >> 1, h = Lp & 1;
        int pm, pn; pg8::TileOrder<NM, NN>::tileL(L0 + tu, pm, pn);
        if (LAT) pm = (pm >> 3) * 9 + 1 + (pm & 7);
        u.pm = pm; u.pn = pn; u.half = h; u.aoff = (unsigned)pm * (256u * LDA * 2u) + (unsigned)h * (128u * LDA * 2u); u.boff = (unsigned)pn * (256u * LDB * 2u);
        return true;
    }
};

template <int kind> struct EpiBf16Route {
    static constexpr bool PERM = true; static constexpr bool PERMA = false;
    bf16* O; int ldc;
    unsigned char* ws; const float* p0; const float* p1;
    static __device__ __forceinline__ float act(int mode, float x, float p) {
        if (kind == 0 || kind == 5) return x;
        if (kind == 1) { const float e = __expf(mode == 1 ? 2.f * x : -x); const float r = __builtin_amdgcn_rcpf(e + 1.f); return mode == 0 ? x : (mode == 1 ? 1.f - 2.f * r : r); }
        if (kind == 2) { const float s = sigmoidf_(x + p); const float dcy = __expf(-0.606531f * s); return mode == 4 ? dcy : (mode == 2 ? s : x); }
        if (kind == 3) { const float s = sigmoidf_(mode == 6 ? -x : x); return mode == 0 ? x : (mode == 3 ? x * s : (1.f - p) * s); }
        return mode == 5 ? gelu_tanh_(x) : x;
    }
    __device__ __forceinline__ void operator()(const pg8::f32x4 (&acc)[2][2][4][2], const pg8::Unit& u, int wr, int wc, int fr, int fq) const {
        bf16* base = O; int ld = ldc, colt = u.pn * 256, mode = 0; const float* par = nullptr;
        if (kind == 1) { if (u.pn < 24) { const int g = u.pn >> 3; base = (bf16*)(ws + (g == 0 ? L0_R : (g == 1 ? L0_K : L0_V))); ld = DM; colt = (u.pn & 7) * 256; }
                         else { const int hg = u.pn - 24; base = (bf16*)(ws + L0_HID) + (size_t)hg * NTOK * 256; ld = 256; colt = 0; mode = hg == 0 ? 1 : (hg == 1 ? 0 : 2); } }
        else if (kind == 2) { const int g = u.pn >> 3; colt = (u.pn & 7) * 256; ld = DM;
                         base = (bf16*)(ws + (g == 0 ? L0_DEC0 : g == 1 ? L0_DEC1 : g == 2 ? L0_IC0 : g == 3 ? L0_IC1 : L0_G));
                         if (g < 2) { mode = 4; par = p0 + g * DM + colt; } else if (g < 4) { mode = 2; par = p1 + (g - 2) * DM + colt; } }
        else if (kind == 3) { const int g = u.pn >> 3; if (g == 0 || g == 2) mode = 3; else if (g >= 3) { mode = 6; par = p0 + (g - 3) * DM + (u.pn & 7) * 256; } }
        else if (kind == 4) { if (u.pn < 8) mode = 5; }
        const int row0 = u.pm * 256 + wr * 64 + fr, col0 = colt + wc * 32 + 8 * fq, pc0 = wc * 32 + 8 * fq;
        const int ai0 = u.half < 0 ? 0 : u.half, nai = u.half < 0 ? 2 : 1;
        if (kind == 5 && u.pn < 16) {
            const int x = wc * 32 + 8 * fq, hl = x >> 6, y = x & 63; const int ncol = u.pn * 256 + hl * 128 + (y < 32 ? y : y + 32);
            const float* RT = (const float*)(ws + WS_ROPE);
#pragma unroll
            for (int ai = 0; ai < 2; ++ai) if (ai < nai)
#pragma unroll
                for (int m = 0; m < 4; ++m) { const int row = row0 + (ai0 + ai) * 128 + m * 16; const int t = row % LTOK;
                    const GAS pg8::f32x4* cs = (const GAS pg8::f32x4*)(RT + ((size_t)t * 64 + y) * 2);
                    const pg8::f32x4 c0 = cs[0], c1 = cs[1], c2 = cs[2], c3 = cs[3];
                    const pg8::f32x4 a0 = acc[ai][0][m][0], a1 = acc[ai][0][m][1], b0 = acc[ai][1][m][0], b1 = acc[ai][1][m][1];
                    pg8::u32x4 wa, wb;
                    wa.x = pk2(a0[0] * c0[0] - b0[0] * c0[1], a0[1] * c0[2] - b0[1] * c0[3]); wa.y = pk2(a0[2] * c1[0] - b0[2] * c1[1], a0[3] * c1[2] - b0[3] * c1[3]);
                    wa.z = pk2(a1[0] * c2[0] - b1[0] * c2[1], a1[1] * c2[2] - b1[1] * c2[3]); wa.w = pk2(a1[2] * c3[0] - b1[2] * c3[1], a1[3] * c3[2] - b1[3] * c3[3]);
                    wb.x = pk2(b0[0] * c0[0] + a0[0] * c0[1], b0[1] * c0[2] + a0[1] * c0[3]); wb.y = pk2(b0[2] * c1[0] + a0[2] * c1[1], b0[3] * c1[2] + a0[3] * c1[3]);
                    wb.z = pk2(b1[0] * c2[0] + a1[0] * c2[1], b1[1] * c2[2] + a1[1] * c2[3]); wb.w = pk2(b1[2] * c3[0] + a1[2] * c3[1], b1[3] * c3[2] + a1[3] * c3[3]);
                    bf16* rp_ = base + (size_t)row * ld + ncol;
                    *(pg8::u32x4*)rp_ = wa; *(pg8::u32x4*)(rp_ + 32) = wb; }
            return;
        }
#pragma unroll
        for (int bj = 0; bj < 2; ++bj) {
            pg8::f32x4 pa = {0.f, 0.f, 0.f, 0.f}, pb = {0.f, 0.f, 0.f, 0.f};
            if ((kind == 2 || kind == 3) && par) { pa = *(const GAS pg8::f32x4*)(par + pc0 + bj * 128); pb = *(const GAS pg8::f32x4*)(par + pc0 + bj * 128 + 4); }
#pragma unroll
            for (int ai = 0; ai < 2; ++ai) if (ai < nai)
#pragma unroll
                for (int m = 0; m < 4; ++m) { bf16* rowp = base + (size_t)(row0 + (ai0 + ai) * 128 + m * 16) * ld + col0 + bj * 128;
                    pg8::f32x4 v0 = acc[ai][bj][m][0], v1 = acc[ai][bj][m][1];
                    if (kind != 0 && kind != 5) {
#pragma unroll
                        for (int j = 0; j < 4; ++j) { v0[j] = act(mode, v0[j], pa[j]); v1[j] = act(mode, v1[j], pb[j]); } }
                    pg8::u32x4 w; w.x = pk2(v0[0], v0[1]); w.y = pk2(v0[2], v0[3]); w.z = pk2(v1[0], v1[1]); w.w = pk2(v1[2], v1[3]);
                    *(pg8::u32x4*)rowp = w; }
        }
    }
};
template <int CTRL> __device__ __forceinline__ float dppz(float v) { return __int_as_float(__builtin_amdgcn_update_dpp(0, __float_as_int(v), CTRL, 0xF, 0xF, true)); }
struct EpiConvAct {
    static constexpr bool PERM = true; static constexpr bool PERMA = true;
    bf16* A; bf16* UB; const float* cw; const float* cb;
    __device__ __forceinline__ void operator()(const pg8::f32x4 (&acc)[2][2][4][2], const pg8::Unit& u, int wr, int wc, int fr, int fq) const {
        const int pc = wc * 32 + 8 * fq, cn = u.pn * 128 + pc;
        const int rowb = u.pm * 256 + wr * 64 + 4 * fr;
        const int ai0 = u.half < 0 ? 0 : u.half, nai = u.half < 0 ? 2 : 1;
        if (fr == 0 || fr == 15) {
            const bool lo = fr == 0; const int run = u.pm * 4 + wr + 2 * ai0;
#pragma unroll
            for (int ai = 0; ai < 2; ++ai) if (ai < nai)
#pragma unroll
                for (int bj = 0; bj < 2; ++bj)
#pragma unroll
                    for (int s = 0; s < 2; ++s) { const pg8::f32x4 a0 = lo ? acc[ai][bj][s][0] : acc[ai][bj][2 + s][0], a1 = lo ? acc[ai][bj][s][1] : acc[ai][bj][2 + s][1];
                        pg8::u32x4 w; w.x = pk2(a0[0], a0[1]); w.y = pk2(a0[2], a0[3]); w.z = pk2(a1[0], a1[1]); w.w = pk2(a1[2], a1[3]);
                        *(pg8::u32x4*)(UB + (size_t)((run + 2 * ai) * 4 + (lo ? s : 2 + s)) * DFF2 + u.pn * 256 + bj * 128 + pc) = w; }
        }
#pragma unroll
        for (int h = 0; h < 2; ++h) {
            const GAS float* wp = (const GAS float*)cw + cn + 4 * h; const GAS float* bp = (const GAS float*)cb + cn + 4 * h;
            const pg8::f32x4 g0 = *(const GAS pg8::f32x4*)wp, g1 = *(const GAS pg8::f32x4*)(wp + DFF2), g2 = *(const GAS pg8::f32x4*)(wp + 2 * DFF2), gb = *(const GAS pg8::f32x4*)bp;
            const pg8::f32x4 v0 = *(const GAS pg8::f32x4*)(wp + DFF), v1 = *(const GAS pg8::f32x4*)(wp + DFF2 + DFF), v2 = *(const GAS pg8::f32x4*)(wp + 2 * DFF2 + DFF), vb = *(const GAS pg8::f32x4*)(bp + DFF);
#pragma unroll
            for (int ai = 0; ai < 2; ++ai) if (ai < nai) {
                __builtin_amdgcn_sched_barrier(0);
                float o[4][4];
#pragma unroll
                for (int j = 0; j < 4; ++j) {
                    const float xg0 = acc[ai][0][0][h][j], xg1 = acc[ai][0][1][h][j], xg2 = acc[ai][0][2][h][j], xg3 = acc[ai][0][3][h][j];
                    const float xv0 = acc[ai][1][0][h][j], xv1 = acc[ai][1][1][h][j], xv2 = acc[ai][1][2][h][j], xv3 = acc[ai][1][3][h][j];
                    const float pg = dppz<0x111>(xg3), ng = dppz<0x101>(xg0), pv = dppz<0x111>(xv3), nv = dppz<0x101>(xv0);
                    const float og0 = gb[j] + g0[j] * pg + g1[j] * xg0 + g2[j] * xg1, ov0 = vb[j] + v0[j] * pv + v1[j] * xv0 + v2[j] * xv1;
                    const float og1 = gb[j] + g0[j] * xg0 + g1[j] * xg1 + g2[j] * xg2, ov1 = vb[j] + v0[j] * xv0 + v1[j] * xv1 + v2[j] * xv2;
                    const float og2 = gb[j] + g0[j] * xg1 + g1[j] * xg2 + g2[j] * xg3, ov2 = vb[j] + v0[j] * xv1 + v1[j] * xv2 + v2[j] * xv3;
                    const float og3 = gb[j] + g0[j] * xg2 + g1[j] * xg3 + g2[j] * ng, ov3 = vb[j] + v0[j] * xv2 + v1[j] * xv3 + v2[j] * nv;
                    o[0][j] = siluf_(og0) * ov0; o[1][j] = siluf_(og1) * ov1; o[2][j] = siluf_(og2) * ov2; o[3][j] = siluf_(og3) * ov3; }
#pragma unroll
                for (int m = 0; m < 4; ++m) { pg8::u32x2 w; w.x = pk2(o[m][0], o[m][1]); w.y = pk2(o[m][2], o[m][3]);
                    *(pg8::u32x2*)(A + (size_t)(rowb + (ai0 + ai) * 128 + m) * DFF + cn + 4 * h) = w; }
            }
            __builtin_amdgcn_sched_barrier(0);
        }
    }
};
struct EpiResid {
    static constexpr bool PERM = true; static constexpr bool PERMA = false;
    bf16* DELTA; const unsigned char* ws; int layer, j;
    __device__ __forceinline__ void operator()(const pg8::f32x4 (&acc)[2][2][4][2], const pg8::Unit& u, int wr, int wc, int fr, int fq) const {
        const int bsel = (u.pm % 9 == 0) ? 4 : (u.pm / 9);
        const float* gate = mod_ptr(ws, layer, bsel, j);
        const int row0 = u.pm * 256 + wr * 64 + fr, col0 = u.pn * 256 + wc * 32 + 8 * fq;
#pragma unroll
        for (int bj = 0; bj < 2; ++bj) {
            const pg8::f32x4 ga = *(const GAS pg8::f32x4*)(gate + col0 + bj * 128), gb = *(const GAS pg8::f32x4*)(gate + col0 + bj * 128 + 4);
#pragma unroll
            for (int ai = 0; ai < 2; ++ai)
#pragma unroll
                for (int m = 0; m < 4; ++m) { const pg8::f32x4 v0 = acc[ai][bj][m][0] * ga, v1 = acc[ai][bj][m][1] * gb;
                    pg8::u32x4 w; w.x = pk2(v0[0], v0[1]); w.y = pk2(v0[2], v0[3]); w.z = pk2(v1[0], v1[1]); w.w = pk2(v1[2], v1[3]);
                    *(pg8::u32x4*)(DELTA + (size_t)(row0 + ai * 128 + m * 16) * DM + col0 + bj * 128) = w; }
        }
    }
};
struct EpiPartial {
    static constexpr bool PERM = true; static constexpr bool PERMA = false;
    bf16* PART;
    __device__ __forceinline__ void operator()(const pg8::f32x4 (&acc)[2][2][4][2], const pg8::Unit& u, int wr, int wc, int fr, int fq) const {
        const int ks = u.pn >> 8, pn = u.pn & 255;
        bf16* base = PART + (size_t)ks * 1024 * DM; const int row0 = (u.pm - 32) * 256 + wr * 64 + fr, col0 = pn * 256 + wc * 32 + 8 * fq;
        const int ai0 = u.half < 0 ? 0 : u.half, nai = u.half < 0 ? 2 : 1;
#pragma unroll
        for (int ai = 0; ai < 2; ++ai) if (ai < nai)
#pragma unroll
            for (int m = 0; m < 4; ++m)
#pragma unroll
                for (int bj = 0; bj < 2; ++bj) { const pg8::f32x4 v0 = acc[ai][bj][m][0], v1 = acc[ai][bj][m][1];
                    pg8::u32x4 w; w.x = pk2(v0[0], v0[1]); w.y = pk2(v0[2], v0[3]); w.z = pk2(v1[0], v1[1]); w.w = pk2(v1[2], v1[3]);
                    *(pg8::u32x4*)(base + (size_t)(row0 + (ai0 + ai) * 128 + m * 16) * DM + col0 + bj * 128) = w; }
    }
};
struct EpiGates {
    static constexpr bool PERM = true; static constexpr bool PERMA = false;
    unsigned char* ws; const float* b_gate; const float* lam;
    __device__ __forceinline__ void operator()(const pg8::f32x4 (&acc)[2][2][4][2], const pg8::Unit& u, int wr, int wc, int fr, int fq) const {
        const int d = u.pn >> 4, nb = (u.pn >> 1) & 7, hf = u.pn & 1;
        const int c0 = nb * 256 + hf * 128 + wc * 32 + 8 * fq;
        const int row0 = u.pm * 256 + wr * 64 + fr;
        const bf16* XB = (const bf16*)(ws + L3_XB);
        bf16* LOGA = (bf16*)(ws + L3_LOGA) + (size_t)d * NTOK * DM; bf16* UU = (bf16*)(ws + L3_UU) + (size_t)d * NTOK * DM;
#pragma unroll
        for (int n = 0; n < 2; ++n) {
            const int c4 = c0 + 4 * n;
            const pg8::f32x4 br = *(const pg8::f32x4*)(b_gate + (size_t)(d * 2 + 0) * DM + c4), bi = *(const pg8::f32x4*)(b_gate + (size_t)(d * 2 + 1) * DM + c4);
            const pg8::f32x4 lm = *(const pg8::f32x4*)(lam + (size_t)d * DM + c4); pg8::f32x4 sp;
#pragma unroll
            for (int j = 0; j < 4; ++j) sp[j] = __logf(1.f + __expf(-lm[j]));
#pragma unroll
            for (int ai = 0; ai < 2; ++ai)
#pragma unroll
                for (int m = 0; m < 4; ++m) { const int row = row0 + ai * 128 + m * 16; const size_t off = (size_t)row * DM + c4;
                    const v2u xw = *(const GAS v2u*)(XB + off);
                    const float xb[4] = {bflo(xw.x), bfhi(xw.x), bflo(xw.y), bfhi(xw.y)};
                    float la[4], uu[4];
#pragma unroll
                    for (int j = 0; j < 4; ++j) { const float rg = sigmoidf_(acc[ai][0][m][n][j] + br[j]), ig = sigmoidf_(acc[ai][1][m][n][j] + bi[j]);
                        const float lg = -8.0f * rg * sp[j]; la[j] = lg;
                        uu[j] = __builtin_amdgcn_sqrtf(fmaxf(1.f - __expf(2.f * lg), 0.f)) * ig * xb[j]; }
                    v2u w; w.x = pk2(la[0], la[1]); w.y = pk2(la[2], la[3]); *(GAS v2u*)(LOGA + off) = w;
                    w.x = pk2(uu[0], uu[1]); w.y = pk2(uu[2], uu[3]); *(GAS v2u*)(UU + off) = w; }
        }
    }
};

template <bool LAT, bool TO_OUT, bool WITH_H, int NSPLIT>
__device__ __forceinline__ void ln_phase(Frame& F, const bf16* DELTA, const float* Zin, float* Zout, float* dout, bf16* H, const float* gam, const float* bet, int mlayer, int jshift, const bf16* PART, int glayer, int jgate) {
    const int gw = GW(F), NGWv = NGW(F); const int nrows = LAT ? NLAT : NTOK;
    for (int idx = gw; idx < nrows; idx += NGWv) {
        int m, b, t; if (LAT) { b = idx >> 11; t = NCTX + (idx & 2047); m = b * LTOK + t; } else { m = idx; b = m / LTOK; t = m % LTOK; }
        const int bsel = (t < NCTX) ? 4 : b;
        f32x4 v[8]; float s = 0.f;
        if (NSPLIT > 0 && m >= 8192) {
            const GAS f32x4* zr = (const GAS f32x4*)(Zin + (size_t)m * DM) + F.lane; const GAS f32x4* gr = (const GAS f32x4*)mod_ptr(F.ws, glayer, bsel, jgate) + F.lane;
            const GAS v2u* pr = (const GAS v2u*)(PART + (size_t)(m - 8192) * DM) + F.lane;
#pragma unroll
            for (int j = 0; j < 8; ++j) { f32x4 a = {0.f, 0.f, 0.f, 0.f};
#pragma unroll
                for (int p = 0; p < NSPLIT; ++p) { const v2u pw = pr[(size_t)p * (1024 * DM / 4) + 64 * j]; a += (f32x4){bflo(pw.x), bfhi(pw.x), bflo(pw.y), bfhi(pw.y)}; }
                v[j] = zr[64 * j] * DN_ALPHA + gr[64 * j] * a; s += (v[j].x + v[j].y) + (v[j].z + v[j].w); }
        } else {
            const GAS f32x4* zr = (const GAS f32x4*)(Zin + (size_t)m * DM) + F.lane; const GAS v2u* dr = (const GAS v2u*)(DELTA + (size_t)m * DM) + F.lane;
#pragma unroll
            for (int j = 0; j < 8; ++j) { const v2u dw = dr[64 * j]; const f32x4 dl = {bflo(dw.x), bfhi(dw.x), bflo(dw.y), bfhi(dw.y)};
                v[j] = zr[64 * j] * DN_ALPHA + dl; s += (v[j].x + v[j].y) + (v[j].z + v[j].w); }
        }
        const float mean = wave_sum(s) * (1.f / DM); float s2 = 0.f;
#pragma unroll
        for (int j = 0; j < 8; ++j) { v[j] = v[j] - mean; s2 += (v[j].x * v[j].x + v[j].y * v[j].y) + (v[j].z * v[j].z + v[j].w * v[j].w); }
        const float rstd = 1.f / sqrtf(wave_sum(s2) * (1.f / DM) + LN_EPS);
        const float* sh = WITH_H ? mod_ptr(F.ws, mlayer, bsel, jshift) : nullptr; const float* sc = WITH_H ? mod_ptr(F.ws, mlayer, bsel, jshift + 1) : nullptr;
        float* zo = TO_OUT ? dout + ((size_t)b * SEQ + (t - NCTX)) * DM : Zout + (size_t)m * DM;
#pragma unroll
        for (int j = 0; j < 8; ++j) { const int col = 256 * j + 4 * F.lane;
            const f32x4 g = *(const f32x4*)(gam + col), be = *(const f32x4*)(bet + col);
            const f32x4 z = v[j] * rstd * g + be;
            *(GAS f32x4*)(zo + col) = z;
            if (WITH_H) { const f32x4 s1 = *(const GAS f32x4*)(sc + col), s0 = *(const GAS f32x4*)(sh + col); const f32x4 h = z * (s1 + 1.f) + s0;
                v2u w; w.x = pk2(h.x, h.y); w.y = pk2(h.z, h.w); *(GAS v2u*)(H + (size_t)m * DM + col) = w; } }
    }
}
__device__ __forceinline__ const float* z0_row(const float* Zb, const float* xin, const float* cin, bool z0in, int m, int b, int t) {
    return z0in ? ((t < NCTX) ? cin + ((size_t)b * NCTX + t) * DM : xin + ((size_t)b * SEQ + (t - NCTX)) * DM) : Zb + (size_t)m * DM;
}
#define LN_ROWINFO(idx_, m_, b_, t_) do { if (LAT) { b_ = (idx_) >> 11; t_ = NCTX + ((idx_) & 2047); m_ = b_ * LTOK + t_; } else { m_ = (idx_); b_ = m_ / LTOK; t_ = m_ % LTOK; } } while (0)
#define LN_SPLIT_D(dst, PARTp, gatep, m_) do { const GAS v2u* pr_ = (const GAS v2u*)((PARTp) + (size_t)((m_) - 8192) * DM) + F.lane; const GAS f32x4* gr_ = (const GAS f32x4*)(gatep) + F.lane; \
        _Pragma("unroll") for (int j_ = 0; j_ < 8; ++j_) { f32x4 a_ = {0.f, 0.f, 0.f, 0.f}; \
            _Pragma("unroll") for (int p_ = 0; p_ < NSPLIT; ++p_) { const v2u pw_ = pr_[(size_t)p_ * (1024 * DM / 4) + 64 * j_]; a_ += (f32x4){bflo(pw_.x), bfhi(pw_.x), bflo(pw_.y), bfhi(pw_.y)}; } \
            a_ = a_ * gr_[64 * j_]; dst[j_].x = pk2(a_.x, a_.y); dst[j_].y = pk2(a_.z, a_.w); } } while (0)
__device__ __forceinline__ f32x4 zq_decode(const f32x4 raw, float sc) { const int a = __float_as_int(raw.x), b = __float_as_int(raw.y);
    return (f32x4){(float)(short)(a & 0xffff), (float)(a >> 16), (float)(short)(b & 0xffff), (float)(b >> 16)} * sc; }
#define ZQ_ROW(Zb_, m_) ((const GAS v2u*)((const unsigned short*)(Zb_) + (size_t)(m_) * DM) + F.lane)
template <bool LAT, int NSPLIT, bool Z0IN>
__device__ __forceinline__ void ln1_phase(Frame& F, bf16* D1, const float* Zb, const float* xin, const float* cin, bf16* H, float* STAT, const float* gam, const float* bet, int layer, const bf16* PART) {
    const int gw = GW(F), NGWv = NGW(F); const int nrows = LAT ? NLAT : NTOK; const int nmain = NSPLIT > 0 ? 8192 : nrows;
    LAS float* Lg = (LAS float*)(F.lds + RING_OFF); LAS float* Lb = Lg + DM; LAS float* Lm = Lb + DM;
    f32x4 zA[8], zB[8]; v2u dA[8], dB[8]; float sA = 1.f, sB = 1.f;
    auto loadz = [&](const int idx, f32x4 (&zz)[8], float& zs) __attribute__((always_inline)) {
        int m, b, t; LN_ROWINFO(idx, m, b, t);
        if (Z0IN) { const GAS f32x4* zr = (const GAS f32x4*)z0_row(Zb, xin, cin, true, m, b, t) + F.lane;
#pragma unroll
            for (int j = 0; j < 8; ++j) zz[j] = zr[64 * j]; }
        else { const GAS v2u* qr = ZQ_ROW(Zb, m); zs = *(const GAS float*)((const float*)(F.ws + WS_ZS) + m);
#pragma unroll
            for (int j = 0; j < 8; ++j) { const v2u pw = qr[64 * j]; zz[j].x = __uint_as_float(pw.x); zz[j].y = __uint_as_float(pw.y); } } };
    auto loadd = [&](const int idx, v2u (&dd)[8]) __attribute__((always_inline)) {
        int m, b, t; LN_ROWINFO(idx, m, b, t); const GAS v2u* dr = (const GAS v2u*)(D1 + (size_t)m * DM) + F.lane;
#pragma unroll
        for (int j = 0; j < 8; ++j) dd[j] = dr[64 * j]; };
    auto row1 = [&](f32x4 (&zc)[8], v2u (&dc)[8], const float zsc, const int idx) __attribute__((always_inline)) {
        int m, b, t; LN_ROWINFO(idx, m, b, t); const int bsel = (t < NCTX) ? 4 : b;
        float s = 0.f;
#pragma unroll
        for (int j = 0; j < 8; ++j) { const f32x4 dl = {bflo(dc[j].x), bfhi(dc[j].x), bflo(dc[j].y), bfhi(dc[j].y)}; const f32x4 z0v = Z0IN ? zc[j] : zq_decode(zc[j], zsc);
            zc[j] = z0v * DN_ALPHA + dl; s += (zc[j].x + zc[j].y) + (zc[j].z + zc[j].w); }
        const float mean = wave_sum(s) * (1.f / DM); float s2 = 0.f;
#pragma unroll
        for (int j = 0; j < 8; ++j) { zc[j] = zc[j] - mean; s2 += (zc[j].x * zc[j].x + zc[j].y * zc[j].y) + (zc[j].z * zc[j].z + zc[j].w * zc[j].w); }
        const float rstd = 1.f / sqrtf(wave_sum(s2) * (1.f / DM) + LN_EPS);
        if (F.lane == 0) *(GAS f32x2*)(STAT + (size_t)m * 2) = (f32x2){mean, rstd};
        const LAS float* sh = Lm + bsel * 2 * DM; const LAS float* sc = sh + DM;
#pragma unroll
        for (int j = 0; j < 8; ++j) { const int col = 256 * j + 4 * F.lane;
            const f32x4 z = zc[j] * rstd * *(const LAS f32x4*)(Lg + col) + *(const LAS f32x4*)(Lb + col);
            const f32x4 h = z * (*(const LAS f32x4*)(sc + col) + 1.f) + *(const LAS f32x4*)(sh + col);
            v2u w; w.x = pk2(h.x, h.y); w.y = pk2(h.z, h.w); *(GAS v2u*)(H + (size_t)m * DM + col) = w; } };
    int idx = gw; bool have = idx < nmain;
    if (have) { loadz(idx, zA, sA); loadd(idx, dA); }
    {
        f32x4 pv[12];
        pv[0] = ((const GAS f32x4*)gam)[F.tid]; pv[1] = ((const GAS f32x4*)bet)[F.tid];
#pragma unroll
        for (int k = 0; k < 10; ++k) { const int v = F.tid + NWAVES * 64 * k, bs = v >> 10, r4 = v & 1023; pv[2 + k] = ((const GAS f32x4*)mod_ptr(F.ws, layer, bs, 3))[r4]; }
        ((LAS f32x4*)Lg)[F.tid] = pv[0]; ((LAS f32x4*)Lb)[F.tid] = pv[1];
#pragma unroll
        for (int k = 0; k < 10; ++k) ((LAS f32x4*)Lm)[F.tid + NWAVES * 64 * k] = pv[2 + k];
    }
    __syncthreads();
    while (have) {
        const int nidx = idx + NGWv; const bool hasn = nidx < nmain;
        if (hasn) { loadz(nidx, zB, sB); loadd(nidx, dB); }
        asm volatile("" ::: "memory");
        row1(zA, dA, sA, idx);
        if (!hasn) break;
        const int fidx = nidx + NGWv; const bool hasf = fidx < nmain;
        if (hasf) { loadz(fidx, zA, sA); loadd(fidx, dA); }
        asm volatile("" ::: "memory");
        row1(zB, dB, sB, nidx);
        idx = fidx; have = hasf;
    }
    if (NSPLIT > 0) {
        for (int ti = 8192 + gw; ti < nrows; ti += NGWv) {
            int m, b, t; LN_ROWINFO(ti, m, b, t);
            loadz(ti, zA, sA); LN_SPLIT_D(dA, PART, mod_ptr(F.ws, layer, (t < NCTX) ? 4 : b, 2), m);
#pragma unroll
            for (int j = 0; j < 8; ++j) *((GAS v2u*)(D1 + (size_t)m * DM) + F.lane + 64 * j) = dA[j];
            asm volatile("" ::: "memory");
            row1(zA, dA, sA, ti);
        }
    }
}
template <bool LAT, bool TO_OUT, bool WITH_H, int NSPLIT, bool Z0IN>
__device__ __forceinline__ void ln2_phase(Frame& F, const bf16* D1, const bf16* D2, const float* Zb, const float* xin, const float* cin, float* Zout, float* dout, bf16* H, const float* STAT,
                                          const float* gam1, const float* bet1, const float* gam2, const float* bet2, int layer, const bf16* PART) {
    const int gw = GW(F), NGWv = NGW(F); const int nrows = LAT ? NLAT : NTOK; const int nmain = NSPLIT > 0 ? 8192 : nrows;
    LAS float* Lg1 = (LAS float*)(F.lds + RING_OFF); LAS float* Lb1 = Lg1 + DM; LAS float* Lg2 = Lb1 + DM; LAS float* Lb2 = Lg2 + DM; LAS float* Lm = Lb2 + DM;
    f32x4 zA[8], zB[8]; v2u d1A[8], d1B[8], d2A[8], d2B[8]; f32x2 stA = {0.f, 0.f}, stB = {0.f, 0.f}; float sA = 1.f, sB = 1.f;
    auto loadz = [&](const int idx, f32x4 (&zz)[8], v2u (&dd1)[8], f32x2& st, float& zs) __attribute__((always_inline)) {
        int m, b, t; LN_ROWINFO(idx, m, b, t);
        if (Z0IN) { const GAS f32x4* zr = (const GAS f32x4*)z0_row(Zb, xin, cin, true, m, b, t) + F.lane;
#pragma unroll
            for (int j = 0; j < 8; ++j) zz[j] = zr[64 * j]; }
        else { const GAS v2u* qr = ZQ_ROW(Zb, m); zs = *(const GAS float*)((const float*)(F.ws + WS_ZS) + m);
#pragma unroll
            for (int j = 0; j < 8; ++j) { const v2u pw = qr[64 * j]; zz[j].x = __uint_as_float(pw.x); zz[j].y = __uint_as_float(pw.y); } }
        const GAS v2u* dr = (const GAS v2u*)(D1 + (size_t)m * DM) + F.lane;
#pragma unroll
        for (int j = 0; j < 8; ++j) dd1[j] = dr[64 * j];
        st = *(const GAS f32x2*)(STAT + (size_t)m * 2); };
    auto loadd2 = [&](const int idx, v2u (&dd2)[8]) __attribute__((always_inline)) {
        int m, b, t; LN_ROWINFO(idx, m, b, t); const GAS v2u* dr = (const GAS v2u*)(D2 + (size_t)m * DM) + F.lane;
#pragma unroll
        for (int j = 0; j < 8; ++j) dd2[j] = dr[64 * j]; };
    auto row2 = [&](f32x4 (&zc)[8], v2u (&d1c)[8], v2u (&d2c)[8], const f32x2 stc, const float zsc, const int idx) __attribute__((always_inline)) {
        int m, b, t; LN_ROWINFO(idx, m, b, t); const int bsel = (t < NCTX) ? 4 : b;
        float s = 0.f;
#pragma unroll
        for (int j = 0; j < 8; ++j) { const int col = 256 * j + 4 * F.lane;
            const f32x4 dl1 = {bflo(d1c[j].x), bfhi(d1c[j].x), bflo(d1c[j].y), bfhi(d1c[j].y)}, dl2 = {bflo(d2c[j].x), bfhi(d2c[j].x), bflo(d2c[j].y), bfhi(d2c[j].y)};
            const f32x4 z0v = Z0IN ? zc[j] : zq_decode(zc[j], zsc);
            const f32x4 z1 = ((z0v * DN_ALPHA + dl1) - stc.x) * stc.y * *(const LAS f32x4*)(Lg1 + col) + *(const LAS f32x4*)(Lb1 + col);
            zc[j] = z1 * DN_ALPHA + dl2; s += (zc[j].x + zc[j].y) + (zc[j].z + zc[j].w); }
        const float mean = wave_sum(s) * (1.f / DM); float s2 = 0.f;
#pragma unroll
        for (int j = 0; j < 8; ++j) { zc[j] = zc[j] - mean; s2 += (zc[j].x * zc[j].x + zc[j].y * zc[j].y) + (zc[j].z * zc[j].z + zc[j].w * zc[j].w); }
        const float rstd = 1.f / sqrtf(wave_sum(s2) * (1.f / DM) + LN_EPS);
        const LAS float* sh = Lm + bsel * 2 * DM; const LAS float* sc = sh + DM;
        float* zo = TO_OUT ? dout + ((size_t)b * SEQ + (t - NCTX)) * DM : nullptr;
        float qinv = 1.f;
        if (!TO_OUT) {
            float am = 0.f;
#pragma unroll
            for (int j = 0; j < 8; ++j) { const int col = 256 * j + 4 * F.lane;
                const f32x4 z = zc[j] * rstd * *(const LAS f32x4*)(Lg2 + col) + *(const LAS f32x4*)(Lb2 + col);
                am = fmaxf(am, fmaxf(fmaxf(fabsf(z.x), fabsf(z.y)), fmaxf(fabsf(z.z), fabsf(z.w)))); }
            am = wave_max(am); const float scq = am > 0.f ? am * (1.f / 32767.f) : 1.f; qinv = am > 0.f ? 32767.f / am : 1.f;
            if (F.lane == 0) *(GAS float*)((float*)(F.ws + WS_ZS) + m) = scq;
        }
#pragma unroll
        for (int j = 0; j < 8; ++j) { const int col = 256 * j + 4 * F.lane;
            const f32x4 z = zc[j] * rstd * *(const LAS f32x4*)(Lg2 + col) + *(const LAS f32x4*)(Lb2 + col);
            if (TO_OUT) *(GAS f32x4*)(zo + col) = z;
            else { const int q0 = __float2int_rn(z.x * qinv), q1 = __float2int_rn(z.y * qinv), q2 = __float2int_rn(z.z * qinv), q3 = __float2int_rn(z.w * qinv);
                v2u pw; pw.x = ((unsigned)q0 & 0xffffu) | ((unsigned)q1 << 16); pw.y = ((unsigned)q2 & 0xffffu) | ((unsigned)q3 << 16);
                *((GAS v2u*)((unsigned short*)Zout + (size_t)m * DM) + F.lane + 64 * j) = pw; }
            if (WITH_H) { const f32x4 h = z * (*(const LAS f32x4*)(sc + col) + 1.f) + *(const LAS f32x4*)(sh + col);
                v2u w; w.x = pk2(h.x, h.y); w.y = pk2(h.z, h.w); *(GAS v2u*)(H + (size_t)m * DM + col) = w; } } };
    int idx = gw; bool have = idx < nmain;
    if (have) { loadz(idx, zA, d1A, stA, sA); loadd2(idx, d2A); }
    {
        f32x4 pv[14];
        pv[0] = ((const GAS f32x4*)gam1)[F.tid]; pv[1] = ((const GAS f32x4*)bet1)[F.tid]; pv[2] = ((const GAS f32x4*)gam2)[F.tid]; pv[3] = ((const GAS f32x4*)bet2)[F.tid];
        if (WITH_H) {
#pragma unroll
            for (int k = 0; k < 10; ++k) { const int v = F.tid + NWAVES * 64 * k, bs = v >> 10, r4 = v & 1023; pv[4 + k] = ((const GAS f32x4*)mod_ptr(F.ws, layer + 1, bs, 0))[r4]; }
        }
        ((LAS f32x4*)Lg1)[F.tid] = pv[0]; ((LAS f32x4*)Lb1)[F.tid] = pv[1]; ((LAS f32x4*)Lg2)[F.tid] = pv[2]; ((LAS f32x4*)Lb2)[F.tid] = pv[3];
        if (WITH_H) {
#pragma unroll
            for (int k = 0; k < 10; ++k) ((LAS f32x4*)Lm)[F.tid + NWAVES * 64 * k] = pv[4 + k];
        }
    }
    __syncthreads();
    while (have) {
        const int nidx = idx + NGWv; const bool hasn = nidx < nmain;
        if (hasn) { loadz(nidx, zB, d1B, stB, sB); loadd2(nidx, d2B); }
        asm volatile("" ::: "memory");
        row2(zA, d1A, d2A, stA, sA, idx);
        if (!hasn) break;
        const int fidx = nidx + NGWv; const bool hasf = fidx < nmain;
        if (hasf) { loadz(fidx, zA, d1A, stA, sA); loadd2(fidx, d2A); }
        asm volatile("" ::: "memory");
        row2(zB, d1B, d2B, stB, sB, nidx);
        idx = fidx; have = hasf;
    }
    if (NSPLIT > 0) {
        for (int ti = 8192 + gw; ti < nrows; ti += NGWv) {
            int m, b, t; LN_ROWINFO(ti, m, b, t);
            loadz(ti, zA, d1A, stA, sA); LN_SPLIT_D(d2A, PART, mod_ptr(F.ws, layer, (t < NCTX) ? 4 : b, 5), m);
            asm volatile("" ::: "memory");
            row2(zA, d1A, d2A, stA, sA, ti);
        }
    }
}
template <bool LAT>
__device__ __forceinline__ void ffn_conv_phase(Frame& F, const bf16* U, bf16* ACT, const float* cw, const float* cb) {
    const int gw = GW(F), NGWv = NGW(F); const int nstrips = (LAT ? NLAT : NTOK) / 16; const int nitems = nstrips * 11;
    for (int it = gw; it < nitems; it += NGWv) {
        const int strip = it / 11, cblk = it % 11; const int c0 = cblk * 512 + F.lane * 8;
        int m0; if (LAT) { const int r = strip * 16; m0 = (r >> 11) * LTOK + NCTX + (r & 2047); } else m0 = strip * 16;
        const int t0 = m0 % LTOK;
        float wg[3][8], wv[3][8], bg[8], bv[8];
#pragma unroll
        for (int k = 0; k < 3; ++k) { const f32x4 a = *(const f32x4*)(cw + (size_t)k * DFF2 + c0), b = *(const f32x4*)(cw + (size_t)k * DFF2 + c0 + 4), c = *(const f32x4*)(cw + (size_t)k * DFF2 + DFF + c0), d = *(const f32x4*)(cw + (size_t)k * DFF2 + DFF + c0 + 4);
#pragma unroll
            for (int j = 0; j < 4; ++j) { wg[k][j] = a[j]; wg[k][4 + j] = b[j]; wv[k][j] = c[j]; wv[k][4 + j] = d[j]; } }
        { const f32x4 a = *(const f32x4*)(cb + c0), b = *(const f32x4*)(cb + c0 + 4), c = *(const f32x4*)(cb + DFF + c0), d = *(const f32x4*)(cb + DFF + c0 + 4);
#pragma unroll
          for (int j = 0; j < 4; ++j) { bg[j] = a[j]; bg[4 + j] = b[j]; bv[j] = c[j]; bv[4 + j] = d[j]; } }
        const bool first_in_seg = (t0 == 0 || t0 == NCTX), last_in_seg = (t0 + 16 == NCTX || t0 + 16 == LTOK);
        const GAS bf16* ug = (const GAS bf16*)U + (size_t)m0 * DFF2 + c0;
        v4u pg = {0u, 0u, 0u, 0u}, pv = {0u, 0u, 0u, 0u};
        if (!first_in_seg) { pg = *(const GAS v4u*)(ug - DFF2); pv = *(const GAS v4u*)(ug - DFF2 + DFF); }
        v4u cg = *(const GAS v4u*)(ug), cv = *(const GAS v4u*)(ug + DFF);
        for (int r = 0; r < 16; ++r) {
            v4u ng = {0u, 0u, 0u, 0u}, nv = {0u, 0u, 0u, 0u};
            if (r < 15 || !last_in_seg) { ng = *(const GAS v4u*)(ug + (size_t)(r + 1) * DFF2); nv = *(const GAS v4u*)(ug + (size_t)(r + 1) * DFF2 + DFF); }
            float o[8];
#pragma unroll
            for (int q = 0; q < 4; ++q) {
                const unsigned pgw = pg[q], cgw = cg[q], ngw = ng[q], pvw = pv[q], cvw = cv[q], nvw = nv[q];
                const float g0 = bg[2 * q] + wg[0][2 * q] * bflo(pgw) + wg[1][2 * q] * bflo(cgw) + wg[2][2 * q] * bflo(ngw);
                const float g1 = bg[2 * q + 1] + wg[0][2 * q + 1] * bfhi(pgw) + wg[1][2 * q + 1] * bfhi(cgw) + wg[2][2 * q + 1] * bfhi(ngw);
                const float v0 = bv[2 * q] + wv[0][2 * q] * bflo(pvw) + wv[1][2 * q] * bflo(cvw) + wv[2][2 * q] * bflo(nvw);
                const float v1 = bv[2 * q + 1] + wv[0][2 * q + 1] * bfhi(pvw) + wv[1][2 * q + 1] * bfhi(cvw) + wv[2][2 * q + 1] * bfhi(nvw);
                o[2 * q] = siluf_(g0) * v0; o[2 * q + 1] = siluf_(g1) * v1; }
            v4u w; w.x = pk2(o[0], o[1]); w.y = pk2(o[2], o[3]); w.z = pk2(o[4], o[5]); w.w = pk2(o[6], o[7]);
            *(GAS v4u*)(ACT + (size_t)(m0 + r) * DFF + c0) = w;
            pg = cg; pv = cv; cg = ng; cv = nv;
        }
    }
}

template <bool LAT>
__device__ __forceinline__ void ffn_fix_phase(Frame& F, const bf16* UB, bf16* ACT, const float* cw, const float* cb) {
    const int gw = GW(F), NGWv = NGW(F); const int nruns = (LAT ? NLAT : NTOK) / 64; const int nitems = nruns * 11;
    for (int it = gw; it < nitems; it += NGWv) {
        const int cblk = it % 11, rl = it / 11;
        int run; if (LAT) { const int r = rl * 64; run = ((r >> 11) * LTOK + NCTX + (r & 2047)) >> 6; } else run = rl;
        const int m0 = run * 64, t0 = m0 % LTOK;
        const bool seg_first = (t0 == 0 || t0 == NCTX), seg_last = (t0 + 64 == NCTX || t0 + 64 == LTOK);
        const int c0 = cblk * 512 + F.lane * 8; const int uc = (c0 >> 7) * 256 + (c0 & 127);
        const GAS bf16* ub = (const GAS bf16*)UB + (size_t)run * 4 * DFF2 + uc;
        v4u rg[6], rv[6];
#pragma unroll
        for (int q = 0; q < 6; ++q) { const int rq = (q == 0 && seg_first) ? 1 : ((q == 5 && seg_last) ? 4 : q);
            const GAS bf16* rp = ub + (ptrdiff_t)(rq - 1) * DFF2; rg[q] = *(const GAS v4u*)rp; rv[q] = *(const GAS v4u*)(rp + 128); }
        float wg[3][8], wv[3][8], bg[8], bv[8];
#pragma unroll
        for (int k = 0; k < 3; ++k) { const GAS float* wp = (const GAS float*)cw + (size_t)k * DFF2 + c0; const f32x4 a = *(const GAS f32x4*)wp, b = *(const GAS f32x4*)(wp + 4), c = *(const GAS f32x4*)(wp + DFF), d = *(const GAS f32x4*)(wp + DFF + 4);
#pragma unroll
            for (int j = 0; j < 4; ++j) { wg[k][j] = a[j]; wg[k][4 + j] = b[j]; wv[k][j] = c[j]; wv[k][4 + j] = d[j]; } }
        { const GAS float* bp = (const GAS float*)cb + c0; const f32x4 a = *(const GAS f32x4*)bp, b = *(const GAS f32x4*)(bp + 4), c = *(const GAS f32x4*)(bp + DFF), d = *(const GAS f32x4*)(bp + DFF + 4);
#pragma unroll
          for (int j = 0; j < 4; ++j) { bg[j] = a[j]; bg[4 + j] = b[j]; bv[j] = c[j]; bv[4 + j] = d[j]; } }
        const float zf = seg_first ? 0.f : 1.f, zl = seg_last ? 0.f : 1.f;
#pragma unroll
        for (int which = 0; which < 2; ++which) {
            const int ip = which ? 3 : 0, ic = which ? 4 : 1, in_ = which ? 5 : 2; const float mp = which ? 1.f : zf, mn = which ? zl : 1.f;
            float o[8];
#pragma unroll
            for (int q = 0; q < 4; ++q) {
                const unsigned pgw = rg[ip][q], cgw = rg[ic][q], ngw = rg[in_][q], pvw = rv[ip][q], cvw = rv[ic][q], nvw = rv[in_][q];
                const float g0 = bg[2 * q] + wg[0][2 * q] * (bflo(pgw) * mp) + wg[1][2 * q] * bflo(cgw) + wg[2][2 * q] * (bflo(ngw) * mn);
                const float g1 = bg[2 * q + 1] + wg[0][2 * q + 1] * (bfhi(pgw) * mp) + wg[1][2 * q + 1] * bfhi(cgw) + wg[2][2 * q + 1] * (bfhi(ngw) * mn);
                const float v0 = bv[2 * q] + wv[0][2 * q] * (bflo(pvw) * mp) + wv[1][2 * q] * bflo(cvw) + wv[2][2 * q] * (bflo(nvw) * mn);
                const float v1 = bv[2 * q + 1] + wv[0][2 * q + 1] * (bfhi(pvw) * mp) + wv[1][2 * q + 1] * bfhi(cvw) + wv[2][2 * q + 1] * (bfhi(nvw) * mn);
                o[2 * q] = siluf_(g0) * v0; o[2 * q + 1] = siluf_(g1) * v1; }
            v4u w; w.x = pk2(o[0], o[1]); w.y = pk2(o[2], o[3]); w.z = pk2(o[4], o[5]); w.w = pk2(o[6], o[7]);
            *(GAS v4u*)(ACT + (size_t)(m0 + (which ? 63 : 0)) * DFF + c0) = w;
        }
    }
}
__device__ __forceinline__ int flip_tok(int s) { return s < NCTX ? (NCTX - 1 - s) : (LTOK + NCTX - 1 - s); }

__device__ __forceinline__ pg8::f32x4 mma_tile(pg8::f32x4 acc, const LAS bf16* A, int lda, const LAS bf16* Bt, int ldb, int ksteps, int lane) {
    const LAS bf16* ap = A + (lane & 15) * lda + (lane >> 4) * 8; const LAS bf16* bp = Bt + (lane & 15) * ldb + (lane >> 4) * 8;
    for (int k = 0; k < ksteps; ++k) { const bf16x8 a = *(const LAS bf16x8*)(ap + k * 32), b = *(const LAS bf16x8*)(bp + k * 32);
        acc = __builtin_amdgcn_mfma_f32_16x16x32_bf16(a, b, acc, 0, 0, 0); }
    return acc;
}
template <int CTRL> __device__ __forceinline__ float dpp_f(float v) { return __int_as_float(__builtin_amdgcn_update_dpp(0, __float_as_int(v), CTRL, 0xF, 0xF, true)); }
__device__ __forceinline__ float red8(float v) { v += dpp_f<0xB1>(v); v += dpp_f<0x4E>(v); v += dpp_f<0x141>(v); return v; }
__device__ __forceinline__ float red16(float v) { v = red8(v); v += dpp_f<0x140>(v); return v; }
__device__ __forceinline__ void unpack8(const v4u w, float (&f)[8]) { f[0] = bflo(w.x); f[1] = bfhi(w.x); f[2] = bflo(w.y); f[3] = bfhi(w.y); f[4] = bflo(w.z); f[5] = bfhi(w.z); f[6] = bflo(w.w); f[7] = bfhi(w.w); }
__device__ __forceinline__ v4u pack8(const float (&f)[8]) { v4u w; w.x = pk2(f[0], f[1]); w.y = pk2(f[2], f[3]); w.z = pk2(f[4], f[5]); w.w = pk2(f[6], f[7]); return w; }
__device__ __forceinline__ void ld8f(const float* p, float (&f)[8]) { const f32x4 a = *(const f32x4*)p, b = *(const f32x4*)(p + 4); f[0] = a.x; f[1] = a.y; f[2] = a.z; f[3] = a.w; f[4] = b.x; f[5] = b.y; f[6] = b.z; f[7] = b.w; }
__device__ __forceinline__ void l0_xs_phase(Frame& F, const float* x, const float* ctx, const float* mu) {
    const int gw = GW(F), NGWv = NGW(F);
    bf16* XS = (bf16*)(F.ws + L0_XS);
    const int c0 = (gw & 3) * 512 + F.lane * 8;
    float mv[6][8];
#pragma unroll
    for (int n = 0; n < 6; ++n) ld8f(mu + (size_t)n * DM + c0, mv[n]);
    for (int it = gw; it < (NTOK / 8) * 4; it += NGWv) {
        const int strip = it >> 2; const int m0 = strip * 8, b = m0 / LTOK, t0 = m0 % LTOK;
        const float* zr = (t0 < NCTX) ? ctx + ((size_t)b * NCTX + t0) * DM : x + ((size_t)b * SEQ + (t0 - NCTX)) * DM;
        const int seg_end = (t0 < NCTX) ? NCTX : LTOK; const bool first = (t0 == 0 || t0 == NCTX);
        const int bsel = (t0 < NCTX) ? 4 : b;
        f32x4 za[10], zb[10];
#pragma unroll
        for (int q = 0; q < 10; ++q) { const bool ok = (q == 0) ? !first : (t0 + q - 1 < seg_end);
            za[q] = (f32x4){0.f, 0.f, 0.f, 0.f}; zb[q] = za[q];
            if (ok) { const GAS float* rp = (const GAS float*)zr + (ptrdiff_t)(q - 1) * DM + c0; za[q] = *(const GAS f32x4*)rp; zb[q] = *(const GAS f32x4*)(rp + 4); } }
        float s0[8], s1[8], hp[8], hc[8], hn[8];
        { const float* sh = mod_ptr(F.ws, 0, bsel, 0) + c0; const float* sc = mod_ptr(F.ws, 0, bsel, 1) + c0;
          const f32x4 a = *(const GAS f32x4*)sh, a2 = *(const GAS f32x4*)(sh + 4), c = *(const GAS f32x4*)sc, c2 = *(const GAS f32x4*)(sc + 4);
#pragma unroll
          for (int j = 0; j < 4; ++j) { s0[j] = a[j]; s0[4 + j] = a2[j]; s1[j] = c[j] + 1.f; s1[4 + j] = c2[j] + 1.f; } }
#pragma unroll
        for (int j = 0; j < 4; ++j) { hp[j] = first ? 0.f : za[0][j] * s1[j] + s0[j]; hp[4 + j] = first ? 0.f : zb[0][j] * s1[4 + j] + s0[4 + j];
                                      hc[j] = za[1][j] * s1[j] + s0[j]; hc[4 + j] = zb[1][j] * s1[4 + j] + s0[4 + j]; }
#pragma unroll
        for (int r = 0; r < 8; ++r) {
            const bool hasn = (t0 + r + 1 < seg_end);
#pragma unroll
            for (int j = 0; j < 4; ++j) { hn[j] = hasn ? za[r + 2][j] * s1[j] + s0[j] : 0.f; hn[4 + j] = hasn ? zb[r + 2][j] * s1[4 + j] + s0[4 + j] : 0.f; }
            const size_t m = (size_t)(m0 + r);
            float dx[8];
#pragma unroll
            for (int j = 0; j < 8; ++j) dx[j] = (hp[j] + hn[j]) * 0.5f - hc[j];
#pragma unroll
            for (int n = 0; n < 6; ++n) { float o[8];
#pragma unroll
                for (int j = 0; j < 8; ++j) o[j] = hc[j] + dx[j] * mv[n][j];
                *(GAS v4u*)(XS + ((size_t)n * NTOK + m) * DM + c0) = pack8(o); }
#pragma unroll
            for (int j = 0; j < 8; ++j) { hp[j] = hc[j]; hc[j] = hn[j]; }
        }
    }
}
__device__ __forceinline__ void l0_prep_phase(Frame& F, const float* k_k, const float* k_a, const float* r_k) {
    const int gw = GW(F), NGWv = NGW(F); unsigned char* ws = F.ws;
    const bf16* R = (const bf16*)(ws + L0_R); const bf16* K = (const bf16*)(ws + L0_K); const bf16* V = (const bf16*)(ws + L0_V);
    bf16* VEC = (bf16*)(ws + L0_VEC); float* SCAL = (float*)(ws + L0_SCAL); float* BONUS = (float*)(ws + L0_BONUS);
    const int l8 = F.lane & 7;
    for (int it = gw; it < NTOK * 4; it += NGWv) {
        const int m = it >> 2, h = (it & 3) * 8 + (F.lane >> 3), b = m / LTOK, t = m % LTOK; const int c0 = h * 64 + l8 * 8; const size_t e = (size_t)m * DM + c0;
        float r[8], k[8], kk[8], tmp[8], par[8];
        unpack8(*(const GAS v4u*)(R + e), r); unpack8(*(const GAS v4u*)(K + e), k);
        const v4u vraw = *(const GAS v4u*)(V + e);
        ld8f(k_k + c0, par); float ss = 0.f;
#pragma unroll
        for (int j = 0; j < 8; ++j) { kk[j] = k[j] * par[j]; ss += kk[j] * kk[j]; }
        ss = red8(ss); const float inv = 1.0f / sqrtf(ss + 1e-12f);
#pragma unroll
        for (int j = 0; j < 8; ++j) kk[j] *= inv;
        float ka[8], kdsum[8]; ld8f(k_a + c0, ka);
#pragma unroll
        for (int j = 0; j < 8; ++j) kdsum[j] = 0.f;
#pragma unroll
        for (int d = 0; d < 2; ++d) {
            float w[8], ic[8], kd[8];
            unpack8(*(const GAS v4u*)((const bf16*)(ws + (d ? L0_DEC1 : L0_DEC0)) + e), w); unpack8(*(const GAS v4u*)((const bf16*)(ws + (d ? L0_IC1 : L0_IC0)) + e), ic);
            float kr = 0.f, kkar = 0.f;
#pragma unroll
            for (int j = 0; j < 8; ++j) { kd[j] = k[j] * (1.f + (ic[j] - 1.f) * ka[j]); kdsum[j] += kd[j]; kr += kd[j] * r[j]; }
            const int s = d ? flip_tok(t) : t; const size_t sidx = (size_t)((d * NB + b) * 32 + h);
            bf16* vp = VEC + (sidx * LTOK + s) * 384 + l8 * 8;
            *(GAS v4u*)(vp) = pack8(w); *(GAS v4u*)(vp + 64) = pack8(kd); *(GAS v4u*)(vp + 128) = pack8(kk);
#pragma unroll
            for (int j = 0; j < 8; ++j) { tmp[j] = kk[j] * ic[j]; kkar += tmp[j] * r[j]; }
            *(GAS v4u*)(vp + 192) = pack8(tmp);
#pragma unroll
            for (int j = 0; j < 8; ++j) tmp[j] = w[j] * r[j];
            *(GAS v4u*)(vp + 256) = pack8(tmp); *(GAS v4u*)(vp + 320) = vraw;
            kr = red8(kr); kkar = red8(kkar);
            if (l8 == 0) *(GAS f32x2*)(SCAL + (sidx * LTOK + s) * 2) = (f32x2){kr, kkar};
        }
        ld8f(r_k + c0, par); float bon = 0.f;
#pragma unroll
        for (int j = 0; j < 8; ++j) bon += r[j] * kdsum[j] * par[j];
        bon = red8(bon);
        if (l8 == 0) BONUS[m * 32 + h] = bon;
    }
}
constexpr int RW_CS = 32;
__device__ __forceinline__ void l0_scan_phase(Frame& F) {
    unsigned char* ws = F.ws; const bf16* VEC = (const bf16*)(ws + L0_VEC); const float* SCAL = (const float*)(ws + L0_SCAL); float* YS = (float*)(ws + L0_YS);
    LAS float* opb = (LAS float*)(F.lds + RING_OFF);
    LAS float* scl = opb + 2 * RW_CS * 384;
    LAS float* ybuf = scl + 2 * RW_CS * 2;
    const int rp = F.tid >> 4, q = F.tid & 15; constexpr int NCH = LTOK / RW_CS;
    for (int sidx = F.vcu; sidx < 256; sidx += F.G) {
        const int d = sidx >> 7, b = (sidx >> 5) & 3, h = sidx & 31;
        const GAS v4u* src = (const GAS v4u*)(VEC + (size_t)sidx * LTOK * 384); const GAS float* ssrc = (const GAS float*)(SCAL + (size_t)sidx * LTOK * 2);
        f32x2 Sa = {0.f, 0.f}, Sb = {0.f, 0.f}, Sc = {0.f, 0.f}, Sd = {0.f, 0.f};
        v4u pre[3]; float psc = 0.f;
#pragma unroll
        for (int k = 0; k < 3; ++k) pre[k] = src[F.tid + 512 * k];
        if (F.tid < RW_CS * 2) psc = ssrc[F.tid];
        __syncthreads();
#pragma unroll
        for (int k = 0; k < 3; ++k) { LAS float* dst = opb + (size_t)(F.tid + 512 * k) * 8; const v4u w = pre[k];
            *(LAS f32x4*)dst = (f32x4){bflo(w.x), bfhi(w.x), bflo(w.y), bfhi(w.y)}; *(LAS f32x4*)(dst + 4) = (f32x4){bflo(w.z), bfhi(w.z), bflo(w.w), bfhi(w.w)}; }
        if (F.tid < RW_CS * 2) scl[F.tid] = psc;
        __syncthreads();
        for (int ch = 0; ch < NCH; ++ch) {
            const int cur = ch & 1;
            if (ch + 1 < NCH) {
#pragma unroll
                for (int k = 0; k < 3; ++k) pre[k] = src[(size_t)(ch + 1) * (RW_CS * 48) + F.tid + 512 * k];
                if (F.tid < RW_CS * 2) psc = ssrc[(ch + 1) * RW_CS * 2 + F.tid]; }
            const LAS float* ob = opb + cur * RW_CS * 384; const LAS float* sb = scl + cur * RW_CS * 2;
            const LAS float* o0 = ob + q * 4; const LAS float* ov = ob + 320 + 2 * rp;
            f32x4 w4 = *(const LAS f32x4*)(o0), k4 = *(const LAS f32x4*)(o0 + 64), c4 = *(const LAS f32x4*)(o0 + 128), a4 = *(const LAS f32x4*)(o0 + 192), r4 = *(const LAS f32x4*)(o0 + 256);
            f32x2 v2 = *(const LAS f32x2*)(ov), sc2 = *(const LAS f32x2*)(sb);
            LAS float* ydst = (q == 0) ? (ybuf + 2 * rp) : (ybuf + RW_CS * 64 + 2 * F.tid);
            const int ystep = (q == 0) ? 64 : 0;
#pragma unroll 4
            for (int s = 0; s < RW_CS; ++s) {
                const int sn = (s + 1 < RW_CS) ? s + 1 : s;
                const LAS float* o = o0 + sn * 384;
                const f32x4 w4n = *(const LAS f32x4*)(o), k4n = *(const LAS f32x4*)(o + 64), c4n = *(const LAS f32x4*)(o + 128), a4n = *(const LAS f32x4*)(o + 192), r4n = *(const LAS f32x4*)(o + 256);
                const f32x2 v2n = *(const LAS f32x2*)(ov + sn * 384), sc2n = *(const LAS f32x2*)(sb + sn * 2);
                f32x2 sa = Sa * c4.x; sa = Sb * c4.y + sa; sa = Sc * c4.z + sa; sa = Sd * c4.w + sa;
                f32x2 yy = Sa * r4.x; yy = Sb * r4.y + yy; yy = Sc * r4.z + yy; yy = Sd * r4.w + yy;
                float sa0 = sa.x, sa1 = sa.y, y0 = yy.x, y1 = yy.y;
                asm volatile("s_nop 1\n\t"
                    "v_add_f32_dpp %0, %0, %0 quad_perm:[1,0,3,2] row_mask:0xf bank_mask:0xf bound_ctrl:1\n\t" "v_add_f32_dpp %1, %1, %1 quad_perm:[1,0,3,2] row_mask:0xf bank_mask:0xf bound_ctrl:1\n\t"
                    "v_add_f32_dpp %2, %2, %2 quad_perm:[1,0,3,2] row_mask:0xf bank_mask:0xf bound_ctrl:1\n\t" "v_add_f32_dpp %3, %3, %3 quad_perm:[1,0,3,2] row_mask:0xf bank_mask:0xf bound_ctrl:1\n\t"
                    "v_add_f32_dpp %0, %0, %0 quad_perm:[2,3,0,1] row_mask:0xf bank_mask:0xf bound_ctrl:1\n\t" "v_add_f32_dpp %1, %1, %1 quad_perm:[2,3,0,1] row_mask:0xf bank_mask:0xf bound_ctrl:1\n\t"
                    "v_add_f32_dpp %2, %2, %2 quad_perm:[2,3,0,1] row_mask:0xf bank_mask:0xf bound_ctrl:1\n\t" "v_add_f32_dpp %3, %3, %3 quad_perm:[2,3,0,1] row_mask:0xf bank_mask:0xf bound_ctrl:1\n\t"
                    "v_add_f32_dpp %0, %0, %0 row_half_mirror row_mask:0xf bank_mask:0xf bound_ctrl:1\n\t" "v_add_f32_dpp %1, %1, %1 row_half_mirror row_mask:0xf bank_mask:0xf bound_ctrl:1\n\t"
                    "v_add_f32_dpp %2, %2, %2 row_half_mirror row_mask:0xf bank_mask:0xf bound_ctrl:1\n\t" "v_add_f32_dpp %3, %3, %3 row_half_mirror row_mask:0xf bank_mask:0xf bound_ctrl:1\n\t"
                    "v_add_f32_dpp %0, %0, %0 row_mirror row_mask:0xf bank_mask:0xf bound_ctrl:1\n\t" "v_add_f32_dpp %1, %1, %1 row_mirror row_mask:0xf bank_mask:0xf bound_ctrl:1\n\t"
                    "v_add_f32_dpp %2, %2, %2 row_mirror row_mask:0xf bank_mask:0xf bound_ctrl:1\n\t" "v_add_f32_dpp %3, %3, %3 row_mirror row_mask:0xf bank_mask:0xf bound_ctrl:1\n\t"
                    "s_nop 0"
                    : "+v"(sa0), "+v"(sa1), "+v"(y0), "+v"(y1));
                sa = (f32x2){sa0, sa1}; yy = (f32x2){y0, y1};
                yy = yy + (v2 * sc2.x - sa * sc2.y);
                Sa = Sa * w4.x + (v2 * k4.x - sa * a4.x); Sb = Sb * w4.y + (v2 * k4.y - sa * a4.y); Sc = Sc * w4.z + (v2 * k4.z - sa * a4.z); Sd = Sd * w4.w + (v2 * k4.w - sa * a4.w);
                *(LAS f32x2*)(ydst + s * ystep) = yy;
                w4 = w4n; k4 = k4n; c4 = c4n; a4 = a4n; r4 = r4n; v2 = v2n; sc2 = sc2n;
            }
            __syncthreads();
            {
                const int s = F.tid >> 4, i4 = (F.tid & 15) * 4; const int step = ch * RW_CS + s; const int t = d ? flip_tok(step) : step;
                const f32x4 yv = *(const LAS f32x4*)(ybuf + s * 64 + i4);
                *(GAS f32x4*)(YS + ((size_t)d * NTOK + (size_t)b * LTOK + t) * DM + h * 64 + i4) = yv; }
            if (ch + 1 < NCH) {
                LAS float* nb = opb + (cur ^ 1) * RW_CS * 384;
#pragma unroll
                for (int k = 0; k < 3; ++k) { LAS float* dst = nb + (size_t)(F.tid + 512 * k) * 8; const v4u w = pre[k];
                    *(LAS f32x4*)dst = (f32x4){bflo(w.x), bfhi(w.x), bflo(w.y), bfhi(w.y)}; *(LAS f32x4*)(dst + 4) = (f32x4){bflo(w.z), bfhi(w.z), bflo(w.w), bfhi(w.w)}; }
                if (F.tid < RW_CS * 2) scl[(cur ^ 1) * RW_CS * 2 + F.tid] = psc; }
            __syncthreads();
        }
    }
}
__device__ __forceinline__ void l0_cscan_phase(Frame& F, const float* k_k, const float* k_a, const float* r_k) {
    unsigned char* ws = F.ws; float* YS = (float*)(ws + L0_XS); float* BON = (float*)(ws + L0_BONUS);
    constexpr int PA = 72, PB = 40, NCH = LTOK / 16;
    LAS bf16* RAW = (LAS bf16*)(F.lds + RING_OFF);
    LAS bf16* Ah = RAW + 5 * 16 * PA; LAS bf16* Rh = Ah + 16 * PA; LAS bf16* Kh = Rh + 16 * PA; LAS bf16* Bh = Kh + 16 * PA;
    LAS bf16* KBt = Bh + 16 * PA;
    LAS bf16* VSt = KBt + 64 * PB;
    LAS bf16* LKp = VSt + 64 * PB;
    LAS bf16* UKB = LKp + 16 * PB;
    LAS bf16* Sb = UKB + 16 * PB;
    LAS float* LB = (LAS float*)(Sb + 64 * PA);
    LAS float* RH = LB + 16 * 20;
    LAS float* Wend = RH + 16 * 68;
    const int tid = F.tid, lane = F.lane, w = F.wave;
    for (int sidx = F.vcu; sidx < 256; sidx += F.G) {
        const int d = sidx >> 7, b = (sidx >> 5) & 3, h = sidx & 31;
        const GAS bf16* gR = (const GAS bf16*)(ws + L0_R) + (size_t)b * LTOK * DM + h * 64;
        const GAS bf16* gK = (const GAS bf16*)(ws + L0_K) + (size_t)b * LTOK * DM + h * 64;
        const GAS bf16* gV = (const GAS bf16*)(ws + L0_V) + (size_t)b * LTOK * DM + h * 64;
        const GAS bf16* gD = (const GAS bf16*)(ws + (d ? L0_DEC1 : L0_DEC0)) + (size_t)b * LTOK * DM + h * 64;
        const GAS bf16* gI = (const GAS bf16*)(ws + (d ? L0_IC1 : L0_IC0)) + (size_t)b * LTOK * DM + h * 64;
        const int ft = tid >> 5, fpart = tid & 31, fti = fpart >> 3, fc = (fpart & 7) * 8;
        const GAS bf16* fbase = fti == 0 ? gR : (fti == 1 ? gK : (fti == 2 ? gV : gD));
        const int t1 = tid >> 5, jp = tid & 31, j2 = 2 * jp;
        const f32x2 kk2 = *(const f32x2*)(k_k + h * 64 + j2), ka2 = *(const f32x2*)(k_a + h * 64 + j2), rk2 = *(const f32x2*)(r_k + h * 64 + j2);
        __syncthreads();
        for (int i = tid; i < 64 * PA / 2; i += 512) ((LAS unsigned*)Sb)[i] = 0u;
        for (int i = tid; i < 64 * PB / 2; i += 512) ((LAS unsigned*)VSt)[i] = 0u;
        for (int i = tid; i < 16 * PB / 2; i += 512) ((LAS unsigned*)LKp)[i] = 0u;
        pg8::f32x4 ST[2]; ST[0] = (pg8::f32x4){0.f, 0.f, 0.f, 0.f}; ST[1] = ST[0];
        v4u pa, pb = {0u, 0u, 0u, 0u};
#define CS_FETCH(chn) do { { const int step_ = (chn) * 16 + ft; const int tk_ = d ? flip_tok(step_) : step_; pa = *(const GAS v4u*)(fbase + (size_t)tk_ * DM + fc); } \
            if (tid < 128) { const int step_ = (chn) * 16 + (tid >> 3); const int tk_ = d ? flip_tok(step_) : step_; pb = *(const GAS v4u*)(gI + (size_t)tk_ * DM + (tid & 7) * 8); } } while (0)
        CS_FETCH(0);
        for (int ch = 0; ch < NCH; ++ch) {
            *(LAS v4u*)(RAW + (fti * 16 + ft) * PA + fc) = pa;
            if (tid < 128) *(LAS v4u*)(RAW + (4 * 16 + (tid >> 3)) * PA + (tid & 7) * 8) = pb;
            if (ch + 1 < NCH) CS_FETCH(ch + 1);
            LDS_BARRIER();
            {
                const unsigned rw = *(const LAS unsigned*)(RAW + (0 * 16 + t1) * PA + j2), kw = *(const LAS unsigned*)(RAW + (1 * 16 + t1) * PA + j2), vw = *(const LAS unsigned*)(RAW + (2 * 16 + t1) * PA + j2);
                const unsigned iw = *(const LAS unsigned*)(RAW + (4 * 16 + t1) * PA + j2);
                const f32x2 r = {bflo(rw), bfhi(rw)}, k = {bflo(kw), bfhi(kw)}, ic = {bflo(iw), bfhi(iw)};
                f32x2 kkv = k * kk2; float ss = kkv.x * kkv.x + kkv.y * kkv.y; ss = red16(ss); ss += __shfl_xor(ss, 16);
                kkv = kkv * (1.0f / sqrtf(ss + 1e-12f));
                const f32x2 kd = k * ((ic - 1.f) * ka2 + 1.f), kka = kkv * ic;
                float bon = r.x * kd.x * rk2.x + r.y * kd.y * rk2.y; bon = red16(bon); bon += __shfl_xor(bon, 16);
                const int step = ch * 16 + t1; const int tk = d ? flip_tok(step) : step;
                if (jp == 0) BON[((size_t)d * NTOK + (size_t)b * LTOK + tk) * 32 + h] = bon;
                f32x2 Wm = {1.f, 1.f};
#pragma unroll
                for (int u = 0; u < 15; ++u) { const unsigned dw = *(const LAS unsigned*)(RAW + (3 * 16 + u) * PA + j2); if (u < t1) { Wm.x *= bflo(dw); Wm.y *= bfhi(dw); } }
                const unsigned dwt = *(const LAS unsigned*)(RAW + (3 * 16 + t1) * PA + j2);
                const f32x2 Wt = {Wm.x * bflo(dwt), Wm.y * bfhi(dwt)}; const f32x2 iW = {__builtin_amdgcn_rcpf(Wt.x), __builtin_amdgcn_rcpf(Wt.y)};
                const f32x2 ah = kkv * Wm, bh = kka * iW, kh = kd * iW, rh = r * Wt;
                *(LAS unsigned*)(Ah + t1 * PA + j2) = pk2(ah.x, ah.y); *(LAS unsigned*)(Rh + t1 * PA + j2) = pk2(rh.x, rh.y);
                *(LAS unsigned*)(Kh + t1 * PA + j2) = pk2(kh.x, kh.y); *(LAS unsigned*)(Bh + t1 * PA + j2) = pk2(bh.x, bh.y);
                const unsigned khw = pk2(kh.x, kh.y), nbw = pk2(-bh.x, -bh.y);
                KBt[j2 * PB + t1] = (bf16)(khw & 0xffff); KBt[(j2 + 1) * PB + t1] = (bf16)(khw >> 16);
                KBt[j2 * PB + 16 + t1] = (bf16)(nbw & 0xffff); KBt[(j2 + 1) * PB + 16 + t1] = (bf16)(nbw >> 16);
                VSt[j2 * PB + t1] = (bf16)(vw & 0xffff); VSt[(j2 + 1) * PB + t1] = (bf16)(vw >> 16);
                if (t1 == 15) *(LAS f32x2*)(Wend + j2) = Wt;
            }
            LDS_BARRIER();
            pg8::f32x4 accg = {0.f, 0.f, 0.f, 0.f};
            const int tr = (lane >> 4) * 4, uc = lane & 15;
            if (w < 4) {
                pg8::f32x4 a = {0.f, 0.f, 0.f, 0.f};
                a = mma_tile(a, (w < 2) ? Ah : Rh, PA, (w == 0 || w == 3) ? Bh : Kh, PA, 2, lane);
#pragma unroll
                for (int r = 0; r < 4; ++r) { const int t = tr + r; const float x = a[r];
                    if (w == 0) LB[uc * 20 + t] = (uc < t) ? x : 0.f;
                    else if (w == 1) LKp[t * PB + uc] = f2bf((uc < t) ? x : 0.f);
                    else if (w == 2) UKB[t * PB + uc] = f2bf((uc <= t) ? x : 0.f);
                    else UKB[t * PB + 16 + uc] = f2bf((uc <= t) ? -x : 0.f); }
            } else accg = mma_tile(accg, Ah, PA, Sb + (w - 4) * 16 * PA, PA, 2, lane);
            LDS_BARRIER();
            pg8::f32x4 accy = {0.f, 0.f, 0.f, 0.f};
            if (w >= 4) { accg = mma_tile(accg, LKp, PB, VSt + (w - 4) * 16 * PB, PB, 1, lane);
#pragma unroll
                for (int r = 0; r < 4; ++r) RH[(tr + r) * 68 + (w - 4) * 16 + uc] = accg[r]; }
            else accy = mma_tile(accy, Rh, PA, Sb + w * 16 * PA, PA, 2, lane);
            LDS_BARRIER();
            if (w == 7) {
                float sg[16];
#pragma unroll
                for (int t = 0; t < 16; ++t) sg[t] = RH[t * 68 + lane];
#pragma unroll
                for (int u = 0; u < 15; ++u) {
#pragma unroll
                    for (int g4 = (u + 1) / 4; g4 < 4; ++g4) { const pg8::f32x4 l4 = *(const LAS pg8::f32x4*)(LB + u * 20 + g4 * 4);
#pragma unroll
                        for (int r = 0; r < 4; ++r) { const int t = g4 * 4 + r; if (t > u) sg[t] -= l4[r] * sg[u]; } } }
                v4u o; o.x = pk2(sg[0], sg[1]); o.y = pk2(sg[2], sg[3]); o.z = pk2(sg[4], sg[5]); o.w = pk2(sg[6], sg[7]); *(LAS v4u*)(VSt + lane * PB + 16) = o;
                o.x = pk2(sg[8], sg[9]); o.y = pk2(sg[10], sg[11]); o.z = pk2(sg[12], sg[13]); o.w = pk2(sg[14], sg[15]); *(LAS v4u*)(VSt + lane * PB + 24) = o;
            }
            LDS_BARRIER();
            if (w < 4) { accy = mma_tile(accy, UKB, PB, VSt + w * 16 * PB, PB, 1, lane);
#pragma unroll
                for (int r = 0; r < 4; ++r) { const int step = ch * 16 + tr + r; const int tk = d ? flip_tok(step) : step;
                    YS[((size_t)d * NTOK + (size_t)b * LTOK + tk) * DM + h * 64 + w * 16 + uc] = accy[r]; } }
            { const int jb = w >> 1; const pg8::f32x4 we = *(const LAS pg8::f32x4*)(Wend + jb * 16 + tr);
#pragma unroll
              for (int q = 0; q < 2; ++q) { const int ib = (w & 1) * 2 + q;
                  pg8::f32x4 a = mma_tile(ST[q], KBt + jb * 16 * PB, PB, VSt + ib * 16 * PB, PB, 1, lane);
                  a = a * we; ST[q] = a;
                  v2u sw; sw.x = pk2(a[0], a[1]); sw.y = pk2(a[2], a[3]);
                  *(LAS v2u*)(Sb + (ib * 16 + uc) * PA + jb * 16 + tr) = sw; } }
            LDS_BARRIER();
        }
#undef CS_FETCH
    }
}
__device__ __forceinline__ void l0_cscan2_phase(Frame& F, const float* k_k, const float* k_a, const float* r_k) {
    unsigned char* ws = F.ws; bf16* YS = (bf16*)(ws + L0_XS); float* BON = (float*)(ws + L0_BONUS);
    constexpr int PA = 72, PB = 40, NCH = LTOK / 16;
    constexpr int O_AH = 0, O_RH = 16 * PA, O_KH = 32 * PA, O_BH = 48 * PA, O_KBT = 64 * PA, O_VST = O_KBT + 64 * PB, O_LKP = O_VST + 64 * PB, O_UKB = O_LKP + 16 * PB, SETSZ = O_UKB + 16 * PB;
    static_assert(SETSZ % 8 == 0, "set size keeps 16-byte alignment");
    constexpr int FSZ = 320 + 16 * 64;
    LAS bf16* SET = (LAS bf16*)(F.lds + RING_OFF);
    LAS bf16* RAW = SET + 2 * SETSZ;
    LAS bf16* Sb = RAW + 4 * 16 * PA;
    LAS float* FSET = (LAS float*)(Sb + 64 * PA);
    LAS float* RH = FSET + 2 * FSZ;
    const int tid = F.tid, lane = F.lane, w = F.wave;
    const int tr = (lane >> 4) * 4, uc = lane & 15;
    for (int sidx = F.vcu; sidx < 256; sidx += F.G) {
        const int d = sidx >> 7, b = (sidx >> 5) & 3, h = sidx & 31;
        const GAS bf16* gR = (const GAS bf16*)(ws + L0_R) + (size_t)b * LTOK * DM + h * 64;
        const GAS bf16* gK = (const GAS bf16*)(ws + L0_K) + (size_t)b * LTOK * DM + h * 64;
        const GAS bf16* gV = (const GAS bf16*)(ws + L0_V) + (size_t)b * LTOK * DM + h * 64;
        const GAS bf16* gD = (const GAS bf16*)(ws + (d ? L0_DEC1 : L0_DEC0)) + (size_t)b * LTOK * DM + h * 64;
        const GAS bf16* gI = (const GAS bf16*)(ws + (d ? L0_IC1 : L0_IC0)) + (size_t)b * LTOK * DM + h * 64;
        const int ft = tid >> 5, fpart = tid & 31, fti = fpart >> 3, fc = (fpart & 7) * 8;
        const GAS bf16* fbase = fti == 0 ? gR : (fti == 1 ? gK : (fti == 2 ? gV : gI));
        const int t1 = (tid >> 4) & 15, j4 = (tid & 15) * 4;
        const f32x4 kk4 = *(const f32x4*)(k_k + h * 64 + j4), ka4 = *(const f32x4*)(k_a + h * 64 + j4), rk4 = *(const f32x4*)(r_k + h * 64 + j4);
        __syncthreads();
        for (int i = tid; i < 64 * PA / 2; i += 512) ((LAS unsigned*)Sb)[i] = 0u;
        for (int i = tid; i < 2 * SETSZ / 2; i += 512) ((LAS unsigned*)SET)[i] = 0u;
        pg8::f32x4 ST[2]; ST[0] = (pg8::f32x4){0.f, 0.f, 0.f, 0.f}; ST[1] = ST[0];
        v4u pa; bf16 dq[16];
#define CS_FETCH(chn) do { { const int step_ = (chn) * 16 + ft; const int tk_ = d ? flip_tok(step_) : step_; pa = *(const GAS v4u*)(fbase + (size_t)tk_ * DM + fc); } \
            if (w == 4) { _Pragma("unroll") for (int t_ = 0; t_ < 16; ++t_) { const int step_ = (chn) * 16 + t_; const int tk_ = d ? flip_tok(step_) : step_; dq[t_] = gD[(size_t)tk_ * DM + lane]; } } } while (0)
#define CS_RAWWRITE(st) do { *(LAS v4u*)(RAW + (fti * 16 + ft) * PA + fc) = pa; \
            if (w == 4) { float W_ = 1.f; LAS float* wc_ = FSET + (st) * FSZ + 320 + lane; _Pragma("unroll") for (int t_ = 0; t_ < 16; ++t_) { W_ *= bf2f(dq[t_]); wc_[t_ * 64] = W_; } } } while (0)
#define CS_STEP1(chn, st) do { LAS bf16* S_ = SET + (st) * SETSZ; const LAS float* wc_ = FSET + (st) * FSZ + 320; \
            const v2u rw = *(const LAS v2u*)(RAW + (0 * 16 + t1) * PA + j4), kw = *(const LAS v2u*)(RAW + (1 * 16 + t1) * PA + j4), vw = *(const LAS v2u*)(RAW + (2 * 16 + t1) * PA + j4), iw = *(const LAS v2u*)(RAW + (3 * 16 + t1) * PA + j4); \
            const f32x4 r = {bflo(rw.x), bfhi(rw.x), bflo(rw.y), bfhi(rw.y)}, k = {bflo(kw.x), bfhi(kw.x), bflo(kw.y), bfhi(kw.y)}, ic = {bflo(iw.x), bfhi(iw.x), bflo(iw.y), bfhi(iw.y)}; \
            const f32x4 Wt = *(const LAS f32x4*)(wc_ + t1 * 64 + j4); f32x4 Wm = {1.f, 1.f, 1.f, 1.f}; if (t1 > 0) Wm = *(const LAS f32x4*)(wc_ + (t1 - 1) * 64 + j4); \
            f32x4 kkv = k * kk4; float ss = (kkv.x * kkv.x + kkv.y * kkv.y) + (kkv.z * kkv.z + kkv.w * kkv.w); \
            const f32x4 kd = k * ((ic - 1.f) * ka4 + 1.f); const f32x4 bt = r * kd * rk4; float bon = (bt.x + bt.y) + (bt.z + bt.w); \
            ss = red16(ss); bon = red16(bon); \
            kkv = kkv * __builtin_amdgcn_rsqf(ss + 1e-12f); const f32x4 kka = kkv * ic; \
            const int step = (chn) * 16 + t1; const int tk = d ? flip_tok(step) : step; \
            if ((tid & 15) == 0) BON[((size_t)d * NTOK + (size_t)b * LTOK + tk) * 32 + h] = bon; \
            const f32x4 iW = {__builtin_amdgcn_rcpf(Wt.x), __builtin_amdgcn_rcpf(Wt.y), __builtin_amdgcn_rcpf(Wt.z), __builtin_amdgcn_rcpf(Wt.w)}; \
            const f32x4 ah = kkv * Wm, bh = kka * iW, kh = kd * iW, rh = r * Wt; \
            v2u o_; o_.x = pk2(ah.x, ah.y); o_.y = pk2(ah.z, ah.w); *(LAS v2u*)(S_ + O_AH + t1 * PA + j4) = o_; \
            o_.x = pk2(rh.x, rh.y); o_.y = pk2(rh.z, rh.w); *(LAS v2u*)(S_ + O_RH + t1 * PA + j4) = o_; \
            v2u kh_; kh_.x = pk2(kh.x, kh.y); kh_.y = pk2(kh.z, kh.w); *(LAS v2u*)(S_ + O_KH + t1 * PA + j4) = kh_; \
            o_.x = pk2(bh.x, bh.y); o_.y = pk2(bh.z, bh.w); *(LAS v2u*)(S_ + O_BH + t1 * PA + j4) = o_; \
            v2u nb_; nb_.x = pk2(-bh.x, -bh.y); nb_.y = pk2(-bh.z, -bh.w); \
            LAS bf16* kb_ = S_ + O_KBT + j4 * PB + t1; LAS bf16* vs_ = S_ + O_VST + j4 * PB + t1; \
            kb_[0] = (bf16)(kh_.x & 0xffff); kb_[PB] = (bf16)(kh_.x >> 16); kb_[2 * PB] = (bf16)(kh_.y & 0xffff); kb_[3 * PB] = (bf16)(kh_.y >> 16); \
            kb_[16] = (bf16)(nb_.x & 0xffff); kb_[PB + 16] = (bf16)(nb_.x >> 16); kb_[2 * PB + 16] = (bf16)(nb_.y & 0xffff); kb_[3 * PB + 16] = (bf16)(nb_.y >> 16); \
            vs_[0] = (bf16)(vw.x & 0xffff); vs_[PB] = (bf16)(vw.x >> 16); vs_[2 * PB] = (bf16)(vw.y & 0xffff); vs_[3 * PB] = (bf16)(vw.y >> 16); } while (0)
#define CS_STEP2(wq, st) do { LAS bf16* S_ = SET + (st) * SETSZ; LAS float* LB_ = FSET + (st) * FSZ; pg8::f32x4 a = {0.f, 0.f, 0.f, 0.f}; \
            a = mma_tile(a, S_ + (((wq) < 2) ? O_AH : O_RH), PA, S_ + (((wq) == 0 || (wq) == 3) ? O_BH : O_KH), PA, 2, lane); \
            _Pragma("unroll") for (int r = 0; r < 4; ++r) { const int t = tr + r; const float x = a[r]; \
                if ((wq) == 0) LB_[uc * 20 + t] = (uc < t) ? x : 0.f; \
                else if ((wq) == 1) S_[O_LKP + t * PB + uc] = f2bf((uc < t) ? x : 0.f); \
                else if ((wq) == 2) S_[O_UKB + t * PB + uc] = f2bf((uc <= t) ? x : 0.f); \
                else S_[O_UKB + t * PB + 16 + uc] = f2bf((uc <= t) ? -x : 0.f); } } while (0)
        CS_FETCH(0); CS_RAWWRITE(0); CS_FETCH(1);
        LDS_BARRIER();
        if (w < 4) CS_STEP1(0, 0);
        LDS_BARRIER();
        if (w < 4) CS_STEP2(w, 0);
        LDS_BARRIER();
        asm volatile("" : "+v"(pa));
        for (int ch = 0; ch < NCH; ++ch) {
            const int cur = ch & 1, nxt = cur ^ 1; LAS bf16* C_ = SET + cur * SETSZ; LAS float* FC_ = FSET + cur * FSZ;
            if (ch + 1 < NCH) { CS_RAWWRITE(nxt); if (ch + 2 < NCH) CS_FETCH(ch + 2); }
            pg8::f32x4 accy = {0.f, 0.f, 0.f, 0.f};
            if (w >= 4) { pg8::f32x4 accg = {0.f, 0.f, 0.f, 0.f};
                accg = mma_tile(accg, C_ + O_AH, PA, Sb + (w - 4) * 16 * PA, PA, 2, lane);
                accg = mma_tile(accg, C_ + O_LKP, PB, C_ + O_VST + (w - 4) * 16 * PB, PB, 1, lane);
#pragma unroll
                for (int r = 0; r < 4; ++r) RH[(tr + r) * 68 + (w - 4) * 16 + uc] = accg[r]; }
            else accy = mma_tile(accy, C_ + O_RH, PA, Sb + w * 16 * PA, PA, 2, lane);
            LDS_BARRIER();
            if (w == 7) {
                float sg[16];
#pragma unroll
                for (int t = 0; t < 16; ++t) sg[t] = RH[t * 68 + lane];
#pragma unroll
                for (int u = 0; u < 15; ++u) {
#pragma unroll
                    for (int g4 = (u + 1) / 4; g4 < 4; ++g4) { const pg8::f32x4 l4 = *(const LAS pg8::f32x4*)(FC_ + u * 20 + g4 * 4);
#pragma unroll
                        for (int r = 0; r < 4; ++r) { const int t = g4 * 4 + r; if (t > u) sg[t] -= l4[r] * sg[u]; } } }
                v4u o; o.x = pk2(sg[0], sg[1]); o.y = pk2(sg[2], sg[3]); o.z = pk2(sg[4], sg[5]); o.w = pk2(sg[6], sg[7]); *(LAS v4u*)(C_ + O_VST + lane * PB + 16) = o;
                o.x = pk2(sg[8], sg[9]); o.y = pk2(sg[10], sg[11]); o.z = pk2(sg[12], sg[13]); o.w = pk2(sg[14], sg[15]); *(LAS v4u*)(C_ + O_VST + lane * PB + 24) = o;
            } else if (w < 4 && ch + 1 < NCH) CS_STEP1(ch + 1, nxt);
            LDS_BARRIER();
            { const int jb = w >> 1, ib0 = (w & 1) * 2; const pg8::f32x4 we = *(const LAS pg8::f32x4*)(FC_ + 320 + 15 * 64 + jb * 16 + tr);
              if (w < 4) accy = mma_tile(accy, C_ + O_UKB, PB, C_ + O_VST + w * 16 * PB, PB, 1, lane);
              pg8::f32x4 a0 = mma_tile(ST[0], C_ + O_KBT + jb * 16 * PB, PB, C_ + O_VST + ib0 * 16 * PB, PB, 1, lane);
              pg8::f32x4 a1 = mma_tile(ST[1], C_ + O_KBT + jb * 16 * PB, PB, C_ + O_VST + (ib0 + 1) * 16 * PB, PB, 1, lane);
              pg8::f32x4 a2 = {0.f, 0.f, 0.f, 0.f}; const int wq = w - 4; LAS bf16* N_ = SET + nxt * SETSZ; LAS float* LBn = FSET + nxt * FSZ;
              const bool do2 = (w >= 4 && ch + 1 < NCH);
              if (do2) a2 = mma_tile(a2, N_ + ((wq < 2) ? O_AH : O_RH), PA, N_ + ((wq == 0 || wq == 3) ? O_BH : O_KH), PA, 2, lane);
              a0 = a0 * we; a1 = a1 * we; ST[0] = a0; ST[1] = a1;
              asm volatile("" : "+v"(pa));
              if (w < 4) {
#pragma unroll
                  for (int r = 0; r < 4; ++r) { const int step = ch * 16 + tr + r; const int tk = d ? flip_tok(step) : step;
                      YS[((size_t)d * NTOK + (size_t)b * LTOK + tk) * DM + h * 64 + w * 16 + uc] = f2bf(accy[r]); } }
              v2u sw; sw.x = pk2(a0[0], a0[1]); sw.y = pk2(a0[2], a0[3]); *(LAS v2u*)(Sb + (ib0 * 16 + uc) * PA + jb * 16 + tr) = sw;
              sw.x = pk2(a1[0], a1[1]); sw.y = pk2(a1[2], a1[3]); *(LAS v2u*)(Sb + ((ib0 + 1) * 16 + uc) * PA + jb * 16 + tr) = sw;
              if (do2) {
#pragma unroll
                  for (int r = 0; r < 4; ++r) { const int t = tr + r; const float x = a2[r];
                      if (wq == 0) LBn[uc * 20 + t] = (uc < t) ? x : 0.f;
                      else if (wq == 1) N_[O_LKP + t * PB + uc] = f2bf((uc < t) ? x : 0.f);
                      else if (wq == 2) N_[O_UKB + t * PB + uc] = f2bf((uc <= t) ? x : 0.f);
                      else N_[O_UKB + t * PB + 16 + uc] = f2bf((uc <= t) ? -x : 0.f); } } }
            LDS_BARRIER();
        }
#undef CS_FETCH
#undef CS_RAWWRITE
#undef CS_STEP1
#undef CS_STEP2
    }
}
__device__ __forceinline__ void l0_post_phase(Frame& F, const float* gn_g, const float* gn_b) {
    const int gw = GW(F), NGWv = NGW(F); unsigned char* ws = F.ws;
    const bf16* YS = (const bf16*)(ws + L0_XS); const bf16* V = (const bf16*)(ws + L0_V); const bf16* G = (const bf16*)(ws + L0_G); const float* BONUS = (const float*)(ws + L0_BONUS);
    bf16* OUTB = (bf16*)(ws + WS_OUTB); const int l8 = F.lane & 7;
    const int hh = (gw & 3) * 8 + (F.lane >> 3), c0 = hh * 64 + l8 * 8;
    float gg[8], gb[8]; ld8f(gn_g + c0, gg); ld8f(gn_b + c0, gb);
    constexpr int UB = 3;
    for (int it0 = gw; it0 < NTOK * 4; it0 += UB * NGWv) {
        v4u wya[UB], wyb[UB], wv[UB], wg[UB]; float b0[UB], b1[UB];
#pragma unroll
        for (int u = 0; u < UB; ++u) { const int it = it0 + u * NGWv; if (it < NTOK * 4) { const int m = it >> 2; const size_t e = (size_t)m * DM + c0;
            wya[u] = *(const GAS v4u*)(YS + e); wyb[u] = *(const GAS v4u*)(YS + (size_t)NTOK * DM + e); wv[u] = *(const GAS v4u*)(V + e); wg[u] = *(const GAS v4u*)(G + e);
            b0[u] = *(const GAS float*)(BONUS + m * 32 + hh); b1[u] = *(const GAS float*)(BONUS + (size_t)NTOK * 32 + m * 32 + hh); } }
#pragma unroll
        for (int u = 0; u < UB; ++u) { const int it = it0 + u * NGWv; if (it < NTOK * 4) { const int m = it >> 2; const size_t e = (size_t)m * DM + c0;
            float y[8], y2[8], v[8], g[8];
            { float ya[8], yb[8]; unpack8(wya[u], ya); unpack8(wyb[u], yb);
#pragma unroll
              for (int j = 0; j < 8; ++j) y[j] = ya[j] + yb[j]; }
            unpack8(wv[u], v); unpack8(wg[u], g);
            float s = 0.f;
#pragma unroll
            for (int j = 0; j < 8; ++j) s += y[j];
            const float mean = red8(s) * (1.f / 64.f); float q2 = 0.f;
#pragma unroll
            for (int j = 0; j < 8; ++j) { y[j] -= mean; q2 += y[j] * y[j]; }
            const float rstd = 1.0f / sqrtf(red8(q2) * (1.f / 64.f) + 64e-5f);
            const float bon = b0[u] + b1[u];
#pragma unroll
            for (int j = 0; j < 8; ++j) y2[j] = ((y[j] * rstd) * gg[j] + gb[j] + bon * v[j]) * g[j];
            *(GAS v4u*)(OUTB + e) = pack8(y2); } }
    }
}

__device__ __forceinline__ void l1_rope_phase(Frame& F) {
    bf16* QKV = (bf16*)(F.ws + L1_QKV); const float* RT = (const float*)(F.ws + WS_ROPE);
    const size_t total = (size_t)NLAT * 256; const size_t stride = (size_t)F.G * 512;
    for (size_t it = (size_t)F.vcu * 512 + F.tid; it < total; it += stride) {
        const int idx = (int)(it >> 8), sub = (int)(it & 255); const int hd = sub >> 3, ax = (sub >> 2) & 1, g8 = sub & 3;
        const int b = idx >> 11, t = NCTX + (idx & 2047); const size_t m = (size_t)b * LTOK + t;
        bf16* pa = QKV + m * 6144 + hd * 128 + ax * 64 + g8 * 8; bf16* pb = pa + 32;
        const v4u wa = *(const GAS v4u*)pa, wb = *(const GAS v4u*)pb;
        const float* cs = RT + ((size_t)t * 64 + ax * 32 + g8 * 8) * 2;
        float a[8] = {bflo(wa.x), bfhi(wa.x), bflo(wa.y), bfhi(wa.y), bflo(wa.z), bfhi(wa.z), bflo(wa.w), bfhi(wa.w)};
        float bb[8] = {bflo(wb.x), bfhi(wb.x), bflo(wb.y), bfhi(wb.y), bflo(wb.z), bfhi(wb.z), bflo(wb.w), bfhi(wb.w)};
        float oa[8], ob[8];
#pragma unroll
        for (int j = 0; j < 8; ++j) { const f32x2 c = *(const GAS f32x2*)(cs + 2 * j); oa[j] = a[j] * c.x - bb[j] * c.y; ob[j] = bb[j] * c.x + a[j] * c.y; }
        v4u w; w.x = pk2(oa[0], oa[1]); w.y = pk2(oa[2], oa[3]); w.z = pk2(oa[4], oa[5]); w.w = pk2(oa[6], oa[7]); *(GAS v4u*)pa = w;
        w.x = pk2(ob[0], ob[1]); w.y = pk2(ob[2], ob[3]); w.z = pk2(ob[4], ob[5]); w.w = pk2(ob[6], ob[7]); *(GAS v4u*)pb = w;
    }
}
__device__ __forceinline__ void l1_attn_phase(Frame& F, char* lds_generic) {
    const att::bf16* QKV = (const att::bf16*)(F.ws + L1_QKV); bf16* O = (bf16*)(F.ws + L1_O);
    constexpr int NLONG = NB * 16 * 2 * 8, NSHORT = NB * 16 * 2;
    for (int u = F.vcu; u < NLONG + NSHORT; u += F.G) {
        int b, hm, vh, qb, seq;
        if (u < NLONG) { qb = 1 + (u & 7); vh = (u >> 3) & 1; hm = (u >> 4) & 15; b = u >> 8; seq = LTOK; }
        else { const int v = u - NLONG; qb = 0; vh = v & 1; hm = (v >> 1) & 15; b = v >> 5; seq = NCTX; }
        const size_t m0 = (size_t)b * LTOK + (size_t)qb * 256, k0 = (size_t)b * LTOK;
        att::attn_dense_body<att::bf16>(QKV + m0 * 6144 + hm * 128, QKV + k0 * 6144 + 2048 + hm * 128, QKV + k0 * 6144 + 4096 + (hm >> 1) * 256 + vh * 128,
                                        O + m0 * 4096 + hm * 256 + vh * 128, seq, lds_generic);
        __syncthreads();
    }
}
__device__ __forceinline__ void l1_combine_phase(Frame& F, const float* lam_vec, const float* sub_g) {
    const int gw = GW(F), NGWv = NGW(F); const bf16* O = (const bf16*)(F.ws + L1_O); bf16* OUTB = (bf16*)(F.ws + WS_OUTB);
    float d01 = 0.f, d23 = 0.f;
    for (int i = F.lane; i < 128; i += 64) { d01 += lam_vec[i] * lam_vec[128 + i]; d23 += lam_vec[256 + i] * lam_vec[384 + i]; }
    const float lam_init = 0.8f - 0.6f * expf(-0.3f * 1.0f);
    const float lam = expf(wave_sum(d01)) - expf(wave_sum(d23)) + lam_init;
    const int l32 = F.lane & 31, hs = F.lane >> 5;
    float sg[8]; ld8f(sub_g + 8 * l32, sg);
    constexpr int UB = 3;
    for (int it0 = gw; it0 < NTOK * 4; it0 += UB * NGWv) {
        v4u w1[UB], w2[UB];
#pragma unroll
        for (int u = 0; u < UB; ++u) { const int it = it0 + u * NGWv; if (it < NTOK * 4) { const int m = it >> 2, h = (it & 3) * 2 + hs; const GAS bf16* op = (const GAS bf16*)O + (size_t)m * 4096 + h * 512 + 8 * l32;
            w1[u] = *(const GAS v4u*)op; w2[u] = *(const GAS v4u*)(op + 256); } }
#pragma unroll
        for (int u = 0; u < UB; ++u) { const int it = it0 + u * NGWv; if (it < NTOK * 4) { const int m = it >> 2, h = (it & 3) * 2 + hs;
            float o1[8], o2[8], o[8]; unpack8(w1[u], o1); unpack8(w2[u], o2); float ss = 0.f;
#pragma unroll
            for (int j = 0; j < 8; ++j) { o[j] = o1[j] - o2[j] * lam; ss += o[j] * o[j]; }
            ss = red16(ss); ss += __shfl_xor(ss, 16);
            const float rs = (1.0f / sqrtf(ss * (1.f / 256.f) + 1e-5f)) * (1.f - lam_init);
#pragma unroll
            for (int j = 0; j < 8; ++j) o[j] = o[j] * rs * sg[j];
            *(GAS v4u*)(OUTB + (size_t)m * DM + h * 256 + 8 * l32) = pack8(o); } }
    }
}

__device__ __forceinline__ void l2_gla_phase(Frame& F) {
    unsigned char* ws = F.ws; const bf16* HGO = (const bf16*)(ws + L2_HGO); bf16* OG = (bf16*)(ws + L2_OG);
    constexpr int PK = 136, PS = 72;
    LAS bf16* QR = (LAS bf16*)(F.lds + RING_OFF);
    LAS bf16* KR = QR + 64 * PK;
    LAS bf16* VR = KR + 64 * PK;
    LAS bf16* QD = QR; LAS bf16* KD = KR;
    LAS bf16* KEt = VR + 64 * PS;
    LAS bf16* Vt = KEt + 128 * PS;
    LAS bf16* Pm = Vt + 64 * PS;
    LAS bf16* St = Pm + 64 * PS;
    LAS float* tot = (LAS float*)(St + 64 * PK);
    LAS float* dec = tot + 8 * 128;
    const int lane = F.lane, w = F.wave, tid = F.tid;
    constexpr int NCHK = LTOK / 64;
    for (int u = F.vcu; u < 256; u += F.G) {
        const int vh = u & 1, h = (u >> 1) & 15, b = (u >> 5) & 3, d = u >> 7;
        pg8::f32x4 S4[4];
#pragma unroll
        for (int vb = 0; vb < 4; ++vb) S4[vb] = (pg8::f32x4){0.f, 0.f, 0.f, 0.f};
        v4u rq[2], rk[2], rv;
        const GAS bf16* hb = (const GAS bf16*)HGO + (size_t)b * LTOK * 10240;
#define GLA_FETCH(chn) do { \
            _Pragma("unroll") for (int k_ = 0; k_ < 2; ++k_) { const int id_ = tid + 512 * k_, s_ = id_ >> 4, c16_ = id_ & 15; const int step_ = (chn) * 64 + s_; const int t_ = d ? flip_tok(step_) : step_; \
                rq[k_] = *(const GAS v4u*)(hb + (size_t)t_ * 10240 + h * 128 + c16_ * 8); rk[k_] = *(const GAS v4u*)(hb + (size_t)t_ * 10240 + (3 + d) * DM + h * 128 + c16_ * 8); } \
            { const int s_ = tid >> 3, c16_ = tid & 7; const int step_ = (chn) * 64 + s_; const int t_ = d ? flip_tok(step_) : step_; rv = *(const GAS v4u*)(hb + (size_t)t_ * 10240 + DM + h * 128 + vh * 64 + c16_ * 8); } } while (0)
        GLA_FETCH(0);
        asm volatile("" : "+v"(rq[0]), "+v"(rq[1]), "+v"(rk[0]), "+v"(rk[1]), "+v"(rv));
        for (int ch = 0; ch < NCHK; ++ch) {
            LDS_BARRIER();
#pragma unroll
            for (int k = 0; k < 2; ++k) { const int id = tid + 512 * k, s = id >> 4, c16 = id & 15; *(LAS v4u*)(QR + s * PK + c16 * 8) = rq[k]; *(LAS v4u*)(KR + s * PK + c16 * 8) = rk[k]; }
            *(LAS v4u*)(VR + (tid >> 3) * PS + (tid & 7) * 8) = rv;
            if (ch + 1 < NCHK) GLA_FETCH(ch + 1);
            LDS_BARRIER();
            const int cp = tid & 63, sg = tid >> 6, c = 2 * cp;
            float k0[8], k1[8], b0[8], b1[8]; float run0 = 0.f, run1 = 0.f;
#pragma unroll
            for (int s = 0; s < 8; ++s) { const unsigned kw = *(const LAS unsigned*)(KR + (sg * 8 + s) * PK + c); k0[s] = bflo(kw); k1[s] = bfhi(kw);
                run0 += __logf(1.f - k0[s]); run1 += __logf(1.f - k1[s]); b0[s] = run0; b1[s] = run1; }
            *(LAS f32x2*)(tot + sg * 128 + c) = (f32x2){run0, run1};
            { const int v = tid & 63, s8 = (tid >> 6) * 8; unsigned short e[8];
#pragma unroll
              for (int s = 0; s < 8; ++s) e[s] = VR[(s8 + s) * PS + v];
              v4u o; o.x = e[0] | ((unsigned)e[1] << 16); o.y = e[2] | ((unsigned)e[3] << 16); o.z = e[4] | ((unsigned)e[5] << 16); o.w = e[6] | ((unsigned)e[7] << 16);
              *(LAS v4u*)(Vt + v * PS + s8) = o; }
#pragma unroll
            for (int vb = 0; vb < 4; ++vb) { v2u sw; sw.x = pk2(S4[vb][0], S4[vb][1]); sw.y = pk2(S4[vb][2], S4[vb][3]);
                *(LAS v2u*)(St + (vb * 16 + (lane & 15)) * PK + 16 * w + (lane >> 4) * 4) = sw; }
            LDS_BARRIER();
            float off0 = 0.f, off1 = 0.f, bend0 = 0.f, bend1 = 0.f;
#pragma unroll
            for (int g = 0; g < 8; ++g) { const f32x2 tg = *(const LAS f32x2*)(tot + g * 128 + c); if (g < sg) { off0 += tg.x; off1 += tg.y; } bend0 += tg.x; bend1 += tg.y; }
            if (sg == 0) *(LAS f32x2*)(dec + c) = (f32x2){__expf(bend0), __expf(bend1)};
            { const float eb0 = __expf(bend0), eb1 = __expf(bend1); float ke0[8], ke1[8];
#pragma unroll
              for (int s = 0; s < 8; ++s) { const int st = sg * 8 + s; const float e0 = __expf(off0 + b0[s]), e1 = __expf(off1 + b1[s]); const float i0 = __builtin_amdgcn_rcpf(e0), i1 = __builtin_amdgcn_rcpf(e1);
                  const unsigned qw = *(const LAS unsigned*)(QR + st * PK + c);
                  *(LAS unsigned*)(QD + st * PK + c) = pk2(bflo(qw) * e0, bfhi(qw) * e1);
                  const float kd0 = k0[s] * i0, kd1 = k1[s] * i1;
                  *(LAS unsigned*)(KD + st * PK + c) = pk2(kd0, kd1); ke0[s] = kd0 * eb0; ke1[s] = kd1 * eb1; }
              v4u o; o.x = pk2(ke0[0], ke0[1]); o.y = pk2(ke0[2], ke0[3]); o.z = pk2(ke0[4], ke0[5]); o.w = pk2(ke0[6], ke0[7]); *(LAS v4u*)(KEt + c * PS + sg * 8) = o;
              o.x = pk2(ke1[0], ke1[1]); o.y = pk2(ke1[2], ke1[3]); o.z = pk2(ke1[4], ke1[5]); o.w = pk2(ke1[6], ke1[7]); *(LAS v4u*)(KEt + (c + 1) * PS + sg * 8) = o; }
            LDS_BARRIER();
            { const int tb = w >> 1;
#pragma unroll
              for (int q2 = 0; q2 < 2; ++q2) { const int sb = (w & 1) * 2 + q2; pg8::f32x4 a = {0.f, 0.f, 0.f, 0.f};
                  if (sb <= tb) a = mma_tile(a, QD + tb * 16 * PK, PK, KD + sb * 16 * PK, PK, 4, lane);
#pragma unroll
                  for (int j = 0; j < 4; ++j) { const int tt = tb * 16 + (lane >> 4) * 4 + j, ss = sb * 16 + (lane & 15); Pm[tt * PS + ss] = f2bf(ss <= tt ? a[j] : 0.f); } } }
            LDS_BARRIER();
            asm volatile("" : "+v"(rq[0]), "+v"(rq[1]), "+v"(rk[0]), "+v"(rk[1]), "+v"(rv));
            { const int tb = w >> 1;
#pragma unroll
              for (int q2 = 0; q2 < 2; ++q2) { const int vb = (w & 1) * 2 + q2; pg8::f32x4 a = {0.f, 0.f, 0.f, 0.f};
                  a = mma_tile(a, Pm + tb * 16 * PS, PS, Vt + vb * 16 * PS, PS, 2, lane);
                  a = mma_tile(a, QD + tb * 16 * PK, PK, St + vb * 16 * PK, PK, 4, lane);
#pragma unroll
                  for (int j = 0; j < 4; ++j) { const int s = tb * 16 + (lane >> 4) * 4 + j; const int step = ch * 64 + s; const int t = d ? flip_tok(step) : step;
                      OG[((size_t)d * NTOK + (size_t)b * LTOK + t) * DM + h * 128 + vh * 64 + vb * 16 + (lane & 15)] = f2bf(a[j]); } } }
#pragma unroll
            for (int vb = 0; vb < 4; ++vb) { pg8::f32x4 a = S4[vb];
#pragma unroll
                for (int j = 0; j < 4; ++j) a[j] *= dec[16 * w + (lane >> 4) * 4 + j];
                S4[vb] = mma_tile(a, KEt + 16 * w * PS, PS, Vt + vb * 16 * PS, PS, 2, lane); }
        }
#undef GLA_FETCH
    }
}
__device__ __forceinline__ void l2_combine_phase(Frame& F, const float* norm_g) {
    const int gw = GW(F), NGWv = NGW(F); const bf16* OG = (const bf16*)(F.ws + L2_OG); const bf16* HGO = (const bf16*)(F.ws + L2_HGO); bf16* OUTB = (bf16*)(F.ws + WS_OUTB);
    const int l16 = F.lane & 15, hq = F.lane >> 4;
    float ng[8]; ld8f(norm_g + 8 * l16, ng);
    constexpr int UB = 3;
    for (int it0 = gw; it0 < NTOK * 4; it0 += UB * NGWv) {
        v4u wa[UB], wb[UB], wg[UB];
#pragma unroll
        for (int u = 0; u < UB; ++u) { const int it = it0 + u * NGWv; if (it < NTOK * 4) { const int m = it >> 2, col = ((it & 3) * 4 + hq) * 128 + 8 * l16; const size_t e = (size_t)m * DM + col;
            wa[u] = *(const GAS v4u*)(OG + e); wb[u] = *(const GAS v4u*)(OG + (size_t)NTOK * DM + e); wg[u] = *(const GAS v4u*)(HGO + (size_t)m * 10240 + 2 * DM + col); } }
#pragma unroll
        for (int u = 0; u < UB; ++u) { const int it = it0 + u * NGWv; if (it < NTOK * 4) { const int m = it >> 2, col = ((it & 3) * 4 + hq) * 128 + 8 * l16;
            float oa[8], ob[8], g[8], o[8]; unpack8(wa[u], oa); unpack8(wb[u], ob); unpack8(wg[u], g); float ss = 0.f;
#pragma unroll
            for (int j = 0; j < 8; ++j) { o[j] = oa[j] + ob[j]; ss += o[j] * o[j]; }
            ss = red16(ss);
            const float rs = 1.0f / sqrtf(ss * (1.f / 128.f) + 1e-5f);
#pragma unroll
            for (int j = 0; j < 8; ++j) o[j] = o[j] * rs * ng[j] * g[j];
            *(GAS v4u*)(OUTB + (size_t)m * DM + col) = pack8(o); } }
    }
}

__device__ __forceinline__ void l3_conv_phase(Frame& F, const float* cw, const float* cb) {
    const int gw = GW(F), NGWv = NGW(F); const bf16* IN = (const bf16*)(F.ws + L3_IN) + DM; bf16* XB = (bf16*)(F.ws + L3_XB);
    const int c0 = (gw & 3) * 512 + F.lane * 8;
    float wk[4][8], bk[8];
#pragma unroll
    for (int k = 0; k < 4; ++k) ld8f(cw + (size_t)k * DM + c0, wk[k]);
    ld8f(cb + c0, bk);
    for (int it = gw; it < (NTOK / 16) * 4; it += NGWv) {
        const int strip = it >> 2; const int m0 = strip * 16, t0 = m0 % LTOK;
        const int seg_end = (t0 < NCTX) ? NCTX : LTOK; const bool first_in_seg = (t0 == 0 || t0 == NCTX);
        const GAS bf16* xg = (const GAS bf16*)IN + (size_t)m0 * 4096 + c0;
        v4u xr[19];
#pragma unroll
        for (int q = 0; q < 19; ++q) { const bool ok = (q == 0) ? !first_in_seg : (t0 + q - 1 < seg_end);
            xr[q] = (v4u){0u, 0u, 0u, 0u}; if (ok) xr[q] = *(const GAS v4u*)(xg + (ptrdiff_t)(q - 1) * 4096); }
#pragma unroll
        for (int r = 0; r < 16; ++r) {
            const v4u x0 = xr[r], x1 = xr[r + 1], x2 = xr[r + 2], x3 = xr[r + 3];
            float o[8];
#pragma unroll
            for (int q = 0; q < 4; ++q) {
                o[2 * q] = bk[2 * q] + wk[0][2 * q] * bflo(x0[q]) + wk[1][2 * q] * bflo(x1[q]) + wk[2][2 * q] * bflo(x2[q]) + wk[3][2 * q] * bflo(x3[q]);
                o[2 * q + 1] = bk[2 * q + 1] + wk[0][2 * q + 1] * bfhi(x0[q]) + wk[1][2 * q + 1] * bfhi(x1[q]) + wk[2][2 * q + 1] * bfhi(x2[q]) + wk[3][2 * q + 1] * bfhi(x3[q]); }
            *(GAS v4u*)(XB + (size_t)(m0 + r) * DM + c0) = pack8(o);
        }
    }
}
__device__ __forceinline__ void l3_scan_phase(Frame& F) {
    unsigned char* ws = F.ws; LAS float* PA = (LAS float*)(F.lds + RING_OFF); LAS float* PH = PA + 512;
    constexpr int SEGL = LTOK / 8, NBLK = SEGL / 16;
    for (int u = F.vcu; u < 256; u += F.G) {
        const int d = u >> 7, b = (u >> 5) & 3, cg = u & 31; const int ch = cg * 64 + F.lane, seg = F.wave;
        const bf16* LOGA = (const bf16*)(ws + L3_LOGA) + (size_t)d * NTOK * DM + (size_t)b * LTOK * DM + ch;
        const bf16* UU = (const bf16*)(ws + L3_UU) + (size_t)d * NTOK * DM + (size_t)b * LTOK * DM + ch;
        bf16* YS = (bf16*)(ws + L3_YS) + (size_t)d * NTOK * DM + (size_t)b * LTOK * DM + ch;
        bf16 laA[16], luA[16], laB[16], luB[16];
        auto ldblk = [&](const int blk, bf16 (&la)[16], bf16 (&lu)[16]) __attribute__((always_inline)) {
#pragma unroll
            for (int s = 0; s < 16; ++s) { const int step = seg * SEGL + blk * 16 + s; const int t = d ? flip_tok(step) : step; la[s] = LOGA[(size_t)t * DM]; lu[s] = UU[(size_t)t * DM]; } };
        float P = 1.f, Hh = 0.f;
        auto scan1 = [&](const bf16 (&la)[16], const bf16 (&lu)[16]) __attribute__((always_inline)) {
#pragma unroll
            for (int s = 0; s < 16; ++s) { const float a = __expf(bf2f(la[s])); Hh = a * Hh + bf2f(lu[s]); P *= a; } };
        auto scan2 = [&](const int blk, const bf16 (&la)[16], const bf16 (&lu)[16]) __attribute__((always_inline)) {
#pragma unroll
            for (int s = 0; s < 16; ++s) { const int step = seg * SEGL + blk * 16 + s; const int t = d ? flip_tok(step) : step; const float a = __expf(bf2f(la[s])); Hh = a * Hh + bf2f(lu[s]); YS[(size_t)t * DM] = f2bf(Hh); } };
        ldblk(0, laA, luA);
#pragma unroll 1
        for (int blk = 0; blk < NBLK; blk += 2) { ldblk(blk + 1, laB, luB); scan1(laA, luA); ldblk(blk + 2 < NBLK ? blk + 2 : NBLK - 1, laA, luA); scan1(laB, luB); }
        __syncthreads();
        PA[F.tid] = P; PH[F.tid] = Hh;
        __syncthreads();
        float carry = 0.f;
        for (int g = 0; g < seg; ++g) carry = PA[g * 64 + F.lane] * carry + PH[g * 64 + F.lane];
        Hh = carry;
        ldblk(0, laA, luA);
#pragma unroll 1
        for (int blk = 0; blk < NBLK; blk += 2) { ldblk(blk + 1, laB, luB); scan2(blk, laA, luA); ldblk(blk + 2 < NBLK ? blk + 2 : NBLK - 1, laA, luA); scan2(blk + 1, laB, luB); }
    }
}
__device__ __forceinline__ void l3_combine_phase(Frame& F) {
    const bf16* YS = (const bf16*)(F.ws + L3_YS); const bf16* IN = (const bf16*)(F.ws + L3_IN); bf16* OUTB = (bf16*)(F.ws + WS_OUTB);
    const size_t total = (size_t)NTOK * DM / 8; const size_t stride = (size_t)F.G * 512;
    constexpr int UB = 3;
    for (size_t i0 = (size_t)F.vcu * 512 + F.tid; i0 < total; i0 += UB * stride) {
        v4u ya[UB], yb[UB], gg[UB];
#pragma unroll
        for (int u = 0; u < UB; ++u) { const size_t i = i0 + u * stride; if (i < total) { const size_t e = i * 8; const size_t m = e / DM, c = e % DM;
            ya[u] = *(const GAS v4u*)(YS + e); yb[u] = *(const GAS v4u*)(YS + (size_t)NTOK * DM + e); gg[u] = *(const GAS v4u*)(IN + m * 4096 + c); } }
#pragma unroll
        for (int u = 0; u < UB; ++u) { const size_t i = i0 + u * stride; if (i < total) { const size_t e = i * 8;
            float a[8], b[8], g[8], o[8]; unpack8(ya[u], a); unpack8(yb[u], b); unpack8(gg[u], g);
#pragma unroll
            for (int j = 0; j < 8; ++j) o[j] = (a[j] + b[j]) * g[j];
            *(GAS v4u*)(OUTB + e) = pack8(o); } }
    }
}
constexpr int N_PHASE_IDS = 1 + 16 * NLAYER;
struct Args { const float* in[43]; float* out; unsigned char* ws; int ph_lo, ph_hi; };
static_assert(sizeof(Args) == 45 * 8 + 8, "Args has no holes");

#ifdef PROBE_MASK
__device__ __forceinline__ int probe_rep(int k) {
    if (k == 0) return 1;
    return ((PROBE_SEL >> (k - 1)) & 1ull) ? 2 : 1;
}
#endif
__global__ void __launch_bounds__(NWAVES * 64, 2) mega_fwd(Args args) {
    extern __shared__ __attribute__((aligned(16))) unsigned char lds[];
    { const int t0 = threadIdx.x; for (int u = t0; u < (LDS_BYTES - LDSCTL_OFF) / 4; u += NWAVES * 64) ((LAS unsigned*)((LAS unsigned char*)lds + LDSCTL_OFF))[u] = 0u; }
    __syncthreads();
#define MKFRAME() Frame F; { int t_ = threadIdx.x; asm volatile("" : "+v"(t_)); int bx_ = blockIdx.x, g_ = gridDim.x; asm volatile("" : "+s"(bx_), "+s"(g_)); \
        F.lds = (LAS unsigned char*)lds; F.MISC = (volatile LAS unsigned*)(F.lds + MISC_OFF); F.tid = t_; F.lane = t_ & 63; F.wave = __builtin_amdgcn_readfirstlane(t_ >> 6); \
        F.G = g_; F.vcu = (g_ % 8 == 0) ? (bx_ % 8) * (g_ / 8) + bx_ / 8 : bx_; F.bx = bx_; F.ws = (unsigned char*)ldarg(44); F.ctl = (gu32*)(F.ws + WS_CTL); }
    const int lo = args.ph_lo, hi = args.ph_hi;
    const bool multi = (hi - lo) > 1;
    XcdBarrier bar; bar.bar = (unsigned*)((unsigned char*)ldarg(44) + WS_CTL) + CW_BAR; bar.x = 0; bar.st = nullptr;
    if (multi) bar = xcd_barrier_post(bar.bar, (volatile LAS unsigned*)((LAS unsigned char*)lds + MISC_OFF) + 8);
#define IN(k) (lo <= (k) && (k) < hi)
#define RUN_GEMM(EPI, MODE, LAT, NM, NN, LDA_, LDB_, KK_, Aptr, Bptr, Eobj) do { typedef Sched<MODE, LAT, NM, NN, LDA_, LDB_> S_t; S_t S_; S_.init(F.G, F.bx); \
        pg8::gemm_phase<EPI, S_t, LDA_, LDB_, KK_, true, true>(F.lds + RING_OFF, (Aptr), (Bptr), S_, (Eobj)); } while (0)
#define RUN_GEMM_SPLIT(SPLIT, KSUB, LDA_, LDB_, Aptr, Bptr, Eobj) do { typedef SchedSplitHalf<SPLIT, KSUB, LDA_, LDB_> S_t; S_t S_; S_.init(F.G, F.bx); \
        pg8::gemm_phase<EpiPartial, S_t, LDA_, LDB_, KSUB, true, true, true>(F.lds + RING_OFF, (Aptr), (Bptr), S_, (Eobj)); } while (0)
#define RUN_GEMM_HT(EPI, LAT, NM, NN, LMAX, NT, LDA_, LDB_, KK_, Aptr, Bptr, Eobj) do { \
        typedef SchedHT<LAT, NM, NN, LMAX, NT, LDA_, LDB_> S_t; S_t S_; S_.init(F.G, F.bx); pg8::gemm_phase<EPI, S_t, LDA_, LDB_, KK_, true, true, 2>(F.lds + RING_OFF, (Aptr), (Bptr), S_, (Eobj)); } while (0)
#define SEAM(k) do { if ((k) + 1 < hi) xcd_barrier(bar); } while (0)
#ifdef PROBE_MASK
#define PH_OPEN(k) if (IN(k)) { _Pragma("unroll 1") for (int rep_ = 0; rep_ < probe_rep(k); ++rep_) {
#define PH_CLOSE(k) if ((k) + 1 < hi || rep_ + 1 < probe_rep(k)) xcd_barrier(bar); } }
#else
#define PH_OPEN(k) if (IN(k)) {
#define PH_CLOSE(k) SEAM(k); }
#endif
#define WSP ((unsigned char*)ldarg(44))
#define Z ((float*)(WSP + WS_Z))
#define PRE ((bf16*)(WSP + WS_PRE))
#define H ((bf16*)(WSP + WS_H))
#define OUTB ((bf16*)(WSP + WS_OUTB))
#define U ((bf16*)(WSP + WS_U))
#define ACT ((bf16*)(WSP + WS_ACT))

#ifndef DIS_P0
    PH_OPEN(0) MKFRAME(); p0_prologue(F); PH_CLOSE(0)
#endif

    for (int layer = 0; layer < NLAYER; ++layer) {
        const int P = 1 + 16 * layer;
        if (layer == 0) {
#ifndef DIS_L0
            PH_OPEN(P + 0) MKFRAME(); l0_xs_phase(F, INP(0), INP(2), INP(12)); PH_CLOSE(P + 0)
#ifndef DIS_L0_G1
            PH_OPEN(P + 1) MKFRAME();
                EpiBf16Route<1> E{nullptr, 0, WSP, nullptr, nullptr};
                RUN_GEMM(EpiBf16Route<1>, 1, false, 36, 27, DM, DM, DM, (const bf16*)(WSP + L0_XS), (const bf16*)(WSP + WS_WA), E); PH_CLOSE(P + 1)
#endif
#ifndef DIS_L0_G2
            PH_OPEN(P + 2) MKFRAME();
                EpiBf16Route<2> E{nullptr, 0, WSP, INP(14), INP(17)};
                RUN_GEMM(EpiBf16Route<2>, 2, false, 36, 40, 256, 256, 256, (const bf16*)(WSP + L0_HID), (const bf16*)(WSP + WS_WL2), E); PH_CLOSE(P + 2)
#endif
#ifndef DIS_L0_PREP
#endif
#ifndef DIS_L0_SCAN
            PH_OPEN(P + 4) MKFRAME(); l0_cscan2_phase(F, INP(22), INP(23), INP(24)); PH_CLOSE(P + 4)
#endif
            PH_OPEN(P + 5) MKFRAME(); l0_post_phase(F, INP(25), INP(26)); PH_CLOSE(P + 5)
#endif
        } else if (layer == 1) {
#ifndef DIS_L1
            PH_OPEN(P + 0) MKFRAME();
                EpiBf16Route<5> E{(bf16*)(WSP + L1_QKV), 6144, WSP, nullptr, nullptr};
                RUN_GEMM_HT(EpiBf16Route<5>, false, 36, 24, 768, 96, DM, DM, DM, H, (const bf16*)(WSP + WS_WQKV), E); PH_CLOSE(P + 0)
            PH_OPEN(P + 2) MKFRAME(); l1_attn_phase(F, (char*)lds + RING_OFF); PH_CLOSE(P + 2)
            PH_OPEN(P + 3) MKFRAME(); l1_combine_phase(F, INP(29), INP(30)); PH_CLOSE(P + 3)
#endif
        } else if (layer == 2) {
#ifndef DIS_L2
            PH_OPEN(P + 0) MKFRAME();
                EpiBf16Route<3> E{(bf16*)(WSP + L2_HGO), 10240, WSP, (const float*)(WSP + WS_LB), nullptr};
                RUN_GEMM(EpiBf16Route<3>, 0, false, 36, 40, DM, DM, DM, H, (const bf16*)(WSP + WS_WHG), E); PH_CLOSE(P + 0)
            PH_OPEN(P + 1) MKFRAME(); l2_gla_phase(F); PH_CLOSE(P + 1)
            PH_OPEN(P + 2) MKFRAME(); l2_combine_phase(F, INP(34)); PH_CLOSE(P + 2)
#endif
        } else {
#ifndef DIS_L3
            PH_OPEN(P + 0) MKFRAME();
                EpiBf16Route<4> E{(bf16*)(WSP + L3_IN), 4096, WSP, nullptr, nullptr};
                RUN_GEMM_HT(EpiBf16Route<4>, false, 36, 16, 512, 64, DM, DM, DM, H, (const bf16*)(WSP + WS_WLR), E); PH_CLOSE(P + 0)
            PH_OPEN(P + 1) MKFRAME(); l3_conv_phase(F, INP(37), INP(38)); PH_CLOSE(P + 1)
            PH_OPEN(P + 2) MKFRAME();
                EpiGates E{WSP, INP(40), INP(41)};
                RUN_GEMM(EpiGates, 3, false, 36, 32, DM, 256, 256, (const bf16*)(WSP + L3_XB), (const bf16*)(WSP + WS_WGATE), E); PH_CLOSE(P + 2)
            PH_OPEN(P + 3) MKFRAME(); l3_scan_phase(F); PH_CLOSE(P + 3)
            PH_OPEN(P + 4) MKFRAME(); l3_combine_phase(F); PH_CLOSE(P + 4)
#endif
        }
#ifndef DIS_COMMON
        const bool last = (layer == NLAYER - 1);
        const float* lng = INP(6) + (size_t)layer * 2 * DM; const float* lnb = INP(7) + (size_t)layer * 2 * DM;
        PH_OPEN(P + 10) MKFRAME();
            const bf16* wB = (const bf16*)(WSP + WS_WO) + (size_t)layer * DM * DM; EpiResid E{PRE, WSP, layer, 2};
            if (last) RUN_GEMM(EpiResid, 0, true, 32, 8, DM, DM, DM, OUTB, wB, E);
            else { RUN_GEMM(EpiResid, 0, false, 32, 8, DM, DM, DM, OUTB, wB, E); EpiPartial EP{(bf16*)(WSP + WS_U)}; RUN_GEMM_SPLIT(4, 512, DM, DM, OUTB, wB, EP); }
            PH_CLOSE(P + 10)
        PH_OPEN(P + 11) MKFRAME();
            if (last) ln1_phase<true, 0, false>(F, PRE, Z, INP(0), INP(2), H, (float*)(WSP + WS_STAT), lng, lnb, layer, nullptr);
            else if (layer == 0) ln1_phase<false, 4, true>(F, PRE, Z, INP(0), INP(2), H, (float*)(WSP + WS_STAT), lng, lnb, layer, (const bf16*)(WSP + WS_U));
            else ln1_phase<false, 4, false>(F, PRE, Z, INP(0), INP(2), H, (float*)(WSP + WS_STAT), lng, lnb, layer, (const bf16*)(WSP + WS_U));
            PH_CLOSE(P + 11)
        PH_OPEN(P + 12) MKFRAME();
            const bf16* wB = (const bf16*)(WSP + WS_WUP) + (size_t)layer * DFF2 * DM; EpiConvAct E{ACT, (bf16*)(WSP + WS_UB), INP(9) + (size_t)layer * 3 * DFF2, INP(10) + (size_t)layer * DFF2};
            if (last) RUN_GEMM_HT(EpiConvAct, true, 32, 44, 1280, 128, DM, DM, DM, H, wB, E); else RUN_GEMM_HT(EpiConvAct, false, 36, 44, 1536, 48, DM, DM, DM, H, wB, E);
            PH_CLOSE(P + 12)
        PH_OPEN(P + 13) MKFRAME(); const float* cw = INP(9) + (size_t)layer * 3 * DFF2; const float* cb = INP(10) + (size_t)layer * DFF2;
            if (last) ffn_fix_phase<true>(F, (const bf16*)(WSP + WS_UB), ACT, cw, cb); else ffn_fix_phase<false>(F, (const bf16*)(WSP + WS_UB), ACT, cw, cb); PH_CLOSE(P + 13)
        PH_OPEN(P + 14) MKFRAME();
            const bf16* wB = (const bf16*)(WSP + WS_WDN) + (size_t)layer * DM * DFF; EpiResid E{PRE + (size_t)NTOK * DM, WSP, layer, 5};
            if (last) RUN_GEMM(EpiResid, 0, true, 32, 8, DFF, DFF, DFF, ACT, wB, E);
            else { RUN_GEMM(EpiResid, 0, false, 32, 8, DFF, DFF, DFF, ACT, wB, E); EpiPartial EP{(bf16*)(WSP + WS_U)}; RUN_GEMM_SPLIT(4, 1408, DFF, DFF, ACT, wB, EP); }
            PH_CLOSE(P + 14)
        PH_OPEN(P + 15) MKFRAME();
            if (last) ln2_phase<true, true, false, 0, false>(F, PRE, PRE + (size_t)NTOK * DM, Z, INP(0), INP(2), nullptr, (float*)ldarg(43), nullptr, (const float*)(WSP + WS_STAT), lng, lnb, lng + DM, lnb + DM, layer, nullptr);
            else if (layer == 0) ln2_phase<false, false, true, 4, true>(F, PRE, PRE + (size_t)NTOK * DM, Z, INP(0), INP(2), Z, nullptr, H, (const float*)(WSP + WS_STAT), lng, lnb, lng + DM, lnb + DM, layer, (const bf16*)(WSP + WS_U));
            else ln2_phase<false, false, true, 4, false>(F, PRE, PRE + (size_t)NTOK * DM, Z, INP(0), INP(2), Z, nullptr, H, (const float*)(WSP + WS_STAT), lng, lnb, lng + DM, lnb + DM, layer, (const bf16*)(WSP + WS_U));
            PH_CLOSE(P + 15)
#endif
    }
#undef IN
#undef SEAM
#undef Z
#undef PRE
#undef H
#undef OUTB
#undef U
#undef ACT
}

static const bool kPhaseUsed[N_PHASE_IDS] = {
    true,
    true, true, true, false, true, true, false, false, false, false, true, true, true, true, true, true,
    true, false, true, true, false, false, false, false, false, false, true, true, true, true, true, true,
    true, true, true, false, false, false, false, false, false, false, true, true, true, true, true, true,
    true, true, true, true, true, false, false, false, false, false, true, true, true, true, true, true };
extern "C" void kernel_launch(void* const* d_in, const int* in_sizes, int n_in, void* d_out, int out_size, void* d_ws, size_t ws_size, hipStream_t stream) {
    static int grid = 0;
    if (grid == 0) {
        if (n_in != 43 || out_size != NLAT * DM || ws_size < WS_END) { fprintf(stderr, "kernel_launch: unexpected shapes: n_in %d out %d ws %zu (need %zu)\n", n_in, out_size, ws_size, (size_t)WS_END); grid = -1; return; }
        int dev = 0, cus = 0, per_cu = 0;
        if (hipGetDevice(&dev) != hipSuccess || hipDeviceGetAttribute(&cus, hipDeviceAttributeMultiprocessorCount, dev) != hipSuccess) { grid = -1; return; }
        if (hipFuncSetAttribute((const void*)mega_fwd, hipFuncAttributeMaxDynamicSharedMemorySize, LDS_BYTES) != hipSuccess) { fprintf(stderr, "kernel_launch: hipFuncSetAttribute failed\n"); grid = -1; return; }
        if (hipOccupancyMaxActiveBlocksPerMultiprocessor(&per_cu, (const void*)mega_fwd, NWAVES * 64, LDS_BYTES) != hipSuccess || per_cu < 1)
            fprintf(stderr, "kernel_launch: occupancy query reports %d workgroups per CU\n", per_cu);
        (void)hipGetLastError();
        grid = cus;
    }
    if (grid < 0) return;
    if (hipMemsetAsync((char*)d_ws + WS_CTL, 0, ZERO_BYTES, stream) != hipSuccess) { fprintf(stderr, "kernel_launch: memset failed\n"); return; }
    Args a{};
    for (int i = 0; i < 43; ++i) a.in[i] = (const float*)d_in[i];
    a.out = (float*)d_out; a.ws = (unsigned char*)d_ws;
#if MK_N_LAUNCHES == 1
    a.ph_lo = 0; a.ph_hi = N_PHASE_IDS;
    hipLaunchKernelGGL(mega_fwd, dim3(grid), dim3(NWAVES * 64), LDS_BYTES, stream, a);
#else
    for (int p = 0; p < N_PHASE_IDS; ++p) { if (!kPhaseUsed[p]) continue; a.ph_lo = p; a.ph_hi = p + 1;
        hipLaunchKernelGGL(mega_fwd, dim3(grid), dim3(NWAVES * 64), LDS_BYTES, stream, a); }
#endif
    const hipError_t le = hipPeekAtLastError();
    if (le != hipSuccess) fprintf(stderr, "kernel_launch: launch failed: %s\n", hipGetErrorName(le));
}
```

```cpp
#include <hip/hip_runtime.h>
#include <cstdio>
#include <cstdint>

namespace pg8 {
#define PG8_LAS __attribute__((address_space(3)))
typedef unsigned short bf16_t;
typedef short bf16x8 __attribute__((ext_vector_type(8)));
typedef float f32x4 __attribute__((ext_vector_type(4)));
typedef float f32x2 __attribute__((ext_vector_type(2)));
typedef unsigned u32x4 __attribute__((ext_vector_type(4)));
typedef unsigned u32x2 __attribute__((ext_vector_type(2)));
constexpr int BM = 256, BK = 64, HALF = 128, HTB = HALF * BK * 2  , STAGE_BYTES = 8 * HTB, NXCD = 8, WGM = 8;

__host__ __device__ __forceinline__ int lds_byte(int r, int c) { const int st = (r >> 4) * 2 + (c >> 5), rr = r & 15, cc = c & 31, ob = rr * 64 + cc * 2; return st * 1024 + (ob ^ (((ob >> 9) & 1) << 5)); }
__host__ __device__ __forceinline__ void stage_rc(int b, int& R, int& C) { const int st = b / 1024, sb = b % 1024, swz = sb ^ (((sb >> 9) & 1) << 5); R = (st >> 1) * 16 + swz / 64; C = (st & 1) * 32 + (swz % 64) / 2; }
__host__ __device__ __forceinline__ int perm32(int rho) { const int n = rho >> 4, i = rho & 15; return 8 * (i >> 2) + 4 * n + (i & 3); }

struct Unit { int pm, pn; unsigned aoff, boff; int half; };
struct Gemm { const bf16_t* A; const bf16_t* Bt; int lda, ldb, K; };

template <int nM, int nN> struct TileOrder {
    static constexpr int nwg = nM * nN;
    int G, c;
    __device__ void init(int G_, int c_) { G = G_; c = c_; }
    __device__ __forceinline__ bool tile(int i, int& pm, int& pn) const { return tileL(i * G + c, pm, pn); }
    static __device__ __forceinline__ bool tileL(int L, int& pm, int& pn) {
        if (L >= nwg) return false;
        int wgid = L; { constexpr int q = nwg / NXCD, r = nwg % NXCD; const int xcd = wgid % NXCD, off = wgid / NXCD; wgid = (xcd < r ? xcd * (q + 1) : r * (q + 1) + (xcd - r) * q) + off; }
        constexpr int nig = WGM * nN; const int gid = wgid / nig, fm = gid * WGM, gsz = (nM - fm) < WGM ? (nM - fm) : WGM;
        pm = fm + ((wgid % nig) % gsz); pn = (wgid % nig) / gsz; return true;
    }
};

typedef __bf16 bf16x2_hw __attribute__((ext_vector_type(2)));
__device__ __forceinline__ unsigned cvt_pk_bf16(float lo, float hi) { const f32x2 v = {lo, hi}; const bf16x2_hw b = __builtin_convertvector(v, bf16x2_hw); return __builtin_bit_cast(unsigned, b); }

template <class Epi, class Sched, int LDA, int LDB, int KK, bool ALIGN_EPI = false, bool SP2 = false, int HM = 0>
__device__ __forceinline__ void gemm_phase(PG8_LAS unsigned char* lds, const bf16_t* gA, const bf16_t* gBt, const Sched& S, const Epi& E) {
    int tid_ = threadIdx.x; asm volatile("" : "+v"(tid_));
    const int tid = tid_, wid = __builtin_amdgcn_readfirstlane(tid >> 6), lane = tid & 63, wr = wid >> 2, wc = wid & 3, fr = lane & 15, fq = lane >> 4;
    constexpr int nt = KK / BK;
    unsigned voffA[2], voffB[2];
#pragma unroll
    for (int i = 0; i < 2; ++i) { int R, C; stage_rc(tid * 16 + i * 8192, R, C); const int Rb = Epi::PERM ? ((R & ~31) + perm32(R & 31)) : R;
        const int Ra = Epi::PERMA ? ((R & ~63) + 4 * (R & 15) + ((R & 63) >> 4)) : R;
        voffA[i] = (unsigned)(Ra * LDA + C) * 2u; voffB[i] = (unsigned)(Rb * LDB + C) * 2u; }
    constexpr size_t kstep = (size_t)(BK * 2);
    constexpr size_t hstepA = (size_t)HALF * LDA * 2, hstepB = (size_t)HALF * LDB * 2;
    const unsigned ldsw = (unsigned)wid * 1024u;
    const int aoff = lds_byte(wr * 64 + fr, fq * 8), boff = lds_byte(wc * 32 + fr, fq * 8);
#define PG8_SA(b, h) (((b) * 2 + (h)) * HTB)
#define PG8_SB(b, h) ((4 + (b) * 2 + (h)) * HTB)
#define PG8_STAGE(bufoff, gbase, voff) do { _Pragma("unroll") for (int _i = 0; _i < 2; ++_i) \
        __builtin_amdgcn_global_load_lds((const unsigned*)((const char*)(gbase) + (voff)[_i]), (PG8_LAS unsigned*)(lds + (bufoff) + ldsw + _i * 8192), 16, 0, 0); } while (0)
#define PG8_LDA(dst, b, h) do { _Pragma("unroll") for (int m = 0; m < 4; ++m) _Pragma("unroll") for (int k = 0; k < 2; ++k) dst[m][k] = *(const PG8_LAS bf16x8*)(lds + PG8_SA(b, h) + aoff + m * 2048 + k * 1024); } while (0)
#define PG8_LDB(dst, b, h) do { _Pragma("unroll") for (int n = 0; n < 2; ++n) _Pragma("unroll") for (int k = 0; k < 2; ++k) dst[n][k] = *(const PG8_LAS bf16x8*)(lds + PG8_SB(b, h) + boff + n * 2048 + k * 1024); } while (0)
#define PG8_MMA(ai, bj, At, Bt) do { __builtin_amdgcn_s_setprio(1); _Pragma("unroll") for (int m = 0; m < 4; ++m) _Pragma("unroll") for (int n = 0; n < 2; ++n) _Pragma("unroll") for (int k = 0; k < 2; ++k) \
        acc[ai][bj][m][n] = __builtin_amdgcn_mfma_f32_16x16x32_bf16(Bt[n][k], At[m][k], acc[ai][bj][m][n], 0, 0, 0); __builtin_amdgcn_s_setprio(0); } while (0)
#define PG8_WAIT_V(n) asm volatile("s_waitcnt vmcnt(" #n ")" ::: "memory")
#define PG8_WAIT_L(n) asm volatile("s_waitcnt lgkmcnt(" #n ")" ::: "memory")
#define PG8_BAR __builtin_amdgcn_s_barrier()
#define PG8_SCHED __builtin_amdgcn_sched_barrier(0)
    Unit cur, nxt; int ui = 0;
    if (!S.next(0, cur)) return;
    f32x4 acc[2][2][4][2];
#pragma unroll
    for (int a = 0; a < 2; ++a)
#pragma unroll
        for (int b = 0; b < 2; ++b)
#pragma unroll
            for (int m = 0; m < 4; ++m)
#pragma unroll
                for (int n = 0; n < 2; ++n) acc[a][b][m][n] = (f32x4){0.f, 0.f, 0.f, 0.f};
    bf16x8 At[4][2], B0[2][2], B1[2][2];
    const char* cA = (const char*)gA + cur.aoff; const char* cB = (const char*)gBt + cur.boff;
    if (HM == 1 || (HM == 2 && cur.half >= 0)) {
        PG8_STAGE(PG8_SB(0, 0), cB, voffB); PG8_STAGE(PG8_SB(0, 1), cB + hstepB, voffB); PG8_STAGE(PG8_SA(0, 0), cA, voffA);
        if (wr == 1) PG8_BAR;
        PG8_WAIT_V(0); PG8_BAR;
        PG8_STAGE(PG8_SB(1, 0), cB + kstep, voffB); PG8_STAGE(PG8_SA(1, 0), cA + kstep, voffA); PG8_STAGE(PG8_SB(1, 1), cB + hstepB + kstep, voffB);
        PG8_WAIT_V(6); PG8_BAR;
    } else if constexpr (SP2) {
        PG8_STAGE(PG8_SB(0, 0), cB, voffB); PG8_STAGE(PG8_SB(0, 1), cB + hstepB, voffB); PG8_STAGE(PG8_SA(0, 0), cA, voffA); PG8_STAGE(PG8_SA(0, 1), cA + hstepA, voffA);
        if (wr == 1) PG8_BAR;
        PG8_WAIT_V(2); PG8_BAR;
        PG8_STAGE(PG8_SB(1, 0), cB + kstep, voffB); PG8_STAGE(PG8_SA(1, 0), cA + kstep, voffA); PG8_STAGE(PG8_SB(1, 1), cB + hstepB + kstep, voffB);
        PG8_WAIT_V(6); PG8_BAR;
    } else {
        PG8_STAGE(PG8_SB(0, 0), cB, voffB); PG8_STAGE(PG8_SA(0, 0), cA, voffA); PG8_STAGE(PG8_SB(0, 1), cB + hstepB, voffB); PG8_STAGE(PG8_SA(0, 1), cA + hstepA, voffA);
        if (wr == 1) PG8_BAR;
        PG8_WAIT_V(4); PG8_BAR;
        PG8_STAGE(PG8_SB(1, 0), cB + kstep, voffB); PG8_STAGE(PG8_SA(1, 0), cA + kstep, voffA); PG8_STAGE(PG8_SB(1, 1), cB + hstepB + kstep, voffB);
        PG8_WAIT_V(6); PG8_BAR;
    }
    for (;;) {
        const bool has_next = S.next(ui + 1, nxt);
        const char* nA = has_next ? (const char*)gA + nxt.aoff : cA; const char* nB = has_next ? (const char*)gBt + nxt.boff : cB;
#define PG8_KT_ADDR const bool last = (t == nt - 2); const char* a1 = cA + (size_t)(t + 1) * kstep; \
            const char* a2 = last ? nA : cA + (size_t)(t + 2) * kstep; const char* b2 = last ? nB : cB + (size_t)(t + 2) * kstep; const char* a3 = a2 + kstep; const char* b3 = b2 + kstep;
        if (HM == 1 || (HM == 2 && cur.half >= 0)) {
#pragma unroll 1
          for (int t = 0; t < nt; t += 2) { PG8_KT_ADDR
            PG8_LDB(B0, 0, 0); PG8_LDB(B1, 0, 1); PG8_SCHED; PG8_LDA(At, 0, 0);
            PG8_WAIT_V(6); PG8_WAIT_L(0); PG8_BAR; PG8_MMA(0, 0, At, B0); PG8_MMA(0, 1, At, B1); PG8_BAR; PG8_SCHED;
            PG8_STAGE(PG8_SB(0, 0), b2, voffB); PG8_STAGE(PG8_SB(0, 1), b2 + hstepB, voffB); PG8_STAGE(PG8_SA(0, 0), a2, voffA);
            PG8_WAIT_V(6); PG8_BAR; PG8_BAR; PG8_SCHED;
            PG8_LDB(B0, 1, 0); PG8_LDB(B1, 1, 1); PG8_SCHED; PG8_LDA(At, 1, 0);
            PG8_WAIT_V(6); PG8_WAIT_L(0); PG8_BAR; PG8_MMA(0, 0, At, B0); PG8_MMA(0, 1, At, B1); PG8_BAR; PG8_SCHED;
            PG8_STAGE(PG8_SB(1, 0), b3, voffB); PG8_STAGE(PG8_SB(1, 1), b3 + hstepB, voffB); PG8_STAGE(PG8_SA(1, 0), a3, voffA);
            PG8_WAIT_V(6); PG8_BAR; PG8_BAR; PG8_SCHED;
            (void)a1;
          }
        } else {
#pragma unroll 1
          for (int t = 0; t < nt; t += 2) { PG8_KT_ADDR
            if constexpr (SP2) {
            PG8_LDB(B0, 0, 0); PG8_LDB(B1, 0, 1); PG8_SCHED; PG8_LDA(At, 0, 0); PG8_STAGE(PG8_SA(1, 1), a1 + hstepA, voffA);
            PG8_WAIT_V(8); PG8_WAIT_L(0); PG8_BAR; PG8_MMA(0, 0, At, B0); PG8_MMA(0, 1, At, B1); PG8_BAR; PG8_SCHED;
            PG8_LDA(At, 0, 1); PG8_STAGE(PG8_SB(0, 0), b2, voffB); PG8_STAGE(PG8_SB(0, 1), b2 + hstepB, voffB); PG8_STAGE(PG8_SA(0, 0), a2, voffA);
            PG8_WAIT_V(8); PG8_WAIT_L(0); PG8_BAR; PG8_MMA(1, 0, At, B0); PG8_MMA(1, 1, At, B1); PG8_BAR; PG8_SCHED;
            PG8_LDB(B0, 1, 0); PG8_LDB(B1, 1, 1); PG8_SCHED; PG8_LDA(At, 1, 0); PG8_STAGE(PG8_SA(0, 1), a2 + hstepA, voffA);
            PG8_WAIT_V(8); PG8_WAIT_L(0); PG8_BAR; PG8_MMA(0, 0, At, B0); PG8_MMA(0, 1, At, B1); PG8_BAR; PG8_SCHED;
            PG8_LDA(At, 1, 1); PG8_STAGE(PG8_SB(1, 0), b3, voffB); PG8_STAGE(PG8_SB(1, 1), b3 + hstepB, voffB); PG8_STAGE(PG8_SA(1, 0), a3, voffA);
            PG8_WAIT_V(8); PG8_WAIT_L(0); PG8_BAR; PG8_MMA(1, 0, At, B0); PG8_MMA(1, 1, At, B1); PG8_BAR; PG8_SCHED;
            } else {
            PG8_LDB(B0, 0, 0); PG8_SCHED; PG8_LDA(At, 0, 0); PG8_STAGE(PG8_SA(1, 1), a1 + hstepA, voffA);
            PG8_WAIT_L(8); PG8_BAR; PG8_WAIT_L(0); PG8_MMA(0, 0, At, B0); PG8_BAR; PG8_SCHED;
            PG8_LDB(B1, 0, 1); PG8_STAGE(PG8_SB(0, 0), b2, voffB);
            PG8_BAR; PG8_WAIT_L(0); PG8_MMA(0, 1, At, B1); PG8_BAR;
            PG8_LDA(At, 0, 1); PG8_STAGE(PG8_SA(0, 0), a2, voffA);
            PG8_BAR; PG8_WAIT_L(0); PG8_MMA(1, 0, At, B0); PG8_BAR; PG8_SCHED;
            PG8_STAGE(PG8_SB(0, 1), b2 + hstepB, voffB);
            PG8_WAIT_V(6); PG8_BAR; PG8_MMA(1, 1, At, B1); PG8_BAR;
            PG8_LDB(B0, 1, 0); PG8_SCHED; PG8_LDA(At, 1, 0); PG8_STAGE(PG8_SA(0, 1), a2 + hstepA, voffA);
            PG8_WAIT_L(8); PG8_BAR; PG8_WAIT_L(0); PG8_MMA(0, 0, At, B0); PG8_BAR; PG8_SCHED;
            PG8_LDB(B1, 1, 1); PG8_STAGE(PG8_SB(1, 0), b3, voffB);
            PG8_BAR; PG8_WAIT_L(0); PG8_MMA(0, 1, At, B1); PG8_BAR;
            PG8_LDA(At, 1, 1); PG8_STAGE(PG8_SA(1, 0), a3, voffA);
            PG8_BAR; PG8_WAIT_L(0); PG8_MMA(1, 0, At, B0); PG8_BAR; PG8_SCHED;
            PG8_STAGE(PG8_SB(1, 1), b3 + hstepB, voffB);
            PG8_WAIT_V(6); PG8_BAR; PG8_MMA(1, 1, At, B1); PG8_BAR;
            }
          }
        }
#undef PG8_KT_ADDR
        if constexpr (ALIGN_EPI) { if (wr == 0) PG8_BAR; }
        E(acc, cur, wr, wc, fr, fq);
        if (!has_next) break;
#pragma unroll
        for (int a = 0; a < 2; ++a)
#pragma unroll
            for (int b = 0; b < 2; ++b)
#pragma unroll
                for (int m = 0; m < 4; ++m)
#pragma unroll
                    for (int n = 0; n < 2; ++n) acc[a][b][m][n] = (f32x4){0.f, 0.f, 0.f, 0.f};
        cur = nxt; cA = nA; cB = nB; ++ui;
        if constexpr (ALIGN_EPI) { if (wr == 1) PG8_BAR; }
    }
    PG8_WAIT_V(0);
    if constexpr (!ALIGN_EPI) { if (wr == 0) PG8_BAR; }
    PG8_BAR;
#undef PG8_SA
#undef PG8_SB
#undef PG8_STAGE
#undef PG8_LDA
#undef PG8_LDB
#undef PG8_MMA
#undef PG8_WAIT_V
#undef PG8_WAIT_L
#undef PG8_BAR
#undef PG8_SCHED
}
}
#include <hip/hip_bf16.h>
#include <cmath>
namespace att {
using bf16 = __hip_bfloat16;
constexpr int   D = 128, NW = 8, QBLK = 32, KVBLK = 64;
constexpr float SCALE = 0.088388347648318440f;
constexpr float THR = 8.f;
constexpr int SDEPTH = 2;
constexpr int LDQ = 6144, LDK = 6144, LDO = 4096;
constexpr size_t SHM_V = KVBLK * D * 2, SHM_K = KVBLK * D * 2, SHM_ATTN = 2 * SHM_V + 2 * SHM_K + NW * 64 * 4;
using bf16x8 = __attribute__((ext_vector_type(8))) short;
using s16x4  = __attribute__((ext_vector_type(4))) short;
using f32x16 = __attribute__((ext_vector_type(16))) float;
using f32x8  = __attribute__((ext_vector_type(8))) float;
using u32x4  = __attribute__((ext_vector_type(4))) unsigned;
#define KSWZ(row, colB) ((row) * 256 + ((colB) ^ (((row) & 7) << 4)))
#define SBAR() __builtin_amdgcn_sched_barrier(0)
__device__ __forceinline__ int crow(int r, int hi) { return (r & 3) + 8 * (r >> 2) + 4 * hi; }
__device__ __forceinline__ unsigned cvtpk(float lo, float hi) {
  unsigned r; asm volatile("v_cvt_pk_bf16_f32 %0, %1, %2" : "=v"(r) : "v"(lo), "v"(hi)); return r;
}
template <typename TIn> struct Stage;
template <> struct Stage<bf16>  { using T = bf16x8;
  __device__ static __forceinline__ T ld8(const bf16* p) { return *reinterpret_cast<const bf16x8*>(p); }
  __device__ static __forceinline__ bf16x8 tobf(T x) { return x; } };
template <> struct Stage<float> { using T = f32x8;
  __device__ static __forceinline__ T ld8(const float* p) { return *reinterpret_cast<const f32x8*>(p); }
  __device__ static __forceinline__ bf16x8 tobf(T x) {
    u32x4 w = {cvtpk(x[0], x[1]), cvtpk(x[2], x[3]), cvtpk(x[4], x[5]), cvtpk(x[6], x[7])}; return *reinterpret_cast<bf16x8*>(&w); } };

__device__ __forceinline__ void partialSM(f32x16& p0, f32x16& p1, float& m_reg, float& mn, float& alpha) {
  constexpr float C = SCALE * 1.4426950408889634f;
  float pmax = p0[0]; for (int r = 1; r < 16; ++r) pmax = fmaxf(pmax, p0[r]); for (int r = 0; r < 16; ++r) pmax = fmaxf(pmax, p1[r]);
  { auto rr = __builtin_amdgcn_permlane32_swap(__float_as_uint(pmax), __float_as_uint(pmax), false, false);
    pmax = fmaxf(__uint_as_float(rr[0]), __uint_as_float(rr[1])); }
  if (__builtin_expect(__all(pmax - m_reg <= THR / SCALE), 1)) { mn = m_reg; alpha = 1.f; }
  else { mn = fmaxf(m_reg, pmax); alpha = __builtin_amdgcn_exp2f((m_reg - mn) * C); m_reg = mn; }
  float mnC = -mn * C;
  for (int r = 0; r < 16; ++r) p0[r] = fmaf(p0[r], C, mnC); for (int r = 0; r < 16; ++r) p1[r] = fmaf(p1[r], C, mnC);
  for (int r = 0; r < 16; ++r) p0[r] = __builtin_amdgcn_exp2f(p0[r]);
}
__device__ __forceinline__ void finishSM(f32x16& p0, f32x16& p1, float alpha, float& l_reg, bf16x8& pa0, bf16x8& pa1, bf16x8& pa2, bf16x8& pa3) {
  for (int r = 0; r < 16; ++r) p1[r] = __builtin_amdgcn_exp2f(p1[r]);
  float ps = 0; for (int r = 0; r < 16; ++r) ps += p0[r]; for (int r = 0; r < 16; ++r) ps += p1[r];
  { auto rr = __builtin_amdgcn_permlane32_swap(__float_as_uint(ps), __float_as_uint(ps), false, false);
    ps = __uint_as_float(rr[0]) + __uint_as_float(rr[1]); }
  l_reg = l_reg * alpha + ps;
#define PK4(P, BASE, OUT) do { unsigned a0 = cvtpk(P[BASE + 0], P[BASE + 1]), a1 = cvtpk(P[BASE + 2], P[BASE + 3]);   \
    unsigned b0 = cvtpk(P[BASE + 4], P[BASE + 5]), b1 = cvtpk(P[BASE + 6], P[BASE + 7]);                              \
    auto r0 = __builtin_amdgcn_permlane32_swap(a0, b0, false, false); auto r1 = __builtin_amdgcn_permlane32_swap(a1, b1, false, false); \
    u32x4 w = {r0[0], r1[0], r0[1], r1[1]}; OUT = *reinterpret_cast<bf16x8*>(&w); } while (0)
  PK4(p0, 0, pa0); PK4(p0, 8, pa1); PK4(p1, 0, pa2); PK4(p1, 8, pa3);
#undef PK4
}
__device__ __forceinline__ void qkt(f32x16& p0, f32x16& p1, const bf16* Ks, const bf16x8* qr, int r32, int hi) {
  p0 = f32x16{}; p1 = f32x16{};
  for (int d0 = 0; d0 < 8; ++d0) { int cb = (d0 * 16 + hi * 8) * 2;
    bf16x8 b0 = *reinterpret_cast<const bf16x8*>((const char*)Ks + KSWZ(r32, cb));
    bf16x8 b1 = *reinterpret_cast<const bf16x8*>((const char*)Ks + KSWZ(32 + r32, cb));
    p0 = __builtin_amdgcn_mfma_f32_32x32x16_bf16(b0, qr[d0], p0, 0, 0, 0);
    p1 = __builtin_amdgcn_mfma_f32_32x32x16_bf16(b1, qr[d0], p1, 0, 0, 0); }
}
__device__ __forceinline__ int v_st(int k, int c) { const int kk = (k & ~0xC) | ((k & 4) << 1) | ((k & 8) >> 1); return ((kk >> 3) * 4 + (c >> 5)) * 512 + ((kk & 7) * 32 + (c & 31)) * 2; }
__device__ __forceinline__ int v_rd_base(int lane) { return ((lane & 3) << 3) | (((lane >> 2) & 3) << 6) | (((lane >> 4) & 1) << 5) | (((lane >> 5) & 1) << 8); }
constexpr int v_rd_off(int d0, int ks, int half) { return d0 * 512 + ks * 4096 + half * 2048; }
template <int OFF> __device__ __forceinline__ s16x4 tr_read(int vb) {
  s16x4 r; asm volatile("ds_read_b64_tr_b16 %0, %1 offset:%2" : "=&v"(r) : "v"(vb), "i"(OFF) : "memory"); return r;
}
template <int D0> __device__ __forceinline__ void pv_one(f32x16& od, int vb, bf16x8 pa0, bf16x8 pa1, bf16x8 pa2, bf16x8 pa3) {
  const s16x4 l0 = tr_read<v_rd_off(D0, 0, 0)>(vb), h0 = tr_read<v_rd_off(D0, 0, 1)>(vb), l1 = tr_read<v_rd_off(D0, 1, 0)>(vb), h1 = tr_read<v_rd_off(D0, 1, 1)>(vb);
  const s16x4 l2 = tr_read<v_rd_off(D0, 2, 0)>(vb), h2 = tr_read<v_rd_off(D0, 2, 1)>(vb), l3 = tr_read<v_rd_off(D0, 3, 0)>(vb), h3 = tr_read<v_rd_off(D0, 3, 1)>(vb);
  asm volatile("s_waitcnt lgkmcnt(0)" ::: "memory"); SBAR();
#define PK(L, H) (bf16x8){L[0], L[1], L[2], L[3], H[0], H[1], H[2], H[3]}
  od = __builtin_amdgcn_mfma_f32_32x32x16_bf16(pa0, PK(l0, h0), od, 0, 0, 0);
  od = __builtin_amdgcn_mfma_f32_32x32x16_bf16(pa1, PK(l1, h1), od, 0, 0, 0);
  od = __builtin_amdgcn_mfma_f32_32x32x16_bf16(pa2, PK(l2, h2), od, 0, 0, 0);
  od = __builtin_amdgcn_mfma_f32_32x32x16_bf16(pa3, PK(l3, h3), od, 0, 0, 0);
#undef PK
}
__device__ __forceinline__ void pv_d0(f32x16* o, int vb, bf16x8 pa0, bf16x8 pa1, bf16x8 pa2, bf16x8 pa3) {
  pv_one<0>(o[0], vb, pa0, pa1, pa2, pa3); pv_one<1>(o[1], vb, pa0, pa1, pa2, pa3); pv_one<2>(o[2], vb, pa0, pa1, pa2, pa3); pv_one<3>(o[3], vb, pa0, pa1, pa2, pa3);
}

template <typename TQ>
__device__ __forceinline__ void attn_dense_body(const TQ* __restrict__ Qb, const bf16* __restrict__ Kh, const bf16* __restrict__ Vh,
                                                unsigned short* __restrict__ Ob, int seq, char* lds) {
  using St = Stage<bf16>; using SQ = Stage<TQ>;
  int tid_ = threadIdx.x; asm volatile("" : "+v"(tid_)); const int tid = tid_, wid = tid >> 6, lane = tid & 63, r32 = lane & 31, hi = lane >> 5;
  bf16* V_lds = (bf16*)lds; bf16* K_lds = (bf16*)(lds + 2 * SHM_V);
  float* ws = (float*)(lds + 2 * SHM_V + 2 * SHM_K) + wid * 64; float* li_l = ws; float* al_l = ws + 32;
  float m_reg = -1e30f, l_reg = 0; f32x16 o[4] = {}; bf16x8 qr[8];
  const TQ* Qw = Qb + (long)(wid * QBLK + r32) * LDQ + hi * 8;
#pragma unroll
  for (int d0 = 0; d0 < 8; ++d0) qr[d0] = SQ::tobf(SQ::ld8(Qw + d0 * 16));
  const int sr = tid >> 4, sc = (tid & 15) * 8, vst0 = v_st(sr, sc), vst1 = v_st(32 + sr, sc);
  const int vb0 = (int)(uintptr_t)V_lds + v_rd_base(lane);
  struct { typename St::T vs0, vs1, ks0, ks1; } sr_[SDEPTH];
#define SLOAD(i, k0) do { sr_[i].vs0 = St::ld8(&Vh[(long)((k0) + sr) * LDK + sc]); sr_[i].vs1 = St::ld8(&Vh[(long)((k0) + 32 + sr) * LDK + sc]); \
    sr_[i].ks0 = St::ld8(&Kh[(long)((k0) + sr) * LDK + sc]); sr_[i].ks1 = St::ld8(&Kh[(long)((k0) + 32 + sr) * LDK + sc]); } while (0)
#define SWRITE(b, i) do { *(bf16x8*)((char*)V_lds + (b) * SHM_V + vst0) = St::tobf(sr_[i].vs0);          \
    *(bf16x8*)((char*)V_lds + (b) * SHM_V + vst1) = St::tobf(sr_[i].vs1); int kc = sc * 2;               \
    *(bf16x8*)((char*)K_lds + (b) * SHM_K + KSWZ(sr, kc)) = St::tobf(sr_[i].ks0);                       \
    *(bf16x8*)((char*)K_lds + (b) * SHM_K + KSWZ(32 + sr, kc)) = St::tobf(sr_[i].ks1); } while (0)
#define SWAIT() do { if constexpr (SDEPTH == 2) asm volatile("s_waitcnt vmcnt(4)" ::: "memory"); else asm volatile("s_waitcnt vmcnt(0)" ::: "memory"); } while (0)
#define RESC(a) do { if (__any((a) < 1.f)) { if (hi == 0) al_l[r32] = (a); asm volatile("s_waitcnt lgkmcnt(0)" ::: "memory"); \
    for (int d = 0; d < 4; ++d) for (int r = 0; r < 16; ++r) o[d][r] *= al_l[crow(r, hi)]; } } while (0)
  f32x16 pA0, pA1, pB0, pB1; float mnA, mnB, alA, alB; bf16x8 pa0, pa1, pa2, pa3; const int NT = seq / KVBLK;
  constexpr int SE = 0, SO = SDEPTH - 1;
  SLOAD(SE, 0); asm volatile("s_waitcnt vmcnt(0)" ::: "memory"); SWRITE(0, SE); __syncthreads();
  qkt(pA0, pA1, K_lds, qr, r32, hi); partialSM(pA0, pA1, m_reg, mnA, alA);
  SLOAD(SO, KVBLK); if constexpr (SDEPTH == 2) { if (2 < NT) SLOAD(SE, 2 * KVBLK); }
  SWAIT(); SWRITE(1, SO); __syncthreads();
  for (int j = 1; j + 1 < NT; j += 2) {
    SBAR(); qkt(pB0, pB1, (bf16*)((char*)K_lds + SHM_K), qr, r32, hi);
    finishSM(pA0, pA1, alA, l_reg, pa0, pa1, pa2, pa3); SBAR();
    SLOAD(SO, (j + SDEPTH) * KVBLK); SBAR();
    pv_d0(o, vb0, pa0, pa1, pa2, pa3); partialSM(pB0, pB1, m_reg, mnB, alB);
    __syncthreads(); SWAIT(); SWRITE(0, SE);
    RESC(alB); __syncthreads();
    SBAR(); qkt(pA0, pA1, K_lds, qr, r32, hi);
    finishSM(pB0, pB1, alB, l_reg, pa0, pa1, pa2, pa3); SBAR();
    if (SDEPTH == 1 || j + 3 < NT) SLOAD(SE, (j + 1 + SDEPTH) * KVBLK); SBAR();
    pv_d0(o, vb0 + (int)SHM_V, pa0, pa1, pa2, pa3); partialSM(pA0, pA1, m_reg, mnA, alA);
    __syncthreads(); SWAIT(); SWRITE(1, SO);
    RESC(alA); __syncthreads();
  }
  SBAR(); qkt(pB0, pB1, (bf16*)((char*)K_lds + SHM_K), qr, r32, hi);
  finishSM(pA0, pA1, alA, l_reg, pa0, pa1, pa2, pa3); SBAR();
  pv_d0(o, vb0, pa0, pa1, pa2, pa3); partialSM(pB0, pB1, m_reg, mnB, alB);
  __syncthreads(); RESC(alB);
  finishSM(pB0, pB1, alB, l_reg, pa0, pa1, pa2, pa3); SBAR();
  pv_d0(o, vb0 + (int)SHM_V, pa0, pa1, pa2, pa3);
  if (hi == 0) li_l[r32] = l_reg; asm volatile("s_waitcnt lgkmcnt(0)" ::: "memory");
  float rli[16];
#pragma unroll
  for (int r = 0; r < 16; ++r) rli[r] = __builtin_amdgcn_rcpf(li_l[crow(r, hi)]);
  unsigned short* Ow = Ob + (long)(wid * QBLK) * LDO;
#pragma unroll
  for (int r = 0; r < 16; ++r) { int orow = crow(r, hi);
    for (int d0 = 0; d0 < 4; ++d0) Ow[(long)orow * LDO + d0 * 32 + r32] = (unsigned short)(pg8::cvt_pk_bf16(o[d0][r] * rli[r], 0.f) & 0xffffu); }
#undef SLOAD
#undef SWRITE
#undef SWAIT
#undef RESC
}
}
constexpr int DM = 2048, NB = 4, SEQ = 2048, NCTX = 256, LTOK = 2304, NTOK = NB * LTOK  , NLAT = NB * SEQ  ;
constexpr int DFF = 5632, DFF2 = 2 * DFF;
constexpr int NLAYER = 4, NMOD = 6;
constexpr float DN_ALPHA = 1.6817928305074290f;
constexpr float LN_EPS = 1e-5f;
constexpr int NWAVES = 8;
#ifndef MK_N_LAUNCHES
#define MK_N_LAUNCHES 1
#endif

constexpr size_t MiB = 1u << 20;
constexpr size_t al256(size_t x) { return (x + 255) / 256 * 256; }
constexpr size_t WS_CTL = 0;
constexpr size_t WS_MOD = 1 * MiB;
constexpr size_t ZERO_BYTES = 2 * MiB;
constexpr size_t WS_ROPE = 2 * MiB;
constexpr size_t WS_LB = WS_ROPE + al256((size_t)LTOK * 64 * 2 * 4);
constexpr size_t WS_STAT = WS_LB + 64 * 1024;
constexpr size_t WS_ZS = WS_STAT + 80 * 1024;
constexpr size_t WS_W0 = 4 * MiB;
static_assert(WS_ZS + (size_t)NTOK * 4 <= WS_W0, "small tables fit below the weight copies");
constexpr size_t WS_WA = WS_W0;
constexpr size_t WS_WL2 = WS_WA + (size_t)6912 * 2048 * 2;
constexpr size_t WS_WO = WS_WL2 + (size_t)10240 * 256 * 2;
constexpr size_t WS_WQKV = WS_WO + (size_t)4 * 2048 * 2048 * 2;
constexpr size_t WS_WHG = WS_WQKV + (size_t)6144 * 2048 * 2;
constexpr size_t WS_WLR = WS_WHG + (size_t)10240 * 2048 * 2;
constexpr size_t WS_WGATE = WS_WLR + (size_t)4096 * 2048 * 2;
constexpr size_t WS_WUP = WS_WGATE + (size_t)32 * 256 * 256 * 2;
constexpr size_t WS_WDN = WS_WUP + (size_t)4 * DFF2 * 2048 * 2;
constexpr size_t WS_WEND = WS_WDN + (size_t)4 * 2048 * DFF * 2;
constexpr size_t WS_Z = al256(WS_WEND);
constexpr size_t WS_PRE = WS_Z + (size_t)NTOK * DM * 4;
constexpr size_t WS_H = WS_PRE + (size_t)NTOK * DM * 4;
constexpr size_t WS_OUTB = WS_H + (size_t)NTOK * DM * 2;
constexpr size_t WS_POOL = WS_OUTB + (size_t)NTOK * DM * 2;
constexpr size_t SLOT = (size_t)NTOK * DM * 2;
constexpr size_t WS_U = WS_POOL;
constexpr size_t WS_ACT = WS_U + (size_t)NTOK * DFF2 * 2;
constexpr size_t WS_UB = WS_U + (size_t)32 * MiB;
constexpr size_t WS_RKV = WS_POOL;
constexpr size_t L0_R = WS_RKV, L0_K = WS_RKV + SLOT, L0_DEC0 = WS_RKV + 2 * SLOT, L0_DEC1 = WS_RKV + 3 * SLOT, L0_IC0 = WS_RKV + 4 * SLOT, L0_IC1 = WS_RKV + 5 * SLOT, L0_V = WS_RKV + 6 * SLOT, L0_G = WS_RKV + 7 * SLOT;
constexpr size_t L0_YS = WS_RKV;
constexpr size_t L0_HID = WS_RKV + 8 * SLOT;
constexpr size_t L0_BONUS = L0_HID + (size_t)3 * NTOK * 256 * 2;
constexpr size_t L0_SCAL = L0_BONUS + (size_t)NTOK * 32 * 4;
constexpr size_t L0_XS = al256(L0_SCAL + (size_t)256 * LTOK * 2 * 4);
constexpr size_t L0_VEC = L0_XS;
constexpr size_t L0_END = L0_VEC + (size_t)256 * LTOK * 6 * 64 * 2;
constexpr size_t L1_QKV = WS_POOL;
constexpr size_t L1_O = L1_QKV + (size_t)NTOK * 6144 * 2;
constexpr size_t L2_HGO = WS_POOL;
constexpr size_t L2_OG = L2_HGO + (size_t)NTOK * 10240 * 2;
constexpr size_t L3_IN = WS_POOL;
constexpr size_t L3_XB = L3_IN + 2 * SLOT;
constexpr size_t L3_LOGA = L3_XB + SLOT;
constexpr size_t L3_UU = L3_LOGA + 2 * SLOT;
constexpr size_t L3_YS = L3_UU + 2 * SLOT;
constexpr size_t WS_END = L0_END;
static_assert(WS_ACT + (size_t)NTOK * DFF * 2 <= WS_END && L3_YS + 4 * SLOT <= WS_END && L2_OG + 4 * SLOT <= WS_END && L1_O + (size_t)NTOK * 4096 * 4 <= WS_END, "pool");
static_assert(WS_END <= (size_t)1536 * MiB, "d_ws map must fit 4 x the largest input");

constexpr int CW_BAR = 4096;
constexpr int RING_OFF = 0, RING_BYTES = 131072;
constexpr int LDSCTL_OFF = RING_BYTES, MISC_OFF = LDSCTL_OFF + 320;
constexpr int LDS_BYTES = 147456;

#define GAS __attribute__((address_space(1)))
#define LAS __attribute__((address_space(3)))
typedef unsigned short bf16;
typedef unsigned v4u __attribute__((ext_vector_type(4)));
typedef unsigned v2u __attribute__((ext_vector_type(2)));
typedef float f32x4 __attribute__((ext_vector_type(4)));
typedef float f32x2 __attribute__((ext_vector_type(2)));
typedef short bf16x8 __attribute__((ext_vector_type(8)));
typedef GAS unsigned gu32;
#define RLX_AGENT __ATOMIC_RELAXED, __HIP_MEMORY_SCOPE_AGENT
#define LDS_WAIT() asm volatile("s_waitcnt lgkmcnt(0)" ::: "memory")
#define VM_WAIT() asm volatile("s_waitcnt vmcnt(0)" ::: "memory")
#define LDS_BARRIER() do { asm volatile("s_waitcnt lgkmcnt(0)" ::: "memory"); __builtin_amdgcn_s_barrier(); asm volatile("" ::: "memory"); } while (0)
__device__ __forceinline__ unsigned pk2(float lo, float hi) { return pg8::cvt_pk_bf16(lo, hi); }
__device__ __forceinline__ float bflo(unsigned w) { return __uint_as_float(w << 16); }
__device__ __forceinline__ float bfhi(unsigned w) { return __uint_as_float(w & 0xffff0000u); }
__device__ __forceinline__ float bf2f(bf16 x) { return __uint_as_float(((unsigned)x) << 16); }
__device__ __forceinline__ bf16 f2bf(float f) { return (bf16)(pk2(f, 0.f) & 0xffffu); }
__device__ __forceinline__ int vzero() { int z; asm volatile("v_mov_b32 %0, 0" : "=v"(z)); return z; }
__device__ __forceinline__ float sigmoidf_(float x) { return __builtin_amdgcn_rcpf(1.f + __expf(-x)); }
__device__ __forceinline__ float siluf_(float x) { return x * sigmoidf_(x); }
__device__ __forceinline__ float tanhf_(float x) { const float e = __expf(2.f * x); return 1.f - 2.f * __builtin_amdgcn_rcpf(e + 1.f); }
__device__ __forceinline__ float gelu_tanh_(float x) { const float u = 0.7978845608028654f * (x + 0.044715f * x * x * x); return 0.5f * x * (1.f + tanhf_(u)); }

#define XB_TMO      128
#define XB_XCNT(j)  (256  + 64 * (j))
#define XB_XSUB(j)  (1280 + 64 * (j))
#define XB_XGEN(j)  (2304 + 64 * (j))
#define XB_TOP      3328
#define XB_TOPGEN   3392
#define XCD_BAR_WORDS 3456
#define XB_SPIN_CAP (1u << 18)
__device__ __forceinline__ unsigned xb_ld(unsigned* p)              { return __hip_atomic_load(p, __ATOMIC_RELAXED, __HIP_MEMORY_SCOPE_AGENT); }
__device__ __forceinline__ unsigned xb_add(unsigned* p, unsigned v) { return __hip_atomic_fetch_add(p, v, __ATOMIC_RELAXED, __HIP_MEMORY_SCOPE_AGENT); }
__device__ __forceinline__ unsigned xb_xcc_id() { return (unsigned)__builtin_amdgcn_s_getreg((3 << 11) | 20) & 0xFu; }
#define XB_SPIN(cond, bar) do { unsigned _sp = 0; while (cond) { __builtin_amdgcn_s_sleep(1); \
    if ((++_sp & 255u) == 0u) { if (xb_ld(&(bar)[XB_TMO])) break; if (_sp > XB_SPIN_CAP) { atomicAdd(&(bar)[XB_TMO], 1u); break; } } } } while (0)
struct XcdBarrier { unsigned* bar; unsigned x; volatile LAS unsigned* st; };
__device__ __forceinline__ XcdBarrier xcd_barrier_post(unsigned* bar, volatile LAS unsigned* st) {
    XcdBarrier b; b.bar = bar; b.x = xb_xcc_id(); b.st = st;
    if (threadIdx.x == 0) (void)xb_add(&bar[XB_XCNT(b.x)], 1u);
    return b;
}
__device__ __forceinline__ void xcd_barrier_complete(unsigned* bar, unsigned x, unsigned& nloc, unsigned& nx) {
    const unsigned G = gridDim.x * gridDim.y * gridDim.z;
    unsigned sum, cnt, mine, sp = 0u;
    for (;;) {
        sum = 0u; cnt = 0u; mine = 0u;
#pragma unroll
        for (unsigned j = 0; j < 16; ++j) { const unsigned c = xb_ld(&bar[XB_XCNT(j)]); sum += c; cnt += (c > 0u) ? 1u : 0u; mine = (j == x) ? c : mine; }
        if (sum == G) break;
        __builtin_amdgcn_s_sleep(1);
        if ((++sp & 255u) == 0u) { if (xb_ld(&bar[XB_TMO])) break; if (sp > XB_SPIN_CAP) { atomicAdd(&bar[XB_TMO], 1u); break; } }
    }
    nloc = mine > 0u ? mine : 1u; nx = cnt > 0u ? cnt : 1u;
}
__device__ __forceinline__ void xcd_barrier(const XcdBarrier& b) {
    asm volatile("s_waitcnt vmcnt(0)" ::: "memory");
    __syncthreads();
    if (threadIdx.x == 0) {
        unsigned* bar = b.bar;
        __builtin_amdgcn_s_waitcnt(0);
        unsigned nloc = b.st[0], nx = b.st[1];
        if (nloc == 0u) { xcd_barrier_complete(bar, b.x, nloc, nx); b.st[0] = nloc; b.st[1] = nx; }
        const unsigned old = xb_add(&bar[XB_XSUB(b.x)], 1u);
        const unsigned gen = old / nloc;
        if (old + 1u == (gen + 1u) * nloc) {
            __builtin_amdgcn_fence(__ATOMIC_RELEASE, "agent");
            asm volatile("s_waitcnt vmcnt(0)" ::: "memory");
            const unsigned og = xb_add(&bar[XB_TOP], 1u);
            const unsigned tg = og / nx;
            if (og + 1u == (tg + 1u) * nx) xb_add(&bar[XB_TOPGEN], 1u);
            else XB_SPIN(xb_ld(&bar[XB_TOPGEN]) == tg, bar);
            __builtin_amdgcn_fence(__ATOMIC_ACQUIRE, "agent");
            xb_add(&bar[XB_XGEN(b.x)], 1u);
            asm volatile("s_waitcnt vmcnt(0)" ::: "memory");
        } else {
            XB_SPIN(xb_ld(&bar[XB_XGEN(b.x)]) == gen, bar);
            __builtin_amdgcn_fence(__ATOMIC_ACQUIRE, "agent");
            asm volatile("s_waitcnt vmcnt(0)" ::: "memory");
        }
    }
    __syncthreads();
}

#define CAS __attribute__((address_space(4)))
__device__ __forceinline__ const void* ldarg(int k) { const CAS char* ka = (const CAS char*)__builtin_amdgcn_kernarg_segment_ptr(); return *(const void* const volatile CAS*)(ka + 8 * k); }
#define INP(k) ((const float*)ldarg(k))
__device__ __forceinline__ float wave_max(float v) {
#pragma unroll
    for (int o = 1; o < 64; o <<= 1) v = fmaxf(v, __shfl_xor(v, o));
    return v;
}
__device__ __forceinline__ float wave_sum(float v) {
#pragma unroll
    for (int o = 1; o < 64; o <<= 1) v += __shfl_xor(v, o);
    return v;
}
struct Frame {
    LAS unsigned char* lds;
    volatile LAS unsigned* MISC;
    gu32* ctl;
    int tid, lane, wave;
    int vcu, G, bx;
    unsigned char* ws;
};
#define GW(F) ((F).vcu * NWAVES + (F).wave)
#define NGW(F) ((F).G * NWAVES)
struct ItemIter { int base, step, lim; };
__device__ __forceinline__ ItemIter item_iter(const Frame& F, int N) {
    ItemIter I;
    I.base = GW(F); I.step = NGW(F); I.lim = N;
    return I;
}

__device__ __forceinline__ void transpose_item(const float* W, int ldw, int Ksrc, int koff, int dstK, int N, bf16* WT, int row_off, LAS float* scr, int item, int lane) {
    const int nblk = N / 32, kb = item / nblk, nb = item % nblk, k0 = 64 * kb, n0 = 32 * nb;
    float tv[32];
#pragma unroll
    for (int i = 0; i < 32; ++i) { const int kk = 2 * i + (lane >> 5); const int ks = k0 + kk - koff;
        tv[i] = 0.f; if (ks >= 0 && ks < Ksrc) tv[i] = W[(size_t)ks * ldw + n0 + (lane & 31)]; }
#pragma unroll
    for (int i = 0; i < 32; ++i) scr[(2 * i + (lane >> 5)) * 33 + (lane & 31)] = tv[i];
    LDS_WAIT(); asm volatile("" ::: "memory");
    const int c = lane & 7;
#pragma unroll
    for (int j = 0; j < 4; ++j) { const int n = (lane >> 3) + 8 * j; const LAS float* s = scr + (8 * c) * 33 + n;
        v4u o; o.x = pk2(s[0 * 33], s[1 * 33]); o.y = pk2(s[2 * 33], s[3 * 33]); o.z = pk2(s[4 * 33], s[5 * 33]); o.w = pk2(s[6 * 33], s[7 * 33]);
        *(GAS v4u*)(WT + (size_t)(row_off + n0 + n) * dstK + k0 + 8 * c) = o; }
    LDS_WAIT(); asm volatile("" ::: "memory");
}
#define TR_RUN(W, ldw, Ksrc, koff, dstK, N, WT, row_off) do { const int _n = ((dstK) / 64) * ((N) / 32); \
    for (int _it = (gw + NGWv - (int)(tr_base % NGWv)) % NGWv; _it < _n; _it += NGWv) transpose_item((W), (ldw), (Ksrc), (koff), (dstK), (N), (WT), (row_off), scr, _it, F.lane); \
    tr_base += _n; } while (0)

__device__ __forceinline__ void p0_prologue(Frame& F) {
    LAS float* scr = (LAS float*)(F.lds + RING_OFF + F.wave * 16384);
    const int gw = GW(F), NGWv = NGW(F);
    unsigned char* ws = F.ws;
    long tr_base = 0;
#if defined(PROBE_MASK) && ((PROBE_MASK >> 10) & 1)
    for (int prep_ = 0; prep_ < 2; ++prep_) {
#else
    {
#endif
    bf16* WA = (bf16*)(ws + WS_WA);
    for (int n = 0; n < 3; ++n) TR_RUN(INP(13) + (size_t)n * DM * DM, DM, DM, 0, DM, DM, WA, n * DM);
    for (int d = 0; d < 2; ++d) TR_RUN(INP(15) + (size_t)d * DM * 96, 96, DM, 0, DM, 96, WA, 6144 + d * 96);
    for (int d = 0; d < 2; ++d) TR_RUN(INP(18) + (size_t)d * DM * 64, 64, DM, 0, DM, 64, WA, 6144 + 256 + d * 64);
    TR_RUN(INP(20), 256, DM, 0, DM, 256, WA, 6144 + 512);
    {
        const size_t nvec = (size_t)(64 + 128) * DM / 8;
        for (size_t i = (size_t)gw * 64 + F.lane; i < nvec; i += (size_t)NGWv * 64) {
            const size_t e = i * 8; const size_t row = e / DM, col = e % DM; const size_t r = row < 64 ? 6144 + 192 + row : 6144 + 256 + 128 + (row - 64);
            *(GAS v4u*)(WA + r * DM + col) = (v4u){0u, 0u, 0u, 0u}; }
    }
    bf16* WL2 = (bf16*)(ws + WS_WL2);
    for (int d = 0; d < 2; ++d) TR_RUN(INP(16) + (size_t)d * 96 * DM, DM, 96, d * 96, 256, DM, WL2, d * DM);
    for (int d = 0; d < 2; ++d) TR_RUN(INP(19) + (size_t)d * 64 * DM, DM, 64, d * 64, 256, DM, WL2, (2 + d) * DM);
    TR_RUN(INP(21), DM, 256, 0, 256, DM, WL2, 4 * DM);
    bf16* WO = (bf16*)(ws + WS_WO);
    TR_RUN(INP(27), DM, DM, 0, DM, DM, WO, 0); TR_RUN(INP(31), DM, DM, 0, DM, DM, WO, DM); TR_RUN(INP(35), DM, DM, 0, DM, DM, WO, 2 * DM); TR_RUN(INP(42), DM, DM, 0, DM, DM, WO, 3 * DM);
    {
        bf16* WQ = (bf16*)(ws + WS_WQKV); const float* Wsrc = INP(28);
        const int nkb = DM / 64, nit = nkb * 128;
        for (int it = (gw + NGWv - (int)(tr_base % NGWv)) % NGWv; it < nit; it += NGWv) { const int kb = it / 128, cb = it % 128; const int tile = cb >> 3, hl = (cb & 7) >> 2, qtr = cb & 3;
            const int db = tile * 8 + (qtr & 1) * 4 + hl * 2 + (qtr >> 1);
            transpose_item(Wsrc + cb * 32, 3 * DM, DM, 0, DM, 32, WQ, db * 32, scr, kb, F.lane); }
        tr_base += nit;
        TR_RUN(Wsrc + 2 * DM, 3 * DM, DM, 0, DM, DM, WQ, 2 * DM);
    }
    TR_RUN(INP(32), 5 * DM, DM, 0, DM, 5 * DM, (bf16*)(ws + WS_WHG), 0);
    TR_RUN(INP(36), 2 * DM, DM, 0, DM, 2 * DM, (bf16*)(ws + WS_WLR), 0);
    {
        bf16* WG = (bf16*)(ws + WS_WGATE);
        for (int q = 0; q < 64; ++q) { const int d = q >> 5, g = (q >> 4) & 1, n = (q >> 1) & 7, hf = q & 1;
            TR_RUN(INP(39) + ((size_t)((d * 2 + g) * 8 + n) * 256) * 256 + hf * 128, 256, 256, 0, 256, 128, WG, ((d * 8 + n) * 2 + hf) * 256 + g * 128); }
    }
    {
        const int nit = (DM / 64) * 352;
        for (int l = 0; l < NLAYER; ++l) { const float* Wsrc = INP(8) + (size_t)l * DM * DFF2;
            for (int it = (gw + NGWv - (int)(tr_base % NGWv)) % NGWv; it < nit; it += NGWv) { const int kb = it / 352, cb = it % 352; const int bj = cb / 176, rem = cb % 176;
                const int db = (rem >> 2) * 8 + bj * 4 + (rem & 3);
                transpose_item(Wsrc + cb * 32, DFF2, DM, 0, DM, 32, (bf16*)(ws + WS_WUP), l * DFF2 + db * 32, scr, kb, F.lane); }
            tr_base += nit; }
    }
    for (int l = 0; l < NLAYER; ++l) TR_RUN(INP(11) + (size_t)l * DFF * DM, DM, DFF, 0, DFF, DM, (bf16*)(ws + WS_WDN), l * DM);
    }
    { float* RT = (float*)(ws + WS_ROPE);
      for (int i = gw * 64 + F.lane; i < LTOK * 64; i += NGWv * 64) { const int t = i >> 6, f = i & 63; float ang = 0.f;
          if (t >= NCTX) { const int p = t - NCTX; const float pos = (float)((f < 32) ? (p >> 6) : (p & 63)); const float invf = powf(10000.0f, -(float)(f & 31) / 32.0f); ang = pos * invf; }
          RT[2 * i] = cosf(ang); RT[2 * i + 1] = sinf(ang); } }
    { float* LB = (float*)(ws + WS_LB); const float* lower = INP(33);
      for (int i = gw * 64 + F.lane; i < 2 * DM; i += NGWv * 64) { const int d = i / DM, c = i % DM; float v[4], mx = -1e30f;
          for (int l = 0; l < 4; ++l) { v[l] = lower[(size_t)(d * 4 + l) * DM + c]; mx = fmaxf(mx, v[l]); }
          float s = 0.f; for (int l = 0; l < 4; ++l) { v[l] = expf(v[l] - mx); s += v[l]; }
          LB[i] = (v[1] + v[2]) / s; } }
    {
        __syncthreads();
        LAS float* cv = (LAS float*)(F.lds + RING_OFF);
        LAS float* red = (LAS float*)(F.lds + RING_OFF + 5 * DM * 4);
        { f32x4 xv[5];
#pragma unroll
          for (int r = 0; r < 5; ++r) xv[r] = ((const GAS f32x4*)((r < 4) ? INP(1) + r * DM : INP(3)))[F.tid];
#pragma unroll
          for (int r = 0; r < 5; ++r) { f32x4 o; o.x = xv[r].x / (1.f + expf(-xv[r].x)); o.y = xv[r].y / (1.f + expf(-xv[r].y)); o.z = xv[r].z / (1.f + expf(-xv[r].z)); o.w = xv[r].w / (1.f + expf(-xv[r].w));
              ((LAS f32x4*)cv)[r * (DM / 4) + F.tid] = o; } }
        __syncthreads();
        float* MOD = (float*)(ws + WS_MOD);
        const int NIT = NLAYER * 96 * 2;
        for (int it = F.vcu; it < NIT; it += F.G) {
            const int l = it / 192, rem = it % 192, cb = rem >> 1, kh = rem & 1;
            const float* Wl = INP(4) + (size_t)l * DM * (NMOD * DM) + cb * 128 + 2 * F.lane;
            const int kbeg = kh * 1024 + F.wave * 128;
            float a0[5], a1[5];
#pragma unroll
            for (int r = 0; r < 5; ++r) { a0[r] = 0.f; a1[r] = 0.f; }
#pragma unroll 4
            for (int kk = 0; kk < 128; ++kk) { const int k = kbeg + kk; const f32x2 w = *(const f32x2*)(Wl + (size_t)k * (NMOD * DM));
#pragma unroll
                for (int r = 0; r < 5; ++r) { const float c = cv[r * DM + k]; a0[r] += c * w.x; a1[r] += c * w.y; } }
#pragma unroll
            for (int r = 0; r < 5; ++r) { red[(F.wave * 5 + r) * 128 + 2 * F.lane] = a0[r]; red[(F.wave * 5 + r) * 128 + 2 * F.lane + 1] = a1[r]; }
            __syncthreads();
            for (int o = F.tid; o < 5 * 128; o += NWAVES * 64) { const int r = o / 128, c = o % 128; float s = 0.f;
#pragma unroll
                for (int w = 0; w < 8; ++w) s += red[(w * 5 + r) * 128 + c];
                const int n = cb * 128 + c; if (kh == 0) s += INP(5)[(size_t)l * NMOD * DM + n];
                atomicAdd(MOD + ((size_t)(l * 5 + r) * NMOD * DM + n), s); }
            __syncthreads();
        }
    }
}

__device__ __forceinline__ const float* mod_ptr(const unsigned char* ws, int layer, int bsel, int j) { return (const float*)(ws + WS_MOD) + ((size_t)((layer * 5 + bsel) * NMOD + j)) * DM; }

template <int MODE, bool LAT, int NM, int NN, int LDA, int LDB> struct Sched {
    pg8::TileOrder<NM, NN> T;
    static constexpr unsigned a_tile = 256u * LDA * 2u, b_tile = 256u * LDB * 2u;
    __device__ void init(int G, int c) { T.init(G, c); }
    __device__ __forceinline__ bool next(int i, pg8::Unit& u) const {
        int pm, pn; if (!T.tile(i, pm, pn)) return false;
        if (LAT) pm = (pm >> 3) * 9 + 1 + (pm & 7);
        u.pm = pm; u.pn = pn; u.half = -1;
        if (MODE == 0) { u.aoff = (unsigned)pm * a_tile; u.boff = (unsigned)pn * b_tile; }
        else if (MODE == 1) { const int grp = pn < 24 ? (pn >> 3) : (pn - 21); u.aoff = ((unsigned)grp * 36u + pm) * a_tile; u.boff = (unsigned)pn * b_tile; }
        else if (MODE == 2) { const int g = pn >> 3, hg = (g == 4) ? 2 : (g >> 1); u.aoff = ((unsigned)hg * 36u + pm) * a_tile; u.boff = (unsigned)pn * b_tile; }
        else { const int n = (pn >> 1) & 7; u.aoff = (unsigned)pm * a_tile + (unsigned)n * 512u; u.boff = (unsigned)pn * b_tile; }
        return true;
    }
};
template <int SPLIT, int KSUB, int LDA, int LDB> struct SchedSplit {
    int G, c;
    __device__ void init(int G_, int c_) { G = G_; c = c_; }
    __device__ __forceinline__ bool next(int i, pg8::Unit& u) const {
        const int L = i * G + c; if (L >= 32 * SPLIT) return false;
        const int tile = L / SPLIT, ks = L % SPLIT; const int pm = 32 + (tile & 3), pn = tile >> 2;
        u.pm = pm; u.pn = pn | (ks << 8); u.half = -1;
        u.aoff = (unsigned)pm * (256u * LDA * 2u) + (unsigned)ks * (KSUB * 2u); u.boff = (unsigned)pn * (256u * LDB * 2u) + (unsigned)ks * (KSUB * 2u);
        return true;
    }
};

template <int SPLIT, int KSUB, int LDA, int LDB> struct SchedSplitHalf {
    int G, c;
    __device__ void init(int G_, int c_) { G = G_; c = c_; }
    __device__ __forceinline__ bool next(int i, pg8::Unit& u) const {
        const int L = i * G + c; if (L >= 64 * SPLIT) return false;
        const int h = L & 1, Lq = L >> 1; const int tile = Lq / SPLIT, ks = Lq % SPLIT; const int pm = 32 + (tile & 3), pn = tile >> 2;
        u.pm = pm; u.pn = pn | (ks << 8); u.half = h;
        u.aoff = (unsigned)pm * (256u * LDA * 2u) + (unsigned)h * (128u * LDA * 2u) + (unsigned)ks * (KSUB * 2u); u.boff = (unsigned)pn * (256u * LDB * 2u) + (unsigned)ks * (KSUB * 2u);
        return true;
    }
};
template <bool LAT, int NM, int NN, int LMAX, int LDA, int LDB> struct SchedHead {
    int G, c;
    __device__ void init(int G_, int c_) { G = G_; c = c_; }
    __device__ __forceinline__ bool next(int i, pg8::Unit& u) const {
        const int L = i * G + c; if (L >= LMAX) return false;
        int pm, pn; pg8::TileOrder<NM, NN>::tileL(L, pm, pn);
        if (LAT) pm = (pm >> 3) * 9 + 1 + (pm & 7);
        u.pm = pm; u.pn = pn; u.half = -1; u.aoff = (unsigned)pm * (256u * LDA * 2u); u.boff = (unsigned)pn * (256u * LDB * 2u);
        return true;
    }
};
template <bool LAT, int NM, int NN, int LMAX, int NT, int LDA, int LDB> struct SchedHT {
    int G, c;
    __device__ void init(int G_, int c_) { G = G_; c = c_; }
    __device__ __forceinline__ bool next(int i, pg8::Unit& u) const {
        const int L = i * G + c; if (L >= LMAX + 2 * NT) return false;
        const bool whole = L < LMAX; const int Lp = L - LMAX; const int h = whole ? 0 : (Lp & 1);
        int pm, pn; pg8::TileOrder<NM, NN>::tileL(whole ? L : LMAX + (Lp >> 1), pm, pn);
        if (LAT) pm = (pm >> 3) * 9 + 1 + (pm & 7);
        u.pm = pm; u.pn = pn; u.half = whole ? -1 : h; u.aoff = (unsigned)pm * (256u * LDA * 2u) + (unsigned)h * (128u * LDA * 2u); u.boff = (unsigned)pn * (256u * LDB * 2u);
        return true;
    }
};
template <bool LAT, int NM, int NN, int L0, int NT, int LDA, int LDB> struct SchedTailHalf {
    int G, c;
    __device__ void init(int G_, int c_) { G = G_; c = c_; }
    __device__ __forceinline__ bool next(int i, pg8::Unit& u) const {
        const int Lp = i * G + c; if (Lp >= 2 * NT) return false;
        const int tu = Lp >> 1, h = Lp & 1;
        int pm, pn; pg8::TileOrder<NM, NN>::tileL(L0 + tu, pm, pn);
        if (LAT) pm = (pm >> 3) * 9 + 1 + (pm & 7);
        u.pm = pm; u.pn = pn; u.half = h; u.aoff = (unsigned)pm * (256u * LDA * 2u) + (unsigned)h * (128u * LDA * 2u); u.boff = (unsigned)pn * (256u * LDB * 2u);
        return true;
    }
};

template <int kind> struct EpiBf16Route {
    static constexpr bool PERM = true; static constexpr bool PERMA = false;
    bf16* O; int ldc;
    unsigned char* ws; const float* p0; const float* p1;
    static __device__ __forceinline__ float act(int mode, float x, float p) {
        if (kind == 0 || kind == 5) return x;
        if (kind == 1) { const float e = __expf(mode == 1 ? 2.f * x : -x); const float r = __builtin_amdgcn_rcpf(e + 1.f); return mode == 0 ? x : (mode == 1 ? 1.f - 2.f * r : r); }
        if (kind == 2) { const float s = sigmoidf_(x + p); const float dcy = __expf(-0.606531f * s); return mode == 4 ? dcy : (mode == 2 ? s : x); }
        if (kind == 3) { const float s = sigmoidf_(mode == 6 ? -x : x); return mode == 0 ? x : (mode == 3 ? x * s : (1.f - p) * s); }
        return mode == 5 ? gelu_tanh_(x) : x;
    }
    __device__ __forceinline__ void operator()(const pg8::f32x4 (&acc)[2][2][4][2], const pg8::Unit& u, int wr, int wc, int fr, int fq) const {
        bf16* base = O; int ld = ldc, colt = u.pn * 256, mode = 0; const float* par = nullptr;
        if (kind == 1) { if (u.pn < 24) { const int g = u.pn >> 3; base = (bf16*)(ws + (g == 0 ? L0_R : (g == 1 ? L0_K : L0_V))); ld = DM; colt = (u.pn & 7) * 256; }
                         else { const int hg = u.pn - 24; base = (bf16*)(ws + L0_HID) + (size_t)hg * NTOK * 256; ld = 256; colt = 0; mode = hg == 0 ? 1 : (hg == 1 ? 0 : 2); } }
        else if (kind == 2) { const int g = u.pn >> 3; colt = (u.pn & 7) * 256; ld = DM;
                         base = (bf16*)(ws + (g == 0 ? L0_DEC0 : g == 1 ? L0_DEC1 : g == 2 ? L0_IC0 : g == 3 ? L0_IC1 : L0_G));
                         if (g < 2) { mode = 4; par = p0 + g * DM + colt; } else if (g < 4) { mode = 2; par = p1 + (g - 2) * DM + colt; } }
        else if (kind == 3) { const int g = u.pn >> 3; if (g == 0 || g == 2) mode = 3; else if (g >= 3) { mode = 6; par = p0 + (g - 3) * DM + (u.pn & 7) * 256; } }
        else if (kind == 4) { if (u.pn < 8) mode = 5; }
        const int row0 = u.pm * 256 + wr * 64 + fr, col0 = colt + wc * 32 + 8 * fq, pc0 = wc * 32 + 8 * fq;
        const int ai0 = u.half < 0 ? 0 : u.half, nai = u.half < 0 ? 2 : 1;
        if (kind == 5 && u.pn < 16) {
            const int x = wc * 32 + 8 * fq, hl = x >> 6, y = x & 63; const int ncol = u.pn * 256 + hl * 128 + (y < 32 ? y : y + 32);
            const float* RT = (const float*)(ws + WS_ROPE);
#pragma unroll
            for (int ai = 0; ai < 2; ++ai) if (ai < nai)
#pragma unroll
                for (int m = 0; m < 4; ++m) { const int row = row0 + (ai0 + ai) * 128 + m * 16; const int t = row % LTOK;
                    const GAS pg8::f32x4* cs = (const GAS pg8::f32x4*)(RT + ((size_t)t * 64 + y) * 2);
                    const pg8::f32x4 c0 = cs[0], c1 = cs[1], c2 = cs[2], c3 = cs[3];
                    const pg8::f32x4 a0 = acc[ai][0][m][0], a1 = acc[ai][0][m][1], b0 = acc[ai][1][m][0], b1 = acc[ai][1][m][1];
                    pg8::u32x4 wa, wb;
                    wa.x = pk2(a0[0] * c0[0] - b0[0] * c0[1], a0[1] * c0[2] - b0[1] * c0[3]); wa.y = pk2(a0[2] * c1[0] - b0[2] * c1[1], a0[3] * c1[2] - b0[3] * c1[3]);
                    wa.z = pk2(a1[0] * c2[0] - b1[0] * c2[1], a1[1] * c2[2] - b1[1] * c2[3]); wa.w = pk2(a1[2] * c3[0] - b1[2] * c3[1], a1[3] * c3[2] - b1[3] * c3[3]);
                    wb.x = pk2(b0[0] * c0[0] + a0[0] * c0[1], b0[1] * c0[2] + a0[1] * c0[3]); wb.y = pk2(b0[2] * c1[0] + a0[2] * c1[1], b0[3] * c1[2] + a0[3] * c1[3]);
                    wb.z = pk2(b1[0] * c2[0] + a1[0] * c2[1], b1[1] * c2[2] + a1[1] * c2[3]); wb.w = pk2(b1[2] * c3[0] + a1[2] * c3[1], b1[3] * c3[2] + a1[3] * c3[3]);
                    bf16* rp_ = base + (size_t)row * ld + ncol;
                    *(pg8::u32x4*)rp_ = wa; *(pg8::u32x4*)(rp_ + 32) = wb; }
            return;
        }
#pragma unroll
        for (int bj = 0; bj < 2; ++bj) {
            pg8::f32x4 pa = {0.f, 0.f, 0.f, 0.f}, pb = {0.f, 0.f, 0.f, 0.f};
            if ((kind == 2 || kind == 3) && par) { pa = *(const GAS pg8::f32x4*)(par + pc0 + bj * 128); pb = *(const GAS pg8::f32x4*)(par + pc0 + bj * 128 + 4); }
#pragma unroll
            for (int ai = 0; ai < 2; ++ai) if (ai < nai)
#pragma unroll
                for (int m = 0; m < 4; ++m) { bf16* rowp = base + (size_t)(row0 + (ai0 + ai) * 128 + m * 16) * ld + col0 + bj * 128;
                    pg8::f32x4 v0 = acc[ai][bj][m][0], v1 = acc[ai][bj][m][1];
                    if (kind != 0 && kind != 5) {
#pragma unroll
                        for (int j = 0; j < 4; ++j) { v0[j] = act(mode, v0[j], pa[j]); v1[j] = act(mode, v1[j], pb[j]); } }
                    pg8::u32x4 w; w.x = pk2(v0[0], v0[1]); w.y = pk2(v0[2], v0[3]); w.z = pk2(v1[0], v1[1]); w.w = pk2(v1[2], v1[3]);
                    *(pg8::u32x4*)rowp = w; }
        }
    }
};
template <int CTRL> __device__ __forceinline__ float dppz(float v) { return __int_as_float(__builtin_amdgcn_update_dpp(0, __float_as_int(v), CTRL, 0xF, 0xF, true)); }
struct EpiConvAct {
    static constexpr bool PERM = true; static constexpr bool PERMA = true;
    bf16* A; bf16* UB; const float* cw; const float* cb;
    __device__ __forceinline__ void operator()(const pg8::f32x4 (&acc)[2][2][4][2], const pg8::Unit& u, int wr, int wc, int fr, int fq) const {
        const int pc = wc * 32 + 8 * fq, cn = u.pn * 128 + pc;
        const int rowb = u.pm * 256 + wr * 64 + 4 * fr;
        const int ai0 = u.half < 0 ? 0 : u.half, nai = u.half < 0 ? 2 : 1;
        if (fr == 0 || fr == 15) {
            const bool lo = fr == 0; const int run = u.pm * 4 + wr + 2 * ai0;
#pragma unroll
            for (int ai = 0; ai < 2; ++ai) if (ai < nai)
#pragma unroll
                for (int bj = 0; bj < 2; ++bj)
#pragma unroll
                    for (int s = 0; s < 2; ++s) { const pg8::f32x4 a0 = lo ? acc[ai][bj][s][0] : acc[ai][bj][2 + s][0], a1 = lo ? acc[ai][bj][s][1] : acc[ai][bj][2 + s][1];
                        pg8::u32x4 w; w.x = pk2(a0[0], a0[1]); w.y = pk2(a0[2], a0[3]); w.z = pk2(a1[0], a1[1]); w.w = pk2(a1[2], a1[3]);
                        *(pg8::u32x4*)(UB + (size_t)((run + 2 * ai) * 4 + (lo ? s : 2 + s)) * DFF2 + u.pn * 256 + bj * 128 + pc) = w; }
        }
#pragma unroll
        for (int h = 0; h < 2; ++h) {
            const GAS float* wp = (const GAS float*)cw + cn + 4 * h; const GAS float* bp = (const GAS float*)cb + cn + 4 * h;
            const pg8::f32x4 g0 = *(const GAS pg8::f32x4*)wp, g1 = *(const GAS pg8::f32x4*)(wp + DFF2), g2 = *(const GAS pg8::f32x4*)(wp + 2 * DFF2), gb = *(const GAS pg8::f32x4*)bp;
            const pg8::f32x4 v0 = *(const GAS pg8::f32x4*)(wp + DFF), v1 = *(const GAS pg8::f32x4*)(wp + DFF2 + DFF), v2 = *(const GAS pg8::f32x4*)(wp + 2 * DFF2 + DFF), vb = *(const GAS pg8::f32x4*)(bp + DFF);
#pragma unroll
            for (int ai = 0; ai < 2; ++ai) if (ai < nai) {
                __builtin_amdgcn_sched_barrier(0);
                float o[4][4];
#pragma unroll
                for (int j = 0; j < 4; ++j) {
                    const float xg0 = acc[ai][0][0][h][j], xg1 = acc[ai][0][1][h][j], xg2 = acc[ai][0][2][h][j], xg3 = acc[ai][0][3][h][j];
                    const float xv0 = acc[ai][1][0][h][j], xv1 = acc[ai][1][1][h][j], xv2 = acc[ai][1][2][h][j], xv3 = acc[ai][1][3][h][j];
                    const float pg = dppz<0x111>(xg3), ng = dppz<0x101>(xg0), pv = dppz<0x111>(xv3), nv = dppz<0x101>(xv0);
                    const float og0 = gb[j] + g0[j] * pg + g1[j] * xg0 + g2[j] * xg1, ov0 = vb[j] + v0[j] * pv + v1[j] * xv0 + v2[j] * xv1;
                    const float og1 = gb[j] + g0[j] * xg0 + g1[j] * xg1 + g2[j] * xg2, ov1 = vb[j] + v0[j] * xv0 + v1[j] * xv1 + v2[j] * xv2;
                    const float og2 = gb[j] + g0[j] * xg1 + g1[j] * xg2 + g2[j] * xg3, ov2 = vb[j] + v0[j] * xv1 + v1[j] * xv2 + v2[j] * xv3;
                    const float og3 = gb[j] + g0[j] * xg2 + g1[j] * xg3 + g2[j] * ng, ov3 = vb[j] + v0[j] * xv2 + v1[j] * xv3 + v2[j] * nv;
                    o[0][j] = siluf_(og0) * ov0; o[1][j] = siluf_(og1) * ov1; o[2][j] = siluf_(og2) * ov2; o[3][j] = siluf_(og3) * ov3; }
#pragma unroll
                for (int m = 0; m < 4; ++m) { pg8::u32x2 w; w.x = pk2(o[m][0], o[m][1]); w.y = pk2(o[m][2], o[m][3]);
                    *(pg8::u32x2*)(A + (size_t)(rowb + (ai0 + ai) * 128 + m) * DFF + cn + 4 * h) = w; }
            }
            __builtin_amdgcn_sched_barrier(0);
        }
    }
};
struct EpiResid {
    static constexpr bool PERM = true; static constexpr bool PERMA = false;
    bf16* DELTA; const unsigned char* ws; int layer, j;
    __device__ __forceinline__ void operator()(const pg8::f32x4 (&acc)[2][2][4][2], const pg8::Unit& u, int wr, int wc, int fr, int fq) const {
        const int bsel = (u.pm % 9 == 0) ? 4 : (u.pm / 9);
        const float* gate = mod_ptr(ws, layer, bsel, j);
        const int row0 = u.pm * 256 + wr * 64 + fr, col0 = u.pn * 256 + wc * 32 + 8 * fq;
#pragma unroll
        for (int bj = 0; bj < 2; ++bj) {
            const pg8::f32x4 ga = *(const GAS pg8::f32x4*)(gate + col0 + bj * 128), gb = *(const GAS pg8::f32x4*)(gate + col0 + bj * 128 + 4);
#pragma unroll
            for (int ai = 0; ai < 2; ++ai)
#pragma unroll
                for (int m = 0; m < 4; ++m) { const pg8::f32x4 v0 = acc[ai][bj][m][0] * ga, v1 = acc[ai][bj][m][1] * gb;
                    pg8::u32x4 w; w.x = pk2(v0[0], v0[1]); w.y = pk2(v0[2], v0[3]); w.z = pk2(v1[0], v1[1]); w.w = pk2(v1[2], v1[3]);
                    *(pg8::u32x4*)(DELTA + (size_t)(row0 + ai * 128 + m * 16) * DM + col0 + bj * 128) = w; }
        }
    }
};
struct EpiPartial {
    static constexpr bool PERM = true; static constexpr bool PERMA = false;
    bf16* PART;
    __device__ __forceinline__ void operator()(const pg8::f32x4 (&acc)[2][2][4][2], const pg8::Unit& u, int wr, int wc, int fr, int fq) const {
        const int ks = u.pn >> 8, pn = u.pn & 255;
        bf16* base = PART + (size_t)ks * 1024 * DM; const int row0 = (u.pm - 32) * 256 + wr * 64 + fr, col0 = pn * 256 + wc * 32 + 8 * fq;
        const int ai0 = u.half < 0 ? 0 : u.half, nai = u.half < 0 ? 2 : 1;
#pragma unroll
        for (int ai = 0; ai < 2; ++ai) if (ai < nai)
#pragma unroll
            for (int m = 0; m < 4; ++m)
#pragma unroll
                for (int bj = 0; bj < 2; ++bj) { const pg8::f32x4 v0 = acc[ai][bj][m][0], v1 = acc[ai][bj][m][1];
                    pg8::u32x4 w; w.x = pk2(v0[0], v0[1]); w.y = pk2(v0[2], v0[3]); w.z = pk2(v1[0], v1[1]); w.w = pk2(v1[2], v1[3]);
                    *(pg8::u32x4*)(base + (size_t)(row0 + (ai0 + ai) * 128 + m * 16) * DM + col0 + bj * 128) = w; }
    }
};
struct EpiGates {
    static constexpr bool PERM = true; static constexpr bool PERMA = false;
    unsigned char* ws; const float* b_gate; const float* lam;
    __device__ __forceinline__ void operator()(const pg8::f32x4 (&acc)[2][2][4][2], const pg8::Unit& u, int wr, int wc, int fr, int fq) const {
        const int d = u.pn >> 4, nb = (u.pn >> 1) & 7, hf = u.pn & 1;
        const int c0 = nb * 256 + hf * 128 + wc * 32 + 8 * fq;
        const int row0 = u.pm * 256 + wr * 64 + fr;
        const bf16* XB = (const bf16*)(ws + L3_XB);
        bf16* LOGA = (bf16*)(ws + L3_LOGA) + (size_t)d * NTOK * DM; bf16* UU = (bf16*)(ws + L3_UU) + (size_t)d * NTOK * DM;
#pragma unroll
        for (int n = 0; n < 2; ++n) {
            const int c4 = c0 + 4 * n;
            const pg8::f32x4 br = *(const pg8::f32x4*)(b_gate + (size_t)(d * 2 + 0) * DM + c4), bi = *(const pg8::f32x4*)(b_gate + (size_t)(d * 2 + 1) * DM + c4);
            const pg8::f32x4 lm = *(const pg8::f32x4*)(lam + (size_t)d * DM + c4); pg8::f32x4 sp;
#pragma unroll
            for (int j = 0; j < 4; ++j) sp[j] = __logf(1.f + __expf(-lm[j]));
#pragma unroll
            for (int ai = 0; ai < 2; ++ai)
#pragma unroll
                for (int m = 0; m < 4; ++m) { const int row = row0 + ai * 128 + m * 16; const size_t off = (size_t)row * DM + c4;
                    const v2u xw = *(const GAS v2u*)(XB + off);
                    const float xb[4] = {bflo(xw.x), bfhi(xw.x), bflo(xw.y), bfhi(xw.y)};
                    float la[4], uu[4];
#pragma unroll
                    for (int j = 0; j < 4; ++j) { const float rg = sigmoidf_(acc[ai][0][m][n][j] + br[j]), ig = sigmoidf_(acc[ai][1][m][n][j] + bi[j]);
                        const float lg = -8.0f * rg * sp[j]; la[j] = lg;
                        uu[j] = __builtin_amdgcn_sqrtf(fmaxf(1.f - __expf(2.f * lg), 0.f)) * ig * xb[j]; }
                    v2u w; w.x = pk2(la[0], la[1]); w.y = pk2(la[2], la[3]); *(GAS v2u*)(LOGA + off) = w;
                    w.x = pk2(uu[0], uu[1]); w.y = pk2(uu[2], uu[3]); *(GAS v2u*)(UU + off) = w; }
        }
    }
};

template <bool LAT, bool TO_OUT, bool WITH_H, int NSPLIT>
__device__ __forceinline__ void ln_phase(Frame& F, const bf16* DELTA, const float* Zin, float* Zout, float* dout, bf16* H, const float* gam, const float* bet, int mlayer, int jshift, const bf16* PART, int glayer, int jgate) {
    const int gw = GW(F), NGWv = NGW(F); const int nrows = LAT ? NLAT : NTOK;
    for (int idx = gw; idx < nrows; idx += NGWv) {
        int m, b, t; if (LAT) { b = idx >> 11; t = NCTX + (idx & 2047); m = b * LTOK + t; } else { m = idx; b = m / LTOK; t = m % LTOK; }
        const int bsel = (t < NCTX) ? 4 : b;
        f32x4 v[8]; float s = 0.f;
        if (NSPLIT > 0 && m >= 8192) {
            const GAS f32x4* zr = (const GAS f32x4*)(Zin + (size_t)m * DM) + F.lane; const GAS f32x4* gr = (const GAS f32x4*)mod_ptr(F.ws, glayer, bsel, jgate) + F.lane;
            const GAS v2u* pr = (const GAS v2u*)(PART + (size_t)(m - 8192) * DM) + F.lane;
#pragma unroll
            for (int j = 0; j < 8; ++j) { f32x4 a = {0.f, 0.f, 0.f, 0.f};
#pragma unroll
                for (int p = 0; p < NSPLIT; ++p) { const v2u pw = pr[(size_t)p * (1024 * DM / 4) + 64 * j]; a += (f32x4){bflo(pw.x), bfhi(pw.x), bflo(pw.y), bfhi(pw.y)}; }
                v[j] = zr[64 * j] * DN_ALPHA + gr[64 * j] * a; s += (v[j].x + v[j].y) + (v[j].z + v[j].w); }
        } else {
            const GAS f32x4* zr = (const GAS f32x4*)(Zin + (size_t)m * DM) + F.lane; const GAS v2u* dr = (const GAS v2u*)(DELTA + (size_t)m * DM) + F.lane;
#pragma unroll
            for (int j = 0; j < 8; ++j) { const v2u dw = dr[64 * j]; const f32x4 dl = {bflo(dw.x), bfhi(dw.x), bflo(dw.y), bfhi(dw.y)};
                v[j] = zr[64 * j] * DN_ALPHA + dl; s += (v[j].x + v[j].y) + (v[j].z + v[j].w); }
        }
        const float mean = wave_sum(s) * (1.f / DM); float s2 = 0.f;
#pragma unroll
        for (int j = 0; j < 8; ++j) { v[j] = v[j] - mean; s2 += (v[j].x * v[j].x + v[j].y * v[j].y) + (v[j].z * v[j].z + v[j].w * v[j].w); }
        const float rstd = 1.f / sqrtf(wave_sum(s2) * (1.f / DM) + LN_EPS);
        const float* sh = WITH_H ? mod_ptr(F.ws, mlayer, bsel, jshift) : nullptr; const float* sc = WITH_H ? mod_ptr(F.ws, mlayer, bsel, jshift + 1) : nullptr;
        float* zo = TO_OUT ? dout + ((size_t)b * SEQ + (t - NCTX)) * DM : Zout + (size_t)m * DM;
#pragma unroll
        for (int j = 0; j < 8; ++j) { const int col = 256 * j + 4 * F.lane;
            const f32x4 g = *(const f32x4*)(gam + col), be = *(const f32x4*)(bet + col);
            const f32x4 z = v[j] * rstd * g + be;
            *(GAS f32x4*)(zo + col) = z;
            if (WITH_H) { const f32x4 s1 = *(const GAS f32x4*)(sc + col), s0 = *(const GAS f32x4*)(sh + col); const f32x4 h = z * (s1 + 1.f) + s0;
                v2u w; w.x = pk2(h.x, h.y); w.y = pk2(h.z, h.w); *(GAS v2u*)(H + (size_t)m * DM + col) = w; } }
    }
}
__device__ __forceinline__ const float* z0_row(const float* Zb, const float* xin, const float* cin, bool z0in, int m, int b, int t) {
    return z0in ? ((t < NCTX) ? cin + ((size_t)b * NCTX + t) * DM : xin + ((size_t)b * SEQ + (t - NCTX)) * DM) : Zb + (size_t)m * DM;
}
#define LN_ROWINFO(idx_, m_, b_, t_) do { if (LAT) { b_ = (idx_) >> 11; t_ = NCTX + ((idx_) & 2047); m_ = b_ * LTOK + t_; } else { m_ = (idx_); b_ = m_ / LTOK; t_ = m_ % LTOK; } } while (0)
#define LNI(j_) (128 * ((j_) >> 1) + 2 * F.lane + ((j_) & 1))
#define LN_SPLIT_D(dst, PARTp, gatep, m_) do { const GAS v2u* pr_ = (const GAS v2u*)((PARTp) + (size_t)((m_) - 8192) * DM); const GAS f32x4* gr_ = (const GAS f32x4*)(gatep); \
        _Pragma("unroll") for (int j_ = 0; j_ < 8; ++j_) { f32x4 a_ = {0.f, 0.f, 0.f, 0.f}; \
            _Pragma("unroll") for (int p_ = 0; p_ < NSPLIT; ++p_) { const v2u pw_ = pr_[(size_t)p_ * (1024 * DM / 4) + LNI(j_)]; a_ += (f32x4){bflo(pw_.x), bfhi(pw_.x), bflo(pw_.y), bfhi(pw_.y)}; } \
            a_ = a_ * gr_[LNI(j_)]; dst[j_].x = pk2(a_.x, a_.y); dst[j_].y = pk2(a_.z, a_.w); } } while (0)
__device__ __forceinline__ f32x4 zq_decode(const f32x4 raw, float sc) { const int a = __float_as_int(raw.x), b = __float_as_int(raw.y);
    return (f32x4){(float)(short)(a & 0xffff), (float)(a >> 16), (float)(short)(b & 0xffff), (float)(b >> 16)} * sc; }
#define ZQ_ROW(Zb_, m_) ((const GAS v4u*)((const unsigned short*)(Zb_) + (size_t)(m_) * DM) + F.lane)
template <bool LAT, int NSPLIT, bool Z0IN>
__device__ __forceinline__ void ln1_phase(Frame& F, bf16* D1, const float* Zb, const float* xin, const float* cin, bf16* H, float* STAT, const float* gam, const float* bet, int layer, const bf16* PART) {
    const int gw = GW(F), NGWv = NGW(F); const int nrows = LAT ? NLAT : NTOK; const int nmain = NSPLIT > 0 ? 8192 : nrows;
    LAS float* Lg = (LAS float*)(F.lds + RING_OFF); LAS float* Lb = Lg + DM; LAS float* Lm = Lb + DM;
    f32x4 zA[8], zB[8]; v2u dA[8], dB[8]; float sA = 1.f, sB = 1.f;
    auto loadz = [&](const int idx, f32x4 (&zz)[8], float& zs) __attribute__((always_inline)) {
        int m, b, t; LN_ROWINFO(idx, m, b, t);
        if (Z0IN) { const GAS f32x4* zr = (const GAS f32x4*)z0_row(Zb, xin, cin, true, m, b, t);
#pragma unroll
            for (int j = 0; j < 8; ++j) zz[j] = zr[LNI(j)]; }
        else { const GAS v4u* qr = ZQ_ROW(Zb, m); zs = *(const GAS float*)((const float*)(F.ws + WS_ZS) + m);
#pragma unroll
            for (int k = 0; k < 4; ++k) { const v4u pw = qr[64 * k]; zz[2 * k].x = __uint_as_float(pw.x); zz[2 * k].y = __uint_as_float(pw.y); zz[2 * k + 1].x = __uint_as_float(pw.z); zz[2 * k + 1].y = __uint_as_float(pw.w); } } };
    auto loadd = [&](const int idx, v2u (&dd)[8]) __attribute__((always_inline)) {
        int m, b, t; LN_ROWINFO(idx, m, b, t); const GAS v4u* dr = (const GAS v4u*)(D1 + (size_t)m * DM) + F.lane;
#pragma unroll
        for (int k = 0; k < 4; ++k) { const v4u pw = dr[64 * k]; dd[2 * k] = (v2u){pw.x, pw.y}; dd[2 * k + 1] = (v2u){pw.z, pw.w}; } };
    auto row1 = [&](f32x4 (&zc)[8], v2u (&dc)[8], const float zsc, const int idx) __attribute__((always_inline)) {
        int m, b, t; LN_ROWINFO(idx, m, b, t); const int bsel = (t < NCTX) ? 4 : b;
        float s = 0.f;
#pragma unroll
        for (int j = 0; j < 8; ++j) { const f32x4 dl = {bflo(dc[j].x), bfhi(dc[j].x), bflo(dc[j].y), bfhi(dc[j].y)}; const f32x4 z0v = Z0IN ? zc[j] : zq_decode(zc[j], zsc);
            zc[j] = z0v * DN_ALPHA + dl; s += (zc[j].x + zc[j].y) + (zc[j].z + zc[j].w); }
        const float mean = wave_sum(s) * (1.f / DM); float s2 = 0.f;
#pragma unroll
        for (int j = 0; j < 8; ++j) { zc[j] = zc[j] - mean; s2 += (zc[j].x * zc[j].x + zc[j].y * zc[j].y) + (zc[j].z * zc[j].z + zc[j].w * zc[j].w); }
        const float rstd = 1.f / sqrtf(wave_sum(s2) * (1.f / DM) + LN_EPS);
        if (F.lane == 0) *(GAS f32x2*)(STAT + (size_t)m * 2) = (f32x2){mean, rstd};
        const LAS float* sh = Lm + bsel * 2 * DM; const LAS float* sc = sh + DM; v2u hw = {0u, 0u};
#pragma unroll
        for (int j = 0; j < 8; ++j) { const int col = 4 * LNI(j);
            const f32x4 z = zc[j] * rstd * *(const LAS f32x4*)(Lg + col) + *(const LAS f32x4*)(Lb + col);
            const f32x4 h = z * (*(const LAS f32x4*)(sc + col) + 1.f) + *(const LAS f32x4*)(sh + col);
            v2u w; w.x = pk2(h.x, h.y); w.y = pk2(h.z, h.w);
            if (j & 1) *(GAS v4u*)(H + (size_t)m * DM + col - 4) = (v4u){hw.x, hw.y, w.x, w.y}; else hw = w; } };
    int idx = gw; bool have = idx < nmain;
    if (have) { loadz(idx, zA, sA); loadd(idx, dA); }
    {
        f32x4 pv[12];
        pv[0] = ((const GAS f32x4*)gam)[F.tid]; pv[1] = ((const GAS f32x4*)bet)[F.tid];
#pragma unroll
        for (int k = 0; k < 10; ++k) { const int v = F.tid + NWAVES * 64 * k, bs = v >> 10, r4 = v & 1023; pv[2 + k] = ((const GAS f32x4*)mod_ptr(F.ws, layer, bs, 3))[r4]; }
        ((LAS f32x4*)Lg)[F.tid] = pv[0]; ((LAS f32x4*)Lb)[F.tid] = pv[1];
#pragma unroll
        for (int k = 0; k < 10; ++k) ((LAS f32x4*)Lm)[F.tid + NWAVES * 64 * k] = pv[2 + k];
    }
    __syncthreads();
    while (have) {
        const int nidx = idx + NGWv; const bool hasn = nidx < nmain;
        if (hasn) { loadz(nidx, zB, sB); loadd(nidx, dB); }
        asm volatile("" ::: "memory");
        row1(zA, dA, sA, idx);
        if (!hasn) break;
        const int fidx = nidx + NGWv; const bool hasf = fidx < nmain;
        if (hasf) { loadz(fidx, zA, sA); loadd(fidx, dA); }
        asm volatile("" ::: "memory");
        row1(zB, dB, sB, nidx);
        idx = fidx; have = hasf;
    }
    if (NSPLIT > 0) {
        for (int ti = 8192 + gw; ti < nrows; ti += NGWv) {
            int m, b, t; LN_ROWINFO(ti, m, b, t);
            loadz(ti, zA, sA); LN_SPLIT_D(dA, PART, mod_ptr(F.ws, layer, (t < NCTX) ? 4 : b, 2), m);
#pragma unroll
            for (int j = 0; j < 8; ++j) *((GAS v2u*)(D1 + (size_t)m * DM) + LNI(j)) = dA[j];
            asm volatile("" ::: "memory");
            row1(zA, dA, sA, ti);
        }
    }
}
template <bool LAT, bool TO_OUT, bool WITH_H, int NSPLIT, bool Z0IN>
__device__ __forceinline__ void ln2_phase(Frame& F, const bf16* D1, const bf16* D2, const float* Zb, const float* xin, const float* cin, float* Zout, float* dout, bf16* H, const float* STAT,
                                          const float* gam1, const float* bet1, const float* gam2, const float* bet2, int layer, const bf16* PART) {
    const int gw = GW(F), NGWv = NGW(F); const int nrows = LAT ? NLAT : NTOK; const int nmain = NSPLIT > 0 ? 8192 : nrows;
    LAS float* Lg1 = (LAS float*)(F.lds + RING_OFF); LAS float* Lb1 = Lg1 + DM; LAS float* Lg2 = Lb1 + DM; LAS float* Lb2 = Lg2 + DM; LAS float* Lm = Lb2 + DM;
    f32x4 zA[8], zB[8]; v2u d1A[8], d1B[8], d2A[8], d2B[8]; f32x2 stA = {0.f, 0.f}, stB = {0.f, 0.f}; float sA = 1.f, sB = 1.f;
    auto loadz = [&](const int idx, f32x4 (&zz)[8], v2u (&dd1)[8], f32x2& st, float& zs) __attribute__((always_inline)) {
        int m, b, t; LN_ROWINFO(idx, m, b, t);
        if (Z0IN) { const GAS f32x4* zr = (const GAS f32x4*)z0_row(Zb, xin, cin, true, m, b, t);
#pragma unroll
            for (int j = 0; j < 8; ++j) zz[j] = zr[LNI(j)]; }
        else { const GAS v4u* qr = ZQ_ROW(Zb, m); zs = *(const GAS float*)((const float*)(F.ws + WS_ZS) + m);
#pragma unroll
            for (int k = 0; k < 4; ++k) { const v4u pw = qr[64 * k]; zz[2 * k].x = __uint_as_float(pw.x); zz[2 * k].y = __uint_as_float(pw.y); zz[2 * k + 1].x = __uint_as_float(pw.z); zz[2 * k + 1].y = __uint_as_float(pw.w); } }
        const GAS v4u* dr = (const GAS v4u*)(D1 + (size_t)m * DM) + F.lane;
#pragma unroll
        for (int k = 0; k < 4; ++k) { const v4u pw = dr[64 * k]; dd1[2 * k] = (v2u){pw.x, pw.y}; dd1[2 * k + 1] = (v2u){pw.z, pw.w}; }
        st = *(const GAS f32x2*)(STAT + (size_t)m * 2); };
    auto loadd2 = [&](const int idx, v2u (&dd2)[8]) __attribute__((always_inline)) {
        int m, b, t; LN_ROWINFO(idx, m, b, t); const GAS v4u* dr = (const GAS v4u*)(D2 + (size_t)m * DM) + F.lane;
#pragma unroll
        for (int k = 0; k < 4; ++k) { const v4u pw = dr[64 * k]; dd2[2 * k] = (v2u){pw.x, pw.y}; dd2[2 * k + 1] = (v2u){pw.z, pw.w}; } };
    auto row2 = [&](f32x4 (&zc)[8], v2u (&d1c)[8], v2u (&d2c)[8], const f32x2 stc, const float zsc, const int idx) __attribute__((always_inline)) {
        int m, b, t; LN_ROWINFO(idx, m, b, t); const int bsel = (t < NCTX) ? 4 : b;
        float s = 0.f;
#pragma unroll
        for (int j = 0; j < 8; ++j) { const int col = 4 * LNI(j);
            const f32x4 dl1 = {bflo(d1c[j].x), bfhi(d1c[j].x), bflo(d1c[j].y), bfhi(d1c[j].y)}, dl2 = {bflo(d2c[j].x), bfhi(d2c[j].x), bflo(d2c[j].y), bfhi(d2c[j].y)};
            const f32x4 z0v = Z0IN ? zc[j] : zq_decode(zc[j], zsc);
            const f32x4 z1 = ((z0v * DN_ALPHA + dl1) - stc.x) * stc.y * *(const LAS f32x4*)(Lg1 + col) + *(const LAS f32x4*)(Lb1 + col);
            zc[j] = z1 * DN_ALPHA + dl2; s += (zc[j].x + zc[j].y) + (zc[j].z + zc[j].w); }
        const float mean = wave_sum(s) * (1.f / DM); float s2 = 0.f;
#pragma unroll
        for (int j = 0; j < 8; ++j) { zc[j] = zc[j] - mean; s2 += (zc[j].x * zc[j].x + zc[j].y * zc[j].y) + (zc[j].z * zc[j].z + zc[j].w * zc[j].w); }
        const float rstd = 1.f / sqrtf(wave_sum(s2) * (1.f / DM) + LN_EPS);
        const LAS float* sh = Lm + bsel * 2 * DM; const LAS float* sc = sh + DM;
        float* zo = TO_OUT ? dout + ((size_t)b * SEQ + (t - NCTX)) * DM : nullptr;
        float qinv = 1.f; v2u qw = {0u, 0u}, hw = {0u, 0u};
        if (!TO_OUT) {
            float am = 0.f;
#pragma unroll
            for (int j = 0; j < 8; ++j) { const int col = 4 * LNI(j);
                const f32x4 z = zc[j] * rstd * *(const LAS f32x4*)(Lg2 + col) + *(const LAS f32x4*)(Lb2 + col);
                am = fmaxf(am, fmaxf(fmaxf(fabsf(z.x), fabsf(z.y)), fmaxf(fabsf(z.z), fabsf(z.w)))); }
            am = wave_max(am); const float scq = am > 0.f ? am * (1.f / 32767.f) : 1.f; qinv = am > 0.f ? 32767.f / am : 1.f;
            if (F.lane == 0) *(GAS float*)((float*)(F.ws + WS_ZS) + m) = scq;
        }
#pragma unroll
        for (int j = 0; j < 8; ++j) { const int col = 4 * LNI(j);
            const f32x4 z = zc[j] * rstd * *(const LAS f32x4*)(Lg2 + col) + *(const LAS f32x4*)(Lb2 + col);
            if (TO_OUT) *(GAS f32x4*)(zo + col) = z;
            else { const int q0 = __float2int_rn(z.x * qinv), q1 = __float2int_rn(z.y * qinv), q2 = __float2int_rn(z.z * qinv), q3 = __float2int_rn(z.w * qinv);
                v2u pw; pw.x = ((unsigned)q0 & 0xffffu) | ((unsigned)q1 << 16); pw.y = ((unsigned)q2 & 0xffffu) | ((unsigned)q3 << 16);
                if (j & 1) *(GAS v4u*)((unsigned short*)Zout + (size_t)m * DM + col - 4) = (v4u){qw.x, qw.y, pw.x, pw.y}; else qw = pw; }
            if (WITH_H) { const f32x4 h = z * (*(const LAS f32x4*)(sc + col) + 1.f) + *(const LAS f32x4*)(sh + col);
                v2u w; w.x = pk2(h.x, h.y); w.y = pk2(h.z, h.w);
                if (j & 1) *(GAS v4u*)(H + (size_t)m * DM + col - 4) = (v4u){hw.x, hw.y, w.x, w.y}; else hw = w; } } };
    int idx = gw; bool have = idx < nmain;
    if (have) { loadz(idx, zA, d1A, stA, sA); loadd2(idx, d2A); }
    {
        f32x4 pv[14];
        pv[0] = ((const GAS f32x4*)gam1)[F.tid]; pv[1] = ((const GAS f32x4*)bet1)[F.tid]; pv[2] = ((const GAS f32x4*)gam2)[F.tid]; pv[3] = ((const GAS f32x4*)bet2)[F.tid];
        if (WITH_H) {
#pragma unroll
            for (int k = 0; k < 10; ++k) { const int v = F.tid + NWAVES * 64 * k, bs = v >> 10, r4 = v & 1023; pv[4 + k] = ((const GAS f32x4*)mod_ptr(F.ws, layer + 1, bs, 0))[r4]; }
        }
        ((LAS f32x4*)Lg1)[F.tid] = pv[0]; ((LAS f32x4*)Lb1)[F.tid] = pv[1]; ((LAS f32x4*)Lg2)[F.tid] = pv[2]; ((LAS f32x4*)Lb2)[F.tid] = pv[3];
        if (WITH_H) {
#pragma unroll
            for (int k = 0; k < 10; ++k) ((LAS f32x4*)Lm)[F.tid + NWAVES * 64 * k] = pv[4 + k];
        }
    }
    __syncthreads();
    while (have) {
        const int nidx = idx + NGWv; const bool hasn = nidx < nmain;
        if (hasn) { loadz(nidx, zB, d1B, stB, sB); loadd2(nidx, d2B); }
        asm volatile("" ::: "memory");
        row2(zA, d1A, d2A, stA, sA, idx);
        if (!hasn) break;
        const int fidx = nidx + NGWv; const bool hasf = fidx < nmain;
        if (hasf) { loadz(fidx, zA, d1A, stA, sA); loadd2(fidx, d2A); }
        asm volatile("" ::: "memory");
        row2(zB, d1B, d2B, stB, sB, nidx);
        idx = fidx; have = hasf;
    }
    if (NSPLIT > 0) {
        for (int ti = 8192 + gw; ti < nrows; ti += NGWv) {
            int m, b, t; LN_ROWINFO(ti, m, b, t);
            loadz(ti, zA, d1A, stA, sA); LN_SPLIT_D(d2A, PART, mod_ptr(F.ws, layer, (t < NCTX) ? 4 : b, 5), m);
            asm volatile("" ::: "memory");
            row2(zA, d1A, d2A, stA, sA, ti);
        }
    }
}
template <bool LAT>
__device__ __forceinline__ void ffn_conv_phase(Frame& F, const bf16* U, bf16* ACT, const float* cw, const float* cb) {
    const int gw = GW(F), NGWv = NGW(F); const int nstrips = (LAT ? NLAT : NTOK) / 16; const int nitems = nstrips * 11;
    for (int it = gw; it < nitems; it += NGWv) {
        const int strip = it / 11, cblk = it % 11; const int c0 = cblk * 512 + F.lane * 8;
        int m0; if (LAT) { const int r = strip * 16; m0 = (r >> 11) * LTOK + NCTX + (r & 2047); } else m0 = strip * 16;
        const int t0 = m0 % LTOK;
        float wg[3][8], wv[3][8], bg[8], bv[8];
#pragma unroll
        for (int k = 0; k < 3; ++k) { const f32x4 a = *(const f32x4*)(cw + (size_t)k * DFF2 + c0), b = *(const f32x4*)(cw + (size_t)k * DFF2 + c0 + 4), c = *(const f32x4*)(cw + (size_t)k * DFF2 + DFF + c0), d = *(const f32x4*)(cw + (size_t)k * DFF2 + DFF + c0 + 4);
#pragma unroll
            for (int j = 0; j < 4; ++j) { wg[k][j] = a[j]; wg[k][4 + j] = b[j]; wv[k][j] = c[j]; wv[k][4 + j] = d[j]; } }
        { const f32x4 a = *(const f32x4*)(cb + c0), b = *(const f32x4*)(cb + c0 + 4), c = *(const f32x4*)(cb + DFF + c0), d = *(const f32x4*)(cb + DFF + c0 + 4);
#pragma unroll
          for (int j = 0; j < 4; ++j) { bg[j] = a[j]; bg[4 + j] = b[j]; bv[j] = c[j]; bv[4 + j] = d[j]; } }
        const bool first_in_seg = (t0 == 0 || t0 == NCTX), last_in_seg = (t0 + 16 == NCTX || t0 + 16 == LTOK);
        const GAS bf16* ug = (const GAS bf16*)U + (size_t)m0 * DFF2 + c0;
        v4u pg = {0u, 0u, 0u, 0u}, pv = {0u, 0u, 0u, 0u};
        if (!first_in_seg) { pg = *(const GAS v4u*)(ug - DFF2); pv = *(const GAS v4u*)(ug - DFF2 + DFF); }
        v4u cg = *(const GAS v4u*)(ug), cv = *(const GAS v4u*)(ug + DFF);
        for (int r = 0; r < 16; ++r) {
            v4u ng = {0u, 0u, 0u, 0u}, nv = {0u, 0u, 0u, 0u};
            if (r < 15 || !last_in_seg) { ng = *(const GAS v4u*)(ug + (size_t)(r + 1) * DFF2); nv = *(const GAS v4u*)(ug + (size_t)(r + 1) * DFF2 + DFF); }
            float o[8];
#pragma unroll
            for (int q = 0; q < 4; ++q) {
                const unsigned pgw = pg[q], cgw = cg[q], ngw = ng[q], pvw = pv[q], cvw = cv[q], nvw = nv[q];
                const float g0 = bg[2 * q] + wg[0][2 * q] * bflo(pgw) + wg[1][2 * q] * bflo(cgw) + wg[2][2 * q] * bflo(ngw);
                const float g1 = bg[2 * q + 1] + wg[0][2 * q + 1] * bfhi(pgw) + wg[1][2 * q + 1] * bfhi(cgw) + wg[2][2 * q + 1] * bfhi(ngw);
                const float v0 = bv[2 * q] + wv[0][2 * q] * bflo(pvw) + wv[1][2 * q] * bflo(cvw) + wv[2][2 * q] * bflo(nvw);
                const float v1 = bv[2 * q + 1] + wv[0][2 * q + 1] * bfhi(pvw) + wv[1][2 * q + 1] * bfhi(cvw) + wv[2][2 * q + 1] * bfhi(nvw);
                o[2 * q] = siluf_(g0) * v0; o[2 * q + 1] = siluf_(g1) * v1; }
            v4u w; w.x = pk2(o[0], o[1]); w.y = pk2(o[2], o[3]); w.z = pk2(o[4], o[5]); w.w = pk2(o[6], o[7]);
            *(GAS v4u*)(ACT + (size_t)(m0 + r) * DFF + c0) = w;
            pg = cg; pv = cv; cg = ng; cv = nv;
        }
    }
}

template <bool LAT>
__device__ __forceinline__ void ffn_fix_phase(Frame& F, const bf16* UB, bf16* ACT, const float* cw, const float* cb) {
    const int gw = GW(F), NGWv = NGW(F); const int nruns = (LAT ? NLAT : NTOK) / 64; const int nitems = nruns * 11;
    for (int it = gw; it < nitems; it += NGWv) {
        const int cblk = it % 11, rl = it / 11;
        int run; if (LAT) { const int r = rl * 64; run = ((r >> 11) * LTOK + NCTX + (r & 2047)) >> 6; } else run = rl;
        const int m0 = run * 64, t0 = m0 % LTOK;
        const bool seg_first = (t0 == 0 || t0 == NCTX), seg_last = (t0 + 64 == NCTX || t0 + 64 == LTOK);
        const int c0 = cblk * 512 + F.lane * 8; const int uc = (c0 >> 7) * 256 + (c0 & 127);
        const GAS bf16* ub = (const GAS bf16*)UB + (size_t)run * 4 * DFF2 + uc;
        v4u rg[6], rv[6];
#pragma unroll
        for (int q = 0; q < 6; ++q) { const int rq = (q == 0 && seg_first) ? 1 : ((q == 5 && seg_last) ? 4 : q);
            const GAS bf16* rp = ub + (ptrdiff_t)(rq - 1) * DFF2; rg[q] = *(const GAS v4u*)rp; rv[q] = *(const GAS v4u*)(rp + 128); }
        float wg[3][8], wv[3][8], bg[8], bv[8];
#pragma unroll
        for (int k = 0; k < 3; ++k) { const GAS float* wp = (const GAS float*)cw + (size_t)k * DFF2 + c0; const f32x4 a = *(const GAS f32x4*)wp, b = *(const GAS f32x4*)(wp + 4), c = *(const GAS f32x4*)(wp + DFF), d = *(const GAS f32x4*)(wp + DFF + 4);
#pragma unroll
            for (int j = 0; j < 4; ++j) { wg[k][j] = a[j]; wg[k][4 + j] = b[j]; wv[k][j] = c[j]; wv[k][4 + j] = d[j]; } }
        { const GAS float* bp = (const GAS float*)cb + c0; const f32x4 a = *(const GAS f32x4*)bp, b = *(const GAS f32x4*)(bp + 4), c = *(const GAS f32x4*)(bp + DFF), d = *(const GAS f32x4*)(bp + DFF + 4);
#pragma unroll
          for (int j = 0; j < 4; ++j) { bg[j] = a[j]; bg[4 + j] = b[j]; bv[j] = c[j]; bv[4 + j] = d[j]; } }
        const float zf = seg_first ? 0.f : 1.f, zl = seg_last ? 0.f : 1.f;
#pragma unroll
        for (int which = 0; which < 2; ++which) {
            const int ip = which ? 3 : 0, ic = which ? 4 : 1, in_ = which ? 5 : 2; const float mp = which ? 1.f : zf, mn = which ? zl : 1.f;
            float o[8];
#pragma unroll
            for (int q = 0; q < 4; ++q) {
                const unsigned pgw = rg[ip][q], cgw = rg[ic][q], ngw = rg[in_][q], pvw = rv[ip][q], cvw = rv[ic][q], nvw = rv[in_][q];
                const float g0 = bg[2 * q] + wg[0][2 * q] * (bflo(pgw) * mp) + wg[1][2 * q] * bflo(cgw) + wg[2][2 * q] * (bflo(ngw) * mn);
                const float g1 = bg[2 * q + 1] + wg[0][2 * q + 1] * (bfhi(pgw) * mp) + wg[1][2 * q + 1] * bfhi(cgw) + wg[2][2 * q + 1] * (bfhi(ngw) * mn);
                const float v0 = bv[2 * q] + wv[0][2 * q] * (bflo(pvw) * mp) + wv[1][2 * q] * bflo(cvw) + wv[2][2 * q] * (bflo(nvw) * mn);
                const float v1 = bv[2 * q + 1] + wv[0][2 * q + 1] * (bfhi(pvw) * mp) + wv[1][2 * q + 1] * bfhi(cvw) + wv[2][2 * q + 1] * (bfhi(nvw) * mn);
                o[2 * q] = siluf_(g0) * v0; o[2 * q + 1] = siluf_(g1) * v1; }
            v4u w; w.x = pk2(o[0], o[1]); w.y = pk2(o[2], o[3]); w.z = pk2(o[4], o[5]); w.w = pk2(o[6], o[7]);
            *(GAS v4u*)(ACT + (size_t)(m0 + (which ? 63 : 0)) * DFF + c0) = w;
        }
    }
}
__device__ __forceinline__ int flip_tok(int s) { return s < NCTX ? (NCTX - 1 - s) : (LTOK + NCTX - 1 - s); }

__device__ __forceinline__ pg8::f32x4 mma_tile(pg8::f32x4 acc, const LAS bf16* A, int lda, const LAS bf16* Bt, int ldb, int ksteps, int lane) {
    const LAS bf16* ap = A + (lane & 15) * lda + (lane >> 4) * 8; const LAS bf16* bp = Bt + (lane & 15) * ldb + (lane >> 4) * 8;
    for (int k = 0; k < ksteps; ++k) { const bf16x8 a = *(const LAS bf16x8*)(ap + k * 32), b = *(const LAS bf16x8*)(bp + k * 32);
        acc = __builtin_amdgcn_mfma_f32_16x16x32_bf16(a, b, acc, 0, 0, 0); }
    return acc;
}
template <int CTRL> __device__ __forceinline__ float dpp_f(float v) { return __int_as_float(__builtin_amdgcn_update_dpp(0, __float_as_int(v), CTRL, 0xF, 0xF, true)); }
__device__ __forceinline__ float red8(float v) { v += dpp_f<0xB1>(v); v += dpp_f<0x4E>(v); v += dpp_f<0x141>(v); return v; }
__device__ __forceinline__ float red16(float v) { v = red8(v); v += dpp_f<0x140>(v); return v; }
__device__ __forceinline__ void unpack8(const v4u w, float (&f)[8]) { f[0] = bflo(w.x); f[1] = bfhi(w.x); f[2] = bflo(w.y); f[3] = bfhi(w.y); f[4] = bflo(w.z); f[5] = bfhi(w.z); f[6] = bflo(w.w); f[7] = bfhi(w.w); }
__device__ __forceinline__ v4u pack8(const float (&f)[8]) { v4u w; w.x = pk2(f[0], f[1]); w.y = pk2(f[2], f[3]); w.z = pk2(f[4], f[5]); w.w = pk2(f[6], f[7]); return w; }
__device__ __forceinline__ void ld8f(const float* p, float (&f)[8]) { const f32x4 a = *(const f32x4*)p, b = *(const f32x4*)(p + 4); f[0] = a.x; f[1] = a.y; f[2] = a.z; f[3] = a.w; f[4] = b.x; f[5] = b.y; f[6] = b.z; f[7] = b.w; }
__device__ __forceinline__ void l0_xs_phase(Frame& F, const float* x, const float* ctx, const float* mu) {
    const int gw = GW(F), NGWv = NGW(F);
    bf16* XS = (bf16*)(F.ws + L0_XS);
    const int c0 = (gw & 3) * 512 + F.lane * 8;
    float mv[6][8];
#pragma unroll
    for (int n = 0; n < 6; ++n) ld8f(mu + (size_t)n * DM + c0, mv[n]);
    for (int it = gw; it < (NTOK / 8) * 4; it += NGWv) {
        const int strip = it >> 2; const int m0 = strip * 8, b = m0 / LTOK, t0 = m0 % LTOK;
        const float* zr = (t0 < NCTX) ? ctx + ((size_t)b * NCTX + t0) * DM : x + ((size_t)b * SEQ + (t0 - NCTX)) * DM;
        const int seg_end = (t0 < NCTX) ? NCTX : LTOK; const bool first = (t0 == 0 || t0 == NCTX);
        const int bsel = (t0 < NCTX) ? 4 : b;
        f32x4 za[10], zb[10];
#pragma unroll
        for (int q = 0; q < 10; ++q) { const bool ok = (q == 0) ? !first : (t0 + q - 1 < seg_end);
            za[q] = (f32x4){0.f, 0.f, 0.f, 0.f}; zb[q] = za[q];
            if (ok) { const GAS float* rp = (const GAS float*)zr + (ptrdiff_t)(q - 1) * DM + c0; za[q] = *(const GAS f32x4*)rp; zb[q] = *(const GAS f32x4*)(rp + 4); } }
        float s0[8], s1[8], hp[8], hc[8], hn[8];
        { const float* sh = mod_ptr(F.ws, 0, bsel, 0) + c0; const float* sc = mod_ptr(F.ws, 0, bsel, 1) + c0;
          const f32x4 a = *(const GAS f32x4*)sh, a2 = *(const GAS f32x4*)(sh + 4), c = *(const GAS f32x4*)sc, c2 = *(const GAS f32x4*)(sc + 4);
#pragma unroll
          for (int j = 0; j < 4; ++j) { s0[j] = a[j]; s0[4 + j] = a2[j]; s1[j] = c[j] + 1.f; s1[4 + j] = c2[j] + 1.f; } }
#pragma unroll
        for (int j = 0; j < 4; ++j) { hp[j] = first ? 0.f : za[0][j] * s1[j] + s0[j]; hp[4 + j] = first ? 0.f : zb[0][j] * s1[4 + j] + s0[4 + j];
                                      hc[j] = za[1][j] * s1[j] + s0[j]; hc[4 + j] = zb[1][j] * s1[4 + j] + s0[4 + j]; }
#pragma unroll
        for (int r = 0; r < 8; ++r) {
            const bool hasn = (t0 + r + 1 < seg_end);
#pragma unroll
            for (int j = 0; j < 4; ++j) { hn[j] = hasn ? za[r + 2][j] * s1[j] + s0[j] : 0.f; hn[4 + j] = hasn ? zb[r + 2][j] * s1[4 + j] + s0[4 + j] : 0.f; }
            const size_t m = (size_t)(m0 + r);
            float dx[8];
#pragma unroll
            for (int j = 0; j < 8; ++j) dx[j] = (hp[j] + hn[j]) * 0.5f - hc[j];
#pragma unroll
            for (int n = 0; n < 6; ++n) { float o[8];
#pragma unroll
                for (int j = 0; j < 8; ++j) o[j] = hc[j] + dx[j] * mv[n][j];
                *(GAS v4u*)(XS + ((size_t)n * NTOK + m) * DM + c0) = pack8(o); }
#pragma unroll
            for (int j = 0; j < 8; ++j) { hp[j] = hc[j]; hc[j] = hn[j]; }
        }
    }
}
__device__ __forceinline__ void l0_prep_phase(Frame& F, const float* k_k, const float* k_a, const float* r_k) {
    const int gw = GW(F), NGWv = NGW(F); unsigned char* ws = F.ws;
    const bf16* R = (const bf16*)(ws + L0_R); const bf16* K = (const bf16*)(ws + L0_K); const bf16* V = (const bf16*)(ws + L0_V);
    bf16* VEC = (bf16*)(ws + L0_VEC); float* SCAL = (float*)(ws + L0_SCAL); float* BONUS = (float*)(ws + L0_BONUS);
    const int l8 = F.lane & 7;
    for (int it = gw; it < NTOK * 4; it += NGWv) {
        const int m = it >> 2, h = (it & 3) * 8 + (F.lane >> 3), b = m / LTOK, t = m % LTOK; const int c0 = h * 64 + l8 * 8; const size_t e = (size_t)m * DM + c0;
        float r[8], k[8], kk[8], tmp[8], par[8];
        unpack8(*(const GAS v4u*)(R + e), r); unpack8(*(const GAS v4u*)(K + e), k);
        const v4u vraw = *(const GAS v4u*)(V + e);
        ld8f(k_k + c0, par); float ss = 0.f;
#pragma unroll
        for (int j = 0; j < 8; ++j) { kk[j] = k[j] * par[j]; ss += kk[j] * kk[j]; }
        ss = red8(ss); const float inv = 1.0f / sqrtf(ss + 1e-12f);
#pragma unroll
        for (int j = 0; j < 8; ++j) kk[j] *= inv;
        float ka[8], kdsum[8]; ld8f(k_a + c0, ka);
#pragma unroll
        for (int j = 0; j < 8; ++j) kdsum[j] = 0.f;
#pragma unroll
        for (int d = 0; d < 2; ++d) {
            float w[8], ic[8], kd[8];
            unpack8(*(const GAS v4u*)((const bf16*)(ws + (d ? L0_DEC1 : L0_DEC0)) + e), w); unpack8(*(const GAS v4u*)((const bf16*)(ws + (d ? L0_IC1 : L0_IC0)) + e), ic);
            float kr = 0.f, kkar = 0.f;
#pragma unroll
            for (int j = 0; j < 8; ++j) { kd[j] = k[j] * (1.f + (ic[j] - 1.f) * ka[j]); kdsum[j] += kd[j]; kr += kd[j] * r[j]; }
            const int s = d ? flip_tok(t) : t; const size_t sidx = (size_t)((d * NB + b) * 32 + h);
            bf16* vp = VEC + (sidx * LTOK + s) * 384 + l8 * 8;
            *(GAS v4u*)(vp) = pack8(w); *(GAS v4u*)(vp + 64) = pack8(kd); *(GAS v4u*)(vp + 128) = pack8(kk);
#pragma unroll
            for (int j = 0; j < 8; ++j) { tmp[j] = kk[j] * ic[j]; kkar += tmp[j] * r[j]; }
            *(GAS v4u*)(vp + 192) = pack8(tmp);
#pragma unroll
            for (int j = 0; j < 8; ++j) tmp[j] = w[j] * r[j];
            *(GAS v4u*)(vp + 256) = pack8(tmp); *(GAS v4u*)(vp + 320) = vraw;
            kr = red8(kr); kkar = red8(kkar);
            if (l8 == 0) *(GAS f32x2*)(SCAL + (sidx * LTOK + s) * 2) = (f32x2){kr, kkar};
        }
        ld8f(r_k + c0, par); float bon = 0.f;
#pragma unroll
        for (int j = 0; j < 8; ++j) bon += r[j] * kdsum[j] * par[j];
        bon = red8(bon);
        if (l8 == 0) BONUS[m * 32 + h] = bon;
    }
}
constexpr int RW_CS = 32;
__device__ __forceinline__ void l0_scan_phase(Frame& F) {
    unsigned char* ws = F.ws; const bf16* VEC = (const bf16*)(ws + L0_VEC); const float* SCAL = (const float*)(ws + L0_SCAL); float* YS = (float*)(ws + L0_YS);
    LAS float* opb = (LAS float*)(F.lds + RING_OFF);
    LAS float* scl = opb + 2 * RW_CS * 384;
    LAS float* ybuf = scl + 2 * RW_CS * 2;
    const int rp = F.tid >> 4, q = F.tid & 15; constexpr int NCH = LTOK / RW_CS;
    for (int sidx = F.vcu; sidx < 256; sidx += F.G) {
        const int d = sidx >> 7, b = (sidx >> 5) & 3, h = sidx & 31;
        const GAS v4u* src = (const GAS v4u*)(VEC + (size_t)sidx * LTOK * 384); const GAS float* ssrc = (const GAS float*)(SCAL + (size_t)sidx * LTOK * 2);
        f32x2 Sa = {0.f, 0.f}, Sb = {0.f, 0.f}, Sc = {0.f, 0.f}, Sd = {0.f, 0.f};
        v4u pre[3]; float psc = 0.f;
#pragma unroll
        for (int k = 0; k < 3; ++k) pre[k] = src[F.tid + 512 * k];
        if (F.tid < RW_CS * 2) psc = ssrc[F.tid];
        __syncthreads();
#pragma unroll
        for (int k = 0; k < 3; ++k) { LAS float* dst = opb + (size_t)(F.tid + 512 * k) * 8; const v4u w = pre[k];
            *(LAS f32x4*)dst = (f32x4){bflo(w.x), bfhi(w.x), bflo(w.y), bfhi(w.y)}; *(LAS f32x4*)(dst + 4) = (f32x4){bflo(w.z), bfhi(w.z), bflo(w.w), bfhi(w.w)}; }
        if (F.tid < RW_CS * 2) scl[F.tid] = psc;
        __syncthreads();
        for (int ch = 0; ch < NCH; ++ch) {
            const int cur = ch & 1;
            if (ch + 1 < NCH) {
#pragma unroll
                for (int k = 0; k < 3; ++k) pre[k] = src[(size_t)(ch + 1) * (RW_CS * 48) + F.tid + 512 * k];
                if (F.tid < RW_CS * 2) psc = ssrc[(ch + 1) * RW_CS * 2 + F.tid]; }
            const LAS float* ob = opb + cur * RW_CS * 384; const LAS float* sb = scl + cur * RW_CS * 2;
            const LAS float* o0 = ob + q * 4; const LAS float* ov = ob + 320 + 2 * rp;
            f32x4 w4 = *(const LAS f32x4*)(o0), k4 = *(const LAS f32x4*)(o0 + 64), c4 = *(const LAS f32x4*)(o0 + 128), a4 = *(const LAS f32x4*)(o0 + 192), r4 = *(const LAS f32x4*)(o0 + 256);
            f32x2 v2 = *(const LAS f32x2*)(ov), sc2 = *(const LAS f32x2*)(sb);
            LAS float* ydst = (q == 0) ? (ybuf + 2 * rp) : (ybuf + RW_CS * 64 + 2 * F.tid);
            const int ystep = (q == 0) ? 64 : 0;
#pragma unroll 4
            for (int s = 0; s < RW_CS; ++s) {
                const int sn = (s + 1 < RW_CS) ? s + 1 : s;
                const LAS float* o = o0 + sn * 384;
                const f32x4 w4n = *(const LAS f32x4*)(o), k4n = *(const LAS f32x4*)(o + 64), c4n = *(const LAS f32x4*)(o + 128), a4n = *(const LAS f32x4*)(o + 192), r4n = *(const LAS f32x4*)(o + 256);
                const f32x2 v2n = *(const LAS f32x2*)(ov + sn * 384), sc2n = *(const LAS f32x2*)(sb + sn * 2);
                f32x2 sa = Sa * c4.x; sa = Sb * c4.y + sa; sa = Sc * c4.z + sa; sa = Sd * c4.w + sa;
                f32x2 yy = Sa * r4.x; yy = Sb * r4.y + yy; yy = Sc * r4.z + yy; yy = Sd * r4.w + yy;
                float sa0 = sa.x, sa1 = sa.y, y0 = yy.x, y1 = yy.y;
                asm volatile("s_nop 1\n\t"
                    "v_add_f32_dpp %0, %0, %0 quad_perm:[1,0,3,2] row_mask:0xf bank_mask:0xf bound_ctrl:1\n\t" "v_add_f32_dpp %1, %1, %1 quad_perm:[1,0,3,2] row_mask:0xf bank_mask:0xf bound_ctrl:1\n\t"
                    "v_add_f32_dpp %2, %2, %2 quad_perm:[1,0,3,2] row_mask:0xf bank_mask:0xf bound_ctrl:1\n\t" "v_add_f32_dpp %3, %3, %3 quad_perm:[1,0,3,2] row_mask:0xf bank_mask:0xf bound_ctrl:1\n\t"
                    "v_add_f32_dpp %0, %0, %0 quad_perm:[2,3,0,1] row_mask:0xf bank_mask:0xf bound_ctrl:1\n\t" "v_add_f32_dpp %1, %1, %1 quad_perm:[2,3,0,1] row_mask:0xf bank_mask:0xf bound_ctrl:1\n\t"
                    "v_add_f32_dpp %2, %2, %2 quad_perm:[2,3,0,1] row_mask:0xf bank_mask:0xf bound_ctrl:1\n\t" "v_add_f32_dpp %3, %3, %3 quad_perm:[2,3,0,1] row_mask:0xf bank_mask:0xf bound_ctrl:1\n\t"
                    "v_add_f32_dpp %0, %0, %0 row_half_mirror row_mask:0xf bank_mask:0xf bound_ctrl:1\n\t" "v_add_f32_dpp %1, %1, %1 row_half_mirror row_mask:0xf bank_mask:0xf bound_ctrl:1\n\t"
                    "v_add_f32_dpp %2, %2, %2 row_half_mirror row_mask:0xf bank_mask:0xf bound_ctrl:1\n\t" "v_add_f32_dpp %3, %3, %3 row_half_mirror row_mask:0xf bank_mask:0xf bound_ctrl:1\n\t"
                    "v_add_f32_dpp %0, %0, %0 row_mirror row_mask:0xf bank_mask:0xf bound_ctrl:1\n\t" "v_add_f32_dpp %1, %1, %1 row_mirror row_mask:0xf bank_mask:0xf bound_ctrl:1\n\t"
                    "v_add_f32_dpp %2, %2, %2 row_mirror row_mask:0xf bank_mask:0xf bound_ctrl:1\n\t" "v_add_f32_dpp %3, %3, %3 row_mirror row_mask:0xf bank_mask:0xf bound_ctrl:1\n\t"
                    "s_nop 0"
                    : "+v"(sa0), "+v"(sa1), "+v"(y0), "+v"(y1));
                sa = (f32x2){sa0, sa1}; yy = (f32x2){y0, y1};
                yy = yy + (v2 * sc2.x - sa * sc2.y);
                Sa = Sa * w4.x + (v2 * k4.x - sa * a4.x); Sb = Sb * w4.y + (v2 * k4.y - sa * a4.y); Sc = Sc * w4.z + (v2 * k4.z - sa * a4.z); Sd = Sd * w4.w + (v2 * k4.w - sa * a4.w);
                *(LAS f32x2*)(ydst + s * ystep) = yy;
                w4 = w4n; k4 = k4n; c4 = c4n; a4 = a4n; r4 = r4n; v2 = v2n; sc2 = sc2n;
            }
            __syncthreads();
            {
                const int s = F.tid >> 4, i4 = (F.tid & 15) * 4; const int step = ch * RW_CS + s; const int t = d ? flip_tok(step) : step;
                const f32x4 yv = *(const LAS f32x4*)(ybuf + s * 64 + i4);
                *(GAS f32x4*)(YS + ((size_t)d * NTOK + (size_t)b * LTOK + t) * DM + h * 64 + i4) = yv; }
            if (ch + 1 < NCH) {
                LAS float* nb = opb + (cur ^ 1) * RW_CS * 384;
#pragma unroll
                for (int k = 0; k < 3; ++k) { LAS float* dst = nb + (size_t)(F.tid + 512 * k) * 8; const v4u w = pre[k];
                    *(LAS f32x4*)dst = (f32x4){bflo(w.x), bfhi(w.x), bflo(w.y), bfhi(w.y)}; *(LAS f32x4*)(dst + 4) = (f32x4){bflo(w.z), bfhi(w.z), bflo(w.w), bfhi(w.w)}; }
                if (F.tid < RW_CS * 2) scl[(cur ^ 1) * RW_CS * 2 + F.tid] = psc; }
            __syncthreads();
        }
    }
}
__device__ __forceinline__ void l0_cscan_phase(Frame& F, const float* k_k, const float* k_a, const float* r_k) {
    unsigned char* ws = F.ws; float* YS = (float*)(ws + L0_XS); float* BON = (float*)(ws + L0_BONUS);
    constexpr int PA = 72, PB = 40, NCH = LTOK / 16;
    LAS bf16* RAW = (LAS bf16*)(F.lds + RING_OFF);
    LAS bf16* Ah = RAW + 5 * 16 * PA; LAS bf16* Rh = Ah + 16 * PA; LAS bf16* Kh = Rh + 16 * PA; LAS bf16* Bh = Kh + 16 * PA;
    LAS bf16* KBt = Bh + 16 * PA;
    LAS bf16* VSt = KBt + 64 * PB;
    LAS bf16* LKp = VSt + 64 * PB;
    LAS bf16* UKB = LKp + 16 * PB;
    LAS bf16* Sb = UKB + 16 * PB;
    LAS float* LB = (LAS float*)(Sb + 64 * PA);
    LAS float* RH = LB + 16 * 20;
    LAS float* Wend = RH + 16 * 68;
    const int tid = F.tid, lane = F.lane, w = F.wave;
    for (int sidx = F.vcu; sidx < 256; sidx += F.G) {
        const int d = sidx >> 7, b = (sidx >> 5) & 3, h = sidx & 31;
        const GAS bf16* gR = (const GAS bf16*)(ws + L0_R) + (size_t)b * LTOK * DM + h * 64;
        const GAS bf16* gK = (const GAS bf16*)(ws + L0_K) + (size_t)b * LTOK * DM + h * 64;
        const GAS bf16* gV = (const GAS bf16*)(ws + L0_V) + (size_t)b * LTOK * DM + h * 64;
        const GAS bf16* gD = (const GAS bf16*)(ws + (d ? L0_DEC1 : L0_DEC0)) + (size_t)b * LTOK * DM + h * 64;
        const GAS bf16* gI = (const GAS bf16*)(ws + (d ? L0_IC1 : L0_IC0)) + (size_t)b * LTOK * DM + h * 64;
        const int ft = tid >> 5, fpart = tid & 31, fti = fpart >> 3, fc = (fpart & 7) * 8;
        const GAS bf16* fbase = fti == 0 ? gR : (fti == 1 ? gK : (fti == 2 ? gV : gD));
        const int t1 = tid >> 5, jp = tid & 31, j2 = 2 * jp;
        const f32x2 kk2 = *(const f32x2*)(k_k + h * 64 + j2), ka2 = *(const f32x2*)(k_a + h * 64 + j2), rk2 = *(const f32x2*)(r_k + h * 64 + j2);
        __syncthreads();
        for (int i = tid; i < 64 * PA / 2; i += 512) ((LAS unsigned*)Sb)[i] = 0u;
        for (int i = tid; i < 64 * PB / 2; i += 512) ((LAS unsigned*)VSt)[i] = 0u;
        for (int i = tid; i < 16 * PB / 2; i += 512) ((LAS unsigned*)LKp)[i] = 0u;
        pg8::f32x4 ST[2]; ST[0] = (pg8::f32x4){0.f, 0.f, 0.f, 0.f}; ST[1] = ST[0];
        v4u pa, pb = {0u, 0u, 0u, 0u};
#define CS_FETCH(chn) do { { const int step_ = (chn) * 16 + ft; const int tk_ = d ? flip_tok(step_) : step_; pa = *(const GAS v4u*)(fbase + (size_t)tk_ * DM + fc); } \
            if (tid < 128) { const int step_ = (chn) * 16 + (tid >> 3); const int tk_ = d ? flip_tok(step_) : step_; pb = *(const GAS v4u*)(gI + (size_t)tk_ * DM + (tid & 7) * 8); } } while (0)
        CS_FETCH(0);
        for (int ch = 0; ch < NCH; ++ch) {
            *(LAS v4u*)(RAW + (fti * 16 + ft) * PA + fc) = pa;
            if (tid < 128) *(LAS v4u*)(RAW + (4 * 16 + (tid >> 3)) * PA + (tid & 7) * 8) = pb;
            if (ch + 1 < NCH) CS_FETCH(ch + 1);
            LDS_BARRIER();
            {
                const unsigned rw = *(const LAS unsigned*)(RAW + (0 * 16 + t1) * PA + j2), kw = *(const LAS unsigned*)(RAW + (1 * 16 + t1) * PA + j2), vw = *(const LAS unsigned*)(RAW + (2 * 16 + t1) * PA + j2);
                const unsigned iw = *(const LAS unsigned*)(RAW + (4 * 16 + t1) * PA + j2);
                const f32x2 r = {bflo(rw), bfhi(rw)}, k = {bflo(kw), bfhi(kw)}, ic = {bflo(iw), bfhi(iw)};
                f32x2 kkv = k * kk2; float ss = kkv.x * kkv.x + kkv.y * kkv.y; ss = red16(ss); ss += __shfl_xor(ss, 16);
                kkv = kkv * (1.0f / sqrtf(ss + 1e-12f));
                const f32x2 kd = k * ((ic - 1.f) * ka2 + 1.f), kka = kkv * ic;
                float bon = r.x * kd.x * rk2.x + r.y * kd.y * rk2.y; bon = red16(bon); bon += __shfl_xor(bon, 16);
                const int step = ch * 16 + t1; const int tk = d ? flip_tok(step) : step;
                if (jp == 0) BON[((size_t)d * NTOK + (size_t)b * LTOK + tk) * 32 + h] = bon;
                f32x2 Wm = {1.f, 1.f};
#pragma unroll
                for (int u = 0; u < 15; ++u) { const unsigned dw = *(const LAS unsigned*)(RAW + (3 * 16 + u) * PA + j2); if (u < t1) { Wm.x *= bflo(dw); Wm.y *= bfhi(dw); } }
                const unsigned dwt = *(const LAS unsigned*)(RAW + (3 * 16 + t1) * PA + j2);
                const f32x2 Wt = {Wm.x * bflo(dwt), Wm.y * bfhi(dwt)}; const f32x2 iW = {__builtin_amdgcn_rcpf(Wt.x), __builtin_amdgcn_rcpf(Wt.y)};
                const f32x2 ah = kkv * Wm, bh = kka * iW, kh = kd * iW, rh = r * Wt;
                *(LAS unsigned*)(Ah + t1 * PA + j2) = pk2(ah.x, ah.y); *(LAS unsigned*)(Rh + t1 * PA + j2) = pk2(rh.x, rh.y);
                *(LAS unsigned*)(Kh + t1 * PA + j2) = pk2(kh.x, kh.y); *(LAS unsigned*)(Bh + t1 * PA + j2) = pk2(bh.x, bh.y);
                const unsigned khw = pk2(kh.x, kh.y), nbw = pk2(-bh.x, -bh.y);
                KBt[j2 * PB + t1] = (bf16)(khw & 0xffff); KBt[(j2 + 1) * PB + t1] = (bf16)(khw >> 16);
                KBt[j2 * PB + 16 + t1] = (bf16)(nbw & 0xffff); KBt[(j2 + 1) * PB + 16 + t1] = (bf16)(nbw >> 16);
                VSt[j2 * PB + t1] = (bf16)(vw & 0xffff); VSt[(j2 + 1) * PB + t1] = (bf16)(vw >> 16);
                if (t1 == 15) *(LAS f32x2*)(Wend + j2) = Wt;
            }
            LDS_BARRIER();
            pg8::f32x4 accg = {0.f, 0.f, 0.f, 0.f};
            const int tr = (lane >> 4) * 4, uc = lane & 15;
            if (w < 4) {
                pg8::f32x4 a = {0.f, 0.f, 0.f, 0.f};
                a = mma_tile(a, (w < 2) ? Ah : Rh, PA, (w == 0 || w == 3) ? Bh : Kh, PA, 2, lane);
#pragma unroll
                for (int r = 0; r < 4; ++r) { const int t = tr + r; const float x = a[r];
                    if (w == 0) LB[uc * 20 + t] = (uc < t) ? x : 0.f;
                    else if (w == 1) LKp[t * PB + uc] = f2bf((uc < t) ? x : 0.f);
                    else if (w == 2) UKB[t * PB + uc] = f2bf((uc <= t) ? x : 0.f);
                    else UKB[t * PB + 16 + uc] = f2bf((uc <= t) ? -x : 0.f); }
            } else accg = mma_tile(accg, Ah, PA, Sb + (w - 4) * 16 * PA, PA, 2, lane);
            LDS_BARRIER();
            pg8::f32x4 accy = {0.f, 0.f, 0.f, 0.f};
            if (w >= 4) { accg = mma_tile(accg, LKp, PB, VSt + (w - 4) * 16 * PB, PB, 1, lane);
#pragma unroll
                for (int r = 0; r < 4; ++r) RH[(tr + r) * 68 + (w - 4) * 16 + uc] = accg[r]; }
            else accy = mma_tile(accy, Rh, PA, Sb + w * 16 * PA, PA, 2, lane);
            LDS_BARRIER();
            if (w == 7) {
                float sg[16];
#pragma unroll
                for (int t = 0; t < 16; ++t) sg[t] = RH[t * 68 + lane];
#pragma unroll
                for (int u = 0; u < 15; ++u) {
#pragma unroll
                    for (int g4 = (u + 1) / 4; g4 < 4; ++g4) { const pg8::f32x4 l4 = *(const LAS pg8::f32x4*)(LB + u * 20 + g4 * 4);
#pragma unroll
                        for (int r = 0; r < 4; ++r) { const int t = g4 * 4 + r; if (t > u) sg[t] -= l4[r] * sg[u]; } } }
                v4u o; o.x = pk2(sg[0], sg[1]); o.y = pk2(sg[2], sg[3]); o.z = pk2(sg[4], sg[5]); o.w = pk2(sg[6], sg[7]); *(LAS v4u*)(VSt + lane * PB + 16) = o;
                o.x = pk2(sg[8], sg[9]); o.y = pk2(sg[10], sg[11]); o.z = pk2(sg[12], sg[13]); o.w = pk2(sg[14], sg[15]); *(LAS v4u*)(VSt + lane * PB + 24) = o;
            }
            LDS_BARRIER();
            if (w < 4) { accy = mma_tile(accy, UKB, PB, VSt + w * 16 * PB, PB, 1, lane);
#pragma unroll
                for (int r = 0; r < 4; ++r) { const int step = ch * 16 + tr + r; const int tk = d ? flip_tok(step) : step;
                    YS[((size_t)d * NTOK + (size_t)b * LTOK + tk) * DM + h * 64 + w * 16 + uc] = accy[r]; } }
            { const int jb = w >> 1; const pg8::f32x4 we = *(const LAS pg8::f32x4*)(Wend + jb * 16 + tr);
#pragma unroll
              for (int q = 0; q < 2; ++q) { const int ib = (w & 1) * 2 + q;
                  pg8::f32x4 a = mma_tile(ST[q], KBt + jb * 16 * PB, PB, VSt + ib * 16 * PB, PB, 1, lane);
                  a = a * we; ST[q] = a;
                  v2u sw; sw.x = pk2(a[0], a[1]); sw.y = pk2(a[2], a[3]);
                  *(LAS v2u*)(Sb + (ib * 16 + uc) * PA + jb * 16 + tr) = sw; } }
            LDS_BARRIER();
        }
#undef CS_FETCH
    }
}
__device__ __forceinline__ void l0_cscan2_phase(Frame& F, const float* k_k, const float* k_a, const float* r_k) {
    unsigned char* ws = F.ws; bf16* YS = (bf16*)(ws + L0_XS); float* BON = (float*)(ws + L0_BONUS);
    constexpr int PA = 72, PB = 40, NCH = LTOK / 16;
    constexpr int O_AH = 0, O_RH = 16 * PA, O_KH = 32 * PA, O_BH = 48 * PA, O_KBT = 64 * PA, O_VST = O_KBT + 64 * PB, O_LKP = O_VST + 64 * PB, O_UKB = O_LKP + 16 * PB, SETSZ = O_UKB + 16 * PB;
    static_assert(SETSZ % 8 == 0, "set size keeps 16-byte alignment");
    constexpr int FSZ = 320 + 16 * 64;
    LAS bf16* SET = (LAS bf16*)(F.lds + RING_OFF);
    LAS bf16* RAW = SET + 2 * SETSZ;
    LAS bf16* Sb = RAW + 4 * 16 * PA;
    LAS float* FSET = (LAS float*)(Sb + 64 * PA);
    LAS float* RH = FSET + 2 * FSZ;
    const int tid = F.tid, lane = F.lane, w = F.wave;
    const int tr = (lane >> 4) * 4, uc = lane & 15;
    for (int sidx = F.vcu; sidx < 256; sidx += F.G) {
        const int d = sidx >> 7, b = (sidx >> 5) & 3, h = sidx & 31;
        const GAS bf16* gR = (const GAS bf16*)(ws + L0_R) + (size_t)b * LTOK * DM + h * 64;
        const GAS bf16* gK = (const GAS bf16*)(ws + L0_K) + (size_t)b * LTOK * DM + h * 64;
        const GAS bf16* gV = (const GAS bf16*)(ws + L0_V) + (size_t)b * LTOK * DM + h * 64;
        const GAS bf16* gD = (const GAS bf16*)(ws + (d ? L0_DEC1 : L0_DEC0)) + (size_t)b * LTOK * DM + h * 64;
        const GAS bf16* gI = (const GAS bf16*)(ws + (d ? L0_IC1 : L0_IC0)) + (size_t)b * LTOK * DM + h * 64;
        const int ft = tid >> 5, fpart = tid & 31, fti = fpart >> 3, fc = (fpart & 7) * 8;
        const GAS bf16* fbase = fti == 0 ? gR : (fti == 1 ? gK : (fti == 2 ? gV : gI));
        const int t1 = (tid >> 4) & 15, j4 = (tid & 15) * 4;
        const f32x4 kk4 = *(const f32x4*)(k_k + h * 64 + j4), ka4 = *(const f32x4*)(k_a + h * 64 + j4), rk4 = *(const f32x4*)(r_k + h * 64 + j4);
        __syncthreads();
        for (int i = tid; i < 64 * PA / 2; i += 512) ((LAS unsigned*)Sb)[i] = 0u;
        for (int i = tid; i < 2 * SETSZ / 2; i += 512) ((LAS unsigned*)SET)[i] = 0u;
        pg8::f32x4 ST[2]; ST[0] = (pg8::f32x4){0.f, 0.f, 0.f, 0.f}; ST[1] = ST[0];
        v4u pa; bf16 dq[16];
#define CS_FETCH(chn) do { { const int step_ = (chn) * 16 + ft; const int tk_ = d ? flip_tok(step_) : step_; pa = *(const GAS v4u*)(fbase + (size_t)tk_ * DM + fc); } \
            if (w == 4) { _Pragma("unroll") for (int t_ = 0; t_ < 16; ++t_) { const int step_ = (chn) * 16 + t_; const int tk_ = d ? flip_tok(step_) : step_; dq[t_] = gD[(size_t)tk_ * DM + lane]; } } } while (0)
#define CS_RAWWRITE(st) do { *(LAS v4u*)(RAW + (fti * 16 + ft) * PA + fc) = pa; \
            if (w == 4) { float W_ = 1.f; LAS float* wc_ = FSET + (st) * FSZ + 320 + lane; _Pragma("unroll") for (int t_ = 0; t_ < 16; ++t_) { W_ *= bf2f(dq[t_]); wc_[t_ * 64] = W_; } } } while (0)
#define CS_STEP1(chn, st) do { LAS bf16* S_ = SET + (st) * SETSZ; const LAS float* wc_ = FSET + (st) * FSZ + 320; \
            const v2u rw = *(const LAS v2u*)(RAW + (0 * 16 + t1) * PA + j4), kw = *(const LAS v2u*)(RAW + (1 * 16 + t1) * PA + j4), vw = *(const LAS v2u*)(RAW + (2 * 16 + t1) * PA + j4), iw = *(const LAS v2u*)(RAW + (3 * 16 + t1) * PA + j4); \
            const f32x4 r = {bflo(rw.x), bfhi(rw.x), bflo(rw.y), bfhi(rw.y)}, k = {bflo(kw.x), bfhi(kw.x), bflo(kw.y), bfhi(kw.y)}, ic = {bflo(iw.x), bfhi(iw.x), bflo(iw.y), bfhi(iw.y)}; \
            const f32x4 Wt = *(const LAS f32x4*)(wc_ + t1 * 64 + j4); f32x4 Wm = {1.f, 1.f, 1.f, 1.f}; if (t1 > 0) Wm = *(const LAS f32x4*)(wc_ + (t1 - 1) * 64 + j4); \
            f32x4 kkv = k * kk4; float ss = (kkv.x * kkv.x + kkv.y * kkv.y) + (kkv.z * kkv.z + kkv.w * kkv.w); \
            const f32x4 kd = k * ((ic - 1.f) * ka4 + 1.f); const f32x4 bt = r * kd * rk4; float bon = (bt.x + bt.y) + (bt.z + bt.w); \
            ss = red16(ss); bon = red16(bon); \
            kkv = kkv * __builtin_amdgcn_rsqf(ss + 1e-12f); const f32x4 kka = kkv * ic; \
            const int step = (chn) * 16 + t1; const int tk = d ? flip_tok(step) : step; \
            if ((tid & 15) == 0) BON[((size_t)d * NTOK + (size_t)b * LTOK + tk) * 32 + h] = bon; \
            const f32x4 iW = {__builtin_amdgcn_rcpf(Wt.x), __builtin_amdgcn_rcpf(Wt.y), __builtin_amdgcn_rcpf(Wt.z), __builtin_amdgcn_rcpf(Wt.w)}; \
            const f32x4 ah = kkv * Wm, bh = kka * iW, kh = kd * iW, rh = r * Wt; \
            v2u o_; o_.x = pk2(ah.x, ah.y); o_.y = pk2(ah.z, ah.w); *(LAS v2u*)(S_ + O_AH + t1 * PA + j4) = o_; \
            o_.x = pk2(rh.x, rh.y); o_.y = pk2(rh.z, rh.w); *(LAS v2u*)(S_ + O_RH + t1 * PA + j4) = o_; \
            v2u kh_; kh_.x = pk2(kh.x, kh.y); kh_.y = pk2(kh.z, kh.w); *(LAS v2u*)(S_ + O_KH + t1 * PA + j4) = kh_; \
            o_.x = pk2(bh.x, bh.y); o_.y = pk2(bh.z, bh.w); *(LAS v2u*)(S_ + O_BH + t1 * PA + j4) = o_; \
            v2u nb_; nb_.x = pk2(-bh.x, -bh.y); nb_.y = pk2(-bh.z, -bh.w); \
            LAS bf16* kb_ = S_ + O_KBT + j4 * PB + t1; LAS bf16* vs_ = S_ + O_VST + j4 * PB + t1; \
            kb_[0] = (bf16)(kh_.x & 0xffff); kb_[PB] = (bf16)(kh_.x >> 16); kb_[2 * PB] = (bf16)(kh_.y & 0xffff); kb_[3 * PB] = (bf16)(kh_.y >> 16); \
            kb_[16] = (bf16)(nb_.x & 0xffff); kb_[PB + 16] = (bf16)(nb_.x >> 16); kb_[2 * PB + 16] = (bf16)(nb_.y & 0xffff); kb_[3 * PB + 16] = (bf16)(nb_.y >> 16); \
            vs_[0] = (bf16)(vw.x & 0xffff); vs_[PB] = (bf16)(vw.x >> 16); vs_[2 * PB] = (bf16)(vw.y & 0xffff); vs_[3 * PB] = (bf16)(vw.y >> 16); } while (0)
#define CS_STEP2(wq, st) do { LAS bf16* S_ = SET + (st) * SETSZ; LAS float* LB_ = FSET + (st) * FSZ; pg8::f32x4 a = {0.f, 0.f, 0.f, 0.f}; \
            a = mma_tile(a, S_ + (((wq) < 2) ? O_AH : O_RH), PA, S_ + (((wq) == 0 || (wq) == 3) ? O_BH : O_KH), PA, 2, lane); \
            _Pragma("unroll") for (int r = 0; r < 4; ++r) { const int t = tr + r; const float x = a[r]; \
                if ((wq) == 0) LB_[uc * 20 + t] = (uc < t) ? x : 0.f; \
                else if ((wq) == 1) S_[O_LKP + t * PB + uc] = f2bf((uc < t) ? x : 0.f); \
                else if ((wq) == 2) S_[O_UKB + t * PB + uc] = f2bf((uc <= t) ? x : 0.f); \
                else S_[O_UKB + t * PB + 16 + uc] = f2bf((uc <= t) ? -x : 0.f); } } while (0)
        CS_FETCH(0); CS_RAWWRITE(0); CS_FETCH(1);
        LDS_BARRIER();
        if (w < 4) CS_STEP1(0, 0);
        LDS_BARRIER();
        if (w < 4) CS_STEP2(w, 0);
        LDS_BARRIER();
        asm volatile("" : "+v"(pa));
        for (int ch = 0; ch < NCH; ++ch) {
            const int cur = ch & 1, nxt = cur ^ 1; LAS bf16* C_ = SET + cur * SETSZ; LAS float* FC_ = FSET + cur * FSZ;
            if (ch + 1 < NCH) { CS_RAWWRITE(nxt); if (ch + 2 < NCH) CS_FETCH(ch + 2); }
            pg8::f32x4 accy = {0.f, 0.f, 0.f, 0.f};
            if (w >= 4) { pg8::f32x4 accg = {0.f, 0.f, 0.f, 0.f};
                accg = mma_tile(accg, C_ + O_AH, PA, Sb + (w - 4) * 16 * PA, PA, 2, lane);
                accg = mma_tile(accg, C_ + O_LKP, PB, C_ + O_VST + (w - 4) * 16 * PB, PB, 1, lane);
#pragma unroll
                for (int r = 0; r < 4; ++r) RH[(tr + r) * 68 + (w - 4) * 16 + uc] = accg[r]; }
            else accy = mma_tile(accy, C_ + O_RH, PA, Sb + w * 16 * PA, PA, 2, lane);
            LDS_BARRIER();
            if (w == 7) {
                float sg[16];
#pragma unroll
                for (int t = 0; t < 16; ++t) sg[t] = RH[t * 68 + lane];
#pragma unroll
                for (int u = 0; u < 15; ++u) {
#pragma unroll
                    for (int g4 = (u + 1) / 4; g4 < 4; ++g4) { const pg8::f32x4 l4 = *(const LAS pg8::f32x4*)(FC_ + u * 20 + g4 * 4);
#pragma unroll
                        for (int r = 0; r < 4; ++r) { const int t = g4 * 4 + r; if (t > u) sg[t] -= l4[r] * sg[u]; } } }
                v4u o; o.x = pk2(sg[0], sg[1]); o.y = pk2(sg[2], sg[3]); o.z = pk2(sg[4], sg[5]); o.w = pk2(sg[6], sg[7]); *(LAS v4u*)(C_ + O_VST + lane * PB + 16) = o;
                o.x = pk2(sg[8], sg[9]); o.y = pk2(sg[10], sg[11]); o.z = pk2(sg[12], sg[13]); o.w = pk2(sg[14], sg[15]); *(LAS v4u*)(C_ + O_VST + lane * PB + 24) = o;
            } else if (w < 4 && ch + 1 < NCH) CS_STEP1(ch + 1, nxt);
            LDS_BARRIER();
            { const int jb = w >> 1, ib0 = (w & 1) * 2; const pg8::f32x4 we = *(const LAS pg8::f32x4*)(FC_ + 320 + 15 * 64 + jb * 16 + tr);
              if (w < 4) accy = mma_tile(accy, C_ + O_UKB, PB, C_ + O_VST + w * 16 * PB, PB, 1, lane);
              pg8::f32x4 a0 = mma_tile(ST[0], C_ + O_KBT + jb * 16 * PB, PB, C_ + O_VST + ib0 * 16 * PB, PB, 1, lane);
              pg8::f32x4 a1 = mma_tile(ST[1], C_ + O_KBT + jb * 16 * PB, PB, C_ + O_VST + (ib0 + 1) * 16 * PB, PB, 1, lane);
              pg8::f32x4 a2 = {0.f, 0.f, 0.f, 0.f}; const int wq = w - 4; LAS bf16* N_ = SET + nxt * SETSZ; LAS float* LBn = FSET + nxt * FSZ;
              const bool do2 = (w >= 4 && ch + 1 < NCH);
              if (do2) a2 = mma_tile(a2, N_ + ((wq < 2) ? O_AH : O_RH), PA, N_ + ((wq == 0 || wq == 3) ? O_BH : O_KH), PA, 2, lane);
              a0 = a0 * we; a1 = a1 * we; ST[0] = a0; ST[1] = a1;
              asm volatile("" : "+v"(pa));
              if (w < 4) {
#pragma unroll
                  for (int r = 0; r < 4; ++r) { const int step = ch * 16 + tr + r; const int tk = d ? flip_tok(step) : step;
                      YS[((size_t)d * NTOK + (size_t)b * LTOK + tk) * DM + h * 64 + w * 16 + uc] = f2bf(accy[r]); } }
              v2u sw; sw.x = pk2(a0[0], a0[1]); sw.y = pk2(a0[2], a0[3]); *(LAS v2u*)(Sb + (ib0 * 16 + uc) * PA + jb * 16 + tr) = sw;
              sw.x = pk2(a1[0], a1[1]); sw.y = pk2(a1[2], a1[3]); *(LAS v2u*)(Sb + ((ib0 + 1) * 16 + uc) * PA + jb * 16 + tr) = sw;
              if (do2) {
#pragma unroll
                  for (int r = 0; r < 4; ++r) { const int t = tr + r; const float x = a2[r];
                      if (wq == 0) LBn[uc * 20 + t] = (uc < t) ? x : 0.f;
                      else if (wq == 1) N_[O_LKP + t * PB + uc] = f2bf((uc < t) ? x : 0.f);
                      else if (wq == 2) N_[O_UKB + t * PB + uc] = f2bf((uc <= t) ? x : 0.f);
                      else N_[O_UKB + t * PB + 16 + uc] = f2bf((uc <= t) ? -x : 0.f); } } }
            LDS_BARRIER();
        }
#undef CS_FETCH
#undef CS_RAWWRITE
#undef CS_STEP1
#undef CS_STEP2
    }
}
__device__ __forceinline__ void l0_post_phase(Frame& F, const float* gn_g, const float* gn_b) {
    const int gw = GW(F), NGWv = NGW(F); unsigned char* ws = F.ws;
    const bf16* YS = (const bf16*)(ws + L0_XS); const bf16* V = (const bf16*)(ws + L0_V); const bf16* G = (const bf16*)(ws + L0_G); const float* BONUS = (const float*)(ws + L0_BONUS);
    bf16* OUTB = (bf16*)(ws + WS_OUTB); const int l8 = F.lane & 7;
    const int hh = (gw & 3) * 8 + (F.lane >> 3), c0 = hh * 64 + l8 * 8;
    float gg[8], gb[8]; ld8f(gn_g + c0, gg); ld8f(gn_b + c0, gb);
    constexpr int UB = 3;
    for (int it0 = gw; it0 < NTOK * 4; it0 += UB * NGWv) {
        v4u wya[UB], wyb[UB], wv[UB], wg[UB]; float b0[UB], b1[UB];
#pragma unroll
        for (int u = 0; u < UB; ++u) { const int it = it0 + u * NGWv; if (it < NTOK * 4) { const int m = it >> 2; const size_t e = (size_t)m * DM + c0;
            wya[u] = *(const GAS v4u*)(YS + e); wyb[u] = *(const GAS v4u*)(YS + (size_t)NTOK * DM + e); wv[u] = *(const GAS v4u*)(V + e); wg[u] = *(const GAS v4u*)(G + e);
            b0[u] = *(const GAS float*)(BONUS + m * 32 + hh); b1[u] = *(const GAS float*)(BONUS + (size_t)NTOK * 32 + m * 32 + hh); } }
#pragma unroll
        for (int u = 0; u < UB; ++u) { const int it = it0 + u * NGWv; if (it < NTOK * 4) { const int m = it >> 2; const size_t e = (size_t)m * DM + c0;
            float y[8], y2[8], v[8], g[8];
            { float ya[8], yb[8]; unpack8(wya[u], ya); unpack8(wyb[u], yb);
#pragma unroll
              for (int j = 0; j < 8; ++j) y[j] = ya[j] + yb[j]; }
            unpack8(wv[u], v); unpack8(wg[u], g);
            float s = 0.f;
#pragma unroll
            for (int j = 0; j < 8; ++j) s += y[j];
            const float mean = red8(s) * (1.f / 64.f); float q2 = 0.f;
#pragma unroll
            for (int j = 0; j < 8; ++j) { y[j] -= mean; q2 += y[j] * y[j]; }
            const float rstd = 1.0f / sqrtf(red8(q2) * (1.f / 64.f) + 64e-5f);
            const float bon = b0[u] + b1[u];
#pragma unroll
            for (int j = 0; j < 8; ++j) y2[j] = ((y[j] * rstd) * gg[j] + gb[j] + bon * v[j]) * g[j];
            *(GAS v4u*)(OUTB + e) = pack8(y2); } }
    }
}

__device__ __forceinline__ void l1_rope_phase(Frame& F) {
    bf16* QKV = (bf16*)(F.ws + L1_QKV); const float* RT = (const float*)(F.ws + WS_ROPE);
    const size_t total = (size_t)NLAT * 256; const size_t stride = (size_t)F.G * 512;
    for (size_t it = (size_t)F.vcu * 512 + F.tid; it < total; it += stride) {
        const int idx = (int)(it >> 8), sub = (int)(it & 255); const int hd = sub >> 3, ax = (sub >> 2) & 1, g8 = sub & 3;
        const int b = idx >> 11, t = NCTX + (idx & 2047); const size_t m = (size_t)b * LTOK + t;
        bf16* pa = QKV + m * 6144 + hd * 128 + ax * 64 + g8 * 8; bf16* pb = pa + 32;
        const v4u wa = *(const GAS v4u*)pa, wb = *(const GAS v4u*)pb;
        const float* cs = RT + ((size_t)t * 64 + ax * 32 + g8 * 8) * 2;
        float a[8] = {bflo(wa.x), bfhi(wa.x), bflo(wa.y), bfhi(wa.y), bflo(wa.z), bfhi(wa.z), bflo(wa.w), bfhi(wa.w)};
        float bb[8] = {bflo(wb.x), bfhi(wb.x), bflo(wb.y), bfhi(wb.y), bflo(wb.z), bfhi(wb.z), bflo(wb.w), bfhi(wb.w)};
        float oa[8], ob[8];
#pragma unroll
        for (int j = 0; j < 8; ++j) { const f32x2 c = *(const GAS f32x2*)(cs + 2 * j); oa[j] = a[j] * c.x - bb[j] * c.y; ob[j] = bb[j] * c.x + a[j] * c.y; }
        v4u w; w.x = pk2(oa[0], oa[1]); w.y = pk2(oa[2], oa[3]); w.z = pk2(oa[4], oa[5]); w.w = pk2(oa[6], oa[7]); *(GAS v4u*)pa = w;
        w.x = pk2(ob[0], ob[1]); w.y = pk2(ob[2], ob[3]); w.z = pk2(ob[4], ob[5]); w.w = pk2(ob[6], ob[7]); *(GAS v4u*)pb = w;
    }
}
__device__ __forceinline__ void l1_attn_phase(Frame& F, char* lds_generic) {
    const att::bf16* QKV = (const att::bf16*)(F.ws + L1_QKV); bf16* O = (bf16*)(F.ws + L1_O);
    constexpr int NLONG = NB * 16 * 2 * 8, NSHORT = NB * 16 * 2;
    for (int u = F.vcu; u < NLONG + NSHORT; u += F.G) {
        int b, hm, vh, qb, seq;
        if (u < NLONG) { qb = 1 + (u & 7); vh = (u >> 3) & 1; hm = (u >> 4) & 15; b = u >> 8; seq = LTOK; }
        else { const int v = u - NLONG; qb = 0; vh = v & 1; hm = (v >> 1) & 15; b = v >> 5; seq = NCTX; }
        const size_t m0 = (size_t)b * LTOK + (size_t)qb * 256, k0 = (size_t)b * LTOK;
        att::attn_dense_body<att::bf16>(QKV + m0 * 6144 + hm * 128, QKV + k0 * 6144 + 2048 + hm * 128, QKV + k0 * 6144 + 4096 + (hm >> 1) * 256 + vh * 128,
                                        O + m0 * 4096 + hm * 256 + vh * 128, seq, lds_generic);
        __syncthreads();
    }
}
__device__ __forceinline__ void l1_combine_phase(Frame& F, const float* lam_vec, const float* sub_g) {
    const int gw = GW(F), NGWv = NGW(F); const bf16* O = (const bf16*)(F.ws + L1_O); bf16* OUTB = (bf16*)(F.ws + WS_OUTB);
    float d01 = 0.f, d23 = 0.f;
    for (int i = F.lane; i < 128; i += 64) { d01 += lam_vec[i] * lam_vec[128 + i]; d23 += lam_vec[256 + i] * lam_vec[384 + i]; }
    const float lam_init = 0.8f - 0.6f * expf(-0.3f * 1.0f);
    const float lam = expf(wave_sum(d01)) - expf(wave_sum(d23)) + lam_init;
    const int l32 = F.lane & 31, hs = F.lane >> 5;
    float sg[8]; ld8f(sub_g + 8 * l32, sg);
    constexpr int UB = 3;
    for (int it0 = gw; it0 < NTOK * 4; it0 += UB * NGWv) {
        v4u w1[UB], w2[UB];
#pragma unroll
        for (int u = 0; u < UB; ++u) { const int it = it0 + u * NGWv; if (it < NTOK * 4) { const int m = it >> 2, h = (it & 3) * 2 + hs; const GAS bf16* op = (const GAS bf16*)O + (size_t)m * 4096 + h * 512 + 8 * l32;
            w1[u] = *(const GAS v4u*)op; w2[u] = *(const GAS v4u*)(op + 256); } }
#pragma unroll
        for (int u = 0; u < UB; ++u) { const int it = it0 + u * NGWv; if (it < NTOK * 4) { const int m = it >> 2, h = (it & 3) * 2 + hs;
            float o1[8], o2[8], o[8]; unpack8(w1[u], o1); unpack8(w2[u], o2); float ss = 0.f;
#pragma unroll
            for (int j = 0; j < 8; ++j) { o[j] = o1[j] - o2[j] * lam; ss += o[j] * o[j]; }
            ss = red16(ss); ss += __shfl_xor(ss, 16);
            const float rs = (1.0f / sqrtf(ss * (1.f / 256.f) + 1e-5f)) * (1.f - lam_init);
#pragma unroll
            for (int j = 0; j < 8; ++j) o[j] = o[j] * rs * sg[j];
            *(GAS v4u*)(OUTB + (size_t)m * DM + h * 256 + 8 * l32) = pack8(o); } }
    }
}

__device__ __forceinline__ void l2_gla_phase(Frame& F) {
    unsigned char* ws = F.ws; const bf16* HGO = (const bf16*)(ws + L2_HGO); bf16* OG = (bf16*)(ws + L2_OG);
    constexpr int PK = 136, PS = 72;
    LAS bf16* QR = (LAS bf16*)(F.lds + RING_OFF);
    LAS bf16* KR = QR + 64 * PK;
    LAS bf16* VR = KR + 64 * PK;
    LAS bf16* QD = QR; LAS bf16* KD = KR;
    LAS bf16* KEt = VR + 64 * PS;
    LAS bf16* Vt = KEt + 128 * PS;
    LAS bf16* Pm = Vt + 64 * PS;
    LAS bf16* St = Pm + 64 * PS;
    LAS float* tot = (LAS float*)(St + 64 * PK);
    LAS float* dec = tot + 8 * 128;
    const int lane = F.lane, w = F.wave, tid = F.tid;
    constexpr int NCHK = LTOK / 64;
    for (int u = F.vcu; u < 256; u += F.G) {
        const int vh = u & 1, h = (u >> 1) & 15, b = (u >> 5) & 3, d = u >> 7;
        pg8::f32x4 S4[4];
#pragma unroll
        for (int vb = 0; vb < 4; ++vb) S4[vb] = (pg8::f32x4){0.f, 0.f, 0.f, 0.f};
        v4u rq[2], rk[2], rv;
        const GAS bf16* hb = (const GAS bf16*)HGO + (size_t)b * LTOK * 10240;
#define GLA_FETCH(chn) do { \
            _Pragma("unroll") for (int k_ = 0; k_ < 2; ++k_) { const int id_ = tid + 512 * k_, s_ = id_ >> 4, c16_ = id_ & 15; const int step_ = (chn) * 64 + s_; const int t_ = d ? flip_tok(step_) : step_; \
                rq[k_] = *(const GAS v4u*)(hb + (size_t)t_ * 10240 + h * 128 + c16_ * 8); rk[k_] = *(const GAS v4u*)(hb + (size_t)t_ * 10240 + (3 + d) * DM + h * 128 + c16_ * 8); } \
            { const int s_ = tid >> 3, c16_ = tid & 7; const int step_ = (chn) * 64 + s_; const int t_ = d ? flip_tok(step_) : step_; rv = *(const GAS v4u*)(hb + (size_t)t_ * 10240 + DM + h * 128 + vh * 64 + c16_ * 8); } } while (0)
        GLA_FETCH(0);
        asm volatile("" : "+v"(rq[0]), "+v"(rq[1]), "+v"(rk[0]), "+v"(rk[1]), "+v"(rv));
        for (int ch = 0; ch < NCHK; ++ch) {
            LDS_BARRIER();
#pragma unroll
            for (int k = 0; k < 2; ++k) { const int id = tid + 512 * k, s = id >> 4, c16 = id & 15; *(LAS v4u*)(QR + s * PK + c16 * 8) = rq[k]; *(LAS v4u*)(KR + s * PK + c16 * 8) = rk[k]; }
            *(LAS v4u*)(VR + (tid >> 3) * PS + (tid & 7) * 8) = rv;
            if (ch + 1 < NCHK) GLA_FETCH(ch + 1);
            LDS_BARRIER();
            const int cp = tid & 63, sg = tid >> 6, c = 2 * cp;
            float k0[8], k1[8], b0[8], b1[8]; float run0 = 0.f, run1 = 0.f;
#pragma unroll
            for (int s = 0; s < 8; ++s) { const unsigned kw = *(const LAS unsigned*)(KR + (sg * 8 + s) * PK + c); k0[s] = bflo(kw); k1[s] = bfhi(kw);
                run0 += __logf(1.f - k0[s]); run1 += __logf(1.f - k1[s]); b0[s] = run0; b1[s] = run1; }
            *(LAS f32x2*)(tot + sg * 128 + c) = (f32x2){run0, run1};
            { const int v = tid & 63, s8 = (tid >> 6) * 8; unsigned short e[8];
#pragma unroll
              for (int s = 0; s < 8; ++s) e[s] = VR[(s8 + s) * PS + v];
              v4u o; o.x = e[0] | ((unsigned)e[1] << 16); o.y = e[2] | ((unsigned)e[3] << 16); o.z = e[4] | ((unsigned)e[5] << 16); o.w = e[6] | ((unsigned)e[7] << 16);
              *(LAS v4u*)(Vt + v * PS + s8) = o; }
#pragma unroll
            for (int vb = 0; vb < 4; ++vb) { v2u sw; sw.x = pk2(S4[vb][0], S4[vb][1]); sw.y = pk2(S4[vb][2], S4[vb][3]);
                *(LAS v2u*)(St + (vb * 16 + (lane & 15)) * PK + 16 * w + (lane >> 4) * 4) = sw; }
            LDS_BARRIER();
            float off0 = 0.f, off1 = 0.f, bend0 = 0.f, bend1 = 0.f;
#pragma unroll
            for (int g = 0; g < 8; ++g) { const f32x2 tg = *(const LAS f32x2*)(tot + g * 128 + c); if (g < sg) { off0 += tg.x; off1 += tg.y; } bend0 += tg.x; bend1 += tg.y; }
            if (sg == 0) *(LAS f32x2*)(dec + c) = (f32x2){__expf(bend0), __expf(bend1)};
            { const float eb0 = __expf(bend0), eb1 = __expf(bend1); float ke0[8], ke1[8];
#pragma unroll
              for (int s = 0; s < 8; ++s) { const int st = sg * 8 + s; const float e0 = __expf(off0 + b0[s]), e1 = __expf(off1 + b1[s]); const float i0 = __builtin_amdgcn_rcpf(e0), i1 = __builtin_amdgcn_rcpf(e1);
                  const unsigned qw = *(const LAS unsigned*)(QR + st * PK + c);
                  *(LAS unsigned*)(QD + st * PK + c) = pk2(bflo(qw) * e0, bfhi(qw) * e1);
                  const float kd0 = k0[s] * i0, kd1 = k1[s] * i1;
                  *(LAS unsigned*)(KD + st * PK + c) = pk2(kd0, kd1); ke0[s] = kd0 * eb0; ke1[s] = kd1 * eb1; }
              v4u o; o.x = pk2(ke0[0], ke0[1]); o.y = pk2(ke0[2], ke0[3]); o.z = pk2(ke0[4], ke0[5]); o.w = pk2(ke0[6], ke0[7]); *(LAS v4u*)(KEt + c * PS + sg * 8) = o;
              o.x = pk2(ke1[0], ke1[1]); o.y = pk2(ke1[2], ke1[3]); o.z = pk2(ke1[4], ke1[5]); o.w = pk2(ke1[6], ke1[7]); *(LAS v4u*)(KEt + (c + 1) * PS + sg * 8) = o; }
            LDS_BARRIER();
            { const int tb = w >> 1;
#pragma unroll
              for (int q2 = 0; q2 < 2; ++q2) { const int sb = (w & 1) * 2 + q2; pg8::f32x4 a = {0.f, 0.f, 0.f, 0.f};
                  if (sb <= tb) a = mma_tile(a, QD + tb * 16 * PK, PK, KD + sb * 16 * PK, PK, 4, lane);
#pragma unroll
                  for (int j = 0; j < 4; ++j) { const int tt = tb * 16 + (lane >> 4) * 4 + j, ss = sb * 16 + (lane & 15); Pm[tt * PS + ss] = f2bf(ss <= tt ? a[j] : 0.f); } } }
            LDS_BARRIER();
            asm volatile("" : "+v"(rq[0]), "+v"(rq[1]), "+v"(rk[0]), "+v"(rk[1]), "+v"(rv));
            { const int tb = w >> 1;
#pragma unroll
              for (int q2 = 0; q2 < 2; ++q2) { const int vb = (w & 1) * 2 + q2; pg8::f32x4 a = {0.f, 0.f, 0.f, 0.f};
                  a = mma_tile(a, Pm + tb * 16 * PS, PS, Vt + vb * 16 * PS, PS, 2, lane);
                  a = mma_tile(a, QD + tb * 16 * PK, PK, St + vb * 16 * PK, PK, 4, lane);
#pragma unroll
                  for (int j = 0; j < 4; ++j) { const int s = tb * 16 + (lane >> 4) * 4 + j; const int step = ch * 64 + s; const int t = d ? flip_tok(step) : step;
                      OG[((size_t)d * NTOK + (size_t)b * LTOK + t) * DM + h * 128 + vh * 64 + vb * 16 + (lane & 15)] = f2bf(a[j]); } } }
#pragma unroll
            for (int vb = 0; vb < 4; ++vb) { pg8::f32x4 a = S4[vb];
#pragma unroll
                for (int j = 0; j < 4; ++j) a[j] *= dec[16 * w + (lane >> 4) * 4 + j];
                S4[vb] = mma_tile(a, KEt + 16 * w * PS, PS, Vt + vb * 16 * PS, PS, 2, lane); }
        }
#undef GLA_FETCH
    }
}
__device__ __forceinline__ void l2_combine_phase(Frame& F, const float* norm_g) {
    const int gw = GW(F), NGWv = NGW(F); const bf16* OG = (const bf16*)(F.ws + L2_OG); const bf16* HGO = (const bf16*)(F.ws + L2_HGO); bf16* OUTB = (bf16*)(F.ws + WS_OUTB);
    const int l16 = F.lane & 15, hq = F.lane >> 4;
    float ng[8]; ld8f(norm_g + 8 * l16, ng);
    constexpr int UB = 3;
    for (int it0 = gw; it0 < NTOK * 4; it0 += UB * NGWv) {
        v4u wa[UB], wb[UB], wg[UB];
#pragma unroll
        for (int u = 0; u < UB; ++u) { const int it = it0 + u * NGWv; if (it < NTOK * 4) { const int m = it >> 2, col = ((it & 3) * 4 + hq) * 128 + 8 * l16; const size_t e = (size_t)m * DM + col;
            wa[u] = *(const GAS v4u*)(OG + e); wb[u] = *(const GAS v4u*)(OG + (size_t)NTOK * DM + e); wg[u] = *(const GAS v4u*)(HGO + (size_t)m * 10240 + 2 * DM + col); } }
#pragma unroll
        for (int u = 0; u < UB; ++u) { const int it = it0 + u * NGWv; if (it < NTOK * 4) { const int m = it >> 2, col = ((it & 3) * 4 + hq) * 128 + 8 * l16;
            float oa[8], ob[8], g[8], o[8]; unpack8(wa[u], oa); unpack8(wb[u], ob); unpack8(wg[u], g); float ss = 0.f;
#pragma unroll
            for (int j = 0; j < 8; ++j) { o[j] = oa[j] + ob[j]; ss += o[j] * o[j]; }
            ss = red16(ss);
            const float rs = 1.0f / sqrtf(ss * (1.f / 128.f) + 1e-5f);
#pragma unroll
            for (int j = 0; j < 8; ++j) o[j] = o[j] * rs * ng[j] * g[j];
            *(GAS v4u*)(OUTB + (size_t)m * DM + col) = pack8(o); } }
    }
}

__device__ __forceinline__ void l3_conv_phase(Frame& F, const float* cw, const float* cb) {
    const int gw = GW(F), NGWv = NGW(F); const bf16* IN = (const bf16*)(F.ws + L3_IN) + DM; bf16* XB = (bf16*)(F.ws + L3_XB);
    const int c0 = (gw & 3) * 512 + F.lane * 8;
    float wk[4][8], bk[8];
#pragma unroll
    for (int k = 0; k < 4; ++k) ld8f(cw + (size_t)k * DM + c0, wk[k]);
    ld8f(cb + c0, bk);
    for (int it = gw; it < (NTOK / 16) * 4; it += NGWv) {
        const int strip = it >> 2; const int m0 = strip * 16, t0 = m0 % LTOK;
        const int seg_end = (t0 < NCTX) ? NCTX : LTOK; const bool first_in_seg = (t0 == 0 || t0 == NCTX);
        const GAS bf16* xg = (const GAS bf16*)IN + (size_t)m0 * 4096 + c0;
        v4u xr[19];
#pragma unroll
        for (int q = 0; q < 19; ++q) { const bool ok = (q == 0) ? !first_in_seg : (t0 + q - 1 < seg_end);
            xr[q] = (v4u){0u, 0u, 0u, 0u}; if (ok) xr[q] = *(const GAS v4u*)(xg + (ptrdiff_t)(q - 1) * 4096); }
#pragma unroll
        for (int r = 0; r < 16; ++r) {
            const v4u x0 = xr[r], x1 = xr[r + 1], x2 = xr[r + 2], x3 = xr[r + 3];
            float o[8];
#pragma unroll
            for (int q = 0; q < 4; ++q) {
                o[2 * q] = bk[2 * q] + wk[0][2 * q] * bflo(x0[q]) + wk[1][2 * q] * bflo(x1[q]) + wk[2][2 * q] * bflo(x2[q]) + wk[3][2 * q] * bflo(x3[q]);
                o[2 * q + 1] = bk[2 * q + 1] + wk[0][2 * q + 1] * bfhi(x0[q]) + wk[1][2 * q + 1] * bfhi(x1[q]) + wk[2][2 * q + 1] * bfhi(x2[q]) + wk[3][2 * q + 1] * bfhi(x3[q]); }
            *(GAS v4u*)(XB + (size_t)(m0 + r) * DM + c0) = pack8(o);
        }
    }
}
__device__ __forceinline__ void l3_scan_phase(Frame& F) {
    unsigned char* ws = F.ws; LAS float* PA = (LAS float*)(F.lds + RING_OFF); LAS float* PH = PA + 512;
    constexpr int SEGL = LTOK / 8, NBLK = SEGL / 16;
    for (int u = F.vcu; u < 256; u += F.G) {
        const int d = u >> 7, b = (u >> 5) & 3, cg = u & 31; const int ch = cg * 64 + F.lane, seg = F.wave;
        const bf16* LOGA = (const bf16*)(ws + L3_LOGA) + (size_t)d * NTOK * DM + (size_t)b * LTOK * DM + ch;
        const bf16* UU = (const bf16*)(ws + L3_UU) + (size_t)d * NTOK * DM + (size_t)b * LTOK * DM + ch;
        bf16* YS = (bf16*)(ws + L3_YS) + (size_t)d * NTOK * DM + (size_t)b * LTOK * DM + ch;
        bf16 laA[16], luA[16], laB[16], luB[16];
        auto ldblk = [&](const int blk, bf16 (&la)[16], bf16 (&lu)[16]) __attribute__((always_inline)) {
#pragma unroll
            for (int s = 0; s < 16; ++s) { const int step = seg * SEGL + blk * 16 + s; const int t = d ? flip_tok(step) : step; la[s] = LOGA[(size_t)t * DM]; lu[s] = UU[(size_t)t * DM]; } };
        float P = 1.f, Hh = 0.f;
        auto scan1 = [&](const bf16 (&la)[16], const bf16 (&lu)[16]) __attribute__((always_inline)) {
#pragma unroll
            for (int s = 0; s < 16; ++s) { const float a = __expf(bf2f(la[s])); Hh = a * Hh + bf2f(lu[s]); P *= a; } };
        auto scan2 = [&](const int blk, const bf16 (&la)[16], const bf16 (&lu)[16]) __attribute__((always_inline)) {
#pragma unroll
            for (int s = 0; s < 16; ++s) { const int step = seg * SEGL + blk * 16 + s; const int t = d ? flip_tok(step) : step; const float a = __expf(bf2f(la[s])); Hh = a * Hh + bf2f(lu[s]); YS[(size_t)t * DM] = f2bf(Hh); } };
        ldblk(0, laA, luA);
#pragma unroll 1
        for (int blk = 0; blk < NBLK; blk += 2) { ldblk(blk + 1, laB, luB); scan1(laA, luA); ldblk(blk + 2 < NBLK ? blk + 2 : NBLK - 1, laA, luA); scan1(laB, luB); }
        __syncthreads();
        PA[F.tid] = P; PH[F.tid] = Hh;
        __syncthreads();
        float carry = 0.f;
        for (int g = 0; g < seg; ++g) carry = PA[g * 64 + F.lane] * carry + PH[g * 64 + F.lane];
        Hh = carry;
        ldblk(0, laA, luA);
#pragma unroll 1
        for (int blk = 0; blk < NBLK; blk += 2) { ldblk(blk + 1, laB, luB); scan2(blk, laA, luA); ldblk(blk + 2 < NBLK ? blk + 2 : NBLK - 1, laA, luA); scan2(blk + 1, laB, luB); }
    }
}
__device__ __forceinline__ void l3_combine_phase(Frame& F) {
    const bf16* YS = (const bf16*)(F.ws + L3_YS); const bf16* IN = (const bf16*)(F.ws + L3_IN); bf16* OUTB = (bf16*)(F.ws + WS_OUTB);
    const size_t total = (size_t)NTOK * DM / 8; const size_t stride = (size_t)F.G * 512;
    constexpr int UB = 3;
    for (size_t i0 = (size_t)F.vcu * 512 + F.tid; i0 < total; i0 += UB * stride) {
        v4u ya[UB], yb[UB], gg[UB];
#pragma unroll
        for (int u = 0; u < UB; ++u) { const size_t i = i0 + u * stride; if (i < total) { const size_t e = i * 8; const size_t m = e / DM, c = e % DM;
            ya[u] = *(const GAS v4u*)(YS + e); yb[u] = *(const GAS v4u*)(YS + (size_t)NTOK * DM + e); gg[u] = *(const GAS v4u*)(IN + m * 4096 + c); } }
#pragma unroll
        for (int u = 0; u < UB; ++u) { const size_t i = i0 + u * stride; if (i < total) { const size_t e = i * 8;
            float a[8], b[8], g[8], o[8]; unpack8(ya[u], a); unpack8(yb[u], b); unpack8(gg[u], g);
#pragma unroll
            for (int j = 0; j < 8; ++j) o[j] = (a[j] + b[j]) * g[j];
            *(GAS v4u*)(OUTB + e) = pack8(o); } }
    }
}
constexpr int N_PHASE_IDS = 1 + 16 * NLAYER;
struct Args { const float* in[43]; float* out; unsigned char* ws; int ph_lo, ph_hi; };
static_assert(sizeof(Args) == 45 * 8 + 8, "Args has no holes");

#ifdef PROBE_MASK
__device__ __forceinline__ int probe_rep(int k) {
    if (k == 0) return 1;
    return ((PROBE_SEL >> (k - 1)) & 1ull) ? 2 : 1;
}
#endif
__global__ void __launch_bounds__(NWAVES * 64, 2) mega_fwd(Args args) {
    extern __shared__ __attribute__((aligned(16))) unsigned char lds[];
    { const int t0 = threadIdx.x; for (int u = t0; u < (LDS_BYTES - LDSCTL_OFF) / 4; u += NWAVES * 64) ((LAS unsigned*)((LAS unsigned char*)lds + LDSCTL_OFF))[u] = 0u; }
    __syncthreads();
#define MKFRAME() Frame F; { int t_ = threadIdx.x; asm volatile("" : "+v"(t_)); int bx_ = blockIdx.x, g_ = gridDim.x; asm volatile("" : "+s"(bx_), "+s"(g_)); \
        F.lds = (LAS unsigned char*)lds; F.MISC = (volatile LAS unsigned*)(F.lds + MISC_OFF); F.tid = t_; F.lane = t_ & 63; F.wave = __builtin_amdgcn_readfirstlane(t_ >> 6); \
        F.G = g_; F.vcu = (g_ % 8 == 0) ? (bx_ % 8) * (g_ / 8) + bx_ / 8 : bx_; F.bx = bx_; F.ws = (unsigned char*)ldarg(44); F.ctl = (gu32*)(F.ws + WS_CTL); }
    const int lo = args.ph_lo, hi = args.ph_hi;
    const bool multi = (hi - lo) > 1;
    XcdBarrier bar; bar.bar = (unsigned*)((unsigned char*)ldarg(44) + WS_CTL) + CW_BAR; bar.x = 0; bar.st = nullptr;
    if (multi) bar = xcd_barrier_post(bar.bar, (volatile LAS unsigned*)((LAS unsigned char*)lds + MISC_OFF) + 8);
#define IN(k) (lo <= (k) && (k) < hi)
#define RUN_GEMM(EPI, MODE, LAT, NM, NN, LDA_, LDB_, KK_, Aptr, Bptr, Eobj) do { typedef Sched<MODE, LAT, NM, NN, LDA_, LDB_> S_t; S_t S_; S_.init(F.G, F.bx); \
        pg8::gemm_phase<EPI, S_t, LDA_, LDB_, KK_, true, true>(F.lds + RING_OFF, (Aptr), (Bptr), S_, (Eobj)); } while (0)
#define RUN_GEMM_SPLIT(SPLIT, KSUB, LDA_, LDB_, Aptr, Bptr, Eobj) do { typedef SchedSplitHalf<SPLIT, KSUB, LDA_, LDB_> S_t; S_t S_; S_.init(F.G, F.bx); \
        pg8::gemm_phase<EpiPartial, S_t, LDA_, LDB_, KSUB, true, true, true>(F.lds + RING_OFF, (Aptr), (Bptr), S_, (Eobj)); } while (0)
#define RUN_GEMM_HT(EPI, LAT, NM, NN, LMAX, NT, LDA_, LDB_, KK_, Aptr, Bptr, Eobj) do { \
        typedef SchedHT<LAT, NM, NN, LMAX, NT, LDA_, LDB_> S_t; S_t S_; S_.init(F.G, F.bx); pg8::gemm_phase<EPI, S_t, LDA_, LDB_, KK_, true, true, 2>(F.lds + RING_OFF, (Aptr), (Bptr), S_, (Eobj)); } while (0)
#define SEAM(k) do { if ((k) + 1 < hi) xcd_barrier(bar); } while (0)
#ifdef PROBE_MASK
#define PH_OPEN(k) if (IN(k)) { _Pragma("unroll 1") for (int rep_ = 0; rep_ < probe_rep(k); ++rep_) {
#define PH_CLOSE(k) if ((k) + 1 < hi || rep_ + 1 < probe_rep(k)) xcd_barrier(bar); } }
#else
#define PH_OPEN(k) if (IN(k)) {
#define PH_CLOSE(k) SEAM(k); }
#endif
#define WSP ((unsigned char*)ldarg(44))
#define Z ((float*)(WSP + WS_Z))
#define PRE ((bf16*)(WSP + WS_PRE))
#define H ((bf16*)(WSP + WS_H))
#define OUTB ((bf16*)(WSP + WS_OUTB))
#define U ((bf16*)(WSP + WS_U))
#define ACT ((bf16*)(WSP + WS_ACT))

#ifndef DIS_P0
    PH_OPEN(0) MKFRAME(); p0_prologue(F); PH_CLOSE(0)
#endif

    for (int layer = 0; layer < NLAYER; ++layer) {
        const int P = 1 + 16 * layer;
        if (layer == 0) {
#ifndef DIS_L0
            PH_OPEN(P + 0) MKFRAME(); l0_xs_phase(F, INP(0), INP(2), INP(12)); PH_CLOSE(P + 0)
#ifndef DIS_L0_G1
            PH_OPEN(P + 1) MKFRAME();
                EpiBf16Route<1> E{nullptr, 0, WSP, nullptr, nullptr};
                RUN_GEMM(EpiBf16Route<1>, 1, false, 36, 27, DM, DM, DM, (const bf16*)(WSP + L0_XS), (const bf16*)(WSP + WS_WA), E); PH_CLOSE(P + 1)
#endif
#ifndef DIS_L0_G2
            PH_OPEN(P + 2) MKFRAME();
                EpiBf16Route<2> E{nullptr, 0, WSP, INP(14), INP(17)};
                RUN_GEMM(EpiBf16Route<2>, 2, false, 36, 40, 256, 256, 256, (const bf16*)(WSP + L0_HID), (const bf16*)(WSP + WS_WL2), E); PH_CLOSE(P + 2)
#endif
#ifndef DIS_L0_PREP
#endif
#ifndef DIS_L0_SCAN
            PH_OPEN(P + 4) MKFRAME(); l0_cscan2_phase(F, INP(22), INP(23), INP(24)); PH_CLOSE(P + 4)
#endif
            PH_OPEN(P + 5) MKFRAME(); l0_post_phase(F, INP(25), INP(26)); PH_CLOSE(P + 5)
#endif
        } else if (layer == 1) {
#ifndef DIS_L1
            PH_OPEN(P + 0) MKFRAME();
                EpiBf16Route<5> E{(bf16*)(WSP + L1_QKV), 6144, WSP, nullptr, nullptr};
                RUN_GEMM_HT(EpiBf16Route<5>, false, 36, 24, 768, 96, DM, DM, DM, H, (const bf16*)(WSP + WS_WQKV), E); PH_CLOSE(P + 0)
            PH_OPEN(P + 2) MKFRAME(); l1_attn_phase(F, (char*)lds + RING_OFF); PH_CLOSE(P + 2)
            PH_OPEN(P + 3) MKFRAME(); l1_combine_phase(F, INP(29), INP(30)); PH_CLOSE(P + 3)
#endif
        } else if (layer == 2) {
#ifndef DIS_L2
            PH_OPEN(P + 0) MKFRAME();
                EpiBf16Route<3> E{(bf16*)(WSP + L2_HGO), 10240, WSP, (const float*)(WSP + WS_LB), nullptr};
                RUN_GEMM(EpiBf16Route<3>, 0, false, 36, 40, DM, DM, DM, H, (const bf16*)(WSP + WS_WHG), E); PH_CLOSE(P + 0)
            PH_OPEN(P + 1) MKFRAME(); l2_gla_phase(F); PH_CLOSE(P + 1)
            PH_OPEN(P + 2) MKFRAME(); l2_combine_phase(F, INP(34)); PH_CLOSE(P + 2)
#endif
        } else {
#ifndef DIS_L3
            PH_OPEN(P + 0) MKFRAME();
                EpiBf16Route<4> E{(bf16*)(WSP + L3_IN), 4096, WSP, nullptr, nullptr};
                RUN_GEMM_HT(EpiBf16Route<4>, false, 36, 16, 512, 64, DM, DM, DM, H, (const bf16*)(WSP + WS_WLR), E); PH_CLOSE(P + 0)
            PH_OPEN(P + 1) MKFRAME(); l3_conv_phase(F, INP(37), INP(38)); PH_CLOSE(P + 1)
            PH_OPEN(P + 2) MKFRAME();
                EpiGates E{WSP, INP(40), INP(41)};
                RUN_GEMM(EpiGates, 3, false, 36, 32, DM, 256, 256, (const bf16*)(WSP + L3_XB), (const bf16*)(WSP + WS_WGATE), E); PH_CLOSE(P + 2)
            PH_OPEN(P + 3) MKFRAME(); l3_scan_phase(F); PH_CLOSE(P + 3)
            PH_OPEN(P + 4) MKFRAME(); l3_combine_phase(F); PH_CLOSE(P + 4)
#endif
        }
#ifndef DIS_COMMON
        const bool last = (layer == NLAYER - 1);
        const float* lng = INP(6) + (size_t)layer * 2 * DM; const float* lnb = INP(7) + (size_t)layer * 2 * DM;
        PH_OPEN(P + 10) MKFRAME();
            const bf16* wB = (const bf16*)(WSP + WS_WO) + (size_t)layer * DM * DM; EpiResid E{PRE, WSP, layer, 2};
            if (last) RUN_GEMM(EpiResid, 0, true, 32, 8, DM, DM, DM, OUTB, wB, E);
            else { RUN_GEMM(EpiResid, 0, false, 32, 8, DM, DM, DM, OUTB, wB, E); EpiPartial EP{(bf16*)(WSP + WS_U)}; RUN_GEMM_SPLIT(4, 512, DM, DM, OUTB, wB, EP); }
            PH_CLOSE(P + 10)
        PH_OPEN(P + 11) MKFRAME();
            if (last) ln1_phase<true, 0, false>(F, PRE, Z, INP(0), INP(2), H, (float*)(WSP + WS_STAT), lng, lnb, layer, nullptr);
            else if (layer == 0) ln1_phase<false, 4, true>(F, PRE, Z, INP(0), INP(2), H, (float*)(WSP + WS_STAT), lng, lnb, layer, (const bf16*)(WSP + WS_U));
            else ln1_phase<false, 4, false>(F, PRE, Z, INP(0), INP(2), H, (float*)(WSP + WS_STAT), lng, lnb, layer, (const bf16*)(WSP + WS_U));
            PH_CLOSE(P + 11)
        PH_OPEN(P + 12) MKFRAME();
            const bf16* wB = (const bf16*)(WSP + WS_WUP) + (size_t)layer * DFF2 * DM; EpiConvAct E{ACT, (bf16*)(WSP + WS_UB), INP(9) + (size_t)layer * 3 * DFF2, INP(10) + (size_t)layer * DFF2};
            if (last) RUN_GEMM_HT(EpiConvAct, true, 32, 44, 1280, 128, DM, DM, DM, H, wB, E); else RUN_GEMM_HT(EpiConvAct, false, 36, 44, 1536, 48, DM, DM, DM, H, wB, E);
            PH_CLOSE(P + 12)
        PH_OPEN(P + 13) MKFRAME(); const float* cw = INP(9) + (size_t)layer * 3 * DFF2; const float* cb = INP(10) + (size_t)layer * DFF2;
            if (last) ffn_fix_phase<true>(F, (const bf16*)(WSP + WS_UB), ACT, cw, cb); else ffn_fix_phase<false>(F, (const bf16*)(WSP + WS_UB), ACT, cw, cb); PH_CLOSE(P + 13)
        PH_OPEN(P + 14) MKFRAME();
            const bf16* wB = (const bf16*)(WSP + WS_WDN) + (size_t)layer * DM * DFF; EpiResid E{PRE + (size_t)NTOK * DM, WSP, layer, 5};
            if (last) RUN_GEMM(EpiResid, 0, true, 32, 8, DFF, DFF, DFF, ACT, wB, E);
            else { RUN_GEMM(EpiResid, 0, false, 32, 8, DFF, DFF, DFF, ACT, wB, E); EpiPartial EP{(bf16*)(WSP + WS_U)}; RUN_GEMM_SPLIT(4, 1408, DFF, DFF, ACT, wB, EP); }
            PH_CLOSE(P + 14)
        PH_OPEN(P + 15) MKFRAME();
            if (last) ln2_phase<true, true, false, 0, false>(F, PRE, PRE + (size_t)NTOK * DM, Z, INP(0), INP(2), nullptr, (float*)ldarg(43), nullptr, (const float*)(WSP + WS_STAT), lng, lnb, lng + DM, lnb + DM, layer, nullptr);
            else if (layer == 0) ln2_phase<false, false, true, 4, true>(F, PRE, PRE + (size_t)NTOK * DM, Z, INP(0), INP(2), Z, nullptr, H, (const float*)(WSP + WS_STAT), lng, lnb, lng + DM, lnb + DM, layer, (const bf16*)(WSP + WS_U));
            else ln2_phase<false, false, true, 4, false>(F, PRE, PRE + (size_t)NTOK * DM, Z, INP(0), INP(2), Z, nullptr, H, (const float*)(WSP + WS_STAT), lng, lnb, lng + DM, lnb + DM, layer, (const bf16*)(WSP + WS_U));
            PH_CLOSE(P + 15)
#endif
    }
#undef IN
#undef SEAM
#undef Z
#undef PRE
#undef H
#undef OUTB
#undef U
#undef ACT
}

static const bool kPhaseUsed[N_PHASE_IDS] = {
    true,
    true, true, true, false, true, true, false, false, false, false, true, true, true, true, true, true,
    true, false, true, true, false, false, false, false, false, false, true, true, true, true, true, true,
    true, true, true, false, false, false, false, false, false, false, true, true, true, true, true, true,
    true, true, true, true, true, false, false, false, false, false, true, true, true, true, true, true };
extern "C" void kernel_launch(void* const* d_in, const int* in_sizes, int n_in, void* d_out, int out_size, void* d_ws, size_t ws_size, hipStream_t stream) {
    static int grid = 0;
    if (grid == 0) {
        if (n_in != 43 || out_size != NLAT * DM || ws_size < WS_END) { fprintf(stderr, "kernel_launch: unexpected shapes: n_in %d out %d ws %zu (need %zu)\n", n_in, out_size, ws_size, (size_t)WS_END); grid = -1; return; }
        int dev = 0, cus = 0, per_cu = 0;
        if (hipGetDevice(&dev) != hipSuccess || hipDeviceGetAttribute(&cus, hipDeviceAttributeMultiprocessorCount, dev) != hipSuccess) { grid = -1; return; }
        if (hipFuncSetAttribute((const void*)mega_fwd, hipFuncAttributeMaxDynamicSharedMemorySize, LDS_BYTES) != hipSuccess) { fprintf(stderr, "kernel_launch: hipFuncSetAttribute failed\n"); grid = -1; return; }
        if (hipOccupancyMaxActiveBlocksPerMultiprocessor(&per_cu, (const void*)mega_fwd, NWAVES * 64, LDS_BYTES) != hipSuccess || per_cu < 1)
            fprintf(stderr, "kernel_launch: occupancy query reports %d workgroups per CU\n", per_cu);
        (void)hipGetLastError();
        grid = cus;
    }
    if (grid < 0) return;
    if (hipMemsetAsync((char*)d_ws + WS_CTL, 0, ZERO_BYTES, stream) != hipSuccess) { fprintf(stderr, "kernel_launch: memset failed\n"); return; }
    Args a{};
    for (int i = 0; i < 43; ++i) a.in[i] = (const float*)d_in[i];
    a.out = (float*)d_out; a.ws = (unsigned char*)d_ws;
#if MK_N_LAUNCHES == 1
    a.ph_lo = 0; a.ph_hi = N_PHASE_IDS;
    hipLaunchKernelGGL(mega_fwd, dim3(grid), dim3(NWAVES * 64), LDS_BYTES, stream, a);
#else
    for (int p = 0; p < N_PHASE_IDS; ++p) { if (!kPhaseUsed[p]) continue; a.ph_lo = p; a.ph_hi = p + 1;
        hipLaunchKernelGGL(mega_fwd, dim3(grid), dim3(NWAVES * 64), LDS_BYTES, stream, a); }
#endif
    const hipError_t le = hipPeekAtLastError();
    if (le != hipSuccess) fprintf(stderr, "kernel_launch: launch failed: %s\n", hipGetErrorName(le));
}
```

```cpp
#include <hip/hip_runtime.h>
#include <cstdio>
#include <cstdint>

namespace pg8 {
#define PG8_LAS __attribute__((address_space(3)))
typedef unsigned short bf16_t;
typedef short bf16x8 __attribute__((ext_vector_type(8)));
typedef float f32x4 __attribute__((ext_vector_type(4)));
typedef float f32x2 __attribute__((ext_vector_type(2)));
typedef unsigned u32x4 __attribute__((ext_vector_type(4)));
typedef unsigned u32x2 __attribute__((ext_vector_type(2)));
constexpr int BM = 256, BK = 64, HALF = 128, HTB = HALF * BK * 2  , STAGE_BYTES = 8 * HTB, NXCD = 8, WGM = 8;

__host__ __device__ __forceinline__ int lds_byte(int r, int c) { const int st = (r >> 4) * 2 + (c >> 5), rr = r & 15, cc = c & 31, ob = rr * 64 + cc * 2; return st * 1024 + (ob ^ (((ob >> 9) & 1) << 5)); }
__host__ __device__ __forceinline__ void stage_rc(int b, int& R, int& C) { const int st = b / 1024, sb = b % 1024, swz = sb ^ (((sb >> 9) & 1) << 5); R = (st >> 1) * 16 + swz / 64; C = (st & 1) * 32 + (swz % 64) / 2; }
__host__ __device__ __forceinline__ int perm32(int rho) { const int n = rho >> 4, i = rho & 15; return 8 * (i >> 2) + 4 * n + (i & 3); }

struct Unit { int pm, pn; unsigned aoff, boff; int half; };
struct Gemm { const bf16_t* A; const bf16_t* Bt; int lda, ldb, K; };

template <int nM, int nN> struct TileOrder {
    static constexpr int nwg = nM * nN;
    int G, c;
    __device__ void init(int G_, int c_) { G = G_; c = c_; }
    __device__ __forceinline__ bool tile(int i, int& pm, int& pn) const { return tileL(i * G + c, pm, pn); }
    static __device__ __forceinline__ bool tileL(int L, int& pm, int& pn) {
        if (L >= nwg) return false;
        int wgid = L; { constexpr int q = nwg / NXCD, r = nwg % NXCD; const int xcd = wgid % NXCD, off = wgid / NXCD; wgid = (xcd < r ? xcd * (q + 1) : r * (q + 1) + (xcd - r) * q) + off; }
        constexpr int nig = WGM * nN; const int gid = wgid / nig, fm = gid * WGM, gsz = (nM - fm) < WGM ? (nM - fm) : WGM;
        pm = fm + ((wgid % nig) % gsz); pn = (wgid % nig) / gsz; return true;
    }
};

typedef __bf16 bf16x2_hw __attribute__((ext_vector_type(2)));
__device__ __forceinline__ unsigned cvt_pk_bf16(float lo, float hi) { const f32x2 v = {lo, hi}; const bf16x2_hw b = __builtin_convertvector(v, bf16x2_hw); return __builtin_bit_cast(unsigned, b); }

template <class Epi, class Sched, int LDA, int LDB, int KK, bool ALIGN_EPI = false, bool SP2 = false, int HM = 0>
__device__ __forceinline__ void gemm_phase(PG8_LAS unsigned char* lds, const bf16_t* gA, const bf16_t* gBt, const Sched& S, const Epi& E) {
    int tid_ = threadIdx.x; asm volatile("" : "+v"(tid_));
    const int tid = tid_, wid = __builtin_amdgcn_readfirstlane(tid >> 6), lane = tid & 63, wr = wid >> 2, wc = wid & 3, fr = lane & 15, fq = lane >> 4;
    constexpr int nt = KK / BK;
    unsigned voffA[2], voffB[2];
#pragma unroll
    for (int i = 0; i < 2; ++i) { int R, C; stage_rc(tid * 16 + i * 8192, R, C); const int Rb = Epi::PERM ? ((R & ~31) + perm32(R & 31)) : R;
        const int Ra = Epi::PERMA ? ((R & ~63) + 4 * (R & 15) + ((R & 63) >> 4)) : R;
        voffA[i] = (unsigned)(Ra * LDA + C) * 2u; voffB[i] = (unsigned)(Rb * LDB + C) * 2u; }
    constexpr size_t kstep = (size_t)(BK * 2);
    constexpr size_t hstepA = (size_t)HALF * LDA * 2, hstepB = (size_t)HALF * LDB * 2;
    const unsigned ldsw = (unsigned)wid * 1024u;
    const int aoff = lds_byte(wr * 64 + fr, fq * 8), boff = lds_byte(wc * 32 + fr, fq * 8);
#define PG8_SA(b, h) (((b) * 2 + (h)) * HTB)
#define PG8_SB(b, h) ((4 + (b) * 2 + (h)) * HTB)
#define PG8_STAGE(bufoff, gbase, voff) do { _Pragma("unroll") for (int _i = 0; _i < 2; ++_i) \
        __builtin_amdgcn_global_load_lds((const unsigned*)((const char*)(gbase) + (voff)[_i]), (PG8_LAS unsigned*)(lds + (bufoff) + ldsw + _i * 8192), 16, 0, 0); } while (0)
#define PG8_LDA(dst, b, h) do { _Pragma("unroll") for (int m = 0; m < 4; ++m) _Pragma("unroll") for (int k = 0; k < 2; ++k) dst[m][k] = *(const PG8_LAS bf16x8*)(lds + PG8_SA(b, h) + aoff + m * 2048 + k * 1024); } while (0)
#define PG8_LDB(dst, b, h) do { _Pragma("unroll") for (int n = 0; n < 2; ++n) _Pragma("unroll") for (int k = 0; k < 2; ++k) dst[n][k] = *(const PG8_LAS bf16x8*)(lds + PG8_SB(b, h) + boff + n * 2048 + k * 1024); } while (0)
#define PG8_MMA(ai, bj, At, Bt) do { __builtin_amdgcn_s_setprio(1); _Pragma("unroll") for (int m = 0; m < 4; ++m) _Pragma("unroll") for (int n = 0; n < 2; ++n) _Pragma("unroll") for (int k = 0; k < 2; ++k) \
        acc[ai][bj][m][n] = __builtin_amdgcn_mfma_f32_16x16x32_bf16(Bt[n][k], At[m][k], acc[ai][bj][m][n], 0, 0, 0); __builtin_amdgcn_s_setprio(0); } while (0)
#define PG8_WAIT_V(n) asm volatile("s_waitcnt vmcnt(" #n ")" ::: "memory")
#define PG8_WAIT_L(n) asm volatile("s_waitcnt lgkmcnt(" #n ")" ::: "memory")
#define PG8_BAR __builtin_amdgcn_s_barrier()
#define PG8_SCHED __builtin_amdgcn_sched_barrier(0)
    Unit cur, nxt; int ui = 0;
    if (!S.next(0, cur)) return;
    f32x4 acc[2][2][4][2];
#pragma unroll
    for (int a = 0; a < 2; ++a)
#pragma unroll
        for (int b = 0; b < 2; ++b)
#pragma unroll
            for (int m = 0; m < 4; ++m)
#pragma unroll
                for (int n = 0; n < 2; ++n) acc[a][b][m][n] = (f32x4){0.f, 0.f, 0.f, 0.f};
    bf16x8 At[4][2], B0[2][2], B1[2][2];
    const char* cA = (const char*)gA + cur.aoff; const char* cB = (const char*)gBt + cur.boff;
    if (HM == 1 || (HM == 2 && cur.half >= 0)) {
        PG8_STAGE(PG8_SB(0, 0), cB, voffB); PG8_STAGE(PG8_SB(0, 1), cB + hstepB, voffB); PG8_STAGE(PG8_SA(0, 0), cA, voffA);
        if (wr == 1) PG8_BAR;
        PG8_WAIT_V(0); PG8_BAR;
        PG8_STAGE(PG8_SB(1, 0), cB + kstep, voffB); PG8_STAGE(PG8_SA(1, 0), cA + kstep, voffA); PG8_STAGE(PG8_SB(1, 1), cB + hstepB + kstep, voffB);
        PG8_WAIT_V(6); PG8_BAR;
    } else if constexpr (SP2) {
        PG8_STAGE(PG8_SB(0, 0), cB, voffB); PG8_STAGE(PG8_SB(0, 1), cB + hstepB, voffB); PG8_STAGE(PG8_SA(0, 0), cA, voffA); PG8_STAGE(PG8_SA(0, 1), cA + hstepA, voffA);
        if (wr == 1) PG8_BAR;
        PG8_WAIT_V(2); PG8_BAR;
        PG8_STAGE(PG8_SB(1, 0), cB + kstep, voffB); PG8_STAGE(PG8_SA(1, 0), cA + kstep, voffA); PG8_STAGE(PG8_SB(1, 1), cB + hstepB + kstep, voffB);
        PG8_WAIT_V(6); PG8_BAR;
    } else {
        PG8_STAGE(PG8_SB(0, 0), cB, voffB); PG8_STAGE(PG8_SA(0, 0), cA, voffA); PG8_STAGE(PG8_SB(0, 1), cB + hstepB, voffB); PG8_STAGE(PG8_SA(0, 1), cA + hstepA, voffA);
        if (wr == 1) PG8_BAR;
        PG8_WAIT_V(4); PG8_BAR;
        PG8_STAGE(PG8_SB(1, 0), cB + kstep, voffB); PG8_STAGE(PG8_SA(1, 0), cA + kstep, voffA); PG8_STAGE(PG8_SB(1, 1), cB + hstepB + kstep, voffB);
        PG8_WAIT_V(6); PG8_BAR;
    }
    for (;;) {
        const bool has_next = S.next(ui + 1, nxt);
        const char* nA = has_next ? (const char*)gA + nxt.aoff : cA; const char* nB = has_next ? (const char*)gBt + nxt.boff : cB;
#define PG8_KT_ADDR const bool last = (t == nt - 2); const char* a1 = cA + (size_t)(t + 1) * kstep; \
            const char* a2 = last ? nA : cA + (size_t)(t + 2) * kstep; const char* b2 = last ? nB : cB + (size_t)(t + 2) * kstep; const char* a3 = a2 + kstep; const char* b3 = b2 + kstep;
        if (HM == 1 || (HM == 2 && cur.half >= 0)) {
#pragma unroll 1
          for (int t = 0; t < nt; t += 2) { PG8_KT_ADDR
            PG8_LDB(B0, 0, 0); PG8_LDB(B1, 0, 1); PG8_SCHED; PG8_LDA(At, 0, 0);
            PG8_WAIT_V(6); PG8_WAIT_L(0); PG8_BAR; PG8_MMA(0, 0, At, B0); PG8_MMA(0, 1, At, B1); PG8_BAR; PG8_SCHED;
            PG8_STAGE(PG8_SB(0, 0), b2, voffB); PG8_STAGE(PG8_SB(0, 1), b2 + hstepB, voffB); PG8_STAGE(PG8_SA(0, 0), a2, voffA);
            PG8_WAIT_V(6); PG8_BAR; PG8_BAR; PG8_SCHED;
            PG8_LDB(B0, 1, 0); PG8_LDB(B1, 1, 1); PG8_SCHED; PG8_LDA(At, 1, 0);
            PG8_WAIT_V(6); PG8_WAIT_L(0); PG8_BAR; PG8_MMA(0, 0, At, B0); PG8_MMA(0, 1, At, B1); PG8_BAR; PG8_SCHED;
            PG8_STAGE(PG8_SB(1, 0), b3, voffB); PG8_STAGE(PG8_SB(1, 1), b3 + hstepB, voffB); PG8_STAGE(PG8_SA(1, 0), a3, voffA);
            PG8_WAIT_V(6); PG8_BAR; PG8_BAR; PG8_SCHED;
            (void)a1;
          }
        } else {
#pragma unroll 1
          for (int t = 0; t < nt; t += 2) { PG8_KT_ADDR
            if constexpr (SP2) {
            PG8_LDB(B0, 0, 0); PG8_LDB(B1, 0, 1); PG8_SCHED; PG8_LDA(At, 0, 0); PG8_STAGE(PG8_SA(1, 1), a1 + hstepA, voffA);
            PG8_WAIT_V(8); PG8_WAIT_L(0); PG8_BAR; PG8_MMA(0, 0, At, B0); PG8_MMA(0, 1, At, B1); PG8_BAR; PG8_SCHED;
            PG8_LDA(At, 0, 1); PG8_STAGE(PG8_SB(0, 0), b2, voffB); PG8_STAGE(PG8_SB(0, 1), b2 + hstepB, voffB); PG8_STAGE(PG8_SA(0, 0), a2, voffA);
            PG8_WAIT_V(8); PG8_WAIT_L(0); PG8_BAR; PG8_MMA(1, 0, At, B0); PG8_MMA(1, 1, At, B1); PG8_BAR; PG8_SCHED;
            PG8_LDB(B0, 1, 0); PG8_LDB(B1, 1, 1); PG8_SCHED; PG8_LDA(At, 1, 0); PG8_STAGE(PG8_SA(0, 1), a2 + hstepA, voffA);
            PG8_WAIT_V(8); PG8_WAIT_L(0); PG8_BAR; PG8_MMA(0, 0, At, B0); PG8_MMA(0, 1, At, B1); PG8_BAR; PG8_SCHED;
            PG8_LDA(At, 1, 1); PG8_STAGE(PG8_SB(1, 0), b3, voffB); PG8_STAGE(PG8_SB(1, 1), b3 + hstepB, voffB); PG8_STAGE(PG8_SA(1, 0), a3, voffA);
            PG8_WAIT_V(8); PG8_WAIT_L(0); PG8_BAR; PG8_MMA(1, 0, At, B0); PG8_MMA(1, 1, At, B1); PG8_BAR; PG8_SCHED;
            } else {
            PG8_LDB(B0, 0, 0); PG8_SCHED; PG8_LDA(At, 0, 0); PG8_STAGE(PG8_SA(1, 1), a1 + hstepA, voffA);
            PG8_WAIT_L(8); PG8_BAR; PG8_WAIT_L(0); PG8_MMA(0, 0, At, B0); PG8_BAR; PG8_SCHED;
            PG8_LDB(B1, 0, 1); PG8_STAGE(PG8_SB(0, 0), b2, voffB);
            PG8_BAR; PG8_WAIT_L(0); PG8_MMA(0, 1, At, B1); PG8_BAR;
            PG8_LDA(At, 0, 1); PG8_STAGE(PG8_SA(0, 0), a2, voffA);
            PG8_BAR; PG8_WAIT_L(0); PG8_MMA(1, 0, At, B0); PG8_BAR; PG8_SCHED;
            PG8_STAGE(PG8_SB(0, 1), b2 + hstepB, voffB);
            PG8_WAIT_V(6); PG8_BAR; PG8_MMA(1, 1, At, B1); PG8_BAR;
            PG8_LDB(B0, 1, 0); PG8_SCHED; PG8_LDA(At, 1, 0); PG8_STAGE(PG8_SA(0, 1), a2 + hstepA, voffA);
            PG8_WAIT_L(8); PG8_BAR; PG8_WAIT_L(0); PG8_MMA(0, 0, At, B0); PG8_BAR; PG8_SCHED;
            PG8_LDB(B1, 1, 1); PG8_STAGE(PG8_SB(1, 0), b3, voffB);
            PG8_BAR; PG8_WAIT_L(0); PG8_MMA(0, 1, At, B1); PG8_BAR;
            PG8_LDA(At, 1, 1); PG8_STAGE(PG8_SA(1, 0), a3, voffA);
            PG8_BAR; PG8_WAIT_L(0); PG8_MMA(1, 0, At, B0); PG8_BAR; PG8_SCHED;
            PG8_STAGE(PG8_SB(1, 1), b3 + hstepB, voffB);
            PG8_WAIT_V(6); PG8_BAR; PG8_MMA(1, 1, At, B1); PG8_BAR;
            }
          }
        }
#undef PG8_KT_ADDR
        if constexpr (ALIGN_EPI) { if (wr == 0) PG8_BAR; }
        E(acc, cur, wr, wc, fr, fq);
        if (!has_next) break;
#pragma unroll
        for (int a = 0; a < 2; ++a)
#pragma unroll
            for (int b = 0; b < 2; ++b)
#pragma unroll
                for (int m = 0; m < 4; ++m)
#pragma unroll
                    for (int n = 0; n < 2; ++n) acc[a][b][m][n] = (f32x4){0.f, 0.f, 0.f, 0.f};
        cur = nxt; cA = nA; cB = nB; ++ui;
        if constexpr (ALIGN_EPI) { if (wr == 1) PG8_BAR; }
    }
    PG8_WAIT_V(0);
    if constexpr (!ALIGN_EPI) { if (wr == 0) PG8_BAR; }
    PG8_BAR;
#undef PG8_SA
#undef PG8_SB
#undef PG8_STAGE
#undef PG8_LDA
#undef PG8_LDB
#undef PG8_MMA
#undef PG8_WAIT_V
#undef PG8_WAIT_L
#undef PG8_BAR
#undef PG8_SCHED
}
}
#include <hip/hip_bf16.h>
#include <cmath>
namespace att {
using bf16 = __hip_bfloat16;
constexpr int   D = 128, NW = 8, QBLK = 32, KVBLK = 64;
constexpr float SCALE = 0.088388347648318440f;
constexpr float THR = 8.f;
constexpr int SDEPTH = 2;
constexpr int LDQ = 6144, LDK = 6144, LDO = 4096;
constexpr size_t SHM_V = KVBLK * D * 2, SHM_K = KVBLK * D * 2, SHM_ATTN = 2 * SHM_V + 2 * SHM_K + NW * 64 * 4;
using bf16x8 = __attribute__((ext_vector_type(8))) short;
using s16x4  = __attribute__((ext_vector_type(4))) short;
using f32x16 = __attribute__((ext_vector_type(16))) float;
using f32x8  = __attribute__((ext_vector_type(8))) float;
using u32x4  = __attribute__((ext_vector_type(4))) unsigned;
#define KSWZ(row, colB) ((row) * 256 + ((colB) ^ (((row) & 7) << 4)))
#define SBAR() __builtin_amdgcn_sched_barrier(0)
__device__ __forceinline__ int crow(int r, int hi) { return (r & 3) + 8 * (r >> 2) + 4 * hi; }
__device__ __forceinline__ unsigned cvtpk(float lo, float hi) {
  unsigned r; asm volatile("v_cvt_pk_bf16_f32 %0, %1, %2" : "=v"(r) : "v"(lo), "v"(hi)); return r;
}
template <typename TIn> struct Stage;
template <> struct Stage<bf16>  { using T = bf16x8;
  __device__ static __forceinline__ T ld8(const bf16* p) { return *reinterpret_cast<const bf16x8*>(p); }
  __device__ static __forceinline__ bf16x8 tobf(T x) { return x; } };
template <> struct Stage<float> { using T = f32x8;
  __device__ static __forceinline__ T ld8(const float* p) { return *reinterpret_cast<const f32x8*>(p); }
  __device__ static __forceinline__ bf16x8 tobf(T x) {
    u32x4 w = {cvtpk(x[0], x[1]), cvtpk(x[2], x[3]), cvtpk(x[4], x[5]), cvtpk(x[6], x[7])}; return *reinterpret_cast<bf16x8*>(&w); } };

__device__ __forceinline__ void partialSM(f32x16& p0, f32x16& p1, float& m_reg, float& mn, float& alpha) {
  constexpr float C = SCALE * 1.4426950408889634f;
  float pmax = p0[0]; for (int r = 1; r < 16; ++r) pmax = fmaxf(pmax, p0[r]); for (int r = 0; r < 16; ++r) pmax = fmaxf(pmax, p1[r]);
  { auto rr = __builtin_amdgcn_permlane32_swap(__float_as_uint(pmax), __float_as_uint(pmax), false, false);
    pmax = fmaxf(__uint_as_float(rr[0]), __uint_as_float(rr[1])); }
  if (__builtin_expect(__all(pmax - m_reg <= THR / SCALE), 1)) { mn = m_reg; alpha = 1.f; }
  else { mn = fmaxf(m_reg, pmax); alpha = __builtin_amdgcn_exp2f((m_reg - mn) * C); m_reg = mn; }
  float mnC = -mn * C;
  for (int r = 0; r < 16; ++r) p0[r] = fmaf(p0[r], C, mnC); for (int r = 0; r < 16; ++r) p1[r] = fmaf(p1[r], C, mnC);
  for (int r = 0; r < 16; ++r) p0[r] = __builtin_amdgcn_exp2f(p0[r]);
}
__device__ __forceinline__ void finishSM(f32x16& p0, f32x16& p1, float alpha, float& l_reg, bf16x8& pa0, bf16x8& pa1, bf16x8& pa2, bf16x8& pa3) {
  for (int r = 0; r < 16; ++r) p1[r] = __builtin_amdgcn_exp2f(p1[r]);
  float ps = 0; for (int r = 0; r < 16; ++r) ps += p0[r]; for (int r = 0; r < 16; ++r) ps += p1[r];
  { auto rr = __builtin_amdgcn_permlane32_swap(__float_as_uint(ps), __float_as_uint(ps), false, false);
    ps = __uint_as_float(rr[0]) + __uint_as_float(rr[1]); }
  l_reg = l_reg * alpha + ps;
#define PK4(P, BASE, OUT) do { unsigned a0 = cvtpk(P[BASE + 0], P[BASE + 1]), a1 = cvtpk(P[BASE + 2], P[BASE + 3]);   \
    unsigned b0 = cvtpk(P[BASE + 4], P[BASE + 5]), b1 = cvtpk(P[BASE + 6], P[BASE + 7]);                              \
    auto r0 = __builtin_amdgcn_permlane32_swap(a0, b0, false, false); auto r1 = __builtin_amdgcn_permlane32_swap(a1, b1, false, false); \
    u32x4 w = {r0[0], r1[0], r0[1], r1[1]}; OUT = *reinterpret_cast<bf16x8*>(&w); } while (0)
  PK4(p0, 0, pa0); PK4(p0, 8, pa1); PK4(p1, 0, pa2); PK4(p1, 8, pa3);
#undef PK4
}
__device__ __forceinline__ void qkt(f32x16& p0, f32x16& p1, const bf16* Ks, const bf16x8* qr, int r32, int hi) {
  p0 = f32x16{}; p1 = f32x16{};
  for (int d0 = 0; d0 < 8; ++d0) { int cb = (d0 * 16 + hi * 8) * 2;
    bf16x8 b0 = *reinterpret_cast<const bf16x8*>((const char*)Ks + KSWZ(r32, cb));
    bf16x8 b1 = *reinterpret_cast<const bf16x8*>((const char*)Ks + KSWZ(32 + r32, cb));
    p0 = __builtin_amdgcn_mfma_f32_32x32x16_bf16(b0, qr[d0], p0, 0, 0, 0);
    p1 = __builtin_amdgcn_mfma_f32_32x32x16_bf16(b1, qr[d0], p1, 0, 0, 0); }
}
__device__ __forceinline__ int v_st(int k, int c) { const int kk = (k & ~0xC) | ((k & 4) << 1) | ((k & 8) >> 1); return ((kk >> 3) * 4 + (c >> 5)) * 512 + ((kk & 7) * 32 + (c & 31)) * 2; }
__device__ __forceinline__ int v_rd_base(int lane) { return ((lane & 3) << 3) | (((lane >> 2) & 3) << 6) | (((lane >> 4) & 1) << 5) | (((lane >> 5) & 1) << 8); }
constexpr int v_rd_off(int d0, int ks, int half) { return d0 * 512 + ks * 4096 + half * 2048; }
template <int OFF> __device__ __forceinline__ s16x4 tr_read(int vb) {
  s16x4 r; asm volatile("ds_read_b64_tr_b16 %0, %1 offset:%2" : "=&v"(r) : "v"(vb), "i"(OFF) : "memory"); return r;
}
template <int D0> __device__ __forceinline__ void pv_one(f32x16& od, int vb, bf16x8 pa0, bf16x8 pa1, bf16x8 pa2, bf16x8 pa3) {
  const s16x4 l0 = tr_read<v_rd_off(D0, 0, 0)>(vb), h0 = tr_read<v_rd_off(D0, 0, 1)>(vb), l1 = tr_read<v_rd_off(D0, 1, 0)>(vb), h1 = tr_read<v_rd_off(D0, 1, 1)>(vb);
  const s16x4 l2 = tr_read<v_rd_off(D0, 2, 0)>(vb), h2 = tr_read<v_rd_off(D0, 2, 1)>(vb), l3 = tr_read<v_rd_off(D0, 3, 0)>(vb), h3 = tr_read<v_rd_off(D0, 3, 1)>(vb);
  asm volatile("s_waitcnt lgkmcnt(0)" ::: "memory"); SBAR();
#define PK(L, H) (bf16x8){L[0], L[1], L[2], L[3], H[0], H[1], H[2], H[3]}
  od = __builtin_amdgcn_mfma_f32_32x32x16_bf16(pa0, PK(l0, h0), od, 0, 0, 0);
  od = __builtin_amdgcn_mfma_f32_32x32x16_bf16(pa1, PK(l1, h1), od, 0, 0, 0);
  od = __builtin_amdgcn_mfma_f32_32x32x16_bf16(pa2, PK(l2, h2), od, 0, 0, 0);
  od = __builtin_amdgcn_mfma_f32_32x32x16_bf16(pa3, PK(l3, h3), od, 0, 0, 0);
#undef PK
}
__device__ __forceinline__ void pv_d0(f32x16* o, int vb, bf16x8 pa0, bf16x8 pa1, bf16x8 pa2, bf16x8 pa3) {
  pv_one<0>(o[0], vb, pa0, pa1, pa2, pa3); pv_one<1>(o[1], vb, pa0, pa1, pa2, pa3); pv_one<2>(o[2], vb, pa0, pa1, pa2, pa3); pv_one<3>(o[3], vb, pa0, pa1, pa2, pa3);
}

template <typename TQ>
__device__ __forceinline__ void attn_dense_body(const TQ* __restrict__ Qb, const bf16* __restrict__ Kh, const bf16* __restrict__ Vh,
                                                unsigned short* __restrict__ Ob, int seq, char* lds) {
  using St = Stage<bf16>; using SQ = Stage<TQ>;
  int tid_ = threadIdx.x; asm volatile("" : "+v"(tid_)); const int tid = tid_, wid = tid >> 6, lane = tid & 63, r32 = lane & 31, hi = lane >> 5;
  bf16* V_lds = (bf16*)lds; bf16* K_lds = (bf16*)(lds + 2 * SHM_V);
  float* ws = (float*)(lds + 2 * SHM_V + 2 * SHM_K) + wid * 64; float* li_l = ws; float* al_l = ws + 32;
  float m_reg = -1e30f, l_reg = 0; f32x16 o[4] = {}; bf16x8 qr[8];
  const TQ* Qw = Qb + (long)(wid * QBLK + r32) * LDQ + hi * 8;
#pragma unroll
  for (int d0 = 0; d0 < 8; ++d0) qr[d0] = SQ::tobf(SQ::ld8(Qw + d0 * 16));
  const int sr = tid >> 4, sc = (tid & 15) * 8, vst0 = v_st(sr, sc), vst1 = v_st(32 + sr, sc);
  const int vb0 = (int)(uintptr_t)V_lds + v_rd_base(lane);
  struct { typename St::T vs0, vs1, ks0, ks1; } sr_[SDEPTH];
#define SLOAD(i, k0) do { sr_[i].vs0 = St::ld8(&Vh[(long)((k0) + sr) * LDK + sc]); sr_[i].vs1 = St::ld8(&Vh[(long)((k0) + 32 + sr) * LDK + sc]); \
    sr_[i].ks0 = St::ld8(&Kh[(long)((k0) + sr) * LDK + sc]); sr_[i].ks1 = St::ld8(&Kh[(long)((k0) + 32 + sr) * LDK + sc]); } while (0)
#define SWRITE(b, i) do { *(bf16x8*)((char*)V_lds + (b) * SHM_V + vst0) = St::tobf(sr_[i].vs0);          \
    *(bf16x8*)((char*)V_lds + (b) * SHM_V + vst1) = St::tobf(sr_[i].vs1); int kc = sc * 2;               \
    *(bf16x8*)((char*)K_lds + (b) * SHM_K + KSWZ(sr, kc)) = St::tobf(sr_[i].ks0);                       \
    *(bf16x8*)((char*)K_lds + (b) * SHM_K + KSWZ(32 + sr, kc)) = St::tobf(sr_[i].ks1); } while (0)
#define SWAIT() do { if constexpr (SDEPTH == 2) asm volatile("s_waitcnt vmcnt(4)" ::: "memory"); else asm volatile("s_waitcnt vmcnt(0)" ::: "memory"); } while (0)
#define RESC(a) do { if (__any((a) < 1.f)) { if (hi == 0) al_l[r32] = (a); asm volatile("s_waitcnt lgkmcnt(0)" ::: "memory"); \
    for (int d = 0; d < 4; ++d) for (int r = 0; r < 16; ++r) o[d][r] *= al_l[crow(r, hi)]; } } while (0)
  f32x16 pA0, pA1, pB0, pB1; float mnA, mnB, alA, alB; bf16x8 pa0, pa1, pa2, pa3; const int NT = seq / KVBLK;
  constexpr int SE = 0, SO = SDEPTH - 1;
  SLOAD(SE, 0); asm volatile("s_waitcnt vmcnt(0)" ::: "memory"); SWRITE(0, SE); __syncthreads();
  qkt(pA0, pA1, K_lds, qr, r32, hi); partialSM(pA0, pA1, m_reg, mnA, alA);
  SLOAD(SO, KVBLK); if constexpr (SDEPTH == 2) { if (2 < NT) SLOAD(SE, 2 * KVBLK); }
  SWAIT(); SWRITE(1, SO); __syncthreads();
  for (int j = 1; j + 1 < NT; j += 2) {
    SBAR(); qkt(pB0, pB1, (bf16*)((char*)K_lds + SHM_K), qr, r32, hi);
    finishSM(pA0, pA1, alA, l_reg, pa0, pa1, pa2, pa3); SBAR();
    SLOAD(SO, (j + SDEPTH) * KVBLK); SBAR();
    pv_d0(o, vb0, pa0, pa1, pa2, pa3); partialSM(pB0, pB1, m_reg, mnB, alB);
    __syncthreads(); SWAIT(); SWRITE(0, SE);
    RESC(alB); __syncthreads();
    SBAR(); qkt(pA0, pA1, K_lds, qr, r32, hi);
    finishSM(pB0, pB1, alB, l_reg, pa0, pa1, pa2, pa3); SBAR();
    if (SDEPTH == 1 || j + 3 < NT) SLOAD(SE, (j + 1 + SDEPTH) * KVBLK); SBAR();
    pv_d0(o, vb0 + (int)SHM_V, pa0, pa1, pa2, pa3); partialSM(pA0, pA1, m_reg, mnA, alA);
    __syncthreads(); SWAIT(); SWRITE(1, SO);
    RESC(alA); __syncthreads();
  }
  SBAR(); qkt(pB0, pB1, (bf16*)((char*)K_lds + SHM_K), qr, r32, hi);
  finishSM(pA0, pA1, alA, l_reg, pa0, pa1, pa2, pa3); SBAR();
  pv_d0(o, vb0, pa0, pa1, pa2, pa3); partialSM(pB0, pB1, m_reg, mnB, alB);
  __syncthreads(); RESC(alB);
  finishSM(pB0, pB1, alB, l_reg, pa0, pa1, pa2, pa3); SBAR();
  pv_d0(o, vb0 + (int)SHM_V, pa0, pa1, pa2, pa3);
  if (hi == 0) li_l[r32] = l_reg; asm volatile("s_waitcnt lgkmcnt(0)" ::: "memory");
  float rli[16];
#pragma unroll
  for (int r = 0; r < 16; ++r) rli[r] = __builtin_amdgcn_rcpf(li_l[crow(r, hi)]);
  unsigned short* Ow = Ob + (long)(wid * QBLK) * LDO;
#pragma unroll
  for (int r = 0; r < 16; ++r) { int orow = crow(r, hi);
    for (int d0 = 0; d0 < 4; ++d0) Ow[(long)orow * LDO + d0 * 32 + r32] = (unsigned short)(pg8::cvt_pk_bf16(o[d0][r] * rli[r], 0.f) & 0xffffu); }
#undef SLOAD
#undef SWRITE
#undef SWAIT
#undef RESC
}
}
constexpr int DM = 2048, NB = 4, SEQ = 2048, NCTX = 256, LTOK = 2304, NTOK = NB * LTOK  , NLAT = NB * SEQ  ;
constexpr int DFF = 5632, DFF2 = 2 * DFF;
constexpr int NLAYER = 4, NMOD = 6;
constexpr float DN_ALPHA = 1.6817928305074290f;
constexpr float LN_EPS = 1e-5f;
constexpr int NWAVES = 8;
#ifndef MK_N_LAUNCHES
#define MK_N_LAUNCHES 1
#endif

constexpr size_t MiB = 1u << 20;
constexpr size_t al256(size_t x) { return (x + 255) / 256 * 256; }
constexpr size_t WS_CTL = 0;
constexpr size_t WS_MOD = 1 * MiB;
constexpr size_t ZERO_BYTES = 2 * MiB;
constexpr size_t WS_ROPE = 2 * MiB;
constexpr size_t WS_LB = WS_ROPE + al256((size_t)LTOK * 64 * 2 * 4);
constexpr size_t WS_STAT = WS_LB + 64 * 1024;
constexpr size_t WS_ZS = WS_STAT + 80 * 1024;
constexpr size_t WS_W0 = 4 * MiB;
static_assert(WS_ZS + (size_t)NTOK * 4 <= WS_W0, "small tables fit below the weight copies");
constexpr size_t WS_WA = WS_W0;
constexpr size_t WS_WL2 = WS_WA + (size_t)6912 * 2048 * 2;
constexpr size_t WS_WO = WS_WL2 + (size_t)10240 * 256 * 2;
constexpr size_t WS_WQKV = WS_WO + (size_t)4 * 2048 * 2048 * 2;
constexpr size_t WS_WHG = WS_WQKV + (size_t)6144 * 2048 * 2;
constexpr size_t WS_WLR = WS_WHG + (size_t)10240 * 2048 * 2;
constexpr size_t WS_WGATE = WS_WLR + (size_t)4096 * 2048 * 2;
constexpr size_t WS_WUP = WS_WGATE + (size_t)32 * 256 * 256 * 2;
constexpr size_t WS_WDN = WS_WUP + (size_t)4 * DFF2 * 2048 * 2;
constexpr size_t WS_WEND = WS_WDN + (size_t)4 * 2048 * DFF * 2;
constexpr size_t WS_Z = al256(WS_WEND);
constexpr size_t WS_PRE = WS_Z + (size_t)NTOK * DM * 4;
constexpr size_t WS_H = WS_PRE + (size_t)NTOK * DM * 4;
constexpr size_t WS_OUTB = WS_H + (size_t)NTOK * DM * 2;
constexpr size_t WS_POOL = WS_OUTB + (size_t)NTOK * DM * 2;
constexpr size_t SLOT = (size_t)NTOK * DM * 2;
constexpr size_t WS_U = WS_POOL;
constexpr size_t WS_ACT = WS_U + (size_t)NTOK * DFF2 * 2;
constexpr size_t WS_UB = WS_U + (size_t)32 * MiB;
constexpr size_t WS_RKV = WS_POOL;
constexpr size_t L0_R = WS_RKV, L0_K = WS_RKV + SLOT, L0_DEC0 = WS_RKV + 2 * SLOT, L0_DEC1 = WS_RKV + 3 * SLOT, L0_IC0 = WS_RKV + 4 * SLOT, L0_IC1 = WS_RKV + 5 * SLOT, L0_V = WS_RKV + 6 * SLOT, L0_G = WS_RKV + 7 * SLOT;
constexpr size_t L0_YS = WS_RKV;
constexpr size_t L0_HID = WS_RKV + 8 * SLOT;
constexpr size_t L0_BONUS = L0_HID + (size_t)3 * NTOK * 256 * 2;
constexpr size_t L0_SCAL = L0_BONUS + (size_t)NTOK * 32 * 4;
constexpr size_t L0_XS = al256(L0_SCAL + (size_t)256 * LTOK * 2 * 4);
constexpr size_t L0_VEC = L0_XS;
constexpr size_t L0_END = L0_VEC + (size_t)256 * LTOK * 6 * 64 * 2;
constexpr size_t L1_QKV = WS_POOL;
constexpr size_t L1_O = L1_QKV + (size_t)NTOK * 6144 * 2;
constexpr size_t L2_HGO = WS_POOL;
constexpr size_t L2_OG = L2_HGO + (size_t)NTOK * 10240 * 2;
constexpr size_t L3_IN = WS_POOL;
constexpr size_t L3_XB = L3_IN + 2 * SLOT;
constexpr size_t L3_LOGA = L3_XB + SLOT;
constexpr size_t L3_UU = L3_LOGA + 2 * SLOT;
constexpr size_t L3_YS = L3_UU + 2 * SLOT;
constexpr size_t WS_END = L0_END;
static_assert(WS_ACT + (size_t)NTOK * DFF * 2 <= WS_END && L3_YS + 4 * SLOT <= WS_END && L2_OG + 4 * SLOT <= WS_END && L1_O + (size_t)NTOK * 4096 * 4 <= WS_END, "pool");
static_assert(WS_END <= (size_t)1536 * MiB, "d_ws map must fit 4 x the largest input");

constexpr int CW_BAR = 4096;
constexpr int RING_OFF = 0, RING_BYTES = 131072;
constexpr int LDSCTL_OFF = RING_BYTES, MISC_OFF = LDSCTL_OFF + 320;
constexpr int LDS_BYTES = 147456;

#define GAS __attribute__((address_space(1)))
#define LAS __attribute__((address_space(3)))
typedef unsigned short bf16;
typedef unsigned v4u __attribute__((ext_vector_type(4)));
typedef unsigned v2u __attribute__((ext_vector_type(2)));
typedef float f32x4 __attribute__((ext_vector_type(4)));
typedef float f32x2 __attribute__((ext_vector_type(2)));
typedef short bf16x8 __attribute__((ext_vector_type(8)));
typedef GAS unsigned gu32;
#define RLX_AGENT __ATOMIC_RELAXED, __HIP_MEMORY_SCOPE_AGENT
#define LDS_WAIT() asm volatile("s_waitcnt lgkmcnt(0)" ::: "memory")
#define VM_WAIT() asm volatile("s_waitcnt vmcnt(0)" ::: "memory")
#define LDS_BARRIER() do { asm volatile("s_waitcnt lgkmcnt(0)" ::: "memory"); __builtin_amdgcn_s_barrier(); asm volatile("" ::: "memory"); } while (0)
__device__ __forceinline__ unsigned pk2(float lo, float hi) { return pg8::cvt_pk_bf16(lo, hi); }
__device__ __forceinline__ float bflo(unsigned w) { return __uint_as_float(w << 16); }
__device__ __forceinline__ float bfhi(unsigned w) { return __uint_as_float(w & 0xffff0000u); }
__device__ __forceinline__ float bf2f(bf16 x) { return __uint_as_float(((unsigned)x) << 16); }
__device__ __forceinline__ bf16 f2bf(float f) { return (bf16)(pk2(f, 0.f) & 0xffffu); }
__device__ __forceinline__ int vzero() { int z; asm volatile("v_mov_b32 %0, 0" : "=v"(z)); return z; }
__device__ __forceinline__ float sigmoidf_(float x) { return __builtin_amdgcn_rcpf(1.f + __expf(-x)); }
__device__ __forceinline__ float siluf_(float x) { return x * sigmoidf_(x); }
__device__ __forceinline__ float tanhf_(float x) { const float e = __expf(2.f * x); return 1.f - 2.f * __builtin_amdgcn_rcpf(e + 1.f); }
__device__ __forceinline__ float gelu_tanh_(float x) { const float u = 0.7978845608028654f * (x + 0.044715f * x * x * x); return 0.5f * x * (1.f + tanhf_(u)); }

#define XB_TMO      128
#define XB_XCNT(j)  (256  + 64 * (j))
#define XB_XSUB(j)  (1280 + 64 * (j))
#define XB_XGEN(j)  (2304 + 64 * (j))
#define XB_TOP      3328
#define XB_TOPGEN   3392
#define XCD_BAR_WORDS 3456
#define XB_SPIN_CAP (1u << 18)
__device__ __forceinline__ unsigned xb_ld(unsigned* p)              { return __hip_atomic_load(p, __ATOMIC_RELAXED, __HIP_MEMORY_SCOPE_AGENT); }
__device__ __forceinline__ unsigned xb_add(unsigned* p, unsigned v) { return __hip_atomic_fetch_add(p, v, __ATOMIC_RELAXED, __HIP_MEMORY_SCOPE_AGENT); }
__device__ __forceinline__ unsigned xb_xcc_id() { return (unsigned)__builtin_amdgcn_s_getreg((3 << 11) | 20) & 0xFu; }
#define XB_SPIN(cond, bar) do { unsigned _sp = 0; while (cond) { __builtin_amdgcn_s_sleep(1); \
    if ((++_sp & 255u) == 0u) { if (xb_ld(&(bar)[XB_TMO])) break; if (_sp > XB_SPIN_CAP) { atomicAdd(&(bar)[XB_TMO], 1u); break; } } } } while (0)
struct XcdBarrier { unsigned* bar; unsigned x; volatile LAS unsigned* st; };
__device__ __forceinline__ XcdBarrier xcd_barrier_post(unsigned* bar, volatile LAS unsigned* st) {
    XcdBarrier b; b.bar = bar; b.x = xb_xcc_id(); b.st = st;
    if (threadIdx.x == 0) (void)xb_add(&bar[XB_XCNT(b.x)], 1u);
    return b;
}
__device__ __forceinline__ void xcd_barrier_complete(unsigned* bar, unsigned x, unsigned& nloc, unsigned& nx) {
    const unsigned G = gridDim.x * gridDim.y * gridDim.z;
    unsigned sum, cnt, mine, sp = 0u;
    for (;;) {
        sum = 0u; cnt = 0u; mine = 0u;
#pragma unroll
        for (unsigned j = 0; j < 16; ++j) { const unsigned c = xb_ld(&bar[XB_XCNT(j)]); sum += c; cnt += (c > 0u) ? 1u : 0u; mine = (j == x) ? c : mine; }
        if (sum == G) break;
        __builtin_amdgcn_s_sleep(1);
        if ((++sp & 255u) == 0u) { if (xb_ld(&bar[XB_TMO])) break; if (sp > XB_SPIN_CAP) { atomicAdd(&bar[XB_TMO], 1u); break; } }
    }
    nloc = mine > 0u ? mine : 1u; nx = cnt > 0u ? cnt : 1u;
}
__device__ __forceinline__ void xcd_barrier(const XcdBarrier& b) {
    asm volatile("s_waitcnt vmcnt(0)" ::: "memory");
    __syncthreads();
    if (threadIdx.x == 0) {
        unsigned* bar = b.bar;
        __builtin_amdgcn_s_waitcnt(0);
        unsigned nloc = b.st[0], nx = b.st[1];
        if (nloc == 0u) { xcd_barrier_complete(bar, b.x, nloc, nx); b.st[0] = nloc; b.st[1] = nx; }
        const unsigned old = xb_add(&bar[XB_XSUB(b.x)], 1u);
        const unsigned gen = old / nloc;
        if (old + 1u == (gen + 1u) * nloc) {
            __builtin_amdgcn_fence(__ATOMIC_RELEASE, "agent");
            asm volatile("s_waitcnt vmcnt(0)" ::: "memory");
            const unsigned og = xb_add(&bar[XB_TOP], 1u);
            const unsigned tg = og / nx;
            if (og + 1u == (tg + 1u) * nx) xb_add(&bar[XB_TOPGEN], 1u);
            else XB_SPIN(xb_ld(&bar[XB_TOPGEN]) == tg, bar);
            __builtin_amdgcn_fence(__ATOMIC_ACQUIRE, "agent");
            xb_add(&bar[XB_XGEN(b.x)], 1u);
            asm volatile("s_waitcnt vmcnt(0)" ::: "memory");
        } else {
            XB_SPIN(xb_ld(&bar[XB_XGEN(b.x)]) == gen, bar);
            __builtin_amdgcn_fence(__ATOMIC_ACQUIRE, "agent");
            asm volatile("s_waitcnt vmcnt(0)" ::: "memory");
        }
    }
    __syncthreads();
}

#define CAS __attribute__((address_space(4)))
__device__ __forceinline__ const void* ldarg(int k) { const CAS char* ka = (const CAS char*)__builtin_amdgcn_kernarg_segment_ptr(); return *(const void* const volatile CAS*)(ka + 8 * k); }
#define INP(k) ((const float*)ldarg(k))
__device__ __forceinline__ float wave_max(float v) {
#pragma unroll
    for (int o = 1; o < 64; o <<= 1) v = fmaxf(v, __shfl_xor(v, o));
    return v;
}
__device__ __forceinline__ float wave_sum(float v) {
#pragma unroll
    for (int o = 1; o < 64; o <<= 1) v += __shfl_xor(v, o);
    return v;
}
struct Frame {
    LAS unsigned char* lds;
    volatile LAS unsigned* MISC;
    gu32* ctl;
    int tid, lane, wave;
    int vcu, G, bx;
    unsigned char* ws;
};
#define GW(F) ((F).vcu * NWAVES + (F).wave)
#define NGW(F) ((F).G * NWAVES)
struct ItemIter { int base, step, lim; };
__device__ __forceinline__ ItemIter item_iter(const Frame& F, int N) {
    ItemIter I;
    I.base = GW(F); I.step = NGW(F); I.lim = N;
    return I;
}

__device__ __forceinline__ void transpose_item(const float* W, int ldw, int Ksrc, int koff, int dstK, int N, bf16* WT, int row_off, LAS float* scr, int item, int lane) {
    const int nblk = N / 32, kb = item / nblk, nb = item % nblk, k0 = 64 * kb, n0 = 32 * nb;
    float tv[32];
#pragma unroll
    for (int i = 0; i < 32; ++i) { const int kk = 2 * i + (lane >> 5); const int ks = k0 + kk - koff;
        tv[i] = 0.f; if (ks >= 0 && ks < Ksrc) tv[i] = W[(size_t)ks * ldw + n0 + (lane & 31)]; }
#pragma unroll
    for (int i = 0; i < 32; ++i) scr[(2 * i + (lane >> 5)) * 33 + (lane & 31)] = tv[i];
    LDS_WAIT(); asm volatile("" ::: "memory");
    const int c = lane & 7;
#pragma unroll
    for (int j = 0; j < 4; ++j) { const int n = (lane >> 3) + 8 * j; const LAS float* s = scr + (8 * c) * 33 + n;
        v4u o; o.x = pk2(s[0 * 33], s[1 * 33]); o.y = pk2(s[2 * 33], s[3 * 33]); o.z = pk2(s[4 * 33], s[5 * 33]); o.w = pk2(s[6 * 33], s[7 * 33]);
        *(GAS v4u*)(WT + (size_t)(row_off + n0 + n) * dstK + k0 + 8 * c) = o; }
    LDS_WAIT(); asm volatile("" ::: "memory");
}
#define TR_RUN(W, ldw, Ksrc, koff, dstK, N, WT, row_off) do { const int _n = ((dstK) / 64) * ((N) / 32); \
    for (int _it = (gw + NGWv - (int)(tr_base % NGWv)) % NGWv; _it < _n; _it += NGWv) transpose_item((W), (ldw), (Ksrc), (koff), (dstK), (N), (WT), (row_off), scr, _it, F.lane); \
    tr_base += _n; } while (0)

__device__ __forceinline__ void p0_prologue(Frame& F) {
    LAS float* scr = (LAS float*)(F.lds + RING_OFF + F.wave * 16384);
    const int gw = GW(F), NGWv = NGW(F);
    unsigned char* ws = F.ws;
    long tr_base = 0;
#if defined(PROBE_MASK) && ((PROBE_MASK >> 10) & 1)
    for (int prep_ = 0; prep_ < 2; ++prep_) {
#else
    {
#endif
    bf16* WA = (bf16*)(ws + WS_WA);
    for (int n = 0; n < 3; ++n) TR_RUN(INP(13) + (size_t)n * DM * DM, DM, DM, 0, DM, DM, WA, n * DM);
    for (int d = 0; d < 2; ++d) TR_RUN(INP(15) + (size_t)d * DM * 96, 96, DM, 0, DM, 96, WA, 6144 + d * 96);
    for (int d = 0; d < 2; ++d) TR_RUN(INP(18) + (size_t)d * DM * 64, 64, DM, 0, DM, 64, WA, 6144 + 256 + d * 64);
    TR_RUN(INP(20), 256, DM, 0, DM, 256, WA, 6144 + 512);
    {
        const size_t nvec = (size_t)(64 + 128) * DM / 8;
        for (size_t i = (size_t)gw * 64 + F.lane; i < nvec; i += (size_t)NGWv * 64) {
            const size_t e = i * 8; const size_t row = e / DM, col = e % DM; const size_t r = row < 64 ? 6144 + 192 + row : 6144 + 256 + 128 + (row - 64);
            *(GAS v4u*)(WA + r * DM + col) = (v4u){0u, 0u, 0u, 0u}; }
    }
    bf16* WL2 = (bf16*)(ws + WS_WL2);
    for (int d = 0; d < 2; ++d) TR_RUN(INP(16) + (size_t)d * 96 * DM, DM, 96, d * 96, 256, DM, WL2, d * DM);
    for (int d = 0; d < 2; ++d) TR_RUN(INP(19) + (size_t)d * 64 * DM, DM, 64, d * 64, 256, DM, WL2, (2 + d) * DM);
    TR_RUN(INP(21), DM, 256, 0, 256, DM, WL2, 4 * DM);
    bf16* WO = (bf16*)(ws + WS_WO);
    TR_RUN(INP(27), DM, DM, 0, DM, DM, WO, 0); TR_RUN(INP(31), DM, DM, 0, DM, DM, WO, DM); TR_RUN(INP(35), DM, DM, 0, DM, DM, WO, 2 * DM); TR_RUN(INP(42), DM, DM, 0, DM, DM, WO, 3 * DM);
    {
        bf16* WQ = (bf16*)(ws + WS_WQKV); const float* Wsrc = INP(28);
        const int nkb = DM / 64, nit = nkb * 128;
        for (int it = (gw + NGWv - (int)(tr_base % NGWv)) % NGWv; it < nit; it += NGWv) { const int kb = it / 128, cb = it % 128; const int tile = cb >> 3, hl = (cb & 7) >> 2, qtr = cb & 3;
            const int db = tile * 8 + (qtr & 1) * 4 + hl * 2 + (qtr >> 1);
            transpose_item(Wsrc + cb * 32, 3 * DM, DM, 0, DM, 32, WQ, db * 32, scr, kb, F.lane); }
        tr_base += nit;
        TR_RUN(Wsrc + 2 * DM, 3 * DM, DM, 0, DM, DM, WQ, 2 * DM);
    }
    TR_RUN(INP(32), 5 * DM, DM, 0, DM, 5 * DM, (bf16*)(ws + WS_WHG), 0);
    TR_RUN(INP(36), 2 * DM, DM, 0, DM, 2 * DM, (bf16*)(ws + WS_WLR), 0);
    {
        bf16* WG = (bf16*)(ws + WS_WGATE);
        for (int q = 0; q < 64; ++q) { const int d = q >> 5, g = (q >> 4) & 1, n = (q >> 1) & 7, hf = q & 1;
            TR_RUN(INP(39) + ((size_t)((d * 2 + g) * 8 + n) * 256) * 256 + hf * 128, 256, 256, 0, 256, 128, WG, ((d * 8 + n) * 2 + hf) * 256 + g * 128); }
    }
    {
        const int nit = (DM / 64) * 352;
        for (int l = 0; l < NLAYER; ++l) { const float* Wsrc = INP(8) + (size_t)l * DM * DFF2;
            for (int it = (gw + NGWv - (int)(tr_base % NGWv)) % NGWv; it < nit; it += NGWv) { const int kb = it / 352, cb = it % 352; const int bj = cb / 176, rem = cb % 176;
                const int db = (rem >> 2) * 8 + bj * 4 + (rem & 3);
                transpose_item(Wsrc + cb * 32, DFF2, DM, 0, DM, 32, (bf16*)(ws + WS_WUP), l * DFF2 + db * 32, scr, kb, F.lane); }
            tr_base += nit; }
    }
    for (int l = 0; l < NLAYER; ++l) TR_RUN(INP(11) + (size_t)l * DFF * DM, DM, DFF, 0, DFF, DM, (bf16*)(ws + WS_WDN), l * DM);
    }
    { float* RT = (float*)(ws + WS_ROPE);
      for (int i = gw * 64 + F.lane; i < LTOK * 64; i += NGWv * 64) { const int t = i >> 6, f = i & 63; float ang = 0.f;
          if (t >= NCTX) { const int p = t - NCTX; const float pos = (float)((f < 32) ? (p >> 6) : (p & 63)); const float invf = powf(10000.0f, -(float)(f & 31) / 32.0f); ang = pos * invf; }
          RT[2 * i] = cosf(ang); RT[2 * i + 1] = sinf(ang); } }
    { float* LB = (float*)(ws + WS_LB); const float* lower = INP(33);
      for (int i = gw * 64 + F.lane; i < 2 * DM; i += NGWv * 64) { const int d = i / DM, c = i % DM; float v[4], mx = -1e30f;
          for (int l = 0; l < 4; ++l) { v[l] = lower[(size_t)(d * 4 + l) * DM + c]; mx = fmaxf(mx, v[l]); }
          float s = 0.f; for (int l = 0; l < 4; ++l) { v[l] = expf(v[l] - mx); s += v[l]; }
          LB[i] = (v[1] + v[2]) / s; } }
    {
        __syncthreads();
        LAS float* cv = (LAS float*)(F.lds + RING_OFF);
        LAS float* red = (LAS float*)(F.lds + RING_OFF + 5 * DM * 4);
        { f32x4 xv[5];
#pragma unroll
          for (int r = 0; r < 5; ++r) xv[r] = ((const GAS f32x4*)((r < 4) ? INP(1) + r * DM : INP(3)))[F.tid];
#pragma unroll
          for (int r = 0; r < 5; ++r) { f32x4 o; o.x = xv[r].x / (1.f + expf(-xv[r].x)); o.y = xv[r].y / (1.f + expf(-xv[r].y)); o.z = xv[r].z / (1.f + expf(-xv[r].z)); o.w = xv[r].w / (1.f + expf(-xv[r].w));
              ((LAS f32x4*)cv)[r * (DM / 4) + F.tid] = o; } }
        __syncthreads();
        float* MOD = (float*)(ws + WS_MOD);
        const int NIT = NLAYER * 96 * 2;
        for (int it = F.vcu; it < NIT; it += F.G) {
            const int l = it / 192, rem = it % 192, cb = rem >> 1, kh = rem & 1;
            const float* Wl = INP(4) + (size_t)l * DM * (NMOD * DM) + cb * 128 + 2 * F.lane;
            const int kbeg = kh * 1024 + F.wave * 128;
            float a0[5], a1[5];
#pragma unroll
            for (int r = 0; r < 5; ++r) { a0[r] = 0.f; a1[r] = 0.f; }
#pragma unroll 4
            for (int kk = 0; kk < 128; ++kk) { const int k = kbeg + kk; const f32x2 w = *(const f32x2*)(Wl + (size_t)k * (NMOD * DM));
#pragma unroll
                for (int r = 0; r < 5; ++r) { const float c = cv[r * DM + k]; a0[r] += c * w.x; a1[r] += c * w.y; } }
#pragma unroll
            for (int r = 0; r < 5; ++r) { red[(F.wave * 5 + r) * 128 + 2 * F.lane] = a0[r]; red[(F.wave * 5 + r) * 128 + 2 * F.lane + 1] = a1[r]; }
            __syncthreads();
            for (int o = F.tid; o < 5 * 128; o += NWAVES * 64) { const int r = o / 128, c = o % 128; float s = 0.f;
#pragma unroll
                for (int w = 0; w < 8; ++w) s += red[(w * 5 + r) * 128 + c];
                const int n = cb * 128 + c; if (kh == 0) s += INP(5)[(size_t)l * NMOD * DM + n];
                atomicAdd(MOD + ((size_t)(l * 5 + r) * NMOD * DM + n), s); }
            __syncthreads();
        }
    }
}

__device__ __forceinline__ const float* mod_ptr(const unsigned char* ws, int layer, int bsel, int j) { return (const float*)(ws + WS_MOD) + ((size_t)((layer * 5 + bsel) * NMOD + j)) * DM; }

template <int MODE, bool LAT, int NM, int NN, int LDA, int LDB> struct Sched {
    pg8::TileOrder<NM, NN> T;
    static constexpr unsigned a_tile = 256u * LDA * 2u, b_tile = 256u * LDB * 2u;
    __device__ void init(int G, int c) { T.init(G, c); }
    __device__ __forceinline__ bool next(int i, pg8::Unit& u) const {
        int pm, pn; if (!T.tile(i, pm, pn)) return false;
        if (LAT) pm = (pm >> 3) * 9 + 1 + (pm & 7);
        u.pm = pm; u.pn = pn; u.half = -1;
        if (MODE == 0) { u.aoff = (unsigned)pm * a_tile; u.boff = (unsigned)pn * b_tile; }
        else if (MODE == 1) { const int grp = pn < 24 ? (pn >> 3) : (pn - 21); u.aoff = ((unsigned)grp * 36u + pm) * a_tile; u.boff = (unsigned)pn * b_tile; }
        else if (MODE == 2) { const int g = pn >> 3, hg = (g == 4) ? 2 : (g >> 1); u.aoff = ((unsigned)hg * 36u + pm) * a_tile; u.boff = (unsigned)pn * b_tile; }
        else { const int n = (pn >> 1) & 7; u.aoff = (unsigned)pm * a_tile + (unsigned)n * 512u; u.boff = (unsigned)pn * b_tile; }
        return true;
    }
};
template <int SPLIT, int KSUB, int LDA, int LDB> struct SchedSplit {
    int G, c;
    __device__ void init(int G_, int c_) { G = G_; c = c_; }
    __device__ __forceinline__ bool next(int i, pg8::Unit& u) const {
        const int L = i * G + c; if (L >= 32 * SPLIT) return false;
        const int tile = L / SPLIT, ks = L % SPLIT; const int pm = 32 + (tile & 3), pn = tile >> 2;
        u.pm = pm; u.pn = pn | (ks << 8); u.half = -1;
        u.aoff = (unsigned)pm * (256u * LDA * 2u) + (unsigned)ks * (KSUB * 2u); u.boff = (unsigned)pn * (256u * LDB * 2u) + (unsigned)ks * (KSUB * 2u);
        return true;
    }
};

template <int SPLIT, int KSUB, int LDA, int LDB> struct SchedSplitHalf {
    int G, c;
    __device__ void init(int G_, int c_) { G = G_; c = c_; }
    __device__ __forceinline__ bool next(int i, pg8::Unit& u) const {
        const int L = i * G + c; if (L >= 64 * SPLIT) return false;
        const int h = L & 1, Lq = L >> 1; const int tile = Lq / SPLIT, ks = Lq % SPLIT; const int pm = 32 + (tile & 3), pn = tile >> 2;
        u.pm = pm; u.pn = pn | (ks << 8); u.half = h;
        u.aoff = (unsigned)pm * (256u * LDA * 2u) + (unsigned)h * (128u * LDA * 2u) + (unsigned)ks * (KSUB * 2u); u.boff = (unsigned)pn * (256u * LDB * 2u) + (unsigned)ks * (KSUB * 2u);
        return true;
    }
};
template <bool LAT, int NM, int NN, int LMAX, int LDA, int LDB> struct SchedHead {
    int G, c;
    __device__ void init(int G_, int c_) { G = G_; c = c_; }
    __device__ __forceinline__ bool next(int i, pg8::Unit& u) const {
        const int L = i * G + c; if (L >= LMAX) return false;
        int pm, pn; pg8::TileOrder<NM, NN>::tileL(L, pm, pn);
        if (LAT) pm = (pm >> 3) * 9 + 1 + (pm & 7);
        u.pm = pm; u.pn = pn; u.half = -1; u.aoff = (unsigned)pm * (256u * LDA * 2u); u.boff = (unsigned)pn * (256u * LDB * 2u);
        return true;
    }
};
template <bool LAT, int NM, int NN, int LMAX, int NT, int LDA, int LDB> struct SchedHT {
    int G, c;
    __device__ void init(int G_, int c_) { G = G_; c = c_; }
    __device__ __forceinline__ bool next(int i, pg8::Unit& u) const {
        const int L = i * G + c; if (L >= LMAX + 2 * NT) return false;
        const bool whole = L < LMAX; const int Lp = L - LMAX; const int h = whole ? 0 : (Lp & 1);
        int pm, pn; pg8::TileOrder<NM, NN>::tileL(whole ? L : LMAX + (Lp >> 1), pm, pn);
        if (LAT) pm = (pm >> 3) * 9 + 1 + (pm & 7);
        u.pm = pm; u.pn = pn; u.half = whole ? -1 : h; u.aoff = (unsigned)pm * (256u * LDA * 2u) + (unsigned)h * (128u * LDA * 2u); u.boff = (unsigned)pn * (256u * LDB * 2u);
        return true;
    }
};
template <bool LAT, int NM, int NN, int L0, int NT, int LDA, int LDB> struct SchedTailHalf {
    int G, c;
    __device__ void init(int G_, int c_) { G = G_; c = c_; }
    __device__ __forceinline__ bool next(int i, pg8::Unit& u) const {
        const int Lp = i * G + c; if (Lp >= 2 * NT) return false;
        const int tu = Lp >> 1, h = Lp & 1;
        int pm, pn; pg8::TileOrder<NM, NN>::tileL(L0 + tu, pm, pn);
        if (LAT) pm = (pm >> 3) * 9 + 1 + (pm & 7);
        u.pm = pm; u.pn = pn; u.half = h; u.aoff = (unsigned)pm * (256u * LDA * 2u) + (unsigned)h * (128u * LDA * 2u); u.boff = (unsigned)pn * (256u * LDB * 2u);
        return true;
    }
};

template <int kind> struct EpiBf16Route {
    static constexpr bool PERM = true; static constexpr bool PERMA = false;
    bf16* O; int ldc;
    unsigned char* ws; const float* p0; const float* p1;
    static __device__ __forceinline__ float act(int mode, float x, float p) {
        if (kind == 0 || kind == 5) return x;
        if (kind == 1) { const float e = __expf(mode == 1 ? 2.f * x : -x); const float r = __builtin_amdgcn_rcpf(e + 1.f); return mode == 0 ? x : (mode == 1 ? 1.f - 2.f * r : r); }
        if (kind == 2) { const float s = sigmoidf_(x + p); const float dcy = __expf(-0.606531f * s); return mode == 4 ? dcy : (mode == 2 ? s : x); }
        if (kind == 3) { const float s = sigmoidf_(mode == 6 ? -x : x); return mode == 0 ? x : (mode == 3 ? x * s : (1.f - p) * s); }
        return mode == 5 ? gelu_tanh_(x) : x;
    }
    __device__ __forceinline__ void operator()(const pg8::f32x4 (&acc)[2][2][4][2], const pg8::Unit& u, int wr, int wc, int fr, int fq) const {
        bf16* base = O; int ld = ldc, colt = u.pn * 256, mode = 0; const float* par = nullptr;
        if (kind == 1) { if (u.pn < 24) { const int g = u.pn >> 3; base = (bf16*)(ws + (g == 0 ? L0_R : (g == 1 ? L0_K : L0_V))); ld = DM; colt = (u.pn & 7) * 256; }
                         else { const int hg = u.pn - 24; base = (bf16*)(ws + L0_HID) + (size_t)hg * NTOK * 256; ld = 256; colt = 0; mode = hg == 0 ? 1 : (hg == 1 ? 0 : 2); } }
        else if (kind == 2) { const int g = u.pn >> 3; colt = (u.pn & 7) * 256; ld = DM;
                         base = (bf16*)(ws + (g == 0 ? L0_DEC0 : g == 1 ? L0_DEC1 : g == 2 ? L0_IC0 : g == 3 ? L0_IC1 : L0_G));
                         if (g < 2) { mode = 4; par = p0 + g * DM + colt; } else if (g < 4) { mode = 2; par = p1 + (g - 2) * DM + colt; } }
        else if (kind == 3) { const int g = u.pn >> 3; if (g == 0 || g == 2) mode = 3; else if (g >= 3) { mode = 6; par = p0 + (g - 3) * DM + (u.pn & 7) * 256; } }
        else if (kind == 4) { if (u.pn < 8) mode = 5; }
        const int row0 = u.pm * 256 + wr * 64 + fr, col0 = colt + wc * 32 + 8 * fq, pc0 = wc * 32 + 8 * fq;
        const int ai0 = u.half < 0 ? 0 : u.half, nai = u.half < 0 ? 2 : 1;
        if (kind == 5 && u.pn < 16) {
            const int x = wc * 32 + 8 * fq, hl = x >> 6, y = x & 63; const int ncol = u.pn * 256 + hl * 128 + (y < 32 ? y : y + 32);
            const float* RT = (const float*)(ws + WS_ROPE);
#pragma unroll
            for (int ai = 0; ai < 2; ++ai) if (ai < nai)
#pragma unroll
                for (int m = 0; m < 4; ++m) { const int row = row0 + (ai0 + ai) * 128 + m * 16; const int t = row % LTOK;
                    const GAS pg8::f32x4* cs = (const GAS pg8::f32x4*)(RT + ((size_t)t * 64 + y) * 2);
                    const pg8::f32x4 c0 = cs[0], c1 = cs[1], c2 = cs[2], c3 = cs[3];
                    const pg8::f32x4 a0 = acc[ai][0][m][0], a1 = acc[ai][0][m][1], b0 = acc[ai][1][m][0], b1 = acc[ai][1][m][1];
                    pg8::u32x4 wa, wb;
                    wa.x = pk2(a0[0] * c0[0] - b0[0] * c0[1], a0[1] * c0[2] - b0[1] * c0[3]); wa.y = pk2(a0[2] * c1[0] - b0[2] * c1[1], a0[3] * c1[2] - b0[3] * c1[3]);
                    wa.z = pk2(a1[0] * c2[0] - b1[0] * c2[1], a1[1] * c2[2] - b1[1] * c2[3]); wa.w = pk2(a1[2] * c3[0] - b1[2] * c3[1], a1[3] * c3[2] - b1[3] * c3[3]);
                    wb.x = pk2(b0[0] * c0[0] + a0[0] * c0[1], b0[1] * c0[2] + a0[1] * c0[3]); wb.y = pk2(b0[2] * c1[0] + a0[2] * c1[1], b0[3] * c1[2] + a0[3] * c1[3]);
                    wb.z = pk2(b1[0] * c2[0] + a1[0] * c2[1], b1[1] * c2[2] + a1[1] * c2[3]); wb.w = pk2(b1[2] * c3[0] + a1[2] * c3[1], b1[3] * c3[2] + a1[3] * c3[3]);
                    bf16* rp_ = base + (size_t)row * ld + ncol;
                    *(pg8::u32x4*)rp_ = wa; *(pg8::u32x4*)(rp_ + 32) = wb; }
            return;
        }
#pragma unroll
        for (int bj = 0; bj < 2; ++bj) {
            pg8::f32x4 pa = {0.f, 0.f, 0.f, 0.f}, pb = {0.f, 0.f, 0.f, 0.f};
            if ((kind == 2 || kind == 3) && par) { pa = *(const GAS pg8::f32x4*)(par + pc0 + bj * 128); pb = *(const GAS pg8::f32x4*)(par + pc0 + bj * 128 + 4); }
#pragma unroll
            for (int ai = 0; ai < 2; ++ai) if (ai < nai)
#pragma unroll
                for (int m = 0; m < 4; ++m) { bf16* rowp = base + (size_t)(row0 + (ai0 + ai) * 128 + m * 16) * ld + col0 + bj * 128;
                    pg8::f32x4 v0 = acc[ai][bj][m][0], v1 = acc[ai][bj][m][1];
                    if (kind != 0 && kind != 5) {
#pragma unroll
                        for (int j = 0; j < 4; ++j) { v0[j] = act(mode, v0[j], pa[j]); v1[j] = act(mode, v1[j], pb[j]); } }
                    pg8::u32x4 w; w.x = pk2(v0[0], v0[1]); w.y = pk2(v0[2], v0[3]); w.z = pk2(v1[0], v1[1]); w.w = pk2(v1[2], v1[3]);
                    *(pg8::u32x4*)rowp = w; }
        }
    }
};
template <int CTRL> __device__ __forceinline__ float dppz(float v) { return __int_as_float(__builtin_amdgcn_update_dpp(0, __float_as_int(v), CTRL, 0xF, 0xF, true)); }
struct EpiConvAct {
    static constexpr bool PERM = true; static constexpr bool PERMA = true;
    bf16* A; bf16* UB; const float* cw; const float* cb;
    __device__ __forceinline__ void operator()(const pg8::f32x4 (&acc)[2][2][4][2], const pg8::Unit& u, int wr, int wc, int fr, int fq) const {
        const int pc = wc * 32 + 8 * fq, cn = u.pn * 128 + pc;
        const int rowb = u.pm * 256 + wr * 64 + 4 * fr;
        const int ai0 = u.half < 0 ? 0 : u.half, nai = u.half < 0 ? 2 : 1;
        if (fr == 0 || fr == 15) {
            const bool lo = fr == 0; const int run = u.pm * 4 + wr + 2 * ai0;
#pragma unroll
            for (int ai = 0; ai < 2; ++ai) if (ai < nai)
#pragma unroll
                for (int bj = 0; bj < 2; ++bj)
#pragma unroll
                    for (int s = 0; s < 2; ++s) { const pg8::f32x4 a0 = lo ? acc[ai][bj][s][0] : acc[ai][bj][2 + s][0], a1 = lo ? acc[ai][bj][s][1] : acc[ai][bj][2 + s][1];
                        pg8::u32x4 w; w.x = pk2(a0[0], a0[1]); w.y = pk2(a0[2], a0[3]); w.z = pk2(a1[0], a1[1]); w.w = pk2(a1[2], a1[3]);
                        *(pg8::u32x4*)(UB + (size_t)((run + 2 * ai) * 4 + (lo ? s : 2 + s)) * DFF2 + u.pn * 256 + bj * 128 + pc) = w; }
        }
        pg8::u32x2 r0[2][4];
#pragma unroll
        for (int h = 0; h < 2; ++h) {
            const GAS float* wp = (const GAS float*)cw + cn + 4 * h; const GAS float* bp = (const GAS float*)cb + cn + 4 * h;
            const pg8::f32x4 g0 = *(const GAS pg8::f32x4*)wp, g1 = *(const GAS pg8::f32x4*)(wp + DFF2), g2 = *(const GAS pg8::f32x4*)(wp + 2 * DFF2), gb = *(const GAS pg8::f32x4*)bp;
            const pg8::f32x4 v0 = *(const GAS pg8::f32x4*)(wp + DFF), v1 = *(const GAS pg8::f32x4*)(wp + DFF2 + DFF), v2 = *(const GAS pg8::f32x4*)(wp + 2 * DFF2 + DFF), vb = *(const GAS pg8::f32x4*)(bp + DFF);
#pragma unroll
            for (int ai = 0; ai < 2; ++ai) if (ai < nai) {
                __builtin_amdgcn_sched_barrier(0);
                float o[4][4];
#pragma unroll
                for (int j = 0; j < 4; ++j) {
                    const float xg0 = acc[ai][0][0][h][j], xg1 = acc[ai][0][1][h][j], xg2 = acc[ai][0][2][h][j], xg3 = acc[ai][0][3][h][j];
                    const float xv0 = acc[ai][1][0][h][j], xv1 = acc[ai][1][1][h][j], xv2 = acc[ai][1][2][h][j], xv3 = acc[ai][1][3][h][j];
                    const float pg = dppz<0x111>(xg3), ng = dppz<0x101>(xg0), pv = dppz<0x111>(xv3), nv = dppz<0x101>(xv0);
                    const float og0 = gb[j] + g0[j] * pg + g1[j] * xg0 + g2[j] * xg1, ov0 = vb[j] + v0[j] * pv + v1[j] * xv0 + v2[j] * xv1;
                    const float og1 = gb[j] + g0[j] * xg0 + g1[j] * xg1 + g2[j] * xg2, ov1 = vb[j] + v0[j] * xv0 + v1[j] * xv1 + v2[j] * xv2;
                    const float og2 = gb[j] + g0[j] * xg1 + g1[j] * xg2 + g2[j] * xg3, ov2 = vb[j] + v0[j] * xv1 + v1[j] * xv2 + v2[j] * xv3;
                    const float og3 = gb[j] + g0[j] * xg2 + g1[j] * xg3 + g2[j] * ng, ov3 = vb[j] + v0[j] * xv2 + v1[j] * xv3 + v2[j] * nv;
                    o[0][j] = siluf_(og0) * ov0; o[1][j] = siluf_(og1) * ov1; o[2][j] = siluf_(og2) * ov2; o[3][j] = siluf_(og3) * ov3; }
#pragma unroll
                for (int m = 0; m < 4; ++m) { pg8::u32x2 w; w.x = pk2(o[m][0], o[m][1]); w.y = pk2(o[m][2], o[m][3]);
                    if (h == 0) r0[ai][m] = w;
                    else { pg8::u32x4 w4; w4.x = r0[ai][m].x; w4.y = r0[ai][m].y; w4.z = w.x; w4.w = w.y; *(pg8::u32x4*)(A + (size_t)(rowb + (ai0 + ai) * 128 + m) * DFF + cn) = w4; } }
            }
            __builtin_amdgcn_sched_barrier(0);
        }
    }
};
struct EpiResid {
    static constexpr bool PERM = true; static constexpr bool PERMA = false;
    bf16* DELTA; const unsigned char* ws; int layer, j;
    __device__ __forceinline__ void operator()(const pg8::f32x4 (&acc)[2][2][4][2], const pg8::Unit& u, int wr, int wc, int fr, int fq) const {
        const int bsel = (u.pm % 9 == 0) ? 4 : (u.pm / 9);
        const float* gate = mod_ptr(ws, layer, bsel, j);
        const int row0 = u.pm * 256 + wr * 64 + fr, col0 = u.pn * 256 + wc * 32 + 8 * fq;
#pragma unroll
        for (int bj = 0; bj < 2; ++bj) {
            const pg8::f32x4 ga = *(const GAS pg8::f32x4*)(gate + col0 + bj * 128), gb = *(const GAS pg8::f32x4*)(gate + col0 + bj * 128 + 4);
#pragma unroll
            for (int ai = 0; ai < 2; ++ai)
#pragma unroll
                for (int m = 0; m < 4; ++m) { const pg8::f32x4 v0 = acc[ai][bj][m][0] * ga, v1 = acc[ai][bj][m][1] * gb;
                    pg8::u32x4 w; w.x = pk2(v0[0], v0[1]); w.y = pk2(v0[2], v0[3]); w.z = pk2(v1[0], v1[1]); w.w = pk2(v1[2], v1[3]);
                    *(pg8::u32x4*)(DELTA + (size_t)(row0 + ai * 128 + m * 16) * DM + col0 + bj * 128) = w; }
        }
    }
};
struct EpiPartial {
    static constexpr bool PERM = true; static constexpr bool PERMA = false;
    bf16* PART;
    __device__ __forceinline__ void operator()(const pg8::f32x4 (&acc)[2][2][4][2], const pg8::Unit& u, int wr, int wc, int fr, int fq) const {
        const int ks = u.pn >> 8, pn = u.pn & 255;
        bf16* base = PART + (size_t)ks * 1024 * DM; const int row0 = (u.pm - 32) * 256 + wr * 64 + fr, col0 = pn * 256 + wc * 32 + 8 * fq;
        const int ai0 = u.half < 0 ? 0 : u.half, nai = u.half < 0 ? 2 : 1;
#pragma unroll
        for (int ai = 0; ai < 2; ++ai) if (ai < nai)
#pragma unroll
            for (int m = 0; m < 4; ++m)
#pragma unroll
                for (int bj = 0; bj < 2; ++bj) { const pg8::f32x4 v0 = acc[ai][bj][m][0], v1 = acc[ai][bj][m][1];
                    pg8::u32x4 w; w.x = pk2(v0[0], v0[1]); w.y = pk2(v0[2], v0[3]); w.z = pk2(v1[0], v1[1]); w.w = pk2(v1[2], v1[3]);
                    *(pg8::u32x4*)(base + (size_t)(row0 + (ai0 + ai) * 128 + m * 16) * DM + col0 + bj * 128) = w; }
    }
};
struct EpiGates {
    static constexpr bool PERM = true; static constexpr bool PERMA = false;
    unsigned char* ws; const float* b_gate; const float* lam;
    __device__ __forceinline__ void operator()(const pg8::f32x4 (&acc)[2][2][4][2], const pg8::Unit& u, int wr, int wc, int fr, int fq) const {
        const int d = u.pn >> 4, nb = (u.pn >> 1) & 7, hf = u.pn & 1;
        const int c0 = nb * 256 + hf * 128 + wc * 32 + 8 * fq;
        const int row0 = u.pm * 256 + wr * 64 + fr;
        const bf16* XB = (const bf16*)(ws + L3_XB);
        bf16* LOGA = (bf16*)(ws + L3_LOGA) + (size_t)d * NTOK * DM; bf16* UU = (bf16*)(ws + L3_UU) + (size_t)d * NTOK * DM;
#pragma unroll
        for (int n = 0; n < 2; ++n) {
            const int c4 = c0 + 4 * n;
            const pg8::f32x4 br = *(const pg8::f32x4*)(b_gate + (size_t)(d * 2 + 0) * DM + c4), bi = *(const pg8::f32x4*)(b_gate + (size_t)(d * 2 + 1) * DM + c4);
            const pg8::f32x4 lm = *(const pg8::f32x4*)(lam + (size_t)d * DM + c4); pg8::f32x4 sp;
#pragma unroll
            for (int j = 0; j < 4; ++j) sp[j] = __logf(1.f + __expf(-lm[j]));
#pragma unroll
            for (int ai = 0; ai < 2; ++ai)
#pragma unroll
                for (int m = 0; m < 4; ++m) { const int row = row0 + ai * 128 + m * 16; const size_t off = (size_t)row * DM + c4;
                    const v2u xw = *(const GAS v2u*)(XB + off);
                    const float xb[4] = {bflo(xw.x), bfhi(xw.x), bflo(xw.y), bfhi(xw.y)};
                    float la[4], uu[4];
#pragma unroll
                    for (int j = 0; j < 4; ++j) { const float rg = sigmoidf_(acc[ai][0][m][n][j] + br[j]), ig = sigmoidf_(acc[ai][1][m][n][j] + bi[j]);
                        const float lg = -8.0f * rg * sp[j]; la[j] = lg;
                        uu[j] = __builtin_amdgcn_sqrtf(fmaxf(1.f - __expf(2.f * lg), 0.f)) * ig * xb[j]; }
                    v2u w; w.x = pk2(la[0], la[1]); w.y = pk2(la[2], la[3]); *(GAS v2u*)(LOGA + off) = w;
                    w.x = pk2(uu[0], uu[1]); w.y = pk2(uu[2], uu[3]); *(GAS v2u*)(UU + off) = w; }
        }
    }
};

template <bool LAT, bool TO_OUT, bool WITH_H, int NSPLIT>
__device__ __forceinline__ void ln_phase(Frame& F, const bf16* DELTA, const float* Zin, float* Zout, float* dout, bf16* H, const float* gam, const float* bet, int mlayer, int jshift, const bf16* PART, int glayer, int jgate) {
    const int gw = GW(F), NGWv = NGW(F); const int nrows = LAT ? NLAT : NTOK;
    for (int idx = gw; idx < nrows; idx += NGWv) {
        int m, b, t; if (LAT) { b = idx >> 11; t = NCTX + (idx & 2047); m = b * LTOK + t; } else { m = idx; b = m / LTOK; t = m % LTOK; }
        const int bsel = (t < NCTX) ? 4 : b;
        f32x4 v[8]; float s = 0.f;
        if (NSPLIT > 0 && m >= 8192) {
            const GAS f32x4* zr = (const GAS f32x4*)(Zin + (size_t)m * DM) + F.lane; const GAS f32x4* gr = (const GAS f32x4*)mod_ptr(F.ws, glayer, bsel, jgate) + F.lane;
            const GAS v2u* pr = (const GAS v2u*)(PART + (size_t)(m - 8192) * DM) + F.lane;
#pragma unroll
            for (int j = 0; j < 8; ++j) { f32x4 a = {0.f, 0.f, 0.f, 0.f};
#pragma unroll
                for (int p = 0; p < NSPLIT; ++p) { const v2u pw = pr[(size_t)p * (1024 * DM / 4) + 64 * j]; a += (f32x4){bflo(pw.x), bfhi(pw.x), bflo(pw.y), bfhi(pw.y)}; }
                v[j] = zr[64 * j] * DN_ALPHA + gr[64 * j] * a; s += (v[j].x + v[j].y) + (v[j].z + v[j].w); }
        } else {
            const GAS f32x4* zr = (const GAS f32x4*)(Zin + (size_t)m * DM) + F.lane; const GAS v2u* dr = (const GAS v2u*)(DELTA + (size_t)m * DM) + F.lane;
#pragma unroll
            for (int j = 0; j < 8; ++j) { const v2u dw = dr[64 * j]; const f32x4 dl = {bflo(dw.x), bfhi(dw.x), bflo(dw.y), bfhi(dw.y)};
                v[j] = zr[64 * j] * DN_ALPHA + dl; s += (v[j].x + v[j].y) + (v[j].z + v[j].w); }
        }
        const float mean = wave_sum(s) * (1.f / DM); float s2 = 0.f;
#pragma unroll
        for (int j = 0; j < 8; ++j) { v[j] = v[j] - mean; s2 += (v[j].x * v[j].x + v[j].y * v[j].y) + (v[j].z * v[j].z + v[j].w * v[j].w); }
        const float rstd = 1.f / sqrtf(wave_sum(s2) * (1.f / DM) + LN_EPS);
        const float* sh = WITH_H ? mod_ptr(F.ws, mlayer, bsel, jshift) : nullptr; const float* sc = WITH_H ? mod_ptr(F.ws, mlayer, bsel, jshift + 1) : nullptr;
        float* zo = TO_OUT ? dout + ((size_t)b * SEQ + (t - NCTX)) * DM : Zout + (size_t)m * DM;
#pragma unroll
        for (int j = 0; j < 8; ++j) { const int col = 256 * j + 4 * F.lane;
            const f32x4 g = *(const f32x4*)(gam + col), be = *(const f32x4*)(bet + col);
            const f32x4 z = v[j] * rstd * g + be;
            *(GAS f32x4*)(zo + col) = z;
            if (WITH_H) { const f32x4 s1 = *(const GAS f32x4*)(sc + col), s0 = *(const GAS f32x4*)(sh + col); const f32x4 h = z * (s1 + 1.f) + s0;
                v2u w; w.x = pk2(h.x, h.y); w.y = pk2(h.z, h.w); *(GAS v2u*)(H + (size_t)m * DM + col) = w; } }
    }
}
__device__ __forceinline__ const float* z0_row(const float* Zb, const float* xin, const float* cin, bool z0in, int m, int b, int t) {
    return z0in ? ((t < NCTX) ? cin + ((size_t)b * NCTX + t) * DM : xin + ((size_t)b * SEQ + (t - NCTX)) * DM) : Zb + (size_t)m * DM;
}
#define LN_ROWINFO(idx_, m_, b_, t_) do { if (LAT) { b_ = (idx_) >> 11; t_ = NCTX + ((idx_) & 2047); m_ = b_ * LTOK + t_; } else { m_ = (idx_); b_ = m_ / LTOK; t_ = m_ % LTOK; } } while (0)
#define LNI(j_) (128 * ((j_) >> 1) + 2 * F.lane + ((j_) & 1))
#define LN_SPLIT_D(dst, PARTp, gatep, m_) do { const GAS v2u* pr_ = (const GAS v2u*)((PARTp) + (size_t)((m_) - 8192) * DM); const GAS f32x4* gr_ = (const GAS f32x4*)(gatep); \
        _Pragma("unroll") for (int j_ = 0; j_ < 8; ++j_) { f32x4 a_ = {0.f, 0.f, 0.f, 0.f}; \
            _Pragma("unroll") for (int p_ = 0; p_ < NSPLIT; ++p_) { const v2u pw_ = pr_[(size_t)p_ * (1024 * DM / 4) + LNI(j_)]; a_ += (f32x4){bflo(pw_.x), bfhi(pw_.x), bflo(pw_.y), bfhi(pw_.y)}; } \
            a_ = a_ * gr_[LNI(j_)]; dst[j_].x = pk2(a_.x, a_.y); dst[j_].y = pk2(a_.z, a_.w); } } while (0)
__device__ __forceinline__ f32x4 zq_decode(const f32x4 raw, float sc) { const int a = __float_as_int(raw.x), b = __float_as_int(raw.y);
    return (f32x4){(float)(short)(a & 0xffff), (float)(a >> 16), (float)(short)(b & 0xffff), (float)(b >> 16)} * sc; }
#define ZQ_ROW(Zb_, m_) ((const GAS v4u*)((const unsigned short*)(Zb_) + (size_t)(m_) * DM) + F.lane)
template <bool LAT, int NSPLIT, bool Z0IN>
__device__ __forceinline__ void ln1_phase(Frame& F, bf16* D1, const float* Zb, const float* xin, const float* cin, bf16* H, float* STAT, const float* gam, const float* bet, int layer, const bf16* PART) {
    const int gw = GW(F), NGWv = NGW(F); const int nrows = LAT ? NLAT : NTOK; const int nmain = NSPLIT > 0 ? 8192 : nrows;
    LAS float* Lg = (LAS float*)(F.lds + RING_OFF); LAS float* Lb = Lg + DM; LAS float* Lm = Lb + DM;
    f32x4 zA[8], zB[8]; v2u dA[8], dB[8]; float sA = 1.f, sB = 1.f;
    auto loadz = [&](const int idx, f32x4 (&zz)[8], float& zs) __attribute__((always_inline)) {
        int m, b, t; LN_ROWINFO(idx, m, b, t);
        if (Z0IN) { const GAS f32x4* zr = (const GAS f32x4*)z0_row(Zb, xin, cin, true, m, b, t);
#pragma unroll
            for (int j = 0; j < 8; ++j) zz[j] = zr[LNI(j)]; }
        else { const GAS v4u* qr = ZQ_ROW(Zb, m); zs = *(const GAS float*)((const float*)(F.ws + WS_ZS) + m);
#pragma unroll
            for (int k = 0; k < 4; ++k) { const v4u pw = qr[64 * k]; zz[2 * k].x = __uint_as_float(pw.x); zz[2 * k].y = __uint_as_float(pw.y); zz[2 * k + 1].x = __uint_as_float(pw.z); zz[2 * k + 1].y = __uint_as_float(pw.w); } } };
    auto loadd = [&](const int idx, v2u (&dd)[8]) __attribute__((always_inline)) {
        int m, b, t; LN_ROWINFO(idx, m, b, t); const GAS v4u* dr = (const GAS v4u*)(D1 + (size_t)m * DM) + F.lane;
#pragma unroll
        for (int k = 0; k < 4; ++k) { const v4u pw = dr[64 * k]; dd[2 * k] = (v2u){pw.x, pw.y}; dd[2 * k + 1] = (v2u){pw.z, pw.w}; } };
    auto row1 = [&](f32x4 (&zc)[8], v2u (&dc)[8], const float zsc, const int idx) __attribute__((always_inline)) {
        int m, b, t; LN_ROWINFO(idx, m, b, t); const int bsel = (t < NCTX) ? 4 : b;
        float s = 0.f;
#pragma unroll
        for (int j = 0; j < 8; ++j) { const f32x4 dl = {bflo(dc[j].x), bfhi(dc[j].x), bflo(dc[j].y), bfhi(dc[j].y)}; const f32x4 z0v = Z0IN ? zc[j] : zq_decode(zc[j], zsc);
            zc[j] = z0v * DN_ALPHA + dl; s += (zc[j].x + zc[j].y) + (zc[j].z + zc[j].w); }
        const float mean = wave_sum(s) * (1.f / DM); float s2 = 0.f;
#pragma unroll
        for (int j = 0; j < 8; ++j) { zc[j] = zc[j] - mean; s2 += (zc[j].x * zc[j].x + zc[j].y * zc[j].y) + (zc[j].z * zc[j].z + zc[j].w * zc[j].w); }
        const float rstd = 1.f / sqrtf(wave_sum(s2) * (1.f / DM) + LN_EPS);
        if (F.lane == 0) *(GAS f32x2*)(STAT + (size_t)m * 2) = (f32x2){mean, rstd};
        const LAS float* sh = Lm + bsel * 2 * DM; const LAS float* sc = sh + DM; v2u hw = {0u, 0u};
#pragma unroll
        for (int j = 0; j < 8; ++j) { const int col = 4 * LNI(j);
            const f32x4 z = zc[j] * rstd * *(const LAS f32x4*)(Lg + col) + *(const LAS f32x4*)(Lb + col);
            const f32x4 h = z * (*(const LAS f32x4*)(sc + col) + 1.f) + *(const LAS f32x4*)(sh + col);
            v2u w; w.x = pk2(h.x, h.y); w.y = pk2(h.z, h.w);
            if (j & 1) *(GAS v4u*)(H + (size_t)m * DM + col - 4) = (v4u){hw.x, hw.y, w.x, w.y}; else hw = w; } };
    int idx = gw; bool have = idx < nmain;
    if (have) { loadz(idx, zA, sA); loadd(idx, dA); }
    {
        f32x4 pv[12];
        pv[0] = ((const GAS f32x4*)gam)[F.tid]; pv[1] = ((const GAS f32x4*)bet)[F.tid];
#pragma unroll
        for (int k = 0; k < 10; ++k) { const int v = F.tid + NWAVES * 64 * k, bs = v >> 10, r4 = v & 1023; pv[2 + k] = ((const GAS f32x4*)mod_ptr(F.ws, layer, bs, 3))[r4]; }
        ((LAS f32x4*)Lg)[F.tid] = pv[0]; ((LAS f32x4*)Lb)[F.tid] = pv[1];
#pragma unroll
        for (int k = 0; k < 10; ++k) ((LAS f32x4*)Lm)[F.tid + NWAVES * 64 * k] = pv[2 + k];
    }
    __syncthreads();
    while (have) {
        const int nidx = idx + NGWv; const bool hasn = nidx < nmain;
        if (hasn) { loadz(nidx, zB, sB); loadd(nidx, dB); }
        asm volatile("" ::: "memory");
        row1(zA, dA, sA, idx);
        if (!hasn) break;
        const int fidx = nidx + NGWv; const bool hasf = fidx < nmain;
        if (hasf) { loadz(fidx, zA, sA); loadd(fidx, dA); }
        asm volatile("" ::: "memory");
        row1(zB, dB, sB, nidx);
        idx = fidx; have = hasf;
    }
    if (NSPLIT > 0) {
        for (int ti = 8192 + gw; ti < nrows; ti += NGWv) {
            int m, b, t; LN_ROWINFO(ti, m, b, t);
            loadz(ti, zA, sA); LN_SPLIT_D(dA, PART, mod_ptr(F.ws, layer, (t < NCTX) ? 4 : b, 2), m);
#pragma unroll
            for (int j = 0; j < 8; ++j) *((GAS v2u*)(D1 + (size_t)m * DM) + LNI(j)) = dA[j];
            asm volatile("" ::: "memory");
            row1(zA, dA, sA, ti);
        }
    }
}
template <bool LAT, bool TO_OUT, bool WITH_H, int NSPLIT, bool Z0IN>
__device__ __forceinline__ void ln2_phase(Frame& F, const bf16* D1, const bf16* D2, const float* Zb, const float* xin, const float* cin, float* Zout, float* dout, bf16* H, const float* STAT,
                                          const float* gam1, const float* bet1, const float* gam2, const float* bet2, int layer, const bf16* PART) {
    const int gw = GW(F), NGWv = NGW(F); const int nrows = LAT ? NLAT : NTOK; const int nmain = NSPLIT > 0 ? 8192 : nrows;
    LAS float* Lg1 = (LAS float*)(F.lds + RING_OFF); LAS float* Lb1 = Lg1 + DM; LAS float* Lg2 = Lb1 + DM; LAS float* Lb2 = Lg2 + DM; LAS float* Lm = Lb2 + DM;
    f32x4 zA[8], zB[8]; v2u d1A[8], d1B[8], d2A[8], d2B[8]; f32x2 stA = {0.f, 0.f}, stB = {0.f, 0.f}; float sA = 1.f, sB = 1.f;
    auto loadz = [&](const int idx, f32x4 (&zz)[8], v2u (&dd1)[8], f32x2& st, float& zs) __attribute__((always_inline)) {
        int m, b, t; LN_ROWINFO(idx, m, b, t);
        if (Z0IN) { const GAS f32x4* zr = (const GAS f32x4*)z0_row(Zb, xin, cin, true, m, b, t);
#pragma unroll
            for (int j = 0; j < 8; ++j) zz[j] = zr[LNI(j)]; }
        else { const GAS v4u* qr = ZQ_ROW(Zb, m); zs = *(const GAS float*)((const float*)(F.ws + WS_ZS) + m);
#pragma unroll
            for (int k = 0; k < 4; ++k) { const v4u pw = qr[64 * k]; zz[2 * k].x = __uint_as_float(pw.x); zz[2 * k].y = __uint_as_float(pw.y); zz[2 * k + 1].x = __uint_as_float(pw.z); zz[2 * k + 1].y = __uint_as_float(pw.w); } }
        const GAS v4u* dr = (const GAS v4u*)(D1 + (size_t)m * DM) + F.lane;
#pragma unroll
        for (int k = 0; k < 4; ++k) { const v4u pw = dr[64 * k]; dd1[2 * k] = (v2u){pw.x, pw.y}; dd1[2 * k + 1] = (v2u){pw.z, pw.w}; }
        st = *(const GAS f32x2*)(STAT + (size_t)m * 2); };
    auto loadd2 = [&](const int idx, v2u (&dd2)[8]) __attribute__((always_inline)) {
        int m, b, t; LN_ROWINFO(idx, m, b, t); const GAS v4u* dr = (const GAS v4u*)(D2 + (size_t)m * DM) + F.lane;
#pragma unroll
        for (int k = 0; k < 4; ++k) { const v4u pw = dr[64 * k]; dd2[2 * k] = (v2u){pw.x, pw.y}; dd2[2 * k + 1] = (v2u){pw.z, pw.w}; } };
    auto row2 = [&](f32x4 (&zc)[8], v2u (&d1c)[8], v2u (&d2c)[8], const f32x2 stc, const float zsc, const int idx) __attribute__((always_inline)) {
        int m, b, t; LN_ROWINFO(idx, m, b, t); const int bsel = (t < NCTX) ? 4 : b;
        float s = 0.f;
#pragma unroll
        for (int j = 0; j < 8; ++j) { const int col = 4 * LNI(j);
            const f32x4 dl1 = {bflo(d1c[j].x), bfhi(d1c[j].x), bflo(d1c[j].y), bfhi(d1c[j].y)}, dl2 = {bflo(d2c[j].x), bfhi(d2c[j].x), bflo(d2c[j].y), bfhi(d2c[j].y)};
            const f32x4 z0v = Z0IN ? zc[j] : zq_decode(zc[j], zsc);
            const f32x4 z1 = ((z0v * DN_ALPHA + dl1) - stc.x) * stc.y * *(const LAS f32x4*)(Lg1 + col) + *(const LAS f32x4*)(Lb1 + col);
            zc[j] = z1 * DN_ALPHA + dl2; s += (zc[j].x + zc[j].y) + (zc[j].z + zc[j].w); }
        const float mean = wave_sum(s) * (1.f / DM); float s2 = 0.f;
#pragma unroll
        for (int j = 0; j < 8; ++j) { zc[j] = zc[j] - mean; s2 += (zc[j].x * zc[j].x + zc[j].y * zc[j].y) + (zc[j].z * zc[j].z + zc[j].w * zc[j].w); }
        const float rstd = 1.f / sqrtf(wave_sum(s2) * (1.f / DM) + LN_EPS);
        const LAS float* sh = Lm + bsel * 2 * DM; const LAS float* sc = sh + DM;
        float* zo = TO_OUT ? dout + ((size_t)b * SEQ + (t - NCTX)) * DM : nullptr;
        float qinv = 1.f; v2u qw = {0u, 0u}, hw = {0u, 0u};
        if (!TO_OUT) {
            float am = 0.f;
#pragma unroll
            for (int j = 0; j < 8; ++j) { const int col = 4 * LNI(j);
                const f32x4 z = zc[j] * rstd * *(const LAS f32x4*)(Lg2 + col) + *(const LAS f32x4*)(Lb2 + col);
                am = fmaxf(am, fmaxf(fmaxf(fabsf(z.x), fabsf(z.y)), fmaxf(fabsf(z.z), fabsf(z.w)))); }
            am = wave_max(am); const float scq = am > 0.f ? am * (1.f / 32767.f) : 1.f; qinv = am > 0.f ? 32767.f / am : 1.f;
            if (F.lane == 0) *(GAS float*)((float*)(F.ws + WS_ZS) + m) = scq;
        }
#pragma unroll
        for (int j = 0; j < 8; ++j) { const int col = 4 * LNI(j);
            const f32x4 z = zc[j] * rstd * *(const LAS f32x4*)(Lg2 + col) + *(const LAS f32x4*)(Lb2 + col);
            if (TO_OUT) *(GAS f32x4*)(zo + col) = z;
            else { const int q0 = __float2int_rn(z.x * qinv), q1 = __float2int_rn(z.y * qinv), q2 = __float2int_rn(z.z * qinv), q3 = __float2int_rn(z.w * qinv);
                v2u pw; pw.x = ((unsigned)q0 & 0xffffu) | ((unsigned)q1 << 16); pw.y = ((unsigned)q2 & 0xffffu) | ((unsigned)q3 << 16);
                if (j & 1) *(GAS v4u*)((unsigned short*)Zout + (size_t)m * DM + col - 4) = (v4u){qw.x, qw.y, pw.x, pw.y}; else qw = pw; }
            if (WITH_H) { const f32x4 h = z * (*(const LAS f32x4*)(sc + col) + 1.f) + *(const LAS f32x4*)(sh + col);
                v2u w; w.x = pk2(h.x, h.y); w.y = pk2(h.z, h.w);
                if (j & 1) *(GAS v4u*)(H + (size_t)m * DM + col - 4) = (v4u){hw.x, hw.y, w.x, w.y}; else hw = w; } } };
    int idx = gw; bool have = idx < nmain;
    if (have) { loadz(idx, zA, d1A, stA, sA); loadd2(idx, d2A); }
    {
        f32x4 pv[14];
        pv[0] = ((const GAS f32x4*)gam1)[F.tid]; pv[1] = ((const GAS f32x4*)bet1)[F.tid]; pv[2] = ((const GAS f32x4*)gam2)[F.tid]; pv[3] = ((const GAS f32x4*)bet2)[F.tid];
        if (WITH_H) {
#pragma unroll
            for (int k = 0; k < 10; ++k) { const int v = F.tid + NWAVES * 64 * k, bs = v >> 10, r4 = v & 1023; pv[4 + k] = ((const GAS f32x4*)mod_ptr(F.ws, layer + 1, bs, 0))[r4]; }
        }
        ((LAS f32x4*)Lg1)[F.tid] = pv[0]; ((LAS f32x4*)Lb1)[F.tid] = pv[1]; ((LAS f32x4*)Lg2)[F.tid] = pv[2]; ((LAS f32x4*)Lb2)[F.tid] = pv[3];
        if (WITH_H) {
#pragma unroll
            for (int k = 0; k < 10; ++k) ((LAS f32x4*)Lm)[F.tid + NWAVES * 64 * k] = pv[4 + k];
        }
    }
    __syncthreads();
    while (have) {
        const int nidx = idx + NGWv; const bool hasn = nidx < nmain;
        if (hasn) { loadz(nidx, zB, d1B, stB, sB); loadd2(nidx, d2B); }
        asm volatile("" ::: "memory");
        row2(zA, d1A, d2A, stA, sA, idx);
        if (!hasn) break;
        const int fidx = nidx + NGWv; const bool hasf = fidx < nmain;
        if (hasf) { loadz(fidx, zA, d1A, stA, sA); loadd2(fidx, d2A); }
        asm volatile("" ::: "memory");
        row2(zB, d1B, d2B, stB, sB, nidx);
        idx = fidx; have = hasf;
    }
    if (NSPLIT > 0) {
        for (int ti = 8192 + gw; ti < nrows; ti += NGWv) {
            int m, b, t; LN_ROWINFO(ti, m, b, t);
            loadz(ti, zA, d1A, stA, sA); LN_SPLIT_D(d2A, PART, mod_ptr(F.ws, layer, (t < NCTX) ? 4 : b, 5), m);
            asm volatile("" ::: "memory");
            row2(zA, d1A, d2A, stA, sA, ti);
        }
    }
}
template <bool LAT>
__device__ __forceinline__ void ffn_conv_phase(Frame& F, const bf16* U, bf16* ACT, const float* cw, const float* cb) {
    const int gw = GW(F), NGWv = NGW(F); const int nstrips = (LAT ? NLAT : NTOK) / 16; const int nitems = nstrips * 11;
    for (int it = gw; it < nitems; it += NGWv) {
        const int strip = it / 11, cblk = it % 11; const int c0 = cblk * 512 + F.lane * 8;
        int m0; if (LAT) { const int r = strip * 16; m0 = (r >> 11) * LTOK + NCTX + (r & 2047); } else m0 = strip * 16;
        const int t0 = m0 % LTOK;
        float wg[3][8], wv[3][8], bg[8], bv[8];
#pragma unroll
        for (int k = 0; k < 3; ++k) { const f32x4 a = *(const f32x4*)(cw + (size_t)k * DFF2 + c0), b = *(const f32x4*)(cw + (size_t)k * DFF2 + c0 + 4), c = *(const f32x4*)(cw + (size_t)k * DFF2 + DFF + c0), d = *(const f32x4*)(cw + (size_t)k * DFF2 + DFF + c0 + 4);
#pragma unroll
            for (int j = 0; j < 4; ++j) { wg[k][j] = a[j]; wg[k][4 + j] = b[j]; wv[k][j] = c[j]; wv[k][4 + j] = d[j]; } }
        { const f32x4 a = *(const f32x4*)(cb + c0), b = *(const f32x4*)(cb + c0 + 4), c = *(const f32x4*)(cb + DFF + c0), d = *(const f32x4*)(cb + DFF + c0 + 4);
#pragma unroll
          for (int j = 0; j < 4; ++j) { bg[j] = a[j]; bg[4 + j] = b[j]; bv[j] = c[j]; bv[4 + j] = d[j]; } }
        const bool first_in_seg = (t0 == 0 || t0 == NCTX), last_in_seg = (t0 + 16 == NCTX || t0 + 16 == LTOK);
        const GAS bf16* ug = (const GAS bf16*)U + (size_t)m0 * DFF2 + c0;
        v4u pg = {0u, 0u, 0u, 0u}, pv = {0u, 0u, 0u, 0u};
        if (!first_in_seg) { pg = *(const GAS v4u*)(ug - DFF2); pv = *(const GAS v4u*)(ug - DFF2 + DFF); }
        v4u cg = *(const GAS v4u*)(ug), cv = *(const GAS v4u*)(ug + DFF);
        for (int r = 0; r < 16; ++r) {
            v4u ng = {0u, 0u, 0u, 0u}, nv = {0u, 0u, 0u, 0u};
            if (r < 15 || !last_in_seg) { ng = *(const GAS v4u*)(ug + (size_t)(r + 1) * DFF2); nv = *(const GAS v4u*)(ug + (size_t)(r + 1) * DFF2 + DFF); }
            float o[8];
#pragma unroll
            for (int q = 0; q < 4; ++q) {
                const unsigned pgw = pg[q], cgw = cg[q], ngw = ng[q], pvw = pv[q], cvw = cv[q], nvw = nv[q];
                const float g0 = bg[2 * q] + wg[0][2 * q] * bflo(pgw) + wg[1][2 * q] * bflo(cgw) + wg[2][2 * q] * bflo(ngw);
                const float g1 = bg[2 * q + 1] + wg[0][2 * q + 1] * bfhi(pgw) + wg[1][2 * q + 1] * bfhi(cgw) + wg[2][2 * q + 1] * bfhi(ngw);
                const float v0 = bv[2 * q] + wv[0][2 * q] * bflo(pvw) + wv[1][2 * q] * bflo(cvw) + wv[2][2 * q] * bflo(nvw);
                const float v1 = bv[2 * q + 1] + wv[0][2 * q + 1] * bfhi(pvw) + wv[1][2 * q + 1] * bfhi(cvw) + wv[2][2 * q + 1] * bfhi(nvw);
                o[2 * q] = siluf_(g0) * v0; o[2 * q + 1] = siluf_(g1) * v1; }
            v4u w; w.x = pk2(o[0], o[1]); w.y = pk2(o[2], o[3]); w.z = pk2(o[4], o[5]); w.w = pk2(o[6], o[7]);
            *(GAS v4u*)(ACT + (size_t)(m0 + r) * DFF + c0) = w;
            pg = cg; pv = cv; cg = ng; cv = nv;
        }
    }
}

template <bool LAT>
__device__ __forceinline__ void ffn_fix_phase(Frame& F, const bf16* UB, bf16* ACT, const float* cw, const float* cb) {
    const int gw = GW(F), NGWv = NGW(F); const int nruns = (LAT ? NLAT : NTOK) / 64; const int nitems = nruns * 11;
    for (int it = gw; it < nitems; it += NGWv) {
        const int cblk = it % 11, rl = it / 11;
        int run; if (LAT) { const int r = rl * 64; run = ((r >> 11) * LTOK + NCTX + (r & 2047)) >> 6; } else run = rl;
        const int m0 = run * 64, t0 = m0 % LTOK;
        const bool seg_first = (t0 == 0 || t0 == NCTX), seg_last = (t0 + 64 == NCTX || t0 + 64 == LTOK);
        const int c0 = cblk * 512 + F.lane * 8; const int uc = (c0 >> 7) * 256 + (c0 & 127);
        const GAS bf16* ub = (const GAS bf16*)UB + (size_t)run * 4 * DFF2 + uc;
        v4u rg[6], rv[6];
#pragma unroll
        for (int q = 0; q < 6; ++q) { const int rq = (q == 0 && seg_first) ? 1 : ((q == 5 && seg_last) ? 4 : q);
            const GAS bf16* rp = ub + (ptrdiff_t)(rq - 1) * DFF2; rg[q] = *(const GAS v4u*)rp; rv[q] = *(const GAS v4u*)(rp + 128); }
        float wg[3][8], wv[3][8], bg[8], bv[8];
#pragma unroll
        for (int k = 0; k < 3; ++k) { const GAS float* wp = (const GAS float*)cw + (size_t)k * DFF2 + c0; const f32x4 a = *(const GAS f32x4*)wp, b = *(const GAS f32x4*)(wp + 4), c = *(const GAS f32x4*)(wp + DFF), d = *(const GAS f32x4*)(wp + DFF + 4);
#pragma unroll
            for (int j = 0; j < 4; ++j) { wg[k][j] = a[j]; wg[k][4 + j] = b[j]; wv[k][j] = c[j]; wv[k][4 + j] = d[j]; } }
        { const GAS float* bp = (const GAS float*)cb + c0; const f32x4 a = *(const GAS f32x4*)bp, b = *(const GAS f32x4*)(bp + 4), c = *(const GAS f32x4*)(bp + DFF), d = *(const GAS f32x4*)(bp + DFF + 4);
#pragma unroll
          for (int j = 0; j < 4; ++j) { bg[j] = a[j]; bg[4 + j] = b[j]; bv[j] = c[j]; bv[4 + j] = d[j]; } }
        const float zf = seg_first ? 0.f : 1.f, zl = seg_last ? 0.f : 1.f;
#pragma unroll
        for (int which = 0; which < 2; ++which) {
            const int ip = which ? 3 : 0, ic = which ? 4 : 1, in_ = which ? 5 : 2; const float mp = which ? 1.f : zf, mn = which ? zl : 1.f;
            float o[8];
#pragma unroll
            for (int q = 0; q < 4; ++q) {
                const unsigned pgw = rg[ip][q], cgw = rg[ic][q], ngw = rg[in_][q], pvw = rv[ip][q], cvw = rv[ic][q], nvw = rv[in_][q];
                const float g0 = bg[2 * q] + wg[0][2 * q] * (bflo(pgw) * mp) + wg[1][2 * q] * bflo(cgw) + wg[2][2 * q] * (bflo(ngw) * mn);
                const float g1 = bg[2 * q + 1] + wg[0][2 * q + 1] * (bfhi(pgw) * mp) + wg[1][2 * q + 1] * bfhi(cgw) + wg[2][2 * q + 1] * (bfhi(ngw) * mn);
                const float v0 = bv[2 * q] + wv[0][2 * q] * (bflo(pvw) * mp) + wv[1][2 * q] * bflo(cvw) + wv[2][2 * q] * (bflo(nvw) * mn);
                const float v1 = bv[2 * q + 1] + wv[0][2 * q + 1] * (bfhi(pvw) * mp) + wv[1][2 * q + 1] * bfhi(cvw) + wv[2][2 * q + 1] * (bfhi(nvw) * mn);
                o[2 * q] = siluf_(g0) * v0; o[2 * q + 1] = siluf_(g1) * v1; }
            v4u w; w.x = pk2(o[0], o[1]); w.y = pk2(o[2], o[3]); w.z = pk2(o[4], o[5]); w.w = pk2(o[6], o[7]);
            *(GAS v4u*)(ACT + (size_t)(m0 + (which ? 63 : 0)) * DFF + c0) = w;
        }
    }
}
__device__ __forceinline__ int flip_tok(int s) { return s < NCTX ? (NCTX - 1 - s) : (LTOK + NCTX - 1 - s); }

__device__ __forceinline__ pg8::f32x4 mma_tile(pg8::f32x4 acc, const LAS bf16* A, int lda, const LAS bf16* Bt, int ldb, int ksteps, int lane) {
    const LAS bf16* ap = A + (lane & 15) * lda + (lane >> 4) * 8; const LAS bf16* bp = Bt + (lane & 15) * ldb + (lane >> 4) * 8;
    for (int k = 0; k < ksteps; ++k) { const bf16x8 a = *(const LAS bf16x8*)(ap + k * 32), b = *(const LAS bf16x8*)(bp + k * 32);
        acc = __builtin_amdgcn_mfma_f32_16x16x32_bf16(a, b, acc, 0, 0, 0); }
    return acc;
}
template <int CTRL> __device__ __forceinline__ float dpp_f(float v) { return __int_as_float(__builtin_amdgcn_update_dpp(0, __float_as_int(v), CTRL, 0xF, 0xF, true)); }
__device__ __forceinline__ float red8(float v) { v += dpp_f<0xB1>(v); v += dpp_f<0x4E>(v); v += dpp_f<0x141>(v); return v; }
__device__ __forceinline__ float red16(float v) { v = red8(v); v += dpp_f<0x140>(v); return v; }
__device__ __forceinline__ void unpack8(const v4u w, float (&f)[8]) { f[0] = bflo(w.x); f[1] = bfhi(w.x); f[2] = bflo(w.y); f[3] = bfhi(w.y); f[4] = bflo(w.z); f[5] = bfhi(w.z); f[6] = bflo(w.w); f[7] = bfhi(w.w); }
__device__ __forceinline__ v4u pack8(const float (&f)[8]) { v4u w; w.x = pk2(f[0], f[1]); w.y = pk2(f[2], f[3]); w.z = pk2(f[4], f[5]); w.w = pk2(f[6], f[7]); return w; }
__device__ __forceinline__ void ld8f(const float* p, float (&f)[8]) { const f32x4 a = *(const f32x4*)p, b = *(const f32x4*)(p + 4); f[0] = a.x; f[1] = a.y; f[2] = a.z; f[3] = a.w; f[4] = b.x; f[5] = b.y; f[6] = b.z; f[7] = b.w; }
__device__ __forceinline__ void l0_xs_phase(Frame& F, const float* x, const float* ctx, const float* mu) {
    const int gw = GW(F), NGWv = NGW(F);
    bf16* XS = (bf16*)(F.ws + L0_XS);
    const int c0 = (gw & 3) * 512 + F.lane * 8;
    float mv[6][8];
#pragma unroll
    for (int n = 0; n < 6; ++n) ld8f(mu + (size_t)n * DM + c0, mv[n]);
    for (int it = gw; it < (NTOK / 8) * 4; it += NGWv) {
        const int strip = it >> 2; const int m0 = strip * 8, b = m0 / LTOK, t0 = m0 % LTOK;
        const float* zr = (t0 < NCTX) ? ctx + ((size_t)b * NCTX + t0) * DM : x + ((size_t)b * SEQ + (t0 - NCTX)) * DM;
        const int seg_end = (t0 < NCTX) ? NCTX : LTOK; const bool first = (t0 == 0 || t0 == NCTX);
        const int bsel = (t0 < NCTX) ? 4 : b;
        f32x4 za[10], zb[10];
#pragma unroll
        for (int q = 0; q < 10; ++q) { const bool ok = (q == 0) ? !first : (t0 + q - 1 < seg_end);
            za[q] = (f32x4){0.f, 0.f, 0.f, 0.f}; zb[q] = za[q];
            if (ok) { const GAS float* rp = (const GAS float*)zr + (ptrdiff_t)(q - 1) * DM + c0; za[q] = *(const GAS f32x4*)rp; zb[q] = *(const GAS f32x4*)(rp + 4); } }
        float s0[8], s1[8], hp[8], hc[8], hn[8];
        { const float* sh = mod_ptr(F.ws, 0, bsel, 0) + c0; const float* sc = mod_ptr(F.ws, 0, bsel, 1) + c0;
          const f32x4 a = *(const GAS f32x4*)sh, a2 = *(const GAS f32x4*)(sh + 4), c = *(const GAS f32x4*)sc, c2 = *(const GAS f32x4*)(sc + 4);
#pragma unroll
          for (int j = 0; j < 4; ++j) { s0[j] = a[j]; s0[4 + j] = a2[j]; s1[j] = c[j] + 1.f; s1[4 + j] = c2[j] + 1.f; } }
#pragma unroll
        for (int j = 0; j < 4; ++j) { hp[j] = first ? 0.f : za[0][j] * s1[j] + s0[j]; hp[4 + j] = first ? 0.f : zb[0][j] * s1[4 + j] + s0[4 + j];
                                      hc[j] = za[1][j] * s1[j] + s0[j]; hc[4 + j] = zb[1][j] * s1[4 + j] + s0[4 + j]; }
#pragma unroll
        for (int r = 0; r < 8; ++r) {
            const bool hasn = (t0 + r + 1 < seg_end);
#pragma unroll
            for (int j = 0; j < 4; ++j) { hn[j] = hasn ? za[r + 2][j] * s1[j] + s0[j] : 0.f; hn[4 + j] = hasn ? zb[r + 2][j] * s1[4 + j] + s0[4 + j] : 0.f; }
            const size_t m = (size_t)(m0 + r);
            float dx[8];
#pragma unroll
            for (int j = 0; j < 8; ++j) dx[j] = (hp[j] + hn[j]) * 0.5f - hc[j];
#pragma unroll
            for (int n = 0; n < 6; ++n) { float o[8];
#pragma unroll
                for (int j = 0; j < 8; ++j) o[j] = hc[j] + dx[j] * mv[n][j];
                *(GAS v4u*)(XS + ((size_t)n * NTOK + m) * DM + c0) = pack8(o); }
#pragma unroll
            for (int j = 0; j < 8; ++j) { hp[j] = hc[j]; hc[j] = hn[j]; }
        }
    }
}
__device__ __forceinline__ void l0_prep_phase(Frame& F, const float* k_k, const float* k_a, const float* r_k) {
    const int gw = GW(F), NGWv = NGW(F); unsigned char* ws = F.ws;
    const bf16* R = (const bf16*)(ws + L0_R); const bf16* K = (const bf16*)(ws + L0_K); const bf16* V = (const bf16*)(ws + L0_V);
    bf16* VEC = (bf16*)(ws + L0_VEC); float* SCAL = (float*)(ws + L0_SCAL); float* BONUS = (float*)(ws + L0_BONUS);
    const int l8 = F.lane & 7;
    for (int it = gw; it < NTOK * 4; it += NGWv) {
        const int m = it >> 2, h = (it & 3) * 8 + (F.lane >> 3), b = m / LTOK, t = m % LTOK; const int c0 = h * 64 + l8 * 8; const size_t e = (size_t)m * DM + c0;
        float r[8], k[8], kk[8], tmp[8], par[8];
        unpack8(*(const GAS v4u*)(R + e), r); unpack8(*(const GAS v4u*)(K + e), k);
        const v4u vraw = *(const GAS v4u*)(V + e);
        ld8f(k_k + c0, par); float ss = 0.f;
#pragma unroll
        for (int j = 0; j < 8; ++j) { kk[j] = k[j] * par[j]; ss += kk[j] * kk[j]; }
        ss = red8(ss); const float inv = 1.0f / sqrtf(ss + 1e-12f);
#pragma unroll
        for (int j = 0; j < 8; ++j) kk[j] *= inv;
        float ka[8], kdsum[8]; ld8f(k_a + c0, ka);
#pragma unroll
        for (int j = 0; j < 8; ++j) kdsum[j] = 0.f;
#pragma unroll
        for (int d = 0; d < 2; ++d) {
            float w[8], ic[8], kd[8];
            unpack8(*(const GAS v4u*)((const bf16*)(ws + (d ? L0_DEC1 : L0_DEC0)) + e), w); unpack8(*(const GAS v4u*)((const bf16*)(ws + (d ? L0_IC1 : L0_IC0)) + e), ic);
            float kr = 0.f, kkar = 0.f;
#pragma unroll
            for (int j = 0; j < 8; ++j) { kd[j] = k[j] * (1.f + (ic[j] - 1.f) * ka[j]); kdsum[j] += kd[j]; kr += kd[j] * r[j]; }
            const int s = d ? flip_tok(t) : t; const size_t sidx = (size_t)((d * NB + b) * 32 + h);
            bf16* vp = VEC + (sidx * LTOK + s) * 384 + l8 * 8;
            *(GAS v4u*)(vp) = pack8(w); *(GAS v4u*)(vp + 64) = pack8(kd); *(GAS v4u*)(vp + 128) = pack8(kk);
#pragma unroll
            for (int j = 0; j < 8; ++j) { tmp[j] = kk[j] * ic[j]; kkar += tmp[j] * r[j]; }
            *(GAS v4u*)(vp + 192) = pack8(tmp);
#pragma unroll
            for (int j = 0; j < 8; ++j) tmp[j] = w[j] * r[j];
            *(GAS v4u*)(vp + 256) = pack8(tmp); *(GAS v4u*)(vp + 320) = vraw;
            kr = red8(kr); kkar = red8(kkar);
            if (l8 == 0) *(GAS f32x2*)(SCAL + (sidx * LTOK + s) * 2) = (f32x2){kr, kkar};
        }
        ld8f(r_k + c0, par); float bon = 0.f;
#pragma unroll
        for (int j = 0; j < 8; ++j) bon += r[j] * kdsum[j] * par[j];
        bon = red8(bon);
        if (l8 == 0) BONUS[m * 32 + h] = bon;
    }
}
constexpr int RW_CS = 32;
__device__ __forceinline__ void l0_scan_phase(Frame& F) {
    unsigned char* ws = F.ws; const bf16* VEC = (const bf16*)(ws + L0_VEC); const float* SCAL = (const float*)(ws + L0_SCAL); float* YS = (float*)(ws + L0_YS);
    LAS float* opb = (LAS float*)(F.lds + RING_OFF);
    LAS float* scl = opb + 2 * RW_CS * 384;
    LAS float* ybuf = scl + 2 * RW_CS * 2;
    const int rp = F.tid >> 4, q = F.tid & 15; constexpr int NCH = LTOK / RW_CS;
    for (int sidx = F.vcu; sidx < 256; sidx += F.G) {
        const int d = sidx >> 7, b = (sidx >> 5) & 3, h = sidx & 31;
        const GAS v4u* src = (const GAS v4u*)(VEC + (size_t)sidx * LTOK * 384); const GAS float* ssrc = (const GAS float*)(SCAL + (size_t)sidx * LTOK * 2);
        f32x2 Sa = {0.f, 0.f}, Sb = {0.f, 0.f}, Sc = {0.f, 0.f}, Sd = {0.f, 0.f};
        v4u pre[3]; float psc = 0.f;
#pragma unroll
        for (int k = 0; k < 3; ++k) pre[k] = src[F.tid + 512 * k];
        if (F.tid < RW_CS * 2) psc = ssrc[F.tid];
        __syncthreads();
#pragma unroll
        for (int k = 0; k < 3; ++k) { LAS float* dst = opb + (size_t)(F.tid + 512 * k) * 8; const v4u w = pre[k];
            *(LAS f32x4*)dst = (f32x4){bflo(w.x), bfhi(w.x), bflo(w.y), bfhi(w.y)}; *(LAS f32x4*)(dst + 4) = (f32x4){bflo(w.z), bfhi(w.z), bflo(w.w), bfhi(w.w)}; }
        if (F.tid < RW_CS * 2) scl[F.tid] = psc;
        __syncthreads();
        for (int ch = 0; ch < NCH; ++ch) {
            const int cur = ch & 1;
            if (ch + 1 < NCH) {
#pragma unroll
                for (int k = 0; k < 3; ++k) pre[k] = src[(size_t)(ch + 1) * (RW_CS * 48) + F.tid + 512 * k];
                if (F.tid < RW_CS * 2) psc = ssrc[(ch + 1) * RW_CS * 2 + F.tid]; }
            const LAS float* ob = opb + cur * RW_CS * 384; const LAS float* sb = scl + cur * RW_CS * 2;
            const LAS float* o0 = ob + q * 4; const LAS float* ov = ob + 320 + 2 * rp;
            f32x4 w4 = *(const LAS f32x4*)(o0), k4 = *(const LAS f32x4*)(o0 + 64), c4 = *(const LAS f32x4*)(o0 + 128), a4 = *(const LAS f32x4*)(o0 + 192), r4 = *(const LAS f32x4*)(o0 + 256);
            f32x2 v2 = *(const LAS f32x2*)(ov), sc2 = *(const LAS f32x2*)(sb);
            LAS float* ydst = (q == 0) ? (ybuf + 2 * rp) : (ybuf + RW_CS * 64 + 2 * F.tid);
            const int ystep = (q == 0) ? 64 : 0;
#pragma unroll 4
            for (int s = 0; s < RW_CS; ++s) {
                const int sn = (s + 1 < RW_CS) ? s + 1 : s;
                const LAS float* o = o0 + sn * 384;
                const f32x4 w4n = *(const LAS f32x4*)(o), k4n = *(const LAS f32x4*)(o + 64), c4n = *(const LAS f32x4*)(o + 128), a4n = *(const LAS f32x4*)(o + 192), r4n = *(const LAS f32x4*)(o + 256);
                const f32x2 v2n = *(const LAS f32x2*)(ov + sn * 384), sc2n = *(const LAS f32x2*)(sb + sn * 2);
                f32x2 sa = Sa * c4.x; sa = Sb * c4.y + sa; sa = Sc * c4.z + sa; sa = Sd * c4.w + sa;
                f32x2 yy = Sa * r4.x; yy = Sb * r4.y + yy; yy = Sc * r4.z + yy; yy = Sd * r4.w + yy;
                float sa0 = sa.x, sa1 = sa.y, y0 = yy.x, y1 = yy.y;
                asm volatile("s_nop 1\n\t"
                    "v_add_f32_dpp %0, %0, %0 quad_perm:[1,0,3,2] row_mask:0xf bank_mask:0xf bound_ctrl:1\n\t" "v_add_f32_dpp %1, %1, %1 quad_perm:[1,0,3,2] row_mask:0xf bank_mask:0xf bound_ctrl:1\n\t"
                    "v_add_f32_dpp %2, %2, %2 quad_perm:[1,0,3,2] row_mask:0xf bank_mask:0xf bound_ctrl:1\n\t" "v_add_f32_dpp %3, %3, %3 quad_perm:[1,0,3,2] row_mask:0xf bank_mask:0xf bound_ctrl:1\n\t"
                    "v_add_f32_dpp %0, %0, %0 quad_perm:[2,3,0,1] row_mask:0xf bank_mask:0xf bound_ctrl:1\n\t" "v_add_f32_dpp %1, %1, %1 quad_perm:[2,3,0,1] row_mask:0xf bank_mask:0xf bound_ctrl:1\n\t"
                    "v_add_f32_dpp %2, %2, %2 quad_perm:[2,3,0,1] row_mask:0xf bank_mask:0xf bound_ctrl:1\n\t" "v_add_f32_dpp %3, %3, %3 quad_perm:[2,3,0,1] row_mask:0xf bank_mask:0xf bound_ctrl:1\n\t"
                    "v_add_f32_dpp %0, %0, %0 row_half_mirror row_mask:0xf bank_mask:0xf bound_ctrl:1\n\t" "v_add_f32_dpp %1, %1, %1 row_half_mirror row_mask:0xf bank_mask:0xf bound_ctrl:1\n\t"
                    "v_add_f32_dpp %2, %2, %2 row_half_mirror row_mask:0xf bank_mask:0xf bound_ctrl:1\n\t" "v_add_f32_dpp %3, %3, %3 row_half_mirror row_mask:0xf bank_mask:0xf bound_ctrl:1\n\t"
                    "v_add_f32_dpp %0, %0, %0 row_mirror row_mask:0xf bank_mask:0xf bound_ctrl:1\n\t" "v_add_f32_dpp %1, %1, %1 row_mirror row_mask:0xf bank_mask:0xf bound_ctrl:1\n\t"
                    "v_add_f32_dpp %2, %2, %2 row_mirror row_mask:0xf bank_mask:0xf bound_ctrl:1\n\t" "v_add_f32_dpp %3, %3, %3 row_mirror row_mask:0xf bank_mask:0xf bound_ctrl:1\n\t"
                    "s_nop 0"
                    : "+v"(sa0), "+v"(sa1), "+v"(y0), "+v"(y1));
                sa = (f32x2){sa0, sa1}; yy = (f32x2){y0, y1};
                yy = yy + (v2 * sc2.x - sa * sc2.y);
                Sa = Sa * w4.x + (v2 * k4.x - sa * a4.x); Sb = Sb * w4.y + (v2 * k4.y - sa * a4.y); Sc = Sc * w4.z + (v2 * k4.z - sa * a4.z); Sd = Sd * w4.w + (v2 * k4.w - sa * a4.w);
                *(LAS f32x2*)(ydst + s * ystep) = yy;
                w4 = w4n; k4 = k4n; c4 = c4n; a4 = a4n; r4 = r4n; v2 = v2n; sc2 = sc2n;
            }
            __syncthreads();
            {
                const int s = F.tid >> 4, i4 = (F.tid & 15) * 4; const int step = ch * RW_CS + s; const int t = d ? flip_tok(step) : step;
                const f32x4 yv = *(const LAS f32x4*)(ybuf + s * 64 + i4);
                *(GAS f32x4*)(YS + ((size_t)d * NTOK + (size_t)b * LTOK + t) * DM + h * 64 + i4) = yv; }
            if (ch + 1 < NCH) {
                LAS float* nb = opb + (cur ^ 1) * RW_CS * 384;
#pragma unroll
                for (int k = 0; k < 3; ++k) { LAS float* dst = nb + (size_t)(F.tid + 512 * k) * 8; const v4u w = pre[k];
                    *(LAS f32x4*)dst = (f32x4){bflo(w.x), bfhi(w.x), bflo(w.y), bfhi(w.y)}; *(LAS f32x4*)(dst + 4) = (f32x4){bflo(w.z), bfhi(w.z), bflo(w.w), bfhi(w.w)}; }
                if (F.tid < RW_CS * 2) scl[(cur ^ 1) * RW_CS * 2 + F.tid] = psc; }
            __syncthreads();
        }
    }
}
__device__ __forceinline__ void l0_cscan_phase(Frame& F, const float* k_k, const float* k_a, const float* r_k) {
    unsigned char* ws = F.ws; float* YS = (float*)(ws + L0_XS); float* BON = (float*)(ws + L0_BONUS);
    constexpr int PA = 72, PB = 40, NCH = LTOK / 16;
    LAS bf16* RAW = (LAS bf16*)(F.lds + RING_OFF);
    LAS bf16* Ah = RAW + 5 * 16 * PA; LAS bf16* Rh = Ah + 16 * PA; LAS bf16* Kh = Rh + 16 * PA; LAS bf16* Bh = Kh + 16 * PA;
    LAS bf16* KBt = Bh + 16 * PA;
    LAS bf16* VSt = KBt + 64 * PB;
    LAS bf16* LKp = VSt + 64 * PB;
    LAS bf16* UKB = LKp + 16 * PB;
    LAS bf16* Sb = UKB + 16 * PB;
    LAS float* LB = (LAS float*)(Sb + 64 * PA);
    LAS float* RH = LB + 16 * 20;
    LAS float* Wend = RH + 16 * 68;
    const int tid = F.tid, lane = F.lane, w = F.wave;
    for (int sidx = F.vcu; sidx < 256; sidx += F.G) {
        const int d = sidx >> 7, b = (sidx >> 5) & 3, h = sidx & 31;
        const GAS bf16* gR = (const GAS bf16*)(ws + L0_R) + (size_t)b * LTOK * DM + h * 64;
        const GAS bf16* gK = (const GAS bf16*)(ws + L0_K) + (size_t)b * LTOK * DM + h * 64;
        const GAS bf16* gV = (const GAS bf16*)(ws + L0_V) + (size_t)b * LTOK * DM + h * 64;
        const GAS bf16* gD = (const GAS bf16*)(ws + (d ? L0_DEC1 : L0_DEC0)) + (size_t)b * LTOK * DM + h * 64;
        const GAS bf16* gI = (const GAS bf16*)(ws + (d ? L0_IC1 : L0_IC0)) + (size_t)b * LTOK * DM + h * 64;
        const int ft = tid >> 5, fpart = tid & 31, fti = fpart >> 3, fc = (fpart & 7) * 8;
        const GAS bf16* fbase = fti == 0 ? gR : (fti == 1 ? gK : (fti == 2 ? gV : gD));
        const int t1 = tid >> 5, jp = tid & 31, j2 = 2 * jp;
        const f32x2 kk2 = *(const f32x2*)(k_k + h * 64 + j2), ka2 = *(const f32x2*)(k_a + h * 64 + j2), rk2 = *(const f32x2*)(r_k + h * 64 + j2);
        __syncthreads();
        for (int i = tid; i < 64 * PA / 2; i += 512) ((LAS unsigned*)Sb)[i] = 0u;
        for (int i = tid; i < 64 * PB / 2; i += 512) ((LAS unsigned*)VSt)[i] = 0u;
        for (int i = tid; i < 16 * PB / 2; i += 512) ((LAS unsigned*)LKp)[i] = 0u;
        pg8::f32x4 ST[2]; ST[0] = (pg8::f32x4){0.f, 0.f, 0.f, 0.f}; ST[1] = ST[0];
        v4u pa, pb = {0u, 0u, 0u, 0u};
#define CS_FETCH(chn) do { { const int step_ = (chn) * 16 + ft; const int tk_ = d ? flip_tok(step_) : step_; pa = *(const GAS v4u*)(fbase + (size_t)tk_ * DM + fc); } \
            if (tid < 128) { const int step_ = (chn) * 16 + (tid >> 3); const int tk_ = d ? flip_tok(step_) : step_; pb = *(const GAS v4u*)(gI + (size_t)tk_ * DM + (tid & 7) * 8); } } while (0)
        CS_FETCH(0);
        for (int ch = 0; ch < NCH; ++ch) {
            *(LAS v4u*)(RAW + (fti * 16 + ft) * PA + fc) = pa;
            if (tid < 128) *(LAS v4u*)(RAW + (4 * 16 + (tid >> 3)) * PA + (tid & 7) * 8) = pb;
            if (ch + 1 < NCH) CS_FETCH(ch + 1);
            LDS_BARRIER();
            {
                const unsigned rw = *(const LAS unsigned*)(RAW + (0 * 16 + t1) * PA + j2), kw = *(const LAS unsigned*)(RAW + (1 * 16 + t1) * PA + j2), vw = *(const LAS unsigned*)(RAW + (2 * 16 + t1) * PA + j2);
                const unsigned iw = *(const LAS unsigned*)(RAW + (4 * 16 + t1) * PA + j2);
                const f32x2 r = {bflo(rw), bfhi(rw)}, k = {bflo(kw), bfhi(kw)}, ic = {bflo(iw), bfhi(iw)};
                f32x2 kkv = k * kk2; float ss = kkv.x * kkv.x + kkv.y * kkv.y; ss = red16(ss); ss += __shfl_xor(ss, 16);
                kkv = kkv * (1.0f / sqrtf(ss + 1e-12f));
                const f32x2 kd = k * ((ic - 1.f) * ka2 + 1.f), kka = kkv * ic;
                float bon = r.x * kd.x * rk2.x + r.y * kd.y * rk2.y; bon = red16(bon); bon += __shfl_xor(bon, 16);
                const int step = ch * 16 + t1; const int tk = d ? flip_tok(step) : step;
                if (jp == 0) BON[((size_t)d * NTOK + (size_t)b * LTOK + tk) * 32 + h] = bon;
                f32x2 Wm = {1.f, 1.f};
#pragma unroll
                for (int u = 0; u < 15; ++u) { const unsigned dw = *(const LAS unsigned*)(RAW + (3 * 16 + u) * PA + j2); if (u < t1) { Wm.x *= bflo(dw); Wm.y *= bfhi(dw); } }
                const unsigned dwt = *(const LAS unsigned*)(RAW + (3 * 16 + t1) * PA + j2);
                const f32x2 Wt = {Wm.x * bflo(dwt), Wm.y * bfhi(dwt)}; const f32x2 iW = {__builtin_amdgcn_rcpf(Wt.x), __builtin_amdgcn_rcpf(Wt.y)};
                const f32x2 ah = kkv * Wm, bh = kka * iW, kh = kd * iW, rh = r * Wt;
                *(LAS unsigned*)(Ah + t1 * PA + j2) = pk2(ah.x, ah.y); *(LAS unsigned*)(Rh + t1 * PA + j2) = pk2(rh.x, rh.y);
                *(LAS unsigned*)(Kh + t1 * PA + j2) = pk2(kh.x, kh.y); *(LAS unsigned*)(Bh + t1 * PA + j2) = pk2(bh.x, bh.y);
                const unsigned khw = pk2(kh.x, kh.y), nbw = pk2(-bh.x, -bh.y);
                KBt[j2 * PB + t1] = (bf16)(khw & 0xffff); KBt[(j2 + 1) * PB + t1] = (bf16)(khw >> 16);
                KBt[j2 * PB + 16 + t1] = (bf16)(nbw & 0xffff); KBt[(j2 + 1) * PB + 16 + t1] = (bf16)(nbw >> 16);
                VSt[j2 * PB + t1] = (bf16)(vw & 0xffff); VSt[(j2 + 1) * PB + t1] = (bf16)(vw >> 16);
                if (t1 == 15) *(LAS f32x2*)(Wend + j2) = Wt;
            }
            LDS_BARRIER();
            pg8::f32x4 accg = {0.f, 0.f, 0.f, 0.f};
            const int tr = (lane >> 4) * 4, uc = lane & 15;
            if (w < 4) {
                pg8::f32x4 a = {0.f, 0.f, 0.f, 0.f};
                a = mma_tile(a, (w < 2) ? Ah : Rh, PA, (w == 0 || w == 3) ? Bh : Kh, PA, 2, lane);
#pragma unroll
                for (int r = 0; r < 4; ++r) { const int t = tr + r; const float x = a[r];
                    if (w == 0) LB[uc * 20 + t] = (uc < t) ? x : 0.f;
                    else if (w == 1) LKp[t * PB + uc] = f2bf((uc < t) ? x : 0.f);
                    else if (w == 2) UKB[t * PB + uc] = f2bf((uc <= t) ? x : 0.f);
                    else UKB[t * PB + 16 + uc] = f2bf((uc <= t) ? -x : 0.f); }
            } else accg = mma_tile(accg, Ah, PA, Sb + (w - 4) * 16 * PA, PA, 2, lane);
            LDS_BARRIER();
            pg8::f32x4 accy = {0.f, 0.f, 0.f, 0.f};
            if (w >= 4) { accg = mma_tile(accg, LKp, PB, VSt + (w - 4) * 16 * PB, PB, 1, lane);
#pragma unroll
                for (int r = 0; r < 4; ++r) RH[(tr + r) * 68 + (w - 4) * 16 + uc] = accg[r]; }
            else accy = mma_tile(accy, Rh, PA, Sb + w * 16 * PA, PA, 2, lane);
            LDS_BARRIER();
            if (w == 7) {
                float sg[16];
#pragma unroll
                for (int t = 0; t < 16; ++t) sg[t] = RH[t * 68 + lane];
#pragma unroll
                for (int u = 0; u < 15; ++u) {
#pragma unroll
                    for (int g4 = (u + 1) / 4; g4 < 4; ++g4) { const pg8::f32x4 l4 = *(const LAS pg8::f32x4*)(LB + u * 20 + g4 * 4);
#pragma unroll
                        for (int r = 0; r < 4; ++r) { const int t = g4 * 4 + r; if (t > u) sg[t] -= l4[r] * sg[u]; } } }
                v4u o; o.x = pk2(sg[0], sg[1]); o.y = pk2(sg[2], sg[3]); o.z = pk2(sg[4], sg[5]); o.w = pk2(sg[6], sg[7]); *(LAS v4u*)(VSt + lane * PB + 16) = o;
                o.x = pk2(sg[8], sg[9]); o.y = pk2(sg[10], sg[11]); o.z = pk2(sg[12], sg[13]); o.w = pk2(sg[14], sg[15]); *(LAS v4u*)(VSt + lane * PB + 24) = o;
            }
            LDS_BARRIER();
            if (w < 4) { accy = mma_tile(accy, UKB, PB, VSt + w * 16 * PB, PB, 1, lane);
#pragma unroll
                for (int r = 0; r < 4; ++r) { const int step = ch * 16 + tr + r; const int tk = d ? flip_tok(step) : step;
                    YS[((size_t)d * NTOK + (size_t)b * LTOK + tk) * DM + h * 64 + w * 16 + uc] = accy[r]; } }
            { const int jb = w >> 1; const pg8::f32x4 we = *(const LAS pg8::f32x4*)(Wend + jb * 16 + tr);
#pragma unroll
              for (int q = 0; q < 2; ++q) { const int ib = (w & 1) * 2 + q;
                  pg8::f32x4 a = mma_tile(ST[q], KBt + jb * 16 * PB, PB, VSt + ib * 16 * PB, PB, 1, lane);
                  a = a * we; ST[q] = a;
                  v2u sw; sw.x = pk2(a[0], a[1]); sw.y = pk2(a[2], a[3]);
                  *(LAS v2u*)(Sb + (ib * 16 + uc) * PA + jb * 16 + tr) = sw; } }
            LDS_BARRIER();
        }
#undef CS_FETCH
    }
}
__device__ __forceinline__ void l0_cscan2_phase(Frame& F, const float* k_k, const float* k_a, const float* r_k) {
    unsigned char* ws = F.ws; bf16* YS = (bf16*)(ws + L0_XS); float* BON = (float*)(ws + L0_BONUS);
    constexpr int PA = 72, PB = 40, NCH = LTOK / 16;
    constexpr int O_AH = 0, O_RH = 16 * PA, O_KH = 32 * PA, O_BH = 48 * PA, O_KBT = 64 * PA, O_VST = O_KBT + 64 * PB, O_LKP = O_VST + 64 * PB, O_UKB = O_LKP + 16 * PB, SETSZ = O_UKB + 16 * PB;
    static_assert(SETSZ % 8 == 0, "set size keeps 16-byte alignment");
    constexpr int FSZ = 320 + 16 * 64;
    LAS bf16* SET = (LAS bf16*)(F.lds + RING_OFF);
    LAS bf16* RAW = SET + 2 * SETSZ;
    LAS bf16* Sb = RAW + 4 * 16 * PA;
    LAS float* FSET = (LAS float*)(Sb + 64 * PA);
    LAS float* RH = FSET + 2 * FSZ;
    const int tid = F.tid, lane = F.lane, w = F.wave;
    const int tr = (lane >> 4) * 4, uc = lane & 15;
    for (int sidx = F.vcu; sidx < 256; sidx += F.G) {
        const int d = sidx >> 7, b = (sidx >> 5) & 3, h = sidx & 31;
        const GAS bf16* gR = (const GAS bf16*)(ws + L0_R) + (size_t)b * LTOK * DM + h * 64;
        const GAS bf16* gK = (const GAS bf16*)(ws + L0_K) + (size_t)b * LTOK * DM + h * 64;
        const GAS bf16* gV = (const GAS bf16*)(ws + L0_V) + (size_t)b * LTOK * DM + h * 64;
        const GAS bf16* gD = (const GAS bf16*)(ws + (d ? L0_DEC1 : L0_DEC0)) + (size_t)b * LTOK * DM + h * 64;
        const GAS bf16* gI = (const GAS bf16*)(ws + (d ? L0_IC1 : L0_IC0)) + (size_t)b * LTOK * DM + h * 64;
        const int ft = tid >> 5, fpart = tid & 31, fti = fpart >> 3, fc = (fpart & 7) * 8;
        const GAS bf16* fbase = fti == 0 ? gR : (fti == 1 ? gK : (fti == 2 ? gV : gI));
        const int t1 = (tid >> 4) & 15, j4 = (tid & 15) * 4;
        const f32x4 kk4 = *(const f32x4*)(k_k + h * 64 + j4), ka4 = *(const f32x4*)(k_a + h * 64 + j4), rk4 = *(const f32x4*)(r_k + h * 64 + j4);
        __syncthreads();
        for (int i = tid; i < 64 * PA / 2; i += 512) ((LAS unsigned*)Sb)[i] = 0u;
        for (int i = tid; i < 2 * SETSZ / 2; i += 512) ((LAS unsigned*)SET)[i] = 0u;
        pg8::f32x4 ST[2]; ST[0] = (pg8::f32x4){0.f, 0.f, 0.f, 0.f}; ST[1] = ST[0];
        v4u pa; bf16 dq[16];
#define CS_FETCH(chn) do { { const int step_ = (chn) * 16 + ft; const int tk_ = d ? flip_tok(step_) : step_; pa = *(const GAS v4u*)(fbase + (size_t)tk_ * DM + fc); } \
            if (w == 4) { _Pragma("unroll") for (int t_ = 0; t_ < 16; ++t_) { const int step_ = (chn) * 16 + t_; const int tk_ = d ? flip_tok(step_) : step_; dq[t_] = gD[(size_t)tk_ * DM + lane]; } } } while (0)
#define CS_RAWWRITE(st) do { *(LAS v4u*)(RAW + (fti * 16 + ft) * PA + fc) = pa; \
            if (w == 4) { float W_ = 1.f; LAS float* wc_ = FSET + (st) * FSZ + 320 + lane; _Pragma("unroll") for (int t_ = 0; t_ < 16; ++t_) { W_ *= bf2f(dq[t_]); wc_[t_ * 64] = W_; } } } while (0)
#define CS_STEP1(chn, st) do { LAS bf16* S_ = SET + (st) * SETSZ; const LAS float* wc_ = FSET + (st) * FSZ + 320; \
            const v2u rw = *(const LAS v2u*)(RAW + (0 * 16 + t1) * PA + j4), kw = *(const LAS v2u*)(RAW + (1 * 16 + t1) * PA + j4), vw = *(const LAS v2u*)(RAW + (2 * 16 + t1) * PA + j4), iw = *(const LAS v2u*)(RAW + (3 * 16 + t1) * PA + j4); \
            const f32x4 r = {bflo(rw.x), bfhi(rw.x), bflo(rw.y), bfhi(rw.y)}, k = {bflo(kw.x), bfhi(kw.x), bflo(kw.y), bfhi(kw.y)}, ic = {bflo(iw.x), bfhi(iw.x), bflo(iw.y), bfhi(iw.y)}; \
            const f32x4 Wt = *(const LAS f32x4*)(wc_ + t1 * 64 + j4); f32x4 Wm = {1.f, 1.f, 1.f, 1.f}; if (t1 > 0) Wm = *(const LAS f32x4*)(wc_ + (t1 - 1) * 64 + j4); \
            f32x4 kkv = k * kk4; float ss = (kkv.x * kkv.x + kkv.y * kkv.y) + (kkv.z * kkv.z + kkv.w * kkv.w); \
            const f32x4 kd = k * ((ic - 1.f) * ka4 + 1.f); const f32x4 bt = r * kd * rk4; float bon = (bt.x + bt.y) + (bt.z + bt.w); \
            ss = red16(ss); bon = red16(bon); \
            kkv = kkv * __builtin_amdgcn_rsqf(ss + 1e-12f); const f32x4 kka = kkv * ic; \
            const int step = (chn) * 16 + t1; const int tk = d ? flip_tok(step) : step; \
            if ((tid & 15) == 0) BON[((size_t)d * NTOK + (size_t)b * LTOK + tk) * 32 + h] = bon; \
            const f32x4 iW = {__builtin_amdgcn_rcpf(Wt.x), __builtin_amdgcn_rcpf(Wt.y), __builtin_amdgcn_rcpf(Wt.z), __builtin_amdgcn_rcpf(Wt.w)}; \
            const f32x4 ah = kkv * Wm, bh = kka * iW, kh = kd * iW, rh = r * Wt; \
            v2u o_; o_.x = pk2(ah.x, ah.y); o_.y = pk2(ah.z, ah.w); *(LAS v2u*)(S_ + O_AH + t1 * PA + j4) = o_; \
            o_.x = pk2(rh.x, rh.y); o_.y = pk2(rh.z, rh.w); *(LAS v2u*)(S_ + O_RH + t1 * PA + j4) = o_; \
            v2u kh_; kh_.x = pk2(kh.x, kh.y); kh_.y = pk2(kh.z, kh.w); *(LAS v2u*)(S_ + O_KH + t1 * PA + j4) = kh_; \
            o_.x = pk2(bh.x, bh.y); o_.y = pk2(bh.z, bh.w); *(LAS v2u*)(S_ + O_BH + t1 * PA + j4) = o_; \
            v2u nb_; nb_.x = pk2(-bh.x, -bh.y); nb_.y = pk2(-bh.z, -bh.w); \
            LAS bf16* kb_ = S_ + O_KBT + j4 * PB + t1; LAS bf16* vs_ = S_ + O_VST + j4 * PB + t1; \
            kb_[0] = (bf16)(kh_.x & 0xffff); kb_[PB] = (bf16)(kh_.x >> 16); kb_[2 * PB] = (bf16)(kh_.y & 0xffff); kb_[3 * PB] = (bf16)(kh_.y >> 16); \
            kb_[16] = (bf16)(nb_.x & 0xffff); kb_[PB + 16] = (bf16)(nb_.x >> 16); kb_[2 * PB + 16] = (bf16)(nb_.y & 0xffff); kb_[3 * PB + 16] = (bf16)(nb_.y >> 16); \
            vs_[0] = (bf16)(vw.x & 0xffff); vs_[PB] = (bf16)(vw.x >> 16); vs_[2 * PB] = (bf16)(vw.y & 0xffff); vs_[3 * PB] = (bf16)(vw.y >> 16); } while (0)
#define CS_STEP2(wq, st) do { LAS bf16* S_ = SET + (st) * SETSZ; LAS float* LB_ = FSET + (st) * FSZ; pg8::f32x4 a = {0.f, 0.f, 0.f, 0.f}; \
            a = mma_tile(a, S_ + (((wq) < 2) ? O_AH : O_RH), PA, S_ + (((wq) == 0 || (wq) == 3) ? O_BH : O_KH), PA, 2, lane); \
            _Pragma("unroll") for (int r = 0; r < 4; ++r) { const int t = tr + r; const float x = a[r]; \
                if ((wq) == 0) LB_[uc * 20 + t] = (uc < t) ? x : 0.f; \
                else if ((wq) == 1) S_[O_LKP + t * PB + uc] = f2bf((uc < t) ? x : 0.f); \
                else if ((wq) == 2) S_[O_UKB + t * PB + uc] = f2bf((uc <= t) ? x : 0.f); \
                else S_[O_UKB + t * PB + 16 + uc] = f2bf((uc <= t) ? -x : 0.f); } } while (0)
        CS_FETCH(0); CS_RAWWRITE(0); CS_FETCH(1);
        LDS_BARRIER();
        if (w < 4) CS_STEP1(0, 0);
        LDS_BARRIER();
        if (w < 4) CS_STEP2(w, 0);
        LDS_BARRIER();
        asm volatile("" : "+v"(pa));
        for (int ch = 0; ch < NCH; ++ch) {
            const int cur = ch & 1, nxt = cur ^ 1; LAS bf16* C_ = SET + cur * SETSZ; LAS float* FC_ = FSET + cur * FSZ;
            if (ch + 1 < NCH) { CS_RAWWRITE(nxt); if (ch + 2 < NCH) CS_FETCH(ch + 2); }
            pg8::f32x4 accy = {0.f, 0.f, 0.f, 0.f};
            if (w >= 4) { pg8::f32x4 accg = {0.f, 0.f, 0.f, 0.f};
                accg = mma_tile(accg, C_ + O_AH, PA, Sb + (w - 4) * 16 * PA, PA, 2, lane);
                accg = mma_tile(accg, C_ + O_LKP, PB, C_ + O_VST + (w - 4) * 16 * PB, PB, 1, lane);
#pragma unroll
                for (int r = 0; r < 4; ++r) RH[(tr + r) * 68 + (w - 4) * 16 + uc] = accg[r]; }
            else accy = mma_tile(accy, C_ + O_RH, PA, Sb + w * 16 * PA, PA, 2, lane);
            LDS_BARRIER();
            if (w == 7) {
                float sg[16];
#pragma unroll
                for (int t = 0; t < 16; ++t) sg[t] = RH[t * 68 + lane];
#pragma unroll
                for (int u = 0; u < 15; ++u) {
#pragma unroll
                    for (int g4 = (u + 1) / 4; g4 < 4; ++g4) { const pg8::f32x4 l4 = *(const LAS pg8::f32x4*)(FC_ + u * 20 + g4 * 4);
#pragma unroll
                        for (int r = 0; r < 4; ++r) { const int t = g4 * 4 + r; if (t > u) sg[t] -= l4[r] * sg[u]; } } }
                v4u o; o.x = pk2(sg[0], sg[1]); o.y = pk2(sg[2], sg[3]); o.z = pk2(sg[4], sg[5]); o.w = pk2(sg[6], sg[7]); *(LAS v4u*)(C_ + O_VST + lane * PB + 16) = o;
                o.x = pk2(sg[8], sg[9]); o.y = pk2(sg[10], sg[11]); o.z = pk2(sg[12], sg[13]); o.w = pk2(sg[14], sg[15]); *(LAS v4u*)(C_ + O_VST + lane * PB + 24) = o;
            } else if (w < 4 && ch + 1 < NCH) CS_STEP1(ch + 1, nxt);
            LDS_BARRIER();
            { const int jb = w >> 1, ib0 = (w & 1) * 2; const pg8::f32x4 we = *(const LAS pg8::f32x4*)(FC_ + 320 + 15 * 64 + jb * 16 + tr);
              if (w < 4) accy = mma_tile(accy, C_ + O_UKB, PB, C_ + O_VST + w * 16 * PB, PB, 1, lane);
              pg8::f32x4 a0 = mma_tile(ST[0], C_ + O_KBT + jb * 16 * PB, PB, C_ + O_VST + ib0 * 16 * PB, PB, 1, lane);
              pg8::f32x4 a1 = mma_tile(ST[1], C_ + O_KBT + jb * 16 * PB, PB, C_ + O_VST + (ib0 + 1) * 16 * PB, PB, 1, lane);
              pg8::f32x4 a2 = {0.f, 0.f, 0.f, 0.f}; const int wq = w - 4; LAS bf16* N_ = SET + nxt * SETSZ; LAS float* LBn = FSET + nxt * FSZ;
              const bool do2 = (w >= 4 && ch + 1 < NCH);
              if (do2) a2 = mma_tile(a2, N_ + ((wq < 2) ? O_AH : O_RH), PA, N_ + ((wq == 0 || wq == 3) ? O_BH : O_KH), PA, 2, lane);
              a0 = a0 * we; a1 = a1 * we; ST[0] = a0; ST[1] = a1;
              asm volatile("" : "+v"(pa));
              if (w < 4) {
#pragma unroll
                  for (int r = 0; r < 4; ++r) { const int step = ch * 16 + tr + r; const int tk = d ? flip_tok(step) : step;
                      YS[((size_t)d * NTOK + (size_t)b * LTOK + tk) * DM + h * 64 + w * 16 + uc] = f2bf(accy[r]); } }
              v2u sw; sw.x = pk2(a0[0], a0[1]); sw.y = pk2(a0[2], a0[3]); *(LAS v2u*)(Sb + (ib0 * 16 + uc) * PA + jb * 16 + tr) = sw;
              sw.x = pk2(a1[0], a1[1]); sw.y = pk2(a1[2], a1[3]); *(LAS v2u*)(Sb + ((ib0 + 1) * 16 + uc) * PA + jb * 16 + tr) = sw;
              if (do2) {
#pragma unroll
                  for (int r = 0; r < 4; ++r) { const int t = tr + r; const float x = a2[r];
                      if (wq == 0) LBn[uc * 20 + t] = (uc < t) ? x : 0.f;
                      else if (wq == 1) N_[O_LKP + t * PB + uc] = f2bf((uc < t) ? x : 0.f);
                      else if (wq == 2) N_[O_UKB + t * PB + uc] = f2bf((uc <= t) ? x : 0.f);
                      else N_[O_UKB + t * PB + 16 + uc] = f2bf((uc <= t) ? -x : 0.f); } } }
            LDS_BARRIER();
        }
#undef CS_FETCH
#undef CS_RAWWRITE
#undef CS_STEP1
#undef CS_STEP2
    }
}
__device__ __forceinline__ void l0_post_phase(Frame& F, const float* gn_g, const float* gn_b) {
    const int gw = GW(F), NGWv = NGW(F); unsigned char* ws = F.ws;
    const bf16* YS = (const bf16*)(ws + L0_XS); const bf16* V = (const bf16*)(ws + L0_V); const bf16* G = (const bf16*)(ws + L0_G); const float* BONUS = (const float*)(ws + L0_BONUS);
    bf16* OUTB = (bf16*)(ws + WS_OUTB); const int l8 = F.lane & 7;
    const int hh = (gw & 3) * 8 + (F.lane >> 3), c0 = hh * 64 + l8 * 8;
    float gg[8], gb[8]; ld8f(gn_g + c0, gg); ld8f(gn_b + c0, gb);
    constexpr int UB = 3;
    for (int it0 = gw; it0 < NTOK * 4; it0 += UB * NGWv) {
        v4u wya[UB], wyb[UB], wv[UB], wg[UB]; float b0[UB], b1[UB];
#pragma unroll
        for (int u = 0; u < UB; ++u) { const int it = it0 + u * NGWv; if (it < NTOK * 4) { const int m = it >> 2; const size_t e = (size_t)m * DM + c0;
            wya[u] = *(const GAS v4u*)(YS + e); wyb[u] = *(const GAS v4u*)(YS + (size_t)NTOK * DM + e); wv[u] = *(const GAS v4u*)(V + e); wg[u] = *(const GAS v4u*)(G + e);
            b0[u] = *(const GAS float*)(BONUS + m * 32 + hh); b1[u] = *(const GAS float*)(BONUS + (size_t)NTOK * 32 + m * 32 + hh); } }
#pragma unroll
        for (int u = 0; u < UB; ++u) { const int it = it0 + u * NGWv; if (it < NTOK * 4) { const int m = it >> 2; const size_t e = (size_t)m * DM + c0;
            float y[8], y2[8], v[8], g[8];
            { float ya[8], yb[8]; unpack8(wya[u], ya); unpack8(wyb[u], yb);
#pragma unroll
              for (int j = 0; j < 8; ++j) y[j] = ya[j] + yb[j]; }
            unpack8(wv[u], v); unpack8(wg[u], g);
            float s = 0.f;
#pragma unroll
            for (int j = 0; j < 8; ++j) s += y[j];
            const float mean = red8(s) * (1.f / 64.f); float q2 = 0.f;
#pragma unroll
            for (int j = 0; j < 8; ++j) { y[j] -= mean; q2 += y[j] * y[j]; }
            const float rstd = 1.0f / sqrtf(red8(q2) * (1.f / 64.f) + 64e-5f);
            const float bon = b0[u] + b1[u];
#pragma unroll
            for (int j = 0; j < 8; ++j) y2[j] = ((y[j] * rstd) * gg[j] + gb[j] + bon * v[j]) * g[j];
            *(GAS v4u*)(OUTB + e) = pack8(y2); } }
    }
}

__device__ __forceinline__ void l1_rope_phase(Frame& F) {
    bf16* QKV = (bf16*)(F.ws + L1_QKV); const float* RT = (const float*)(F.ws + WS_ROPE);
    const size_t total = (size_t)NLAT * 256; const size_t stride = (size_t)F.G * 512;
    for (size_t it = (size_t)F.vcu * 512 + F.tid; it < total; it += stride) {
        const int idx = (int)(it >> 8), sub = (int)(it & 255); const int hd = sub >> 3, ax = (sub >> 2) & 1, g8 = sub & 3;
        const int b = idx >> 11, t = NCTX + (idx & 2047); const size_t m = (size_t)b * LTOK + t;
        bf16* pa = QKV + m * 6144 + hd * 128 + ax * 64 + g8 * 8; bf16* pb = pa + 32;
        const v4u wa = *(const GAS v4u*)pa, wb = *(const GAS v4u*)pb;
        const float* cs = RT + ((size_t)t * 64 + ax * 32 + g8 * 8) * 2;
        float a[8] = {bflo(wa.x), bfhi(wa.x), bflo(wa.y), bfhi(wa.y), bflo(wa.z), bfhi(wa.z), bflo(wa.w), bfhi(wa.w)};
        float bb[8] = {bflo(wb.x), bfhi(wb.x), bflo(wb.y), bfhi(wb.y), bflo(wb.z), bfhi(wb.z), bflo(wb.w), bfhi(wb.w)};
        float oa[8], ob[8];
#pragma unroll
        for (int j = 0; j < 8; ++j) { const f32x2 c = *(const GAS f32x2*)(cs + 2 * j); oa[j] = a[j] * c.x - bb[j] * c.y; ob[j] = bb[j] * c.x + a[j] * c.y; }
        v4u w; w.x = pk2(oa[0], oa[1]); w.y = pk2(oa[2], oa[3]); w.z = pk2(oa[4], oa[5]); w.w = pk2(oa[6], oa[7]); *(GAS v4u*)pa = w;
        w.x = pk2(ob[0], ob[1]); w.y = pk2(ob[2], ob[3]); w.z = pk2(ob[4], ob[5]); w.w = pk2(ob[6], ob[7]); *(GAS v4u*)pb = w;
    }
}
__device__ __forceinline__ void l1_attn_phase(Frame& F, char* lds_generic) {
    const att::bf16* QKV = (const att::bf16*)(F.ws + L1_QKV); bf16* O = (bf16*)(F.ws + L1_O);
    constexpr int NLONG = NB * 16 * 2 * 8, NSHORT = NB * 16 * 2;
    for (int u = F.vcu; u < NLONG + NSHORT; u += F.G) {
        int b, hm, vh, qb, seq;
        if (u < NLONG) { qb = 1 + (u & 7); vh = (u >> 3) & 1; hm = (u >> 4) & 15; b = u >> 8; seq = LTOK; }
        else { const int v = u - NLONG; qb = 0; vh = v & 1; hm = (v >> 1) & 15; b = v >> 5; seq = NCTX; }
        const size_t m0 = (size_t)b * LTOK + (size_t)qb * 256, k0 = (size_t)b * LTOK;
        att::attn_dense_body<att::bf16>(QKV + m0 * 6144 + hm * 128, QKV + k0 * 6144 + 2048 + hm * 128, QKV + k0 * 6144 + 4096 + (hm >> 1) * 256 + vh * 128,
                                        O + m0 * 4096 + hm * 256 + vh * 128, seq, lds_generic);
        __syncthreads();
    }
}
__device__ __forceinline__ void l1_combine_phase(Frame& F, const float* lam_vec, const float* sub_g) {
    const int gw = GW(F), NGWv = NGW(F); const bf16* O = (const bf16*)(F.ws + L1_O); bf16* OUTB = (bf16*)(F.ws + WS_OUTB);
    float d01 = 0.f, d23 = 0.f;
    for (int i = F.lane; i < 128; i += 64) { d01 += lam_vec[i] * lam_vec[128 + i]; d23 += lam_vec[256 + i] * lam_vec[384 + i]; }
    const float lam_init = 0.8f - 0.6f * expf(-0.3f * 1.0f);
    const float lam = expf(wave_sum(d01)) - expf(wave_sum(d23)) + lam_init;
    const int l32 = F.lane & 31, hs = F.lane >> 5;
    float sg[8]; ld8f(sub_g + 8 * l32, sg);
    constexpr int UB = 3;
    for (int it0 = gw; it0 < NTOK * 4; it0 += UB * NGWv) {
        v4u w1[UB], w2[UB];
#pragma unroll
        for (int u = 0; u < UB; ++u) { const int it = it0 + u * NGWv; if (it < NTOK * 4) { const int m = it >> 2, h = (it & 3) * 2 + hs; const GAS bf16* op = (const GAS bf16*)O + (size_t)m * 4096 + h * 512 + 8 * l32;
            w1[u] = *(const GAS v4u*)op; w2[u] = *(const GAS v4u*)(op + 256); } }
#pragma unroll
        for (int u = 0; u < UB; ++u) { const int it = it0 + u * NGWv; if (it < NTOK * 4) { const int m = it >> 2, h = (it & 3) * 2 + hs;
            float o1[8], o2[8], o[8]; unpack8(w1[u], o1); unpack8(w2[u], o2); float ss = 0.f;
#pragma unroll
            for (int j = 0; j < 8; ++j) { o[j] = o1[j] - o2[j] * lam; ss += o[j] * o[j]; }
            ss = red16(ss); ss += __shfl_xor(ss, 16);
            const float rs = (1.0f / sqrtf(ss * (1.f / 256.f) + 1e-5f)) * (1.f - lam_init);
#pragma unroll
            for (int j = 0; j < 8; ++j) o[j] = o[j] * rs * sg[j];
            *(GAS v4u*)(OUTB + (size_t)m * DM + h * 256 + 8 * l32) = pack8(o); } }
    }
}

__device__ __forceinline__ void l2_gla_phase(Frame& F) {
    unsigned char* ws = F.ws; const bf16* HGO = (const bf16*)(ws + L2_HGO); bf16* OG = (bf16*)(ws + L2_OG);
    constexpr int PK = 136, PS = 72;
    LAS bf16* QR = (LAS bf16*)(F.lds + RING_OFF);
    LAS bf16* KR = QR + 64 * PK;
    LAS bf16* VR = KR + 64 * PK;
    LAS bf16* QD = QR; LAS bf16* KD = KR;
    LAS bf16* KEt = VR + 64 * PS;
    LAS bf16* Vt = KEt + 128 * PS;
    LAS bf16* Pm = Vt + 64 * PS;
    LAS bf16* St = Pm + 64 * PS;
    LAS float* tot = (LAS float*)(St + 64 * PK);
    LAS float* dec = tot + 8 * 128;
    const int lane = F.lane, w = F.wave, tid = F.tid;
    constexpr int NCHK = LTOK / 64;
    for (int u = F.vcu; u < 256; u += F.G) {
        const int vh = u & 1, h = (u >> 1) & 15, b = (u >> 5) & 3, d = u >> 7;
        pg8::f32x4 S4[4];
#pragma unroll
        for (int vb = 0; vb < 4; ++vb) S4[vb] = (pg8::f32x4){0.f, 0.f, 0.f, 0.f};
        v4u rq[2], rk[2], rv;
        const GAS bf16* hb = (const GAS bf16*)HGO + (size_t)b * LTOK * 10240;
#define GLA_FETCH(chn) do { \
            _Pragma("unroll") for (int k_ = 0; k_ < 2; ++k_) { const int id_ = tid + 512 * k_, s_ = id_ >> 4, c16_ = id_ & 15; const int step_ = (chn) * 64 + s_; const int t_ = d ? flip_tok(step_) : step_; \
                rq[k_] = *(const GAS v4u*)(hb + (size_t)t_ * 10240 + h * 128 + c16_ * 8); rk[k_] = *(const GAS v4u*)(hb + (size_t)t_ * 10240 + (3 + d) * DM + h * 128 + c16_ * 8); } \
            { const int s_ = tid >> 3, c16_ = tid & 7; const int step_ = (chn) * 64 + s_; const int t_ = d ? flip_tok(step_) : step_; rv = *(const GAS v4u*)(hb + (size_t)t_ * 10240 + DM + h * 128 + vh * 64 + c16_ * 8); } } while (0)
        GLA_FETCH(0);
        asm volatile("" : "+v"(rq[0]), "+v"(rq[1]), "+v"(rk[0]), "+v"(rk[1]), "+v"(rv));
        for (int ch = 0; ch < NCHK; ++ch) {
            LDS_BARRIER();
#pragma unroll
            for (int k = 0; k < 2; ++k) { const int id = tid + 512 * k, s = id >> 4, c16 = id & 15; *(LAS v4u*)(QR + s * PK + c16 * 8) = rq[k]; *(LAS v4u*)(KR + s * PK + c16 * 8) = rk[k]; }
            *(LAS v4u*)(VR + (tid >> 3) * PS + (tid & 7) * 8) = rv;
            if (ch + 1 < NCHK) GLA_FETCH(ch + 1);
            LDS_BARRIER();
            const int cp = tid & 63, sg = tid >> 6, c = 2 * cp;
            float k0[8], k1[8], b0[8], b1[8]; float run0 = 0.f, run1 = 0.f;
#pragma unroll
            for (int s = 0; s < 8; ++s) { const unsigned kw = *(const LAS unsigned*)(KR + (sg * 8 + s) * PK + c); k0[s] = bflo(kw); k1[s] = bfhi(kw);
                run0 += __logf(1.f - k0[s]); run1 += __logf(1.f - k1[s]); b0[s] = run0; b1[s] = run1; }
            *(LAS f32x2*)(tot + sg * 128 + c) = (f32x2){run0, run1};
            { const int v = tid & 63, s8 = (tid >> 6) * 8; unsigned short e[8];
#pragma unroll
              for (int s = 0; s < 8; ++s) e[s] = VR[(s8 + s) * PS + v];
              v4u o; o.x = e[0] | ((unsigned)e[1] << 16); o.y = e[2] | ((unsigned)e[3] << 16); o.z = e[4] | ((unsigned)e[5] << 16); o.w = e[6] | ((unsigned)e[7] << 16);
              *(LAS v4u*)(Vt + v * PS + s8) = o; }
#pragma unroll
            for (int vb = 0; vb < 4; ++vb) { v2u sw; sw.x = pk2(S4[vb][0], S4[vb][1]); sw.y = pk2(S4[vb][2], S4[vb][3]);
                *(LAS v2u*)(St + (vb * 16 + (lane & 15)) * PK + 16 * w + (lane >> 4) * 4) = sw; }
            LDS_BARRIER();
            float off0 = 0.f, off1 = 0.f, bend0 = 0.f, bend1 = 0.f;
#pragma unroll
            for (int g = 0; g < 8; ++g) { const f32x2 tg = *(const LAS f32x2*)(tot + g * 128 + c); if (g < sg) { off0 += tg.x; off1 += tg.y; } bend0 += tg.x; bend1 += tg.y; }
            if (sg == 0) *(LAS f32x2*)(dec + c) = (f32x2){__expf(bend0), __expf(bend1)};
            { const float eb0 = __expf(bend0), eb1 = __expf(bend1); float ke0[8], ke1[8];
#pragma unroll
              for (int s = 0; s < 8; ++s) { const int st = sg * 8 + s; const float e0 = __expf(off0 + b0[s]), e1 = __expf(off1 + b1[s]); const float i0 = __builtin_amdgcn_rcpf(e0), i1 = __builtin_amdgcn_rcpf(e1);
                  const unsigned qw = *(const LAS unsigned*)(QR + st * PK + c);
                  *(LAS unsigned*)(QD + st * PK + c) = pk2(bflo(qw) * e0, bfhi(qw) * e1);
                  const float kd0 = k0[s] * i0, kd1 = k1[s] * i1;
                  *(LAS unsigned*)(KD + st * PK + c) = pk2(kd0, kd1); ke0[s] = kd0 * eb0; ke1[s] = kd1 * eb1; }
              v4u o; o.x = pk2(ke0[0], ke0[1]); o.y = pk2(ke0[2], ke0[3]); o.z = pk2(ke0[4], ke0[5]); o.w = pk2(ke0[6], ke0[7]); *(LAS v4u*)(KEt + c * PS + sg * 8) = o;
              o.x = pk2(ke1[0], ke1[1]); o.y = pk2(ke1[2], ke1[3]); o.z = pk2(ke1[4], ke1[5]); o.w = pk2(ke1[6], ke1[7]); *(LAS v4u*)(KEt + (c + 1) * PS + sg * 8) = o; }
            LDS_BARRIER();
            { const int tb = w >> 1;
#pragma unroll
              for (int q2 = 0; q2 < 2; ++q2) { const int sb = (w & 1) * 2 + q2; pg8::f32x4 a = {0.f, 0.f, 0.f, 0.f};
                  if (sb <= tb) a = mma_tile(a, QD + tb * 16 * PK, PK, KD + sb * 16 * PK, PK, 4, lane);
#pragma unroll
                  for (int j = 0; j < 4; ++j) { const int tt = tb * 16 + (lane >> 4) * 4 + j, ss = sb * 16 + (lane & 15); Pm[tt * PS + ss] = f2bf(ss <= tt ? a[j] : 0.f); } } }
            LDS_BARRIER();
            asm volatile("" : "+v"(rq[0]), "+v"(rq[1]), "+v"(rk[0]), "+v"(rk[1]), "+v"(rv));
            { const int tb = w >> 1;
#pragma unroll
              for (int q2 = 0; q2 < 2; ++q2) { const int vb = (w & 1) * 2 + q2; pg8::f32x4 a = {0.f, 0.f, 0.f, 0.f};
                  a = mma_tile(a, Pm + tb * 16 * PS, PS, Vt + vb * 16 * PS, PS, 2, lane);
                  a = mma_tile(a, QD + tb * 16 * PK, PK, St + vb * 16 * PK, PK, 4, lane);
#pragma unroll
                  for (int j = 0; j < 4; ++j) { const int s = tb * 16 + (lane >> 4) * 4 + j; const int step = ch * 64 + s; const int t = d ? flip_tok(step) : step;
                      OG[((size_t)d * NTOK + (size_t)b * LTOK + t) * DM + h * 128 + vh * 64 + vb * 16 + (lane & 15)] = f2bf(a[j]); } } }
#pragma unroll
            for (int vb = 0; vb < 4; ++vb) { pg8::f32x4 a = S4[vb];
#pragma unroll
                for (int j = 0; j < 4; ++j) a[j] *= dec[16 * w + (lane >> 4) * 4 + j];
                S4[vb] = mma_tile(a, KEt + 16 * w * PS, PS, Vt + vb * 16 * PS, PS, 2, lane); }
        }
#undef GLA_FETCH
    }
}
__device__ __forceinline__ void l2_combine_phase(Frame& F, const float* norm_g) {
    const int gw = GW(F), NGWv = NGW(F); const bf16* OG = (const bf16*)(F.ws + L2_OG); const bf16* HGO = (const bf16*)(F.ws + L2_HGO); bf16* OUTB = (bf16*)(F.ws + WS_OUTB);
    const int l16 = F.lane & 15, hq = F.lane >> 4;
    float ng[8]; ld8f(norm_g + 8 * l16, ng);
    constexpr int UB = 3;
    for (int it0 = gw; it0 < NTOK * 4; it0 += UB * NGWv) {
        v4u wa[UB], wb[UB], wg[UB];
#pragma unroll
        for (int u = 0; u < UB; ++u) { const int it = it0 + u * NGWv; if (it < NTOK * 4) { const int m = it >> 2, col = ((it & 3) * 4 + hq) * 128 + 8 * l16; const size_t e = (size_t)m * DM + col;
            wa[u] = *(const GAS v4u*)(OG + e); wb[u] = *(const GAS v4u*)(OG + (size_t)NTOK * DM + e); wg[u] = *(const GAS v4u*)(HGO + (size_t)m * 10240 + 2 * DM + col); } }
#pragma unroll
        for (int u = 0; u < UB; ++u) { const int it = it0 + u * NGWv; if (it < NTOK * 4) { const int m = it >> 2, col = ((it & 3) * 4 + hq) * 128 + 8 * l16;
            float oa[8], ob[8], g[8], o[8]; unpack8(wa[u], oa); unpack8(wb[u], ob); unpack8(wg[u], g); float ss = 0.f;
#pragma unroll
            for (int j = 0; j < 8; ++j) { o[j] = oa[j] + ob[j]; ss += o[j] * o[j]; }
            ss = red16(ss);
            const float rs = 1.0f / sqrtf(ss * (1.f / 128.f) + 1e-5f);
#pragma unroll
            for (int j = 0; j < 8; ++j) o[j] = o[j] * rs * ng[j] * g[j];
            *(GAS v4u*)(OUTB + (size_t)m * DM + col) = pack8(o); } }
    }
}

__device__ __forceinline__ void l3_conv_phase(Frame& F, const float* cw, const float* cb) {
    const int gw = GW(F), NGWv = NGW(F); const bf16* IN = (const bf16*)(F.ws + L3_IN) + DM; bf16* XB = (bf16*)(F.ws + L3_XB);
    const int c0 = (gw & 3) * 512 + F.lane * 8;
    float wk[4][8], bk[8];
#pragma unroll
    for (int k = 0; k < 4; ++k) ld8f(cw + (size_t)k * DM + c0, wk[k]);
    ld8f(cb + c0, bk);
    for (int it = gw; it < (NTOK / 16) * 4; it += NGWv) {
        const int strip = it >> 2; const int m0 = strip * 16, t0 = m0 % LTOK;
        const int seg_end = (t0 < NCTX) ? NCTX : LTOK; const bool first_in_seg = (t0 == 0 || t0 == NCTX);
        const GAS bf16* xg = (const GAS bf16*)IN + (size_t)m0 * 4096 + c0;
        v4u xr[19];
#pragma unroll
        for (int q = 0; q < 19; ++q) { const bool ok = (q == 0) ? !first_in_seg : (t0 + q - 1 < seg_end);
            xr[q] = (v4u){0u, 0u, 0u, 0u}; if (ok) xr[q] = *(const GAS v4u*)(xg + (ptrdiff_t)(q - 1) * 4096); }
#pragma unroll
        for (int r = 0; r < 16; ++r) {
            const v4u x0 = xr[r], x1 = xr[r + 1], x2 = xr[r + 2], x3 = xr[r + 3];
            float o[8];
#pragma unroll
            for (int q = 0; q < 4; ++q) {
                o[2 * q] = bk[2 * q] + wk[0][2 * q] * bflo(x0[q]) + wk[1][2 * q] * bflo(x1[q]) + wk[2][2 * q] * bflo(x2[q]) + wk[3][2 * q] * bflo(x3[q]);
                o[2 * q + 1] = bk[2 * q + 1] + wk[0][2 * q + 1] * bfhi(x0[q]) + wk[1][2 * q + 1] * bfhi(x1[q]) + wk[2][2 * q + 1] * bfhi(x2[q]) + wk[3][2 * q + 1] * bfhi(x3[q]); }
            *(GAS v4u*)(XB + (size_t)(m0 + r) * DM + c0) = pack8(o);
        }
    }
}
__device__ __forceinline__ void l3_scan_phase(Frame& F) {
    unsigned char* ws = F.ws; LAS float* PA = (LAS float*)(F.lds + RING_OFF); LAS float* PH = PA + 512;
    constexpr int SEGL = LTOK / 8, NBLK = SEGL / 16;
    for (int u = F.vcu; u < 256; u += F.G) {
        const int d = u >> 7, b = (u >> 5) & 3, cg = u & 31; const int ch = cg * 64 + F.lane, seg = F.wave;
        const bf16* LOGA = (const bf16*)(ws + L3_LOGA) + (size_t)d * NTOK * DM + (size_t)b * LTOK * DM + ch;
        const bf16* UU = (const bf16*)(ws + L3_UU) + (size_t)d * NTOK * DM + (size_t)b * LTOK * DM + ch;
        bf16* YS = (bf16*)(ws + L3_YS) + (size_t)d * NTOK * DM + (size_t)b * LTOK * DM + ch;
        bf16 laA[16], luA[16], laB[16], luB[16];
        auto ldblk = [&](const int blk, bf16 (&la)[16], bf16 (&lu)[16]) __attribute__((always_inline)) {
#pragma unroll
            for (int s = 0; s < 16; ++s) { const int step = seg * SEGL + blk * 16 + s; const int t = d ? flip_tok(step) : step; la[s] = LOGA[(size_t)t * DM]; lu[s] = UU[(size_t)t * DM]; } };
        float P = 1.f, Hh = 0.f;
        auto scan1 = [&](const bf16 (&la)[16], const bf16 (&lu)[16]) __attribute__((always_inline)) {
#pragma unroll
            for (int s = 0; s < 16; ++s) { const float a = __expf(bf2f(la[s])); Hh = a * Hh + bf2f(lu[s]); P *= a; } };
        auto scan2 = [&](const int blk, const bf16 (&la)[16], const bf16 (&lu)[16]) __attribute__((always_inline)) {
#pragma unroll
            for (int s = 0; s < 16; ++s) { const int step = seg * SEGL + blk * 16 + s; const int t = d ? flip_tok(step) : step; const float a = __expf(bf2f(la[s])); Hh = a * Hh + bf2f(lu[s]); YS[(size_t)t * DM] = f2bf(Hh); } };
        ldblk(0, laA, luA);
#pragma unroll 1
        for (int blk = 0; blk < NBLK; blk += 2) { ldblk(blk + 1, laB, luB); scan1(laA, luA); ldblk(blk + 2 < NBLK ? blk + 2 : NBLK - 1, laA, luA); scan1(laB, luB); }
        __syncthreads();
        PA[F.tid] = P; PH[F.tid] = Hh;
        __syncthreads();
        float carry = 0.f;
        for (int g = 0; g < seg; ++g) carry = PA[g * 64 + F.lane] * carry + PH[g * 64 + F.lane];
        Hh = carry;
        ldblk(0, laA, luA);
#pragma unroll 1
        for (int blk = 0; blk < NBLK; blk += 2) { ldblk(blk + 1, laB, luB); scan2(blk, laA, luA); ldblk(blk + 2 < NBLK ? blk + 2 : NBLK - 1, laA, luA); scan2(blk + 1, laB, luB); }
    }
}
__device__ __forceinline__ void l3_combine_phase(Frame& F) {
    const bf16* YS = (const bf16*)(F.ws + L3_YS); const bf16* IN = (const bf16*)(F.ws + L3_IN); bf16* OUTB = (bf16*)(F.ws + WS_OUTB);
    const size_t total = (size_t)NTOK * DM / 8; const size_t stride = (size_t)F.G * 512;
    constexpr int UB = 3;
    for (size_t i0 = (size_t)F.vcu * 512 + F.tid; i0 < total; i0 += UB * stride) {
        v4u ya[UB], yb[UB], gg[UB];
#pragma unroll
        for (int u = 0; u < UB; ++u) { const size_t i = i0 + u * stride; if (i < total) { const size_t e = i * 8; const size_t m = e / DM, c = e % DM;
            ya[u] = *(const GAS v4u*)(YS + e); yb[u] = *(const GAS v4u*)(YS + (size_t)NTOK * DM + e); gg[u] = *(const GAS v4u*)(IN + m * 4096 + c); } }
#pragma unroll
        for (int u = 0; u < UB; ++u) { const size_t i = i0 + u * stride; if (i < total) { const size_t e = i * 8;
            float a[8], b[8], g[8], o[8]; unpack8(ya[u], a); unpack8(yb[u], b); unpack8(gg[u], g);
#pragma unroll
            for (int j = 0; j < 8; ++j) o[j] = (a[j] + b[j]) * g[j];
            *(GAS v4u*)(OUTB + e) = pack8(o); } }
    }
}
constexpr int N_PHASE_IDS = 1 + 16 * NLAYER;
struct Args { const float* in[43]; float* out; unsigned char* ws; int ph_lo, ph_hi; };
static_assert(sizeof(Args) == 45 * 8 + 8, "Args has no holes");

#ifdef PROBE_MASK
__device__ __forceinline__ int probe_rep(int k) {
    if (k == 0) return 1;
    return ((PROBE_SEL >> (k - 1)) & 1ull) ? 2 : 1;
}
#endif
__global__ void __launch_bounds__(NWAVES * 64, 2) mega_fwd(Args args) {
    extern __shared__ __attribute__((aligned(16))) unsigned char lds[];
    { const int t0 = threadIdx.x; for (int u = t0; u < (LDS_BYTES - LDSCTL_OFF) / 4; u += NWAVES * 64) ((LAS unsigned*)((LAS unsigned char*)lds + LDSCTL_OFF))[u] = 0u; }
    __syncthreads();
#define MKFRAME() Frame F; { int t_ = threadIdx.x; asm volatile("" : "+v"(t_)); int bx_ = blockIdx.x, g_ = gridDim.x; asm volatile("" : "+s"(bx_), "+s"(g_)); \
        F.lds = (LAS unsigned char*)lds; F.MISC = (volatile LAS unsigned*)(F.lds + MISC_OFF); F.tid = t_; F.lane = t_ & 63; F.wave = __builtin_amdgcn_readfirstlane(t_ >> 6); \
        F.G = g_; F.vcu = (g_ % 8 == 0) ? (bx_ % 8) * (g_ / 8) + bx_ / 8 : bx_; F.bx = bx_; F.ws = (unsigned char*)ldarg(44); F.ctl = (gu32*)(F.ws + WS_CTL); }
    const int lo = args.ph_lo, hi = args.ph_hi;
    const bool multi = (hi - lo) > 1;
    XcdBarrier bar; bar.bar = (unsigned*)((unsigned char*)ldarg(44) + WS_CTL) + CW_BAR; bar.x = 0; bar.st = nullptr;
    if (multi) bar = xcd_barrier_post(bar.bar, (volatile LAS unsigned*)((LAS unsigned char*)lds + MISC_OFF) + 8);
#define IN(k) (lo <= (k) && (k) < hi)
#define RUN_GEMM(EPI, MODE, LAT, NM, NN, LDA_, LDB_, KK_, Aptr, Bptr, Eobj) do { typedef Sched<MODE, LAT, NM, NN, LDA_, LDB_> S_t; S_t S_; S_.init(F.G, F.bx); \
        pg8::gemm_phase<EPI, S_t, LDA_, LDB_, KK_, true, true>(F.lds + RING_OFF, (Aptr), (Bptr), S_, (Eobj)); } while (0)
#define RUN_GEMM_SPLIT(SPLIT, KSUB, LDA_, LDB_, Aptr, Bptr, Eobj) do { typedef SchedSplitHalf<SPLIT, KSUB, LDA_, LDB_> S_t; S_t S_; S_.init(F.G, F.bx); \
        pg8::gemm_phase<EpiPartial, S_t, LDA_, LDB_, KSUB, true, true, true>(F.lds + RING_OFF, (Aptr), (Bptr), S_, (Eobj)); } while (0)
#define RUN_GEMM_HT(EPI, LAT, NM, NN, LMAX, NT, LDA_, LDB_, KK_, Aptr, Bptr, Eobj) do { \
        typedef SchedHT<LAT, NM, NN, LMAX, NT, LDA_, LDB_> S_t; S_t S_; S_.init(F.G, F.bx); pg8::gemm_phase<EPI, S_t, LDA_, LDB_, KK_, true, true, 2>(F.lds + RING_OFF, (Aptr), (Bptr), S_, (Eobj)); } while (0)
#define SEAM(k) do { if ((k) + 1 < hi) xcd_barrier(bar); } while (0)
#ifdef PROBE_MASK
#define PH_OPEN(k) if (IN(k)) { _Pragma("unroll 1") for (int rep_ = 0; rep_ < probe_rep(k); ++rep_) {
#define PH_CLOSE(k) if ((k) + 1 < hi || rep_ + 1 < probe_rep(k)) xcd_barrier(bar); } }
#else
#define PH_OPEN(k) if (IN(k)) {
#define PH_CLOSE(k) SEAM(k); }
#endif
#define WSP ((unsigned char*)ldarg(44))
#define Z ((float*)(WSP + WS_Z))
#define PRE ((bf16*)(WSP + WS_PRE))
#define H ((bf16*)(WSP + WS_H))
#define OUTB ((bf16*)(WSP + WS_OUTB))
#define U ((bf16*)(WSP + WS_U))
#define ACT ((bf16*)(WSP + WS_ACT))

#ifndef DIS_P0
    PH_OPEN(0) MKFRAME(); p0_prologue(F); PH_CLOSE(0)
#endif

    for (int layer = 0; layer < NLAYER; ++layer) {
        const int P = 1 + 16 * layer;
        if (layer == 0) {
#ifndef DIS_L0
            PH_OPEN(P + 0) MKFRAME(); l0_xs_phase(F, INP(0), INP(2), INP(12)); PH_CLOSE(P + 0)
#ifndef DIS_L0_G1
            PH_OPEN(P + 1) MKFRAME();
                EpiBf16Route<1> E{nullptr, 0, WSP, nullptr, nullptr};
                RUN_GEMM(EpiBf16Route<1>, 1, false, 36, 27, DM, DM, DM, (const bf16*)(WSP + L0_XS), (const bf16*)(WSP + WS_WA), E); PH_CLOSE(P + 1)
#endif
#ifndef DIS_L0_G2
            PH_OPEN(P + 2) MKFRAME();
                EpiBf16Route<2> E{nullptr, 0, WSP, INP(14), INP(17)};
                RUN_GEMM(EpiBf16Route<2>, 2, false, 36, 40, 256, 256, 256, (const bf16*)(WSP + L0_HID), (const bf16*)(WSP + WS_WL2), E); PH_CLOSE(P + 2)
#endif
#ifndef DIS_L0_PREP
#endif
#ifndef DIS_L0_SCAN
            PH_OPEN(P + 4) MKFRAME(); l0_cscan2_phase(F, INP(22), INP(23), INP(24)); PH_CLOSE(P + 4)
#endif
            PH_OPEN(P + 5) MKFRAME(); l0_post_phase(F, INP(25), INP(26)); PH_CLOSE(P + 5)
#endif
        } else if (layer == 1) {
#ifndef DIS_L1
            PH_OPEN(P + 0) MKFRAME();
                EpiBf16Route<5> E{(bf16*)(WSP + L1_QKV), 6144, WSP, nullptr, nullptr};
                RUN_GEMM_HT(EpiBf16Route<5>, false, 36, 24, 768, 96, DM, DM, DM, H, (const bf16*)(WSP + WS_WQKV), E); PH_CLOSE(P + 0)
            PH_OPEN(P + 2) MKFRAME(); l1_attn_phase(F, (char*)lds + RING_OFF); PH_CLOSE(P + 2)
            PH_OPEN(P + 3) MKFRAME(); l1_combine_phase(F, INP(29), INP(30)); PH_CLOSE(P + 3)
#endif
        } else if (layer == 2) {
#ifndef DIS_L2
            PH_OPEN(P + 0) MKFRAME();
                EpiBf16Route<3> E{(bf16*)(WSP + L2_HGO), 10240, WSP, (const float*)(WSP + WS_LB), nullptr};
                RUN_GEMM(EpiBf16Route<3>, 0, false, 36, 40, DM, DM, DM, H, (const bf16*)(WSP + WS_WHG), E); PH_CLOSE(P + 0)
            PH_OPEN(P + 1) MKFRAME(); l2_gla_phase(F); PH_CLOSE(P + 1)
            PH_OPEN(P + 2) MKFRAME(); l2_combine_phase(F, INP(34)); PH_CLOSE(P + 2)
#endif
        } else {
#ifndef DIS_L3
            PH_OPEN(P + 0) MKFRAME();
                EpiBf16Route<4> E{(bf16*)(WSP + L3_IN), 4096, WSP, nullptr, nullptr};
                RUN_GEMM_HT(EpiBf16Route<4>, false, 36, 16, 512, 64, DM, DM, DM, H, (const bf16*)(WSP + WS_WLR), E); PH_CLOSE(P + 0)
            PH_OPEN(P + 1) MKFRAME(); l3_conv_phase(F, INP(37), INP(38)); PH_CLOSE(P + 1)
            PH_OPEN(P + 2) MKFRAME();
                EpiGates E{WSP, INP(40), INP(41)};
                RUN_GEMM(EpiGates, 3, false, 36, 32, DM, 256, 256, (const bf16*)(WSP + L3_XB), (const bf16*)(WSP + WS_WGATE), E); PH_CLOSE(P + 2)
            PH_OPEN(P + 3) MKFRAME(); l3_scan_phase(F); PH_CLOSE(P + 3)
            PH_OPEN(P + 4) MKFRAME(); l3_combine_phase(F); PH_CLOSE(P + 4)
#endif
        }
#ifndef DIS_COMMON
        const bool last = (layer == NLAYER - 1);
        const float* lng = INP(6) + (size_t)layer * 2 * DM; const float* lnb = INP(7) + (size_t)layer * 2 * DM;
        PH_OPEN(P + 10) MKFRAME();
            const bf16* wB = (const bf16*)(WSP + WS_WO) + (size_t)layer * DM * DM; EpiResid E{PRE, WSP, layer, 2};
            if (last) RUN_GEMM(EpiResid, 0, true, 32, 8, DM, DM, DM, OUTB, wB, E);
            else { RUN_GEMM(EpiResid, 0, false, 32, 8, DM, DM, DM, OUTB, wB, E); EpiPartial EP{(bf16*)(WSP + WS_U)}; RUN_GEMM_SPLIT(4, 512, DM, DM, OUTB, wB, EP); }
            PH_CLOSE(P + 10)
        PH_OPEN(P + 11) MKFRAME();
            if (last) ln1_phase<true, 0, false>(F, PRE, Z, INP(0), INP(2), H, (float*)(WSP + WS_STAT), lng, lnb, layer, nullptr);
            else if (layer == 0) ln1_phase<false, 4, true>(F, PRE, Z, INP(0), INP(2), H, (float*)(WSP + WS_STAT), lng, lnb, layer, (const bf16*)(WSP + WS_U));
            else ln1_phase<false, 4, false>(F, PRE, Z, INP(0), INP(2), H, (float*)(WSP + WS_STAT), lng, lnb, layer, (const bf16*)(WSP + WS_U));
            PH_CLOSE(P + 11)
        PH_OPEN(P + 12) MKFRAME();
            const bf16* wB = (const bf16*)(WSP + WS_WUP) + (size_t)layer * DFF2 * DM; EpiConvAct E{ACT, (bf16*)(WSP + WS_UB), INP(9) + (size_t)layer * 3 * DFF2, INP(10) + (size_t)layer * DFF2};
            if (last) RUN_GEMM_HT(EpiConvAct, true, 32, 44, 1280, 128, DM, DM, DM, H, wB, E); else RUN_GEMM_HT(EpiConvAct, false, 36, 44, 1536, 48, DM, DM, DM, H, wB, E);
            PH_CLOSE(P + 12)
        PH_OPEN(P + 13) MKFRAME(); const float* cw = INP(9) + (size_t)layer * 3 * DFF2; const float* cb = INP(10) + (size_t)layer * DFF2;
            if (last) ffn_fix_phase<true>(F, (const bf16*)(WSP + WS_UB), ACT, cw, cb); else ffn_fix_phase<false>(F, (const bf16*)(WSP + WS_UB), ACT, cw, cb); PH_CLOSE(P + 13)
        PH_OPEN(P + 14) MKFRAME();
            const bf16* wB = (const bf16*)(WSP + WS_WDN) + (size_t)layer * DM * DFF; EpiResid E{PRE + (size_t)NTOK * DM, WSP, layer, 5};
            if (last) RUN_GEMM(EpiResid, 0, true, 32, 8, DFF, DFF, DFF, ACT, wB, E);
            else { RUN_GEMM(EpiResid, 0, false, 32, 8, DFF, DFF, DFF, ACT, wB, E); EpiPartial EP{(bf16*)(WSP + WS_U)}; RUN_GEMM_SPLIT(4, 1408, DFF, DFF, ACT, wB, EP); }
            PH_CLOSE(P + 14)
        PH_OPEN(P + 15) MKFRAME();
            if (last) ln2_phase<true, true, false, 0, false>(F, PRE, PRE + (size_t)NTOK * DM, Z, INP(0), INP(2), nullptr, (float*)ldarg(43), nullptr, (const float*)(WSP + WS_STAT), lng, lnb, lng + DM, lnb + DM, layer, nullptr);
            else if (layer == 0) ln2_phase<false, false, true, 4, true>(F, PRE, PRE + (size_t)NTOK * DM, Z, INP(0), INP(2), Z, nullptr, H, (const float*)(WSP + WS_STAT), lng, lnb, lng + DM, lnb + DM, layer, (const bf16*)(WSP + WS_U));
            else ln2_phase<false, false, true, 4, false>(F, PRE, PRE + (size_t)NTOK * DM, Z, INP(0), INP(2), Z, nullptr, H, (const float*)(WSP + WS_STAT), lng, lnb, lng + DM, lnb + DM, layer, (const bf16*)(WSP + WS_U));
            PH_CLOSE(P + 15)
#endif
    }
#undef IN
#undef SEAM
#undef Z
#undef PRE
#undef H
#undef OUTB
#undef U
#undef ACT
}

static const bool kPhaseUsed[N_PHASE_IDS] = {
    true,
    true, true, true, false, true, true, false, false, false, false, true, true, true, true, true, true,
    true, false, true, true, false, false, false, false, false, false, true, true, true, true, true, true,
    true, true, true, false, false, false, false, false, false, false, true, true, true, true, true, true,
    true, true, true, true, true, false, false, false, false, false, true, true, true, true, true, true };
extern "C" void kernel_launch(void* const* d_in, const int* in_sizes, int n_in, void* d_out, int out_size, void* d_ws, size_t ws_size, hipStream_t stream) {
    static int grid = 0;
    if (grid == 0) {
        if (n_in != 43 || out_size != NLAT * DM || ws_size < WS_END) { fprintf(stderr, "kernel_launch: unexpected shapes: n_in %d out %d ws %zu (need %zu)\n", n_in, out_size, ws_size, (size_t)WS_END); grid = -1; return; }
        int dev = 0, cus = 0, per_cu = 0;
        if (hipGetDevice(&dev) != hipSuccess || hipDeviceGetAttribute(&cus, hipDeviceAttributeMultiprocessorCount, dev) != hipSuccess) { grid = -1; return; }
        if (hipFuncSetAttribute((const void*)mega_fwd, hipFuncAttributeMaxDynamicSharedMemorySize, LDS_BYTES) != hipSuccess) { fprintf(stderr, "kernel_launch: hipFuncSetAttribute failed\n"); grid = -1; return; }
        if (hipOccupancyMaxActiveBlocksPerMultiprocessor(&per_cu, (const void*)mega_fwd, NWAVES * 64, LDS_BYTES) != hipSuccess || per_cu < 1)
            fprintf(stderr, "kernel_launch: occupancy query reports %d workgroups per CU\n", per_cu);
        (void)hipGetLastError();
        grid = cus;
    }
    if (grid < 0) return;
    if (hipMemsetAsync((char*)d_ws + WS_CTL, 0, ZERO_BYTES, stream) != hipSuccess) { fprintf(stderr, "kernel_launch: memset failed\n"); return; }
    Args a{};
    for (int i = 0; i < 43; ++i) a.in[i] = (const float*)d_in[i];
    a.out = (float*)d_out; a.ws = (unsigned char*)d_ws;
#if MK_N_LAUNCHES == 1
    a.ph_lo = 0; a.ph_hi = N_PHASE_IDS;
    hipLaunchKernelGGL(mega_fwd, dim3(grid), dim3(NWAVES * 64), LDS_BYTES, stream, a);
#else
    for (int p = 0; p < N_PHASE_IDS; ++p) { if (!kPhaseUsed[p]) continue; a.ph_lo = p; a.ph_hi = p + 1;
        hipLaunchKernelGGL(mega_fwd, dim3(grid), dim3(NWAVES * 64), LDS_BYTES, stream, a); }
#endif
    const hipError_t le = hipPeekAtLastError();
    if (le != hipSuccess) fprintf(stderr, "kernel_launch: launch failed: %s\n", hipGetErrorName(le));
}
```

```cpp
#include <hip/hip_runtime.h>
#include <cstdio>
#include <cstdint>

namespace pg8 {
#define PG8_LAS __attribute__((address_space(3)))
typedef unsigned short bf16_t;
typedef short bf16x8 __attribute__((ext_vector_type(8)));
typedef float f32x4 __attribute__((ext_vector_type(4)));
typedef float f32x2 __attribute__((ext_vector_type(2)));
typedef unsigned u32x4 __attribute__((ext_vector_type(4)));
typedef unsigned u32x2 __attribute__((ext_vector_type(2)));
constexpr int BM = 256, BK = 64, HALF = 128, HTB = HALF * BK * 2  , STAGE_BYTES = 8 * HTB, NXCD = 8, WGM = 8;

__host__ __device__ __forceinline__ int lds_byte(int r, int c) { const int st = (r >> 4) * 2 + (c >> 5), rr = r & 15, cc = c & 31, ob = rr * 64 + cc * 2; return st * 1024 + (ob ^ (((ob >> 9) & 1) << 5)); }
__host__ __device__ __forceinline__ void stage_rc(int b, int& R, int& C) { const int st = b / 1024, sb = b % 1024, swz = sb ^ (((sb >> 9) & 1) << 5); R = (st >> 1) * 16 + swz / 64; C = (st & 1) * 32 + (swz % 64) / 2; }
__host__ __device__ __forceinline__ int perm32(int rho) { const int n = rho >> 4, i = rho & 15; return 8 * (i >> 2) + 4 * n + (i & 3); }

struct Unit { int pm, pn; unsigned aoff, boff; int half; };
struct Gemm { const bf16_t* A; const bf16_t* Bt; int lda, ldb, K; };

template <int nM, int nN> struct TileOrder {
    static constexpr int nwg = nM * nN;
    int G, c;
    __device__ void init(int G_, int c_) { G = G_; c = c_; }
    __device__ __forceinline__ bool tile(int i, int& pm, int& pn) const { return tileL(i * G + c, pm, pn); }
    static __device__ __forceinline__ bool tileL(int L, int& pm, int& pn) {
        if (L >= nwg) return false;
        int wgid = L; { constexpr int q = nwg / NXCD, r = nwg % NXCD; const int xcd = wgid % NXCD, off = wgid / NXCD; wgid = (xcd < r ? xcd * (q + 1) : r * (q + 1) + (xcd - r) * q) + off; }
        constexpr int nig = WGM * nN; const int gid = wgid / nig, fm = gid * WGM, gsz = (nM - fm) < WGM ? (nM - fm) : WGM;
        pm = fm + ((wgid % nig) % gsz); pn = (wgid % nig) / gsz; return true;
    }
};

typedef __bf16 bf16x2_hw __attribute__((ext_vector_type(2)));
__device__ __forceinline__ unsigned cvt_pk_bf16(float lo, float hi) { const f32x2 v = {lo, hi}; const bf16x2_hw b = __builtin_convertvector(v, bf16x2_hw); return __builtin_bit_cast(unsigned, b); }

template <class Epi, class Sched, int LDA, int LDB, int KK, bool ALIGN_EPI = false, bool SP2 = false, int HM = 0>
__device__ __forceinline__ void gemm_phase(PG8_LAS unsigned char* lds, const bf16_t* gA, const bf16_t* gBt, const Sched& S, const Epi& E) {
    int tid_ = threadIdx.x; asm volatile("" : "+v"(tid_));
    const int tid = tid_, wid = __builtin_amdgcn_readfirstlane(tid >> 6), lane = tid & 63, wr = wid >> 2, wc = wid & 3, fr = lane & 15, fq = lane >> 4;
    constexpr int nt = KK / BK;
    unsigned voffA[2], voffB[2];
#pragma unroll
    for (int i = 0; i < 2; ++i) { int R, C; stage_rc(tid * 16 + i * 8192, R, C); const int Rb = Epi::PERM ? ((R & ~31) + perm32(R & 31)) : R;
        const int Ra = Epi::PERMA ? ((R & ~63) + 4 * (R & 15) + ((R & 63) >> 4)) : R;
        voffA[i] = (unsigned)(Ra * LDA + C) * 2u; voffB[i] = (unsigned)(Rb * LDB + C) * 2u; }
    constexpr size_t kstep = (size_t)(BK * 2);
    constexpr size_t hstepA = (size_t)HALF * LDA * 2, hstepB = (size_t)HALF * LDB * 2;
    const unsigned ldsw = (unsigned)wid * 1024u;
    const int aoff = lds_byte(wr * 64 + fr, fq * 8), boff = lds_byte(wc * 32 + fr, fq * 8);
#define PG8_SA(b, h) (((b) * 2 + (h)) * HTB)
#define PG8_SB(b, h) ((4 + (b) * 2 + (h)) * HTB)
#define PG8_STAGE(bufoff, gbase, voff) do { _Pragma("unroll") for (int _i = 0; _i < 2; ++_i) \
        __builtin_amdgcn_global_load_lds((const unsigned*)((const char*)(gbase) + (voff)[_i]), (PG8_LAS unsigned*)(lds + (bufoff) + ldsw + _i * 8192), 16, 0, 0); } while (0)
#define PG8_LDA(dst, b, h) do { _Pragma("unroll") for (int m = 0; m < 4; ++m) _Pragma("unroll") for (int k = 0; k < 2; ++k) dst[m][k] = *(const PG8_LAS bf16x8*)(lds + PG8_SA(b, h) + aoff + m * 2048 + k * 1024); } while (0)
#define PG8_LDB(dst, b, h) do { _Pragma("unroll") for (int n = 0; n < 2; ++n) _Pragma("unroll") for (int k = 0; k < 2; ++k) dst[n][k] = *(const PG8_LAS bf16x8*)(lds + PG8_SB(b, h) + boff + n * 2048 + k * 1024); } while (0)
#define PG8_MMA(ai, bj, At, Bt) do { __builtin_amdgcn_s_setprio(1); _Pragma("unroll") for (int m = 0; m < 4; ++m) _Pragma("unroll") for (int n = 0; n < 2; ++n) _Pragma("unroll") for (int k = 0; k < 2; ++k) \
        acc[ai][bj][m][n] = __builtin_amdgcn_mfma_f32_16x16x32_bf16(Bt[n][k], At[m][k], acc[ai][bj][m][n], 0, 0, 0); __builtin_amdgcn_s_setprio(0); } while (0)
#define PG8_WAIT_V(n) asm volatile("s_waitcnt vmcnt(" #n ")" ::: "memory")
#define PG8_WAIT_L(n) asm volatile("s_waitcnt lgkmcnt(" #n ")" ::: "memory")
#define PG8_BAR __builtin_amdgcn_s_barrier()
#define PG8_SCHED __builtin_amdgcn_sched_barrier(0)
    Unit cur, nxt; int ui = 0;
    if (!S.next(0, cur)) return;
    f32x4 acc[2][2][4][2];
#pragma unroll
    for (int a = 0; a < 2; ++a)
#pragma unroll
        for (int b = 0; b < 2; ++b)
#pragma unroll
            for (int m = 0; m < 4; ++m)
#pragma unroll
                for (int n = 0; n < 2; ++n) acc[a][b][m][n] = (f32x4){0.f, 0.f, 0.f, 0.f};
    bf16x8 At[4][2], B0[2][2], B1[2][2];
    const char* cA = (const char*)gA + cur.aoff; const char* cB = (const char*)gBt + cur.boff;
    if (HM == 1 || (HM == 2 && cur.half >= 0)) {
        PG8_STAGE(PG8_SB(0, 0), cB, voffB); PG8_STAGE(PG8_SB(0, 1), cB + hstepB, voffB); PG8_STAGE(PG8_SA(0, 0), cA, voffA);
        if (wr == 1) PG8_BAR;
        PG8_WAIT_V(0); PG8_BAR;
        PG8_STAGE(PG8_SB(1, 0), cB + kstep, voffB); PG8_STAGE(PG8_SA(1, 0), cA + kstep, voffA); PG8_STAGE(PG8_SB(1, 1), cB + hstepB + kstep, voffB);
        PG8_WAIT_V(6); PG8_BAR;
    } else if constexpr (SP2) {
        PG8_STAGE(PG8_SB(0, 0), cB, voffB); PG8_STAGE(PG8_SB(0, 1), cB + hstepB, voffB); PG8_STAGE(PG8_SA(0, 0), cA, voffA); PG8_STAGE(PG8_SA(0, 1), cA + hstepA, voffA);
        if (wr == 1) PG8_BAR;
        PG8_WAIT_V(2); PG8_BAR;
        PG8_STAGE(PG8_SB(1, 0), cB + kstep, voffB); PG8_STAGE(PG8_SA(1, 0), cA + kstep, voffA); PG8_STAGE(PG8_SB(1, 1), cB + hstepB + kstep, voffB);
        PG8_WAIT_V(6); PG8_BAR;
    } else {
        PG8_STAGE(PG8_SB(0, 0), cB, voffB); PG8_STAGE(PG8_SA(0, 0), cA, voffA); PG8_STAGE(PG8_SB(0, 1), cB + hstepB, voffB); PG8_STAGE(PG8_SA(0, 1), cA + hstepA, voffA);
        if (wr == 1) PG8_BAR;
        PG8_WAIT_V(4); PG8_BAR;
        PG8_STAGE(PG8_SB(1, 0), cB + kstep, voffB); PG8_STAGE(PG8_SA(1, 0), cA + kstep, voffA); PG8_STAGE(PG8_SB(1, 1), cB + hstepB + kstep, voffB);
        PG8_WAIT_V(6); PG8_BAR;
    }
    for (;;) {
        const bool has_next = S.next(ui + 1, nxt);
        const char* nA = has_next ? (const char*)gA + nxt.aoff : cA; const char* nB = has_next ? (const char*)gBt + nxt.boff : cB;
#define PG8_KT_ADDR const bool last = (t == nt - 2); const char* a1 = cA + (size_t)(t + 1) * kstep; \
            const char* a2 = last ? nA : cA + (size_t)(t + 2) * kstep; const char* b2 = last ? nB : cB + (size_t)(t + 2) * kstep; const char* a3 = a2 + kstep; const char* b3 = b2 + kstep;
        if (HM == 1 || (HM == 2 && cur.half >= 0)) {
#pragma unroll 1
          for (int t = 0; t < nt; t += 2) { PG8_KT_ADDR
            PG8_LDB(B0, 0, 0); PG8_LDB(B1, 0, 1); PG8_SCHED; PG8_LDA(At, 0, 0);
            PG8_WAIT_V(6); PG8_WAIT_L(0); PG8_BAR; PG8_MMA(0, 0, At, B0); PG8_MMA(0, 1, At, B1); PG8_BAR; PG8_SCHED;
            PG8_STAGE(PG8_SB(0, 0), b2, voffB); PG8_STAGE(PG8_SB(0, 1), b2 + hstepB, voffB); PG8_STAGE(PG8_SA(0, 0), a2, voffA);
            PG8_WAIT_V(6); PG8_BAR; PG8_BAR; PG8_SCHED;
            PG8_LDB(B0, 1, 0); PG8_LDB(B1, 1, 1); PG8_SCHED; PG8_LDA(At, 1, 0);
            PG8_WAIT_V(6); PG8_WAIT_L(0); PG8_BAR; PG8_MMA(0, 0, At, B0); PG8_MMA(0, 1, At, B1); PG8_BAR; PG8_SCHED;
            PG8_STAGE(PG8_SB(1, 0), b3, voffB); PG8_STAGE(PG8_SB(1, 1), b3 + hstepB, voffB); PG8_STAGE(PG8_SA(1, 0), a3, voffA);
            PG8_WAIT_V(6); PG8_BAR; PG8_BAR; PG8_SCHED;
            (void)a1;
          }
        } else {
#pragma unroll 1
          for (int t = 0; t < nt; t += 2) { PG8_KT_ADDR
            if constexpr (SP2) {
            PG8_LDB(B0, 0, 0); PG8_LDB(B1, 0, 1); PG8_SCHED; PG8_LDA(At, 0, 0); PG8_STAGE(PG8_SA(1, 1), a1 + hstepA, voffA);
            PG8_WAIT_V(8); PG8_WAIT_L(0); PG8_BAR; PG8_MMA(0, 0, At, B0); PG8_MMA(0, 1, At, B1); PG8_BAR; PG8_SCHED;
            PG8_LDA(At, 0, 1); PG8_STAGE(PG8_SB(0, 0), b2, voffB); PG8_STAGE(PG8_SB(0, 1), b2 + hstepB, voffB); PG8_STAGE(PG8_SA(0, 0), a2, voffA);
            PG8_WAIT_V(8); PG8_WAIT_L(0); PG8_BAR; PG8_MMA(1, 0, At, B0); PG8_MMA(1, 1, At, B1); PG8_BAR; PG8_SCHED;
            PG8_LDB(B0, 1, 0); PG8_LDB(B1, 1, 1); PG8_SCHED; PG8_LDA(At, 1, 0); PG8_STAGE(PG8_SA(0, 1), a2 + hstepA, voffA);
            PG8_WAIT_V(8); PG8_WAIT_L(0); PG8_BAR; PG8_MMA(0, 0, At, B0); PG8_MMA(0, 1, At, B1); PG8_BAR; PG8_SCHED;
            PG8_LDA(At, 1, 1); PG8_STAGE(PG8_SB(1, 0), b3, voffB); PG8_STAGE(PG8_SB(1, 1), b3 + hstepB, voffB); PG8_STAGE(PG8_SA(1, 0), a3, voffA);
            PG8_WAIT_V(8); PG8_WAIT_L(0); PG8_BAR; PG8_MMA(1, 0, At, B0); PG8_MMA(1, 1, At, B1); PG8_BAR; PG8_SCHED;
            } else {
            PG8_LDB(B0, 0, 0); PG8_SCHED; PG8_LDA(At, 0, 0); PG8_STAGE(PG8_SA(1, 1), a1 + hstepA, voffA);
            PG8_WAIT_L(8); PG8_BAR; PG8_WAIT_L(0); PG8_MMA(0, 0, At, B0); PG8_BAR; PG8_SCHED;
            PG8_LDB(B1, 0, 1); PG8_STAGE(PG8_SB(0, 0), b2, voffB);
            PG8_BAR; PG8_WAIT_L(0); PG8_MMA(0, 1, At, B1); PG8_BAR;
            PG8_LDA(At, 0, 1); PG8_STAGE(PG8_SA(0, 0), a2, voffA);
            PG8_BAR; PG8_WAIT_L(0); PG8_MMA(1, 0, At, B0); PG8_BAR; PG8_SCHED;
            PG8_STAGE(PG8_SB(0, 1), b2 + hstepB, voffB);
            PG8_WAIT_V(6); PG8_BAR; PG8_MMA(1, 1, At, B1); PG8_BAR;
            PG8_LDB(B0, 1, 0); PG8_SCHED; PG8_LDA(At, 1, 0); PG8_STAGE(PG8_SA(0, 1), a2 + hstepA, voffA);
            PG8_WAIT_L(8); PG8_BAR; PG8_WAIT_L(0); PG8_MMA(0, 0, At, B0); PG8_BAR; PG8_SCHED;
            PG8_LDB(B1, 1, 1); PG8_STAGE(PG8_SB(1, 0), b3, voffB);
            PG8_BAR; PG8_WAIT_L(0); PG8_MMA(0, 1, At, B1); PG8_BAR;
            PG8_LDA(At, 1, 1); PG8_STAGE(PG8_SA(1, 0), a3, voffA);
            PG8_BAR; PG8_WAIT_L(0); PG8_MMA(1, 0, At, B0); PG8_BAR; PG8_SCHED;
            PG8_STAGE(PG8_SB(1, 1), b3 + hstepB, voffB);
            PG8_WAIT_V(6); PG8_BAR; PG8_MMA(1, 1, At, B1); PG8_BAR;
            }
          }
        }
#undef PG8_KT_ADDR
        if constexpr (ALIGN_EPI) { if (wr == 0) PG8_BAR; }
        E(acc, cur, wr, wc, fr, fq);
        if (!has_next) break;
#pragma unroll
        for (int a = 0; a < 2; ++a)
#pragma unroll
            for (int b = 0; b < 2; ++b)
#pragma unroll
                for (int m = 0; m < 4; ++m)
#pragma unroll
                    for (int n = 0; n < 2; ++n) acc[a][b][m][n] = (f32x4){0.f, 0.f, 0.f, 0.f};
        cur = nxt; cA = nA; cB = nB; ++ui;
        if constexpr (ALIGN_EPI) { if (wr == 1) PG8_BAR; }
    }
    PG8_WAIT_V(0);
    if constexpr (!ALIGN_EPI) { if (wr == 0) PG8_BAR; }
    PG8_BAR;
#undef PG8_SA
#undef PG8_SB
#undef PG8_STAGE
#undef PG8_LDA
#undef PG8_LDB
#undef PG8_MMA
#undef PG8_WAIT_V
#undef PG8_WAIT_L
#undef PG8_BAR
#undef PG8_SCHED
}
}
#include <hip/hip_bf16.h>
#include <cmath>
namespace att {
using bf16 = __hip_bfloat16;
constexpr int   D = 128, NW = 8, QBLK = 32, KVBLK = 64;
constexpr float SCALE = 0.088388347648318440f;
constexpr float THR = 8.f;
constexpr int SDEPTH = 2;
constexpr int LDQ = 6144, LDK = 6144, LDO = 4096;
constexpr size_t SHM_V = KVBLK * D * 2, SHM_K = KVBLK * D * 2, SHM_ATTN = 2 * SHM_V + 2 * SHM_K + NW * 64 * 4;
using bf16x8 = __attribute__((ext_vector_type(8))) short;
using s16x4  = __attribute__((ext_vector_type(4))) short;
using f32x16 = __attribute__((ext_vector_type(16))) float;
using f32x8  = __attribute__((ext_vector_type(8))) float;
using u32x4  = __attribute__((ext_vector_type(4))) unsigned;
#define KSWZ(row, colB) ((row) * 256 + ((colB) ^ (((row) & 7) << 4)))
#define SBAR() __builtin_amdgcn_sched_barrier(0)
__device__ __forceinline__ int crow(int r, int hi) { return (r & 3) + 8 * (r >> 2) + 4 * hi; }
__device__ __forceinline__ unsigned cvtpk(float lo, float hi) {
  unsigned r; asm volatile("v_cvt_pk_bf16_f32 %0, %1, %2" : "=v"(r) : "v"(lo), "v"(hi)); return r;
}
template <typename TIn> struct Stage;
template <> struct Stage<bf16>  { using T = bf16x8;
  __device__ static __forceinline__ T ld8(const bf16* p) { return *reinterpret_cast<const bf16x8*>(p); }
  __device__ static __forceinline__ bf16x8 tobf(T x) { return x; } };
template <> struct Stage<float> { using T = f32x8;
  __device__ static __forceinline__ T ld8(const float* p) { return *reinterpret_cast<const f32x8*>(p); }
  __device__ static __forceinline__ bf16x8 tobf(T x) {
    u32x4 w = {cvtpk(x[0], x[1]), cvtpk(x[2], x[3]), cvtpk(x[4], x[5]), cvtpk(x[6], x[7])}; return *reinterpret_cast<bf16x8*>(&w); } };

__device__ __forceinline__ void partialSM(f32x16& p0, f32x16& p1, float& m_reg, float& mn, float& alpha) {
  constexpr float C = SCALE * 1.4426950408889634f;
  float pmax = p0[0]; for (int r = 1; r < 16; ++r) pmax = fmaxf(pmax, p0[r]); for (int r = 0; r < 16; ++r) pmax = fmaxf(pmax, p1[r]);
  { auto rr = __builtin_amdgcn_permlane32_swap(__float_as_uint(pmax), __float_as_uint(pmax), false, false);
    pmax = fmaxf(__uint_as_float(rr[0]), __uint_as_float(rr[1])); }
  if (__builtin_expect(__all(pmax - m_reg <= THR / SCALE), 1)) { mn = m_reg; alpha = 1.f; }
  else { mn = fmaxf(m_reg, pmax); alpha = __builtin_amdgcn_exp2f((m_reg - mn) * C); m_reg = mn; }
  float mnC = -mn * C;
  for (int r = 0; r < 16; ++r) p0[r] = fmaf(p0[r], C, mnC); for (int r = 0; r < 16; ++r) p1[r] = fmaf(p1[r], C, mnC);
  for (int r = 0; r < 16; ++r) p0[r] = __builtin_amdgcn_exp2f(p0[r]);
}
__device__ __forceinline__ void finishSM(f32x16& p0, f32x16& p1, float alpha, float& l_reg, bf16x8& pa0, bf16x8& pa1, bf16x8& pa2, bf16x8& pa3) {
  for (int r = 0; r < 16; ++r) p1[r] = __builtin_amdgcn_exp2f(p1[r]);
  float ps = 0; for (int r = 0; r < 16; ++r) ps += p0[r]; for (int r = 0; r < 16; ++r) ps += p1[r];
  { auto rr = __builtin_amdgcn_permlane32_swap(__float_as_uint(ps), __float_as_uint(ps), false, false);
    ps = __uint_as_float(rr[0]) + __uint_as_float(rr[1]); }
  l_reg = l_reg * alpha + ps;
#define PK4(P, BASE, OUT) do { unsigned a0 = cvtpk(P[BASE + 0], P[BASE + 1]), a1 = cvtpk(P[BASE + 2], P[BASE + 3]);   \
    unsigned b0 = cvtpk(P[BASE + 4], P[BASE + 5]), b1 = cvtpk(P[BASE + 6], P[BASE + 7]);                              \
    auto r0 = __builtin_amdgcn_permlane32_swap(a0, b0, false, false); auto r1 = __builtin_amdgcn_permlane32_swap(a1, b1, false, false); \
    u32x4 w = {r0[0], r1[0], r0[1], r1[1]}; OUT = *reinterpret_cast<bf16x8*>(&w); } while (0)
  PK4(p0, 0, pa0); PK4(p0, 8, pa1); PK4(p1, 0, pa2); PK4(p1, 8, pa3);
#undef PK4
}
__device__ __forceinline__ void qkt(f32x16& p0, f32x16& p1, const bf16* Ks, const bf16x8* qr, int r32, int hi) {
  p0 = f32x16{}; p1 = f32x16{};
  for (int d0 = 0; d0 < 8; ++d0) { int cb = (d0 * 16 + hi * 8) * 2;
    bf16x8 b0 = *reinterpret_cast<const bf16x8*>((const char*)Ks + KSWZ(r32, cb));
    bf16x8 b1 = *reinterpret_cast<const bf16x8*>((const char*)Ks + KSWZ(32 + r32, cb));
    p0 = __builtin_amdgcn_mfma_f32_32x32x16_bf16(b0, qr[d0], p0, 0, 0, 0);
    p1 = __builtin_amdgcn_mfma_f32_32x32x16_bf16(b1, qr[d0], p1, 0, 0, 0); }
}
__device__ __forceinline__ int v_st(int k, int c) { const int kk = (k & ~0xC) | ((k & 4) << 1) | ((k & 8) >> 1); return ((kk >> 3) * 4 + (c >> 5)) * 512 + ((kk & 7) * 32 + (c & 31)) * 2; }
__device__ __forceinline__ int v_rd_base(int lane) { return ((lane & 3) << 3) | (((lane >> 2) & 3) << 6) | (((lane >> 4) & 1) << 5) | (((lane >> 5) & 1) << 8); }
constexpr int v_rd_off(int d0, int ks, int half) { return d0 * 512 + ks * 4096 + half * 2048; }
template <int OFF> __device__ __forceinline__ s16x4 tr_read(int vb) {
  s16x4 r; asm volatile("ds_read_b64_tr_b16 %0, %1 offset:%2" : "=&v"(r) : "v"(vb), "i"(OFF) : "memory"); return r;
}
template <int D0> __device__ __forceinline__ void pv_one(f32x16& od, int vb, bf16x8 pa0, bf16x8 pa1, bf16x8 pa2, bf16x8 pa3) {
  const s16x4 l0 = tr_read<v_rd_off(D0, 0, 0)>(vb), h0 = tr_read<v_rd_off(D0, 0, 1)>(vb), l1 = tr_read<v_rd_off(D0, 1, 0)>(vb), h1 = tr_read<v_rd_off(D0, 1, 1)>(vb);
  const s16x4 l2 = tr_read<v_rd_off(D0, 2, 0)>(vb), h2 = tr_read<v_rd_off(D0, 2, 1)>(vb), l3 = tr_read<v_rd_off(D0, 3, 0)>(vb), h3 = tr_read<v_rd_off(D0, 3, 1)>(vb);
  asm volatile("s_waitcnt lgkmcnt(0)" ::: "memory"); SBAR();
#define PK(L, H) (bf16x8){L[0], L[1], L[2], L[3], H[0], H[1], H[2], H[3]}
  od = __builtin_amdgcn_mfma_f32_32x32x16_bf16(pa0, PK(l0, h0), od, 0, 0, 0);
  od = __builtin_amdgcn_mfma_f32_32x32x16_bf16(pa1, PK(l1, h1), od, 0, 0, 0);
  od = __builtin_amdgcn_mfma_f32_32x32x16_bf16(pa2, PK(l2, h2), od, 0, 0, 0);
  od = __builtin_amdgcn_mfma_f32_32x32x16_bf16(pa3, PK(l3, h3), od, 0, 0, 0);
#undef PK
}
__device__ __forceinline__ void pv_d0(f32x16* o, int vb, bf16x8 pa0, bf16x8 pa1, bf16x8 pa2, bf16x8 pa3) {
  pv_one<0>(o[0], vb, pa0, pa1, pa2, pa3); pv_one<1>(o[1], vb, pa0, pa1, pa2, pa3); pv_one<2>(o[2], vb, pa0, pa1, pa2, pa3); pv_one<3>(o[3], vb, pa0, pa1, pa2, pa3);
}

template <typename TQ>
__device__ __forceinline__ void attn_dense_body(const TQ* __restrict__ Qb, const bf16* __restrict__ Kh, const bf16* __restrict__ Vh,
                                                unsigned short* __restrict__ Ob, int seq, char* lds) {
  using St = Stage<bf16>; using SQ = Stage<TQ>;
  int tid_ = threadIdx.x; asm volatile("" : "+v"(tid_)); const int tid = tid_, wid = tid >> 6, lane = tid & 63, r32 = lane & 31, hi = lane >> 5;
  bf16* V_lds = (bf16*)lds; bf16* K_lds = (bf16*)(lds + 2 * SHM_V);
  float* ws = (float*)(lds + 2 * SHM_V + 2 * SHM_K) + wid * 64; float* li_l = ws; float* al_l = ws + 32;
  float m_reg = -1e30f, l_reg = 0; f32x16 o[4] = {}; bf16x8 qr[8];
  const TQ* Qw = Qb + (long)(wid * QBLK + r32) * LDQ + hi * 8;
#pragma unroll
  for (int d0 = 0; d0 < 8; ++d0) qr[d0] = SQ::tobf(SQ::ld8(Qw + d0 * 16));
  const int sr = tid >> 4, sc = (tid & 15) * 8, vst0 = v_st(sr, sc), vst1 = v_st(32 + sr, sc);
  const int vb0 = (int)(uintptr_t)V_lds + v_rd_base(lane);
  struct { typename St::T vs0, vs1, ks0, ks1; } sr_[SDEPTH];
#define SLOAD(i, k0) do { sr_[i].vs0 = St::ld8(&Vh[(long)((k0) + sr) * LDK + sc]); sr_[i].vs1 = St::ld8(&Vh[(long)((k0) + 32 + sr) * LDK + sc]); \
    sr_[i].ks0 = St::ld8(&Kh[(long)((k0) + sr) * LDK + sc]); sr_[i].ks1 = St::ld8(&Kh[(long)((k0) + 32 + sr) * LDK + sc]); } while (0)
#define SWRITE(b, i) do { *(bf16x8*)((char*)V_lds + (b) * SHM_V + vst0) = St::tobf(sr_[i].vs0);          \
    *(bf16x8*)((char*)V_lds + (b) * SHM_V + vst1) = St::tobf(sr_[i].vs1); int kc = sc * 2;               \
    *(bf16x8*)((char*)K_lds + (b) * SHM_K + KSWZ(sr, kc)) = St::tobf(sr_[i].ks0);                       \
    *(bf16x8*)((char*)K_lds + (b) * SHM_K + KSWZ(32 + sr, kc)) = St::tobf(sr_[i].ks1); } while (0)
#define SWAIT() do { if constexpr (SDEPTH == 2) asm volatile("s_waitcnt vmcnt(4)" ::: "memory"); else asm volatile("s_waitcnt vmcnt(0)" ::: "memory"); } while (0)
#define RESC(a) do { if (__any((a) < 1.f)) { if (hi == 0) al_l[r32] = (a); asm volatile("s_waitcnt lgkmcnt(0)" ::: "memory"); \
    for (int d = 0; d < 4; ++d) for (int r = 0; r < 16; ++r) o[d][r] *= al_l[crow(r, hi)]; } } while (0)
  f32x16 pA0, pA1, pB0, pB1; float mnA, mnB, alA, alB; bf16x8 pa0, pa1, pa2, pa3; const int NT = seq / KVBLK;
  constexpr int SE = 0, SO = SDEPTH - 1;
  SLOAD(SE, 0); asm volatile("s_waitcnt vmcnt(0)" ::: "memory"); SWRITE(0, SE); __syncthreads();
  qkt(pA0, pA1, K_lds, qr, r32, hi); partialSM(pA0, pA1, m_reg, mnA, alA);
  SLOAD(SO, KVBLK); if constexpr (SDEPTH == 2) { if (2 < NT) SLOAD(SE, 2 * KVBLK); }
  SWAIT(); SWRITE(1, SO); __syncthreads();
  for (int j = 1; j + 1 < NT; j += 2) {
    SBAR(); qkt(pB0, pB1, (bf16*)((char*)K_lds + SHM_K), qr, r32, hi);
    finishSM(pA0, pA1, alA, l_reg, pa0, pa1, pa2, pa3); SBAR();
    SLOAD(SO, (j + SDEPTH) * KVBLK); SBAR();
    pv_d0(o, vb0, pa0, pa1, pa2, pa3); partialSM(pB0, pB1, m_reg, mnB, alB);
    __syncthreads(); SWAIT(); SWRITE(0, SE);
    RESC(alB); __syncthreads();
    SBAR(); qkt(pA0, pA1, K_lds, qr, r32, hi);
    finishSM(pB0, pB1, alB, l_reg, pa0, pa1, pa2, pa3); SBAR();
    if (SDEPTH == 1 || j + 3 < NT) SLOAD(SE, (j + 1 + SDEPTH) * KVBLK); SBAR();
    pv_d0(o, vb0 + (int)SHM_V, pa0, pa1, pa2, pa3); partialSM(pA0, pA1, m_reg, mnA, alA);
    __syncthreads(); SWAIT(); SWRITE(1, SO);
    RESC(alA); __syncthreads();
  }
  SBAR(); qkt(pB0, pB1, (bf16*)((char*)K_lds + SHM_K), qr, r32, hi);
  finishSM(pA0, pA1, alA, l_reg, pa0, pa1, pa2, pa3); SBAR();
  pv_d0(o, vb0, pa0, pa1, pa2, pa3); partialSM(pB0, pB1, m_reg, mnB, alB);
  __syncthreads(); RESC(alB);
  finishSM(pB0, pB1, alB, l_reg, pa0, pa1, pa2, pa3); SBAR();
  pv_d0(o, vb0 + (int)SHM_V, pa0, pa1, pa2, pa3);
  if (hi == 0) li_l[r32] = l_reg; asm volatile("s_waitcnt lgkmcnt(0)" ::: "memory");
  float rli[16];
#pragma unroll
  for (int r = 0; r < 16; ++r) rli[r] = __builtin_amdgcn_rcpf(li_l[crow(r, hi)]);
  unsigned short* Ow = Ob + (long)(wid * QBLK) * LDO;
#pragma unroll
  for (int r = 0; r < 16; ++r) { int orow = crow(r, hi);
    for (int d0 = 0; d0 < 4; ++d0) Ow[(long)orow * LDO + d0 * 32 + r32] = (unsigned short)(pg8::cvt_pk_bf16(o[d0][r] * rli[r], 0.f) & 0xffffu); }
#undef SLOAD
#undef SWRITE
#undef SWAIT
#undef RESC
}
}
constexpr int DM = 2048, NB = 4, SEQ = 2048, NCTX = 256, LTOK = 2304, NTOK = NB * LTOK  , NLAT = NB * SEQ  ;
constexpr int DFF = 5632, DFF2 = 2 * DFF;
constexpr int NLAYER = 4, NMOD = 6;
constexpr float DN_ALPHA = 1.6817928305074290f;
constexpr float LN_EPS = 1e-5f;
constexpr int NWAVES = 8;
#ifndef MK_N_LAUNCHES
#define MK_N_LAUNCHES 1
#endif

constexpr size_t MiB = 1u << 20;
constexpr size_t al256(size_t x) { return (x + 255) / 256 * 256; }
constexpr size_t WS_CTL = 0;
constexpr size_t WS_MOD = 1 * MiB;
constexpr size_t ZERO_BYTES = 2 * MiB;
constexpr size_t WS_ROPE = 2 * MiB;
constexpr size_t WS_LB = WS_ROPE + al256((size_t)LTOK * 64 * 2 * 4);
constexpr size_t WS_STAT = WS_LB + 64 * 1024;
constexpr size_t WS_ZS = WS_STAT + 80 * 1024;
constexpr size_t WS_W0 = 4 * MiB;
static_assert(WS_ZS + (size_t)NTOK * 4 <= WS_W0, "small tables fit below the weight copies");
constexpr size_t WS_WA = WS_W0;
constexpr size_t WS_WL2 = WS_WA + (size_t)6912 * 2048 * 2;
constexpr size_t WS_WO = WS_WL2 + (size_t)10240 * 256 * 2;
constexpr size_t WS_WQKV = WS_WO + (size_t)4 * 2048 * 2048 * 2;
constexpr size_t WS_WHG = WS_WQKV + (size_t)6144 * 2048 * 2;
constexpr size_t WS_WLR = WS_WHG + (size_t)10240 * 2048 * 2;
constexpr size_t WS_WGATE = WS_WLR + (size_t)4096 * 2048 * 2;
constexpr size_t WS_WUP = WS_WGATE + (size_t)32 * 256 * 256 * 2;
constexpr size_t WS_WDN = WS_WUP + (size_t)4 * DFF2 * 2048 * 2;
constexpr size_t WS_WEND = WS_WDN + (size_t)4 * 2048 * DFF * 2;
constexpr size_t WS_Z = al256(WS_WEND);
constexpr size_t WS_PRE = WS_Z + (size_t)NTOK * DM * 4;
constexpr size_t WS_H = WS_PRE + (size_t)NTOK * DM * 4;
constexpr size_t WS_OUTB = WS_H + (size_t)NTOK * DM * 2;
constexpr size_t WS_POOL = WS_OUTB + (size_t)NTOK * DM * 2;
constexpr size_t SLOT = (size_t)NTOK * DM * 2;
constexpr size_t WS_U = WS_POOL;
constexpr size_t WS_ACT = WS_U + (size_t)NTOK * DFF2 * 2;
constexpr size_t WS_UB = WS_U + (size_t)32 * MiB;
constexpr size_t WS_RKV = WS_POOL;
constexpr size_t L0_R = WS_RKV, L0_K = WS_RKV + SLOT, L0_DEC0 = WS_RKV + 2 * SLOT, L0_DEC1 = WS_RKV + 3 * SLOT, L0_IC0 = WS_RKV + 4 * SLOT, L0_IC1 = WS_RKV + 5 * SLOT, L0_V = WS_RKV + 6 * SLOT, L0_G = WS_RKV + 7 * SLOT;
constexpr size_t L0_YS = WS_RKV;
constexpr size_t L0_HID = WS_RKV + 8 * SLOT;
constexpr size_t L0_BONUS = L0_HID + (size_t)3 * NTOK * 256 * 2;
constexpr size_t L0_SCAL = L0_BONUS + (size_t)NTOK * 32 * 4;
constexpr size_t L0_XS = al256(L0_SCAL + (size_t)256 * LTOK * 2 * 4);
constexpr size_t L0_VEC = L0_XS;
constexpr size_t L0_END = L0_VEC + (size_t)256 * LTOK * 6 * 64 * 2;
constexpr size_t L1_QKV = WS_POOL;
constexpr size_t L1_O = L1_QKV + (size_t)NTOK * 6144 * 2;
constexpr size_t L2_HGO = WS_POOL;
constexpr size_t L2_OG = L2_HGO + (size_t)NTOK * 10240 * 2;
constexpr size_t L3_IN = WS_POOL;
constexpr size_t L3_XB = L3_IN + 2 * SLOT;
constexpr size_t L3_LOGA = L3_XB + SLOT;
constexpr size_t L3_UU = L3_LOGA + 2 * SLOT;
constexpr size_t L3_YS = L3_UU + 2 * SLOT;
constexpr size_t WS_END = L0_END;
static_assert(WS_ACT + (size_t)NTOK * DFF * 2 <= WS_END && L3_YS + 4 * SLOT <= WS_END && L2_OG + 4 * SLOT <= WS_END && L1_O + (size_t)NTOK * 4096 * 4 <= WS_END, "pool");
static_assert(WS_END <= (size_t)1536 * MiB, "d_ws map must fit 4 x the largest input");

constexpr int CW_BAR = 4096;
constexpr int RING_OFF = 0, RING_BYTES = 131072;
constexpr int LDSCTL_OFF = RING_BYTES, MISC_OFF = LDSCTL_OFF + 320;
constexpr int LDS_BYTES = 147456;

#define GAS __attribute__((address_space(1)))
#define LAS __attribute__((address_space(3)))
typedef unsigned short bf16;
typedef unsigned v4u __attribute__((ext_vector_type(4)));
typedef unsigned v2u __attribute__((ext_vector_type(2)));
typedef float f32x4 __attribute__((ext_vector_type(4)));
typedef float f32x2 __attribute__((ext_vector_type(2)));
typedef short bf16x8 __attribute__((ext_vector_type(8)));
typedef GAS unsigned gu32;
#define RLX_AGENT __ATOMIC_RELAXED, __HIP_MEMORY_SCOPE_AGENT
#define LDS_WAIT() asm volatile("s_waitcnt lgkmcnt(0)" ::: "memory")
#define VM_WAIT() asm volatile("s_waitcnt vmcnt(0)" ::: "memory")
#define LDS_BARRIER() do { asm volatile("s_waitcnt lgkmcnt(0)" ::: "memory"); __builtin_amdgcn_s_barrier(); asm volatile("" ::: "memory"); } while (0)
__device__ __forceinline__ unsigned pk2(float lo, float hi) { return pg8::cvt_pk_bf16(lo, hi); }
__device__ __forceinline__ float bflo(unsigned w) { return __uint_as_float(w << 16); }
__device__ __forceinline__ float bfhi(unsigned w) { return __uint_as_float(w & 0xffff0000u); }
__device__ __forceinline__ float bf2f(bf16 x) { return __uint_as_float(((unsigned)x) << 16); }
__device__ __forceinline__ bf16 f2bf(float f) { return (bf16)(pk2(f, 0.f) & 0xffffu); }
__device__ __forceinline__ int vzero() { int z; asm volatile("v_mov_b32 %0, 0" : "=v"(z)); return z; }
__device__ __forceinline__ float sigmoidf_(float x) { return __builtin_amdgcn_rcpf(1.f + __expf(-x)); }
__device__ __forceinline__ float siluf_(float x) { return x * sigmoidf_(x); }
__device__ __forceinline__ float tanhf_(float x) { const float e = __expf(2.f * x); return 1.f - 2.f * __builtin_amdgcn_rcpf(e + 1.f); }
__device__ __forceinline__ float gelu_tanh_(float x) { const float u = 0.7978845608028654f * (x + 0.044715f * x * x * x); return 0.5f * x * (1.f + tanhf_(u)); }

#define XB_TMO      128
#define XB_XCNT(j)  (256  + 64 * (j))
#define XB_XSUB(j)  (1280 + 64 * (j))
#define XB_XGEN(j)  (2304 + 64 * (j))
#define XB_TOP      3328
#define XB_TOPGEN   3392
#define XCD_BAR_WORDS 3456
#define XB_SPIN_CAP (1u << 18)
__device__ __forceinline__ unsigned xb_ld(unsigned* p)              { return __hip_atomic_load(p, __ATOMIC_RELAXED, __HIP_MEMORY_SCOPE_AGENT); }
__device__ __forceinline__ unsigned xb_add(unsigned* p, unsigned v) { return __hip_atomic_fetch_add(p, v, __ATOMIC_RELAXED, __HIP_MEMORY_SCOPE_AGENT); }
__device__ __forceinline__ unsigned xb_xcc_id() { return (unsigned)__builtin_amdgcn_s_getreg((3 << 11) | 20) & 0xFu; }
#define XB_SPIN(cond, bar) do { unsigned _sp = 0; while (cond) { __builtin_amdgcn_s_sleep(1); \
    if ((++_sp & 255u) == 0u) { if (xb_ld(&(bar)[XB_TMO])) break; if (_sp > XB_SPIN_CAP) { atomicAdd(&(bar)[XB_TMO], 1u); break; } } } } while (0)
struct XcdBarrier { unsigned* bar; unsigned x; volatile LAS unsigned* st; };
__device__ __forceinline__ XcdBarrier xcd_barrier_post(unsigned* bar, volatile LAS unsigned* st) {
    XcdBarrier b; b.bar = bar; b.x = xb_xcc_id(); b.st = st;
    if (threadIdx.x == 0) (void)xb_add(&bar[XB_XCNT(b.x)], 1u);
    return b;
}
__device__ __forceinline__ void xcd_barrier_complete(unsigned* bar, unsigned x, unsigned& nloc, unsigned& nx) {
    const unsigned G = gridDim.x * gridDim.y * gridDim.z;
    unsigned sum, cnt, mine, sp = 0u;
    for (;;) {
        sum = 0u; cnt = 0u; mine = 0u;
#pragma unroll
        for (unsigned j = 0; j < 16; ++j) { const unsigned c = xb_ld(&bar[XB_XCNT(j)]); sum += c; cnt += (c > 0u) ? 1u : 0u; mine = (j == x) ? c : mine; }
        if (sum == G) break;
        __builtin_amdgcn_s_sleep(1);
        if ((++sp & 255u) == 0u) { if (xb_ld(&bar[XB_TMO])) break; if (sp > XB_SPIN_CAP) { atomicAdd(&bar[XB_TMO], 1u); break; } }
    }
    nloc = mine > 0u ? mine : 1u; nx = cnt > 0u ? cnt : 1u;
}
__device__ __forceinline__ void xcd_barrier(const XcdBarrier& b) {
    asm volatile("s_waitcnt vmcnt(0)" ::: "memory");
    __syncthreads();
    if (threadIdx.x == 0) {
        unsigned* bar = b.bar;
        __builtin_amdgcn_s_waitcnt(0);
        unsigned nloc = b.st[0], nx = b.st[1];
        if (nloc == 0u) { xcd_barrier_complete(bar, b.x, nloc, nx); b.st[0] = nloc; b.st[1] = nx; }
        const unsigned old = xb_add(&bar[XB_XSUB(b.x)], 1u);
        const unsigned gen = old / nloc;
        if (old + 1u == (gen + 1u) * nloc) {
            __builtin_amdgcn_fence(__ATOMIC_RELEASE, "agent");
            asm volatile("s_waitcnt vmcnt(0)" ::: "memory");
            const unsigned og = xb_add(&bar[XB_TOP], 1u);
            const unsigned tg = og / nx;
            if (og + 1u == (tg + 1u) * nx) xb_add(&bar[XB_TOPGEN], 1u);
            else XB_SPIN(xb_ld(&bar[XB_TOPGEN]) == tg, bar);
            __builtin_amdgcn_fence(__ATOMIC_ACQUIRE, "agent");
            xb_add(&bar[XB_XGEN(b.x)], 1u);
            asm volatile("s_waitcnt vmcnt(0)" ::: "memory");
        } else {
            XB_SPIN(xb_ld(&bar[XB_XGEN(b.x)]) == gen, bar);
            __builtin_amdgcn_fence(__ATOMIC_ACQUIRE, "agent");
            asm volatile("s_waitcnt vmcnt(0)" ::: "memory");
        }
    }
    __syncthreads();
}

#define CAS __attribute__((address_space(4)))
__device__ __forceinline__ const void* ldarg(int k) { const CAS char* ka = (const CAS char*)__builtin_amdgcn_kernarg_segment_ptr(); return *(const void* const volatile CAS*)(ka + 8 * k); }
#define INP(k) ((const float*)ldarg(k))
__device__ __forceinline__ float wave_max(float v) {
#pragma unroll
    for (int o = 1; o < 64; o <<= 1) v = fmaxf(v, __shfl_xor(v, o));
    return v;
}
__device__ __forceinline__ float wave_sum(float v) {
#pragma unroll
    for (int o = 1; o < 64; o <<= 1) v += __shfl_xor(v, o);
    return v;
}
struct Frame {
    LAS unsigned char* lds;
    volatile LAS unsigned* MISC;
    gu32* ctl;
    int tid, lane, wave;
    int vcu, G, bx;
    unsigned char* ws;
};
#define GW(F) ((F).vcu * NWAVES + (F).wave)
#define NGW(F) ((F).G * NWAVES)
struct ItemIter { int base, step, lim; };
__device__ __forceinline__ ItemIter item_iter(const Frame& F, int N) {
    ItemIter I;
    I.base = GW(F); I.step = NGW(F); I.lim = N;
    return I;
}

__device__ __forceinline__ void transpose_item(const float* W, int ldw, int Ksrc, int koff, int dstK, int N, bf16* WT, int row_off, LAS float* scr, int item, int lane) {
    const int nblk = N / 32, kb = item / nblk, nb = item % nblk, k0 = 64 * kb, n0 = 32 * nb;
    float tv[32];
#pragma unroll
    for (int i = 0; i < 32; ++i) { const int kk = 2 * i + (lane >> 5); const int ks = k0 + kk - koff;
        tv[i] = 0.f; if (ks >= 0 && ks < Ksrc) tv[i] = W[(size_t)ks * ldw + n0 + (lane & 31)]; }
#pragma unroll
    for (int i = 0; i < 32; ++i) scr[(2 * i + (lane >> 5)) * 33 + (lane & 31)] = tv[i];
    LDS_WAIT(); asm volatile("" ::: "memory");
    const int c = lane & 7;
#pragma unroll
    for (int j = 0; j < 4; ++j) { const int n = (lane >> 3) + 8 * j; const LAS float* s = scr + (8 * c) * 33 + n;
        v4u o; o.x = pk2(s[0 * 33], s[1 * 33]); o.y = pk2(s[2 * 33], s[3 * 33]); o.z = pk2(s[4 * 33], s[5 * 33]); o.w = pk2(s[6 * 33], s[7 * 33]);
        *(GAS v4u*)(WT + (size_t)(row_off + n0 + n) * dstK + k0 + 8 * c) = o; }
    LDS_WAIT(); asm volatile("" ::: "memory");
}
#define TR_RUN(W, ldw, Ksrc, koff, dstK, N, WT, row_off) do { const int _n = ((dstK) / 64) * ((N) / 32); \
    for (int _it = (gw + NGWv - (int)(tr_base % NGWv)) % NGWv; _it < _n; _it += NGWv) transpose_item((W), (ldw), (Ksrc), (koff), (dstK), (N), (WT), (row_off), scr, _it, F.lane); \
    tr_base += _n; } while (0)

__device__ __forceinline__ void p0_prologue(Frame& F) {
    LAS float* scr = (LAS float*)(F.lds + RING_OFF + F.wave * 16384);
    const int gw = GW(F), NGWv = NGW(F);
    unsigned char* ws = F.ws;
    long tr_base = 0;
#if defined(PROBE_MASK) && ((PROBE_MASK >> 10) & 1)
    for (int prep_ = 0; prep_ < 2; ++prep_) {
#else
    {
#endif
    bf16* WA = (bf16*)(ws + WS_WA);
    for (int n = 0; n < 3; ++n) TR_RUN(INP(13) + (size_t)n * DM * DM, DM, DM, 0, DM, DM, WA, n * DM);
    for (int d = 0; d < 2; ++d) TR_RUN(INP(15) + (size_t)d * DM * 96, 96, DM, 0, DM, 96, WA, 6144 + d * 96);
    for (int d = 0; d < 2; ++d) TR_RUN(INP(18) + (size_t)d * DM * 64, 64, DM, 0, DM, 64, WA, 6144 + 256 + d * 64);
    TR_RUN(INP(20), 256, DM, 0, DM, 256, WA, 6144 + 512);
    {
        const size_t nvec = (size_t)(64 + 128) * DM / 8;
        for (size_t i = (size_t)gw * 64 + F.lane; i < nvec; i += (size_t)NGWv * 64) {
            const size_t e = i * 8; const size_t row = e / DM, col = e % DM; const size_t r = row < 64 ? 6144 + 192 + row : 6144 + 256 + 128 + (row - 64);
            *(GAS v4u*)(WA + r * DM + col) = (v4u){0u, 0u, 0u, 0u}; }
    }
    bf16* WL2 = (bf16*)(ws + WS_WL2);
    for (int d = 0; d < 2; ++d) TR_RUN(INP(16) + (size_t)d * 96 * DM, DM, 96, d * 96, 256, DM, WL2, d * DM);
    for (int d = 0; d < 2; ++d) TR_RUN(INP(19) + (size_t)d * 64 * DM, DM, 64, d * 64, 256, DM, WL2, (2 + d) * DM);
    TR_RUN(INP(21), DM, 256, 0, 256, DM, WL2, 4 * DM);
    bf16* WO = (bf16*)(ws + WS_WO);
    TR_RUN(INP(27), DM, DM, 0, DM, DM, WO, 0); TR_RUN(INP(31), DM, DM, 0, DM, DM, WO, DM); TR_RUN(INP(35), DM, DM, 0, DM, DM, WO, 2 * DM); TR_RUN(INP(42), DM, DM, 0, DM, DM, WO, 3 * DM);
    {
        bf16* WQ = (bf16*)(ws + WS_WQKV); const float* Wsrc = INP(28);
        const int nkb = DM / 64, nit = nkb * 128;
        for (int it = (gw + NGWv - (int)(tr_base % NGWv)) % NGWv; it < nit; it += NGWv) { const int kb = it / 128, cb = it % 128; const int tile = cb >> 3, hl = (cb & 7) >> 2, qtr = cb & 3;
            const int db = tile * 8 + (qtr & 1) * 4 + hl * 2 + (qtr >> 1);
            transpose_item(Wsrc + cb * 32, 3 * DM, DM, 0, DM, 32, WQ, db * 32, scr, kb, F.lane); }
        tr_base += nit;
        TR_RUN(Wsrc + 2 * DM, 3 * DM, DM, 0, DM, DM, WQ, 2 * DM);
    }
    TR_RUN(INP(32), 5 * DM, DM, 0, DM, 5 * DM, (bf16*)(ws + WS_WHG), 0);
    TR_RUN(INP(36), 2 * DM, DM, 0, DM, 2 * DM, (bf16*)(ws + WS_WLR), 0);
    {
        bf16* WG = (bf16*)(ws + WS_WGATE);
        for (int q = 0; q < 64; ++q) { const int d = q >> 5, g = (q >> 4) & 1, n = (q >> 1) & 7, hf = q & 1;
            TR_RUN(INP(39) + ((size_t)((d * 2 + g) * 8 + n) * 256) * 256 + hf * 128, 256, 256, 0, 256, 128, WG, ((d * 8 + n) * 2 + hf) * 256 + g * 128); }
    }
    {
        const int nit = (DM / 64) * 352;
        for (int l = 0; l < NLAYER; ++l) { const float* Wsrc = INP(8) + (size_t)l * DM * DFF2;
            for (int it = (gw + NGWv - (int)(tr_base % NGWv)) % NGWv; it < nit; it += NGWv) { const int kb = it / 352, cb = it % 352; const int bj = cb / 176, rem = cb % 176;
                const int db = (rem >> 2) * 8 + bj * 4 + (rem & 3);
                transpose_item(Wsrc + cb * 32, DFF2, DM, 0, DM, 32, (bf16*)(ws + WS_WUP), l * DFF2 + db * 32, scr, kb, F.lane); }
            tr_base += nit; }
    }
    for (int l = 0; l < NLAYER; ++l) TR_RUN(INP(11) + (size_t)l * DFF * DM, DM, DFF, 0, DFF, DM, (bf16*)(ws + WS_WDN), l * DM);
    }
    { float* RT = (float*)(ws + WS_ROPE);
      for (int i = gw * 64 + F.lane; i < LTOK * 64; i += NGWv * 64) { const int t = i >> 6, f = i & 63; float ang = 0.f;
          if (t >= NCTX) { const int p = t - NCTX; const float pos = (float)((f < 32) ? (p >> 6) : (p & 63)); const float invf = powf(10000.0f, -(float)(f & 31) / 32.0f); ang = pos * invf; }
          RT[2 * i] = cosf(ang); RT[2 * i + 1] = sinf(ang); } }
    { float* LB = (float*)(ws + WS_LB); const float* lower = INP(33);
      for (int i = gw * 64 + F.lane; i < 2 * DM; i += NGWv * 64) { const int d = i / DM, c = i % DM; float v[4], mx = -1e30f;
          for (int l = 0; l < 4; ++l) { v[l] = lower[(size_t)(d * 4 + l) * DM + c]; mx = fmaxf(mx, v[l]); }
          float s = 0.f; for (int l = 0; l < 4; ++l) { v[l] = expf(v[l] - mx); s += v[l]; }
          LB[i] = (v[1] + v[2]) / s; } }
    {
        __syncthreads();
        LAS float* cv = (LAS float*)(F.lds + RING_OFF);
        LAS float* red = (LAS float*)(F.lds + RING_OFF + 5 * DM * 4);
        { f32x4 xv[5];
#pragma unroll
          for (int r = 0; r < 5; ++r) xv[r] = ((const GAS f32x4*)((r < 4) ? INP(1) + r * DM : INP(3)))[F.tid];
#pragma unroll
          for (int r = 0; r < 5; ++r) { f32x4 o; o.x = xv[r].x / (1.f + expf(-xv[r].x)); o.y = xv[r].y / (1.f + expf(-xv[r].y)); o.z = xv[r].z / (1.f + expf(-xv[r].z)); o.w = xv[r].w / (1.f + expf(-xv[r].w));
              ((LAS f32x4*)cv)[r * (DM / 4) + F.tid] = o; } }
        __syncthreads();
        float* MOD = (float*)(ws + WS_MOD);
        const int NIT = NLAYER * 96 * 2;
        for (int it = F.vcu; it < NIT; it += F.G) {
            const int l = it / 192, rem = it % 192, cb = rem >> 1, kh = rem & 1;
            const float* Wl = INP(4) + (size_t)l * DM * (NMOD * DM) + cb * 128 + 2 * F.lane;
            const int kbeg = kh * 1024 + F.wave * 128;
            float a0[5], a1[5];
#pragma unroll
            for (int r = 0; r < 5; ++r) { a0[r] = 0.f; a1[r] = 0.f; }
#pragma unroll 4
            for (int kk = 0; kk < 128; ++kk) { const int k = kbeg + kk; const f32x2 w = *(const f32x2*)(Wl + (size_t)k * (NMOD * DM));
#pragma unroll
                for (int r = 0; r < 5; ++r) { const float c = cv[r * DM + k]; a0[r] += c * w.x; a1[r] += c * w.y; } }
#pragma unroll
            for (int r = 0; r < 5; ++r) { red[(F.wave * 5 + r) * 128 + 2 * F.lane] = a0[r]; red[(F.wave * 5 + r) * 128 + 2 * F.lane + 1] = a1[r]; }
            __syncthreads();
            for (int o = F.tid; o < 5 * 128; o += NWAVES * 64) { const int r = o / 128, c = o % 128; float s = 0.f;
#pragma unroll
                for (int w = 0; w < 8; ++w) s += red[(w * 5 + r) * 128 + c];
                const int n = cb * 128 + c; if (kh == 0) s += INP(5)[(size_t)l * NMOD * DM + n];
                atomicAdd(MOD + ((size_t)(l * 5 + r) * NMOD * DM + n), s); }
            __syncthreads();
        }
    }
}

__device__ __forceinline__ const float* mod_ptr(const unsigned char* ws, int layer, int bsel, int j) { return (const float*)(ws + WS_MOD) + ((size_t)((layer * 5 + bsel) * NMOD + j)) * DM; }

template <int MODE, bool LAT, int NM, int NN, int LDA, int LDB> struct Sched {
    pg8::TileOrder<NM, NN> T;
    static constexpr unsigned a_tile = 256u * LDA * 2u, b_tile = 256u * LDB * 2u;
    __device__ void init(int G, int c) { T.init(G, c); }
    __device__ __forceinline__ bool next(int i, pg8::Unit& u) const {
        int pm, pn; if (!T.tile(i, pm, pn)) return false;
        if (LAT) pm = (pm >> 3) * 9 + 1 + (pm & 7);
        u.pm = pm; u.pn = pn; u.half = -1;
        if (MODE == 0) { u.aoff = (unsigned)pm * a_tile; u.boff = (unsigned)pn * b_tile; }
        else if (MODE == 1) { const int grp = pn < 24 ? (pn >> 3) : (pn - 21); u.aoff = ((unsigned)grp * 36u + pm) * a_tile; u.boff = (unsigned)pn * b_tile; }
        else if (MODE == 2) { const int g = pn >> 3, hg = (g == 4) ? 2 : (g >> 1); u.aoff = ((unsigned)hg * 36u + pm) * a_tile; u.boff = (unsigned)pn * b_tile; }
        else { const int n = (pn >> 1) & 7; u.aoff = (unsigned)pm * a_tile + (unsigned)n * 512u; u.boff = (unsigned)pn * b_tile; }
        return true;
    }
};
template <int SPLIT, int KSUB, int LDA, int LDB> struct SchedSplit {
    int G, c;
    __device__ void init(int G_, int c_) { G = G_; c = c_; }
    __device__ __forceinline__ bool next(int i, pg8::Unit& u) const {
        const int L = i * G + c; if (L >= 32 * SPLIT) return false;
        const int tile = L / SPLIT, ks = L % SPLIT; const int pm = 32 + (tile & 3), pn = tile >> 2;
        u.pm = pm; u.pn = pn | (ks << 8); u.half = -1;
        u.aoff = (unsigned)pm * (256u * LDA * 2u) + (unsigned)ks * (KSUB * 2u); u.boff = (unsigned)pn * (256u * LDB * 2u) + (unsigned)ks * (KSUB * 2u);
        return true;
    }
};

template <int SPLIT, int KSUB, int LDA, int LDB> struct SchedSplitHalf {
    int G, c;
    __device__ void init(int G_, int c_) { G = G_; c = c_; }
    __device__ __forceinline__ bool next(int i, pg8::Unit& u) const {
        const int L = i * G + c; if (L >= 64 * SPLIT) return false;
        const int h = L & 1, Lq = L >> 1; const int tile = Lq / SPLIT, ks = Lq % SPLIT; const int pm = 32 + (tile & 3), pn = tile >> 2;
        u.pm = pm; u.pn = pn | (ks << 8); u.half = h;
        u.aoff = (unsigned)pm * (256u * LDA * 2u) + (unsigned)h * (128u * LDA * 2u) + (unsigned)ks * (KSUB * 2u); u.boff = (unsigned)pn * (256u * LDB * 2u) + (unsigned)ks * (KSUB * 2u);
        return true;
    }
};
template <bool LAT, int NM, int NN, int LMAX, int LDA, int LDB> struct SchedHead {
    int G, c;
    __device__ void init(int G_, int c_) { G = G_; c = c_; }
    __device__ __forceinline__ bool next(int i, pg8::Unit& u) const {
        const int L = i * G + c; if (L >= LMAX) return false;
        int pm, pn; pg8::TileOrder<NM, NN>::tileL(L, pm, pn);
        if (LAT) pm = (pm >> 3) * 9 + 1 + (pm & 7);
        u.pm = pm; u.pn = pn; u.half = -1; u.aoff = (unsigned)pm * (256u * LDA * 2u); u.boff = (unsigned)pn * (256u * LDB * 2u);
        return true;
    }
};
template <bool LAT, int NM, int NN, int LMAX, int NT, int LDA, int LDB> struct SchedHT {
    int G, c;
    __device__ void init(int G_, int c_) { G = G_; c = c_; }
    __device__ __forceinline__ bool next(int i, pg8::Unit& u) const {
        const int L = i * G + c; if (L >= LMAX + 2 * NT) return false;
        const bool whole = L < LMAX; const int Lp = L - LMAX; const int h = whole ? 0 : (Lp & 1);
        int pm, pn; pg8::TileOrder<NM, NN>::tileL(whole ? L : LMAX + (Lp >> 1), pm, pn);
        if (LAT) pm = (pm >> 3) * 9 + 1 + (pm & 7);
        u.pm = pm; u.pn = pn; u.half = whole ? -1 : h; u.aoff = (unsigned)pm * (256u * LDA * 2u) + (unsigned)h * (128u * LDA * 2u); u.boff = (unsigned)pn * (256u * LDB * 2u);
        return true;
    }
};
template <bool LAT, int NM, int NN, int L0, int NT, int LDA, int LDB> struct SchedTailHalf {
    int G, c;
    __device__ void init(int G_, int c_) { G = G_; c = c_; }
    __device__ __forceinline__ bool next(int i, pg8::Unit& u) const {
        const int Lp = i * G + c; if (Lp >= 2 * NT) return false;
        const int tu = Lp >> 1, h = Lp & 1;
        int pm, pn; pg8::TileOrder<NM, NN>::tileL(L0 + tu, pm, pn);
        if (LAT) pm = (pm >> 3) * 9 + 1 + (pm & 7);
        u.pm = pm; u.pn = pn; u.half = h; u.aoff = (unsigned)pm * (256u * LDA * 2u) + (unsigned)h * (128u * LDA * 2u); u.boff = (unsigned)pn * (256u * LDB * 2u);
        return true;
    }
};

template <int kind> struct EpiBf16Route {
    static constexpr bool PERM = true; static constexpr bool PERMA = false;
    bf16* O; int ldc;
    unsigned char* ws; const float* p0; const float* p1;
    static __device__ __forceinline__ float act(int mode, float x, float p) {
        if (kind == 0 || kind == 5) return x;
        if (kind == 1) { const float e = __expf(mode == 1 ? 2.f * x : -x); const float r = __builtin_amdgcn_rcpf(e + 1.f); return mode == 0 ? x : (mode == 1 ? 1.f - 2.f * r : r); }
        if (kind == 2) { const float s = sigmoidf_(x + p); const float dcy = __expf(-0.606531f * s); return mode == 4 ? dcy : (mode == 2 ? s : x); }
        if (kind == 3) { const float s = sigmoidf_(mode == 6 ? -x : x); return mode == 0 ? x : (mode == 3 ? x * s : (1.f - p) * s); }
        return mode == 5 ? gelu_tanh_(x) : x;
    }
    __device__ __forceinline__ void operator()(const pg8::f32x4 (&acc)[2][2][4][2], const pg8::Unit& u, int wr, int wc, int fr, int fq) const {
        bf16* base = O; int ld = ldc, colt = u.pn * 256, mode = 0; const float* par = nullptr;
        if (kind == 1) { if (u.pn < 24) { const int g = u.pn >> 3; base = (bf16*)(ws + (g == 0 ? L0_R : (g == 1 ? L0_K : L0_V))); ld = DM; colt = (u.pn & 7) * 256; }
                         else { const int hg = u.pn - 24; base = (bf16*)(ws + L0_HID) + (size_t)hg * NTOK * 256; ld = 256; colt = 0; mode = hg == 0 ? 1 : (hg == 1 ? 0 : 2); } }
        else if (kind == 2) { const int g = u.pn >> 3; colt = (u.pn & 7) * 256; ld = DM;
                         base = (bf16*)(ws + (g == 0 ? L0_DEC0 : g == 1 ? L0_DEC1 : g == 2 ? L0_IC0 : g == 3 ? L0_IC1 : L0_G));
                         if (g < 2) { mode = 4; par = p0 + g * DM + colt; } else if (g < 4) { mode = 2; par = p1 + (g - 2) * DM + colt; } }
        else if (kind == 3) { const int g = u.pn >> 3; if (g == 0 || g == 2) mode = 3; else if (g >= 3) { mode = 6; par = p0 + (g - 3) * DM + (u.pn & 7) * 256; } }
        else if (kind == 4) { if (u.pn < 8) mode = 5; }
        const int row0 = u.pm * 256 + wr * 64 + fr, col0 = colt + wc * 32 + 8 * fq, pc0 = wc * 32 + 8 * fq;
        const int ai0 = u.half < 0 ? 0 : u.half, nai = u.half < 0 ? 2 : 1;
        if (kind == 5 && u.pn < 16) {
            const int x = wc * 32 + 8 * fq, hl = x >> 6, y = x & 63; const int ncol = u.pn * 256 + hl * 128 + (y < 32 ? y : y + 32);
            const float* RT = (const float*)(ws + WS_ROPE);
#pragma unroll
            for (int ai = 0; ai < 2; ++ai) if (ai < nai)
#pragma unroll
                for (int m = 0; m < 4; ++m) { const int row = row0 + (ai0 + ai) * 128 + m * 16; const int t = row % LTOK;
                    const GAS pg8::f32x4* cs = (const GAS pg8::f32x4*)(RT + ((size_t)t * 64 + y) * 2);
                    const pg8::f32x4 c0 = cs[0], c1 = cs[1], c2 = cs[2], c3 = cs[3];
                    const pg8::f32x4 a0 = acc[ai][0][m][0], a1 = acc[ai][0][m][1], b0 = acc[ai][1][m][0], b1 = acc[ai][1][m][1];
                    pg8::u32x4 wa, wb;
                    wa.x = pk2(a0[0] * c0[0] - b0[0] * c0[1], a0[1] * c0[2] - b0[1] * c0[3]); wa.y = pk2(a0[2] * c1[0] - b0[2] * c1[1], a0[3] * c1[2] - b0[3] * c1[3]);
                    wa.z = pk2(a1[0] * c2[0] - b1[0] * c2[1], a1[1] * c2[2] - b1[1] * c2[3]); wa.w = pk2(a1[2] * c3[0] - b1[2] * c3[1], a1[3] * c3[2] - b1[3] * c3[3]);
                    wb.x = pk2(b0[0] * c0[0] + a0[0] * c0[1], b0[1] * c0[2] + a0[1] * c0[3]); wb.y = pk2(b0[2] * c1[0] + a0[2] * c1[1], b0[3] * c1[2] + a0[3] * c1[3]);
                    wb.z = pk2(b1[0] * c2[0] + a1[0] * c2[1], b1[1] * c2[2] + a1[1] * c2[3]); wb.w = pk2(b1[2] * c3[0] + a1[2] * c3[1], b1[3] * c3[2] + a1[3] * c3[3]);
                    bf16* rp_ = base + (size_t)row * ld + ncol;
                    *(pg8::u32x4*)rp_ = wa; *(pg8::u32x4*)(rp_ + 32) = wb; }
            return;
        }
#pragma unroll
        for (int bj = 0; bj < 2; ++bj) {
            pg8::f32x4 pa = {0.f, 0.f, 0.f, 0.f}, pb = {0.f, 0.f, 0.f, 0.f};
            if ((kind == 2 || kind == 3) && par) { pa = *(const GAS pg8::f32x4*)(par + pc0 + bj * 128); pb = *(const GAS pg8::f32x4*)(par + pc0 + bj * 128 + 4); }
#pragma unroll
            for (int ai = 0; ai < 2; ++ai) if (ai < nai)
#pragma unroll
                for (int m = 0; m < 4; ++m) { bf16* rowp = base + (size_t)(row0 + (ai0 + ai) * 128 + m * 16) * ld + col0 + bj * 128;
                    pg8::f32x4 v0 = acc[ai][bj][m][0], v1 = acc[ai][bj][m][1];
                    if (kind != 0 && kind != 5) {
#pragma unroll
                        for (int j = 0; j < 4; ++j) { v0[j] = act(mode, v0[j], pa[j]); v1[j] = act(mode, v1[j], pb[j]); } }
                    pg8::u32x4 w; w.x = pk2(v0[0], v0[1]); w.y = pk2(v0[2], v0[3]); w.z = pk2(v1[0], v1[1]); w.w = pk2(v1[2], v1[3]);
                    *(pg8::u32x4*)rowp = w; }
        }
    }
};
template <int CTRL> __device__ __forceinline__ float dppz(float v) { return __int_as_float(__builtin_amdgcn_update_dpp(0, __float_as_int(v), CTRL, 0xF, 0xF, true)); }
struct EpiConvAct {
    static constexpr bool PERM = true; static constexpr bool PERMA = true;
    bf16* A; bf16* UB; const float* cw; const float* cb;
    __device__ __forceinline__ void operator()(const pg8::f32x4 (&acc)[2][2][4][2], const pg8::Unit& u, int wr, int wc, int fr, int fq) const {
        const int pc = wc * 32 + 8 * fq, cn = u.pn * 128 + pc;
        const int rowb = u.pm * 256 + wr * 64 + 4 * fr;
        const int ai0 = u.half < 0 ? 0 : u.half, nai = u.half < 0 ? 2 : 1;
        if (fr == 0 || fr == 15) {
            const bool lo = fr == 0; const int run = u.pm * 4 + wr + 2 * ai0;
#pragma unroll
            for (int ai = 0; ai < 2; ++ai) if (ai < nai)
#pragma unroll
                for (int bj = 0; bj < 2; ++bj)
#pragma unroll
                    for (int s = 0; s < 2; ++s) { const pg8::f32x4 a0 = lo ? acc[ai][bj][s][0] : acc[ai][bj][2 + s][0], a1 = lo ? acc[ai][bj][s][1] : acc[ai][bj][2 + s][1];
                        pg8::u32x4 w; w.x = pk2(a0[0], a0[1]); w.y = pk2(a0[2], a0[3]); w.z = pk2(a1[0], a1[1]); w.w = pk2(a1[2], a1[3]);
                        *(pg8::u32x4*)(UB + (size_t)((run + 2 * ai) * 4 + (lo ? s : 2 + s)) * DFF2 + u.pn * 256 + bj * 128 + pc) = w; }
        }
        pg8::u32x2 r0[2][4];
#pragma unroll
        for (int h = 0; h < 2; ++h) {
            const GAS float* wp = (const GAS float*)cw + cn + 4 * h; const GAS float* bp = (const GAS float*)cb + cn + 4 * h;
            const pg8::f32x4 g0 = *(const GAS pg8::f32x4*)wp, g1 = *(const GAS pg8::f32x4*)(wp + DFF2), g2 = *(const GAS pg8::f32x4*)(wp + 2 * DFF2), gb = *(const GAS pg8::f32x4*)bp;
            const pg8::f32x4 v0 = *(const GAS pg8::f32x4*)(wp + DFF), v1 = *(const GAS pg8::f32x4*)(wp + DFF2 + DFF), v2 = *(const GAS pg8::f32x4*)(wp + 2 * DFF2 + DFF), vb = *(const GAS pg8::f32x4*)(bp + DFF);
#pragma unroll
            for (int ai = 0; ai < 2; ++ai) if (ai < nai) {
                __builtin_amdgcn_sched_barrier(0);
                float o[4][4];
#pragma unroll
                for (int j = 0; j < 4; ++j) {
                    const float xg0 = acc[ai][0][0][h][j], xg1 = acc[ai][0][1][h][j], xg2 = acc[ai][0][2][h][j], xg3 = acc[ai][0][3][h][j];
                    const float xv0 = acc[ai][1][0][h][j], xv1 = acc[ai][1][1][h][j], xv2 = acc[ai][1][2][h][j], xv3 = acc[ai][1][3][h][j];
                    const float pg = dppz<0x111>(xg3), ng = dppz<0x101>(xg0), pv = dppz<0x111>(xv3), nv = dppz<0x101>(xv0);
                    const float og0 = gb[j] + g0[j] * pg + g1[j] * xg0 + g2[j] * xg1, ov0 = vb[j] + v0[j] * pv + v1[j] * xv0 + v2[j] * xv1;
                    const float og1 = gb[j] + g0[j] * xg0 + g1[j] * xg1 + g2[j] * xg2, ov1 = vb[j] + v0[j] * xv0 + v1[j] * xv1 + v2[j] * xv2;
                    const float og2 = gb[j] + g0[j] * xg1 + g1[j] * xg2 + g2[j] * xg3, ov2 = vb[j] + v0[j] * xv1 + v1[j] * xv2 + v2[j] * xv3;
                    const float og3 = gb[j] + g0[j] * xg2 + g1[j] * xg3 + g2[j] * ng, ov3 = vb[j] + v0[j] * xv2 + v1[j] * xv3 + v2[j] * nv;
                    o[0][j] = siluf_(og0) * ov0; o[1][j] = siluf_(og1) * ov1; o[2][j] = siluf_(og2) * ov2; o[3][j] = siluf_(og3) * ov3; }
#pragma unroll
                for (int m = 0; m < 4; ++m) { pg8::u32x2 w; w.x = pk2(o[m][0], o[m][1]); w.y = pk2(o[m][2], o[m][3]);
                    if (h == 0) r0[ai][m] = w;
                    else { pg8::u32x4 w4; w4.x = r0[ai][m].x; w4.y = r0[ai][m].y; w4.z = w.x; w4.w = w.y; *(pg8::u32x4*)(A + (size_t)(rowb + (ai0 + ai) * 128 + m) * DFF + cn) = w4; } }
            }
            __builtin_amdgcn_sched_barrier(0);
        }
    }
};
struct EpiResid {
    static constexpr bool PERM = true; static constexpr bool PERMA = false;
    bf16* DELTA; const unsigned char* ws; int layer, j;
    __device__ __forceinline__ void operator()(const pg8::f32x4 (&acc)[2][2][4][2], const pg8::Unit& u, int wr, int wc, int fr, int fq) const {
        const int bsel = (u.pm % 9 == 0) ? 4 : (u.pm / 9);
        const float* gate = mod_ptr(ws, layer, bsel, j);
        const int row0 = u.pm * 256 + wr * 64 + fr, col0 = u.pn * 256 + wc * 32 + 8 * fq;
#pragma unroll
        for (int bj = 0; bj < 2; ++bj) {
            const pg8::f32x4 ga = *(const GAS pg8::f32x4*)(gate + col0 + bj * 128), gb = *(const GAS pg8::f32x4*)(gate + col0 + bj * 128 + 4);
#pragma unroll
            for (int ai = 0; ai < 2; ++ai)
#pragma unroll
                for (int m = 0; m < 4; ++m) { const pg8::f32x4 v0 = acc[ai][bj][m][0] * ga, v1 = acc[ai][bj][m][1] * gb;
                    pg8::u32x4 w; w.x = pk2(v0[0], v0[1]); w.y = pk2(v0[2], v0[3]); w.z = pk2(v1[0], v1[1]); w.w = pk2(v1[2], v1[3]);
                    *(pg8::u32x4*)(DELTA + (size_t)(row0 + ai * 128 + m * 16) * DM + col0 + bj * 128) = w; }
        }
    }
};
struct EpiPartial {
    static constexpr bool PERM = true; static constexpr bool PERMA = false;
    bf16* PART;
    __device__ __forceinline__ void operator()(const pg8::f32x4 (&acc)[2][2][4][2], const pg8::Unit& u, int wr, int wc, int fr, int fq) const {
        const int ks = u.pn >> 8, pn = u.pn & 255;
        bf16* base = PART + (size_t)ks * 1024 * DM; const int row0 = (u.pm - 32) * 256 + wr * 64 + fr, col0 = pn * 256 + wc * 32 + 8 * fq;
        const int ai0 = u.half < 0 ? 0 : u.half, nai = u.half < 0 ? 2 : 1;
#pragma unroll
        for (int ai = 0; ai < 2; ++ai) if (ai < nai)
#pragma unroll
            for (int m = 0; m < 4; ++m)
#pragma unroll
                for (int bj = 0; bj < 2; ++bj) { const pg8::f32x4 v0 = acc[ai][bj][m][0], v1 = acc[ai][bj][m][1];
                    pg8::u32x4 w; w.x = pk2(v0[0], v0[1]); w.y = pk2(v0[2], v0[3]); w.z = pk2(v1[0], v1[1]); w.w = pk2(v1[2], v1[3]);
                    *(pg8::u32x4*)(base + (size_t)(row0 + (ai0 + ai) * 128 + m * 16) * DM + col0 + bj * 128) = w; }
    }
};
struct EpiGates {
    static constexpr bool PERM = true; static constexpr bool PERMA = false;
    unsigned char* ws; const float* b_gate; const float* lam;
    __device__ __forceinline__ void operator()(const pg8::f32x4 (&acc)[2][2][4][2], const pg8::Unit& u, int wr, int wc, int fr, int fq) const {
        const int d = u.pn >> 4, nb = (u.pn >> 1) & 7, hf = u.pn & 1;
        const int c0 = nb * 256 + hf * 128 + wc * 32 + 8 * fq;
        const int row0 = u.pm * 256 + wr * 64 + fr;
        const bf16* XB = (const bf16*)(ws + L3_XB);
        bf16* LOGA = (bf16*)(ws + L3_LOGA) + (size_t)d * NTOK * DM; bf16* UU = (bf16*)(ws + L3_UU) + (size_t)d * NTOK * DM;
        v4u xw[2][4];
#pragma unroll
        for (int ai = 0; ai < 2; ++ai)
#pragma unroll
            for (int m = 0; m < 4; ++m) xw[ai][m] = *(const GAS v4u*)(XB + (size_t)(row0 + ai * 128 + m * 16) * DM + c0);
        v2u kla[2][4], kuu[2][4];
#pragma unroll
        for (int n = 0; n < 2; ++n) {
            const int c4 = c0 + 4 * n;
            const pg8::f32x4 br = *(const pg8::f32x4*)(b_gate + (size_t)(d * 2 + 0) * DM + c4), bi = *(const pg8::f32x4*)(b_gate + (size_t)(d * 2 + 1) * DM + c4);
            const pg8::f32x4 lm = *(const pg8::f32x4*)(lam + (size_t)d * DM + c4); pg8::f32x4 sp;
#pragma unroll
            for (int j = 0; j < 4; ++j) sp[j] = __logf(1.f + __expf(-lm[j]));
#pragma unroll
            for (int ai = 0; ai < 2; ++ai)
#pragma unroll
                for (int m = 0; m < 4; ++m) { const size_t off = (size_t)(row0 + ai * 128 + m * 16) * DM + c0;
                    const unsigned x01 = n ? xw[ai][m].z : xw[ai][m].x, x23 = n ? xw[ai][m].w : xw[ai][m].y;
                    float xb[4]; xb[0] = bflo(x01); xb[1] = bfhi(x01); xb[2] = bflo(x23); xb[3] = bfhi(x23);
                    float la[4], uu[4];
#pragma unroll
                    for (int j = 0; j < 4; ++j) { const float rg = sigmoidf_(acc[ai][0][m][n][j] + br[j]), ig = sigmoidf_(acc[ai][1][m][n][j] + bi[j]);
                        const float lg = -8.0f * rg * sp[j]; la[j] = lg;
                        uu[j] = __builtin_amdgcn_sqrtf(fmaxf(1.f - __expf(2.f * lg), 0.f)) * ig * xb[j]; }
                    v2u wl; wl.x = pk2(la[0], la[1]); wl.y = pk2(la[2], la[3]); v2u wu; wu.x = pk2(uu[0], uu[1]); wu.y = pk2(uu[2], uu[3]);
                    if (n == 0) { kla[ai][m] = wl; kuu[ai][m] = wu; }
                    else { v4u o1; o1.x = kla[ai][m].x; o1.y = kla[ai][m].y; o1.z = wl.x; o1.w = wl.y; *(GAS v4u*)(LOGA + off) = o1;
                           v4u o2; o2.x = kuu[ai][m].x; o2.y = kuu[ai][m].y; o2.z = wu.x; o2.w = wu.y; *(GAS v4u*)(UU + off) = o2; } }
        }
    }
};

template <bool LAT, bool TO_OUT, bool WITH_H, int NSPLIT>
__device__ __forceinline__ void ln_phase(Frame& F, const bf16* DELTA, const float* Zin, float* Zout, float* dout, bf16* H, const float* gam, const float* bet, int mlayer, int jshift, const bf16* PART, int glayer, int jgate) {
    const int gw = GW(F), NGWv = NGW(F); const int nrows = LAT ? NLAT : NTOK;
    for (int idx = gw; idx < nrows; idx += NGWv) {
        int m, b, t; if (LAT) { b = idx >> 11; t = NCTX + (idx & 2047); m = b * LTOK + t; } else { m = idx; b = m / LTOK; t = m % LTOK; }
        const int bsel = (t < NCTX) ? 4 : b;
        f32x4 v[8]; float s = 0.f;
        if (NSPLIT > 0 && m >= 8192) {
            const GAS f32x4* zr = (const GAS f32x4*)(Zin + (size_t)m * DM) + F.lane; const GAS f32x4* gr = (const GAS f32x4*)mod_ptr(F.ws, glayer, bsel, jgate) + F.lane;
            const GAS v2u* pr = (const GAS v2u*)(PART + (size_t)(m - 8192) * DM) + F.lane;
#pragma unroll
            for (int j = 0; j < 8; ++j) { f32x4 a = {0.f, 0.f, 0.f, 0.f};
#pragma unroll
                for (int p = 0; p < NSPLIT; ++p) { const v2u pw = pr[(size_t)p * (1024 * DM / 4) + 64 * j]; a += (f32x4){bflo(pw.x), bfhi(pw.x), bflo(pw.y), bfhi(pw.y)}; }
                v[j] = zr[64 * j] * DN_ALPHA + gr[64 * j] * a; s += (v[j].x + v[j].y) + (v[j].z + v[j].w); }
        } else {
            const GAS f32x4* zr = (const GAS f32x4*)(Zin + (size_t)m * DM) + F.lane; const GAS v2u* dr = (const GAS v2u*)(DELTA + (size_t)m * DM) + F.lane;
#pragma unroll
            for (int j = 0; j < 8; ++j) { const v2u dw = dr[64 * j]; const f32x4 dl = {bflo(dw.x), bfhi(dw.x), bflo(dw.y), bfhi(dw.y)};
                v[j] = zr[64 * j] * DN_ALPHA + dl; s += (v[j].x + v[j].y) + (v[j].z + v[j].w); }
        }
        const float mean = wave_sum(s) * (1.f / DM); float s2 = 0.f;
#pragma unroll
        for (int j = 0; j < 8; ++j) { v[j] = v[j] - mean; s2 += (v[j].x * v[j].x + v[j].y * v[j].y) + (v[j].z * v[j].z + v[j].w * v[j].w); }
        const float rstd = 1.f / sqrtf(wave_sum(s2) * (1.f / DM) + LN_EPS);
        const float* sh = WITH_H ? mod_ptr(F.ws, mlayer, bsel, jshift) : nullptr; const float* sc = WITH_H ? mod_ptr(F.ws, mlayer, bsel, jshift + 1) : nullptr;
        float* zo = TO_OUT ? dout + ((size_t)b * SEQ + (t - NCTX)) * DM : Zout + (size_t)m * DM;
#pragma unroll
        for (int j = 0; j < 8; ++j) { const int col = 256 * j + 4 * F.lane;
            const f32x4 g = *(const f32x4*)(gam + col), be = *(const f32x4*)(bet + col);
            const f32x4 z = v[j] * rstd * g + be;
            *(GAS f32x4*)(zo + col) = z;
            if (WITH_H) { const f32x4 s1 = *(const GAS f32x4*)(sc + col), s0 = *(const GAS f32x4*)(sh + col); const f32x4 h = z * (s1 + 1.f) + s0;
                v2u w; w.x = pk2(h.x, h.y); w.y = pk2(h.z, h.w); *(GAS v2u*)(H + (size_t)m * DM + col) = w; } }
    }
}
__device__ __forceinline__ const float* z0_row(const float* Zb, const float* xin, const float* cin, bool z0in, int m, int b, int t) {
    return z0in ? ((t < NCTX) ? cin + ((size_t)b * NCTX + t) * DM : xin + ((size_t)b * SEQ + (t - NCTX)) * DM) : Zb + (size_t)m * DM;
}
#define LN_ROWINFO(idx_, m_, b_, t_) do { if (LAT) { b_ = (idx_) >> 11; t_ = NCTX + ((idx_) & 2047); m_ = b_ * LTOK + t_; } else { m_ = (idx_); b_ = m_ / LTOK; t_ = m_ % LTOK; } } while (0)
#define LNI(j_) (128 * ((j_) >> 1) + 2 * F.lane + ((j_) & 1))
#define LN_SPLIT_D(dst, PARTp, gatep, m_) do { const GAS v2u* pr_ = (const GAS v2u*)((PARTp) + (size_t)((m_) - 8192) * DM); const GAS f32x4* gr_ = (const GAS f32x4*)(gatep); \
        _Pragma("unroll") for (int j_ = 0; j_ < 8; ++j_) { f32x4 a_ = {0.f, 0.f, 0.f, 0.f}; \
            _Pragma("unroll") for (int p_ = 0; p_ < NSPLIT; ++p_) { const v2u pw_ = pr_[(size_t)p_ * (1024 * DM / 4) + LNI(j_)]; a_ += (f32x4){bflo(pw_.x), bfhi(pw_.x), bflo(pw_.y), bfhi(pw_.y)}; } \
            a_ = a_ * gr_[LNI(j_)]; dst[j_].x = pk2(a_.x, a_.y); dst[j_].y = pk2(a_.z, a_.w); } } while (0)
__device__ __forceinline__ f32x4 zq_decode(const f32x4 raw, float sc) { const int a = __float_as_int(raw.x), b = __float_as_int(raw.y);
    return (f32x4){(float)(short)(a & 0xffff), (float)(a >> 16), (float)(short)(b & 0xffff), (float)(b >> 16)} * sc; }
#define ZQ_ROW(Zb_, m_) ((const GAS v4u*)((const unsigned short*)(Zb_) + (size_t)(m_) * DM) + F.lane)
template <bool LAT, int NSPLIT, bool Z0IN>
__device__ __forceinline__ void ln1_phase(Frame& F, bf16* D1, const float* Zb, const float* xin, const float* cin, bf16* H, float* STAT, const float* gam, const float* bet, int layer, const bf16* PART) {
    const int gw = GW(F), NGWv = NGW(F); const int nrows = LAT ? NLAT : NTOK; const int nmain = NSPLIT > 0 ? 8192 : nrows;
    LAS float* Lg = (LAS float*)(F.lds + RING_OFF); LAS float* Lb = Lg + DM; LAS float* Lm = Lb + DM;
    f32x4 zA[8], zB[8]; v2u dA[8], dB[8]; float sA = 1.f, sB = 1.f;
    auto loadz = [&](const int idx, f32x4 (&zz)[8], float& zs) __attribute__((always_inline)) {
        int m, b, t; LN_ROWINFO(idx, m, b, t);
        if (Z0IN) { const GAS f32x4* zr = (const GAS f32x4*)z0_row(Zb, xin, cin, true, m, b, t);
#pragma unroll
            for (int j = 0; j < 8; ++j) zz[j] = zr[LNI(j)]; }
        else { const GAS v4u* qr = ZQ_ROW(Zb, m); zs = *(const GAS float*)((const float*)(F.ws + WS_ZS) + m);
#pragma unroll
            for (int k = 0; k < 4; ++k) { const v4u pw = qr[64 * k]; zz[2 * k].x = __uint_as_float(pw.x); zz[2 * k].y = __uint_as_float(pw.y); zz[2 * k + 1].x = __uint_as_float(pw.z); zz[2 * k + 1].y = __uint_as_float(pw.w); } } };
    auto loadd = [&](const int idx, v2u (&dd)[8]) __attribute__((always_inline)) {
        int m, b, t; LN_ROWINFO(idx, m, b, t); const GAS v4u* dr = (const GAS v4u*)(D1 + (size_t)m * DM) + F.lane;
#pragma unroll
        for (int k = 0; k < 4; ++k) { const v4u pw = dr[64 * k]; dd[2 * k] = (v2u){pw.x, pw.y}; dd[2 * k + 1] = (v2u){pw.z, pw.w}; } };
    auto row1 = [&](f32x4 (&zc)[8], v2u (&dc)[8], const float zsc, const int idx) __attribute__((always_inline)) {
        int m, b, t; LN_ROWINFO(idx, m, b, t); const int bsel = (t < NCTX) ? 4 : b;
        float s = 0.f;
#pragma unroll
        for (int j = 0; j < 8; ++j) { const f32x4 dl = {bflo(dc[j].x), bfhi(dc[j].x), bflo(dc[j].y), bfhi(dc[j].y)}; const f32x4 z0v = Z0IN ? zc[j] : zq_decode(zc[j], zsc);
            zc[j] = z0v * DN_ALPHA + dl; s += (zc[j].x + zc[j].y) + (zc[j].z + zc[j].w); }
        const float mean = wave_sum(s) * (1.f / DM); float s2 = 0.f;
#pragma unroll
        for (int j = 0; j < 8; ++j) { zc[j] = zc[j] - mean; s2 += (zc[j].x * zc[j].x + zc[j].y * zc[j].y) + (zc[j].z * zc[j].z + zc[j].w * zc[j].w); }
        const float rstd = 1.f / sqrtf(wave_sum(s2) * (1.f / DM) + LN_EPS);
        if (F.lane == 0) *(GAS f32x2*)(STAT + (size_t)m * 2) = (f32x2){mean, rstd};
        const LAS float* sh = Lm + bsel * 2 * DM; const LAS float* sc = sh + DM; v2u hw = {0u, 0u};
#pragma unroll
        for (int j = 0; j < 8; ++j) { const int col = 4 * LNI(j);
            const f32x4 z = zc[j] * rstd * *(const LAS f32x4*)(Lg + col) + *(const LAS f32x4*)(Lb + col);
            const f32x4 h = z * (*(const LAS f32x4*)(sc + col) + 1.f) + *(const LAS f32x4*)(sh + col);
            v2u w; w.x = pk2(h.x, h.y); w.y = pk2(h.z, h.w);
            if (j & 1) *(GAS v4u*)(H + (size_t)m * DM + col - 4) = (v4u){hw.x, hw.y, w.x, w.y}; else hw = w; } };
    int idx = gw; bool have = idx < nmain;
    if (have) { loadz(idx, zA, sA); loadd(idx, dA); }
    {
        f32x4 pv[12];
        pv[0] = ((const GAS f32x4*)gam)[F.tid]; pv[1] = ((const GAS f32x4*)bet)[F.tid];
#pragma unroll
        for (int k = 0; k < 10; ++k) { const int v = F.tid + NWAVES * 64 * k, bs = v >> 10, r4 = v & 1023; pv[2 + k] = ((const GAS f32x4*)mod_ptr(F.ws, layer, bs, 3))[r4]; }
        ((LAS f32x4*)Lg)[F.tid] = pv[0]; ((LAS f32x4*)Lb)[F.tid] = pv[1];
#pragma unroll
        for (int k = 0; k < 10; ++k) ((LAS f32x4*)Lm)[F.tid + NWAVES * 64 * k] = pv[2 + k];
    }
    __syncthreads();
    while (have) {
        const int nidx = idx + NGWv; const bool hasn = nidx < nmain;
        if (hasn) { loadz(nidx, zB, sB); loadd(nidx, dB); }
        asm volatile("" ::: "memory");
        row1(zA, dA, sA, idx);
        if (!hasn) break;
        const int fidx = nidx + NGWv; const bool hasf = fidx < nmain;
        if (hasf) { loadz(fidx, zA, sA); loadd(fidx, dA); }
        asm volatile("" ::: "memory");
        row1(zB, dB, sB, nidx);
        idx = fidx; have = hasf;
    }
    if (NSPLIT > 0) {
        for (int ti = 8192 + gw; ti < nrows; ti += NGWv) {
            int m, b, t; LN_ROWINFO(ti, m, b, t);
            loadz(ti, zA, sA); LN_SPLIT_D(dA, PART, mod_ptr(F.ws, layer, (t < NCTX) ? 4 : b, 2), m);
#pragma unroll
            for (int k = 0; k < 4; ++k) { v4u o; o.x = dA[2 * k].x; o.y = dA[2 * k].y; o.z = dA[2 * k + 1].x; o.w = dA[2 * k + 1].y; *((GAS v4u*)(D1 + (size_t)m * DM) + 64 * k + F.lane) = o; }
            asm volatile("" ::: "memory");
            row1(zA, dA, sA, ti);
        }
    }
}
template <bool LAT, bool TO_OUT, bool WITH_H, int NSPLIT, bool Z0IN>
__device__ __forceinline__ void ln2_phase(Frame& F, const bf16* D1, const bf16* D2, const float* Zb, const float* xin, const float* cin, float* Zout, float* dout, bf16* H, const float* STAT,
                                          const float* gam1, const float* bet1, const float* gam2, const float* bet2, int layer, const bf16* PART) {
    const int gw = GW(F), NGWv = NGW(F); const int nrows = LAT ? NLAT : NTOK; const int nmain = NSPLIT > 0 ? 8192 : nrows;
    LAS float* Lg1 = (LAS float*)(F.lds + RING_OFF); LAS float* Lb1 = Lg1 + DM; LAS float* Lg2 = Lb1 + DM; LAS float* Lb2 = Lg2 + DM; LAS float* Lm = Lb2 + DM;
    f32x4 zA[8], zB[8]; v2u d1A[8], d1B[8], d2A[8], d2B[8]; f32x2 stA = {0.f, 0.f}, stB = {0.f, 0.f}; float sA = 1.f, sB = 1.f;
    auto loadz = [&](const int idx, f32x4 (&zz)[8], v2u (&dd1)[8], f32x2& st, float& zs) __attribute__((always_inline)) {
        int m, b, t; LN_ROWINFO(idx, m, b, t);
        if (Z0IN) { const GAS f32x4* zr = (const GAS f32x4*)z0_row(Zb, xin, cin, true, m, b, t);
#pragma unroll
            for (int j = 0; j < 8; ++j) zz[j] = zr[LNI(j)]; }
        else { const GAS v4u* qr = ZQ_ROW(Zb, m); zs = *(const GAS float*)((const float*)(F.ws + WS_ZS) + m);
#pragma unroll
            for (int k = 0; k < 4; ++k) { const v4u pw = qr[64 * k]; zz[2 * k].x = __uint_as_float(pw.x); zz[2 * k].y = __uint_as_float(pw.y); zz[2 * k + 1].x = __uint_as_float(pw.z); zz[2 * k + 1].y = __uint_as_float(pw.w); } }
        const GAS v4u* dr = (const GAS v4u*)(D1 + (size_t)m * DM) + F.lane;
#pragma unroll
        for (int k = 0; k < 4; ++k) { const v4u pw = dr[64 * k]; dd1[2 * k] = (v2u){pw.x, pw.y}; dd1[2 * k + 1] = (v2u){pw.z, pw.w}; }
        st = *(const GAS f32x2*)(STAT + (size_t)m * 2); };
    auto loadd2 = [&](const int idx, v2u (&dd2)[8]) __attribute__((always_inline)) {
        int m, b, t; LN_ROWINFO(idx, m, b, t); const GAS v4u* dr = (const GAS v4u*)(D2 + (size_t)m * DM) + F.lane;
#pragma unroll
        for (int k = 0; k < 4; ++k) { const v4u pw = dr[64 * k]; dd2[2 * k] = (v2u){pw.x, pw.y}; dd2[2 * k + 1] = (v2u){pw.z, pw.w}; } };
    auto row2 = [&](f32x4 (&zc)[8], v2u (&d1c)[8], v2u (&d2c)[8], const f32x2 stc, const float zsc, const int idx) __attribute__((always_inline)) {
        int m, b, t; LN_ROWINFO(idx, m, b, t); const int bsel = (t < NCTX) ? 4 : b;
        float s = 0.f;
#pragma unroll
        for (int j = 0; j < 8; ++j) { const int col = 4 * LNI(j);
            const f32x4 dl1 = {bflo(d1c[j].x), bfhi(d1c[j].x), bflo(d1c[j].y), bfhi(d1c[j].y)}, dl2 = {bflo(d2c[j].x), bfhi(d2c[j].x), bflo(d2c[j].y), bfhi(d2c[j].y)};
            const f32x4 z0v = Z0IN ? zc[j] : zq_decode(zc[j], zsc);
            const f32x4 z1 = ((z0v * DN_ALPHA + dl1) - stc.x) * stc.y * *(const LAS f32x4*)(Lg1 + col) + *(const LAS f32x4*)(Lb1 + col);
            zc[j] = z1 * DN_ALPHA + dl2; s += (zc[j].x + zc[j].y) + (zc[j].z + zc[j].w); }
        const float mean = wave_sum(s) * (1.f / DM); float s2 = 0.f;
#pragma unroll
        for (int j = 0; j < 8; ++j) { zc[j] = zc[j] - mean; s2 += (zc[j].x * zc[j].x + zc[j].y * zc[j].y) + (zc[j].z * zc[j].z + zc[j].w * zc[j].w); }
        const float rstd = 1.f / sqrtf(wave_sum(s2) * (1.f / DM) + LN_EPS);
        const LAS float* sh = Lm + bsel * 2 * DM; const LAS float* sc = sh + DM;
        float* zo = TO_OUT ? dout + ((size_t)b * SEQ + (t - NCTX)) * DM : nullptr;
        float qinv = 1.f; v2u qw = {0u, 0u}, hw = {0u, 0u};
        if (!TO_OUT) {
            float am = 0.f;
#pragma unroll
            for (int j = 0; j < 8; ++j) { const int col = 4 * LNI(j);
                const f32x4 z = zc[j] * rstd * *(const LAS f32x4*)(Lg2 + col) + *(const LAS f32x4*)(Lb2 + col);
                am = fmaxf(am, fmaxf(fmaxf(fabsf(z.x), fabsf(z.y)), fmaxf(fabsf(z.z), fabsf(z.w)))); }
            am = wave_max(am); const float scq = am > 0.f ? am * (1.f / 32767.f) : 1.f; qinv = am > 0.f ? 32767.f / am : 1.f;
            if (F.lane == 0) *(GAS float*)((float*)(F.ws + WS_ZS) + m) = scq;
        }
#pragma unroll
        for (int j = 0; j < 8; ++j) { const int col = 4 * LNI(j);
            const f32x4 z = zc[j] * rstd * *(const LAS f32x4*)(Lg2 + col) + *(const LAS f32x4*)(Lb2 + col);
            if (TO_OUT) *(GAS f32x4*)(zo + col) = z;
            else { const int q0 = __float2int_rn(z.x * qinv), q1 = __float2int_rn(z.y * qinv), q2 = __float2int_rn(z.z * qinv), q3 = __float2int_rn(z.w * qinv);
                v2u pw; pw.x = ((unsigned)q0 & 0xffffu) | ((unsigned)q1 << 16); pw.y = ((unsigned)q2 & 0xffffu) | ((unsigned)q3 << 16);
                if (j & 1) *(GAS v4u*)((unsigned short*)Zout + (size_t)m * DM + col - 4) = (v4u){qw.x, qw.y, pw.x, pw.y}; else qw = pw; }
            if (WITH_H) { const f32x4 h = z * (*(const LAS f32x4*)(sc + col) + 1.f) + *(const LAS f32x4*)(sh + col);
                v2u w; w.x = pk2(h.x, h.y); w.y = pk2(h.z, h.w);
                if (j & 1) *(GAS v4u*)(H + (size_t)m * DM + col - 4) = (v4u){hw.x, hw.y, w.x, w.y}; else hw = w; } } };
    int idx = gw; bool have = idx < nmain;
    if (have) { loadz(idx, zA, d1A, stA, sA); loadd2(idx, d2A); }
    {
        f32x4 pv[14];
        pv[0] = ((const GAS f32x4*)gam1)[F.tid]; pv[1] = ((const GAS f32x4*)bet1)[F.tid]; pv[2] = ((const GAS f32x4*)gam2)[F.tid]; pv[3] = ((const GAS f32x4*)bet2)[F.tid];
        if (WITH_H) {
#pragma unroll
            for (int k = 0; k < 10; ++k) { const int v = F.tid + NWAVES * 64 * k, bs = v >> 10, r4 = v & 1023; pv[4 + k] = ((const GAS f32x4*)mod_ptr(F.ws, layer + 1, bs, 0))[r4]; }
        }
        ((LAS f32x4*)Lg1)[F.tid] = pv[0]; ((LAS f32x4*)Lb1)[F.tid] = pv[1]; ((LAS f32x4*)Lg2)[F.tid] = pv[2]; ((LAS f32x4*)Lb2)[F.tid] = pv[3];
        if (WITH_H) {
#pragma unroll
            for (int k = 0; k < 10; ++k) ((LAS f32x4*)Lm)[F.tid + NWAVES * 64 * k] = pv[4 + k];
        }
    }
    __syncthreads();
    while (have) {
        const int nidx = idx + NGWv; const bool hasn = nidx < nmain;
        if (hasn) { loadz(nidx, zB, d1B, stB, sB); loadd2(nidx, d2B); }
        asm volatile("" ::: "memory");
        row2(zA, d1A, d2A, stA, sA, idx);
        if (!hasn) break;
        const int fidx = nidx + NGWv; const bool hasf = fidx < nmain;
        if (hasf) { loadz(fidx, zA, d1A, stA, sA); loadd2(fidx, d2A); }
        asm volatile("" ::: "memory");
        row2(zB, d1B, d2B, stB, sB, nidx);
        idx = fidx; have = hasf;
    }
    if (NSPLIT > 0) {
        for (int ti = 8192 + gw; ti < nrows; ti += NGWv) {
            int m, b, t; LN_ROWINFO(ti, m, b, t);
            loadz(ti, zA, d1A, stA, sA); LN_SPLIT_D(d2A, PART, mod_ptr(F.ws, layer, (t < NCTX) ? 4 : b, 5), m);
            asm volatile("" ::: "memory");
            row2(zA, d1A, d2A, stA, sA, ti);
        }
    }
}
template <bool LAT>
__device__ __forceinline__ void ffn_conv_phase(Frame& F, const bf16* U, bf16* ACT, const float* cw, const float* cb) {
    const int gw = GW(F), NGWv = NGW(F); const int nstrips = (LAT ? NLAT : NTOK) / 16; const int nitems = nstrips * 11;
    for (int it = gw; it < nitems; it += NGWv) {
        const int strip = it / 11, cblk = it % 11; const int c0 = cblk * 512 + F.lane * 8;
        int m0; if (LAT) { const int r = strip * 16; m0 = (r >> 11) * LTOK + NCTX + (r & 2047); } else m0 = strip * 16;
        const int t0 = m0 % LTOK;
        float wg[3][8], wv[3][8], bg[8], bv[8];
#pragma unroll
        for (int k = 0; k < 3; ++k) { const f32x4 a = *(const f32x4*)(cw + (size_t)k * DFF2 + c0), b = *(const f32x4*)(cw + (size_t)k * DFF2 + c0 + 4), c = *(const f32x4*)(cw + (size_t)k * DFF2 + DFF + c0), d = *(const f32x4*)(cw + (size_t)k * DFF2 + DFF + c0 + 4);
#pragma unroll
            for (int j = 0; j < 4; ++j) { wg[k][j] = a[j]; wg[k][4 + j] = b[j]; wv[k][j] = c[j]; wv[k][4 + j] = d[j]; } }
        { const f32x4 a = *(const f32x4*)(cb + c0), b = *(const f32x4*)(cb + c0 + 4), c = *(const f32x4*)(cb + DFF + c0), d = *(const f32x4*)(cb + DFF + c0 + 4);
#pragma unroll
          for (int j = 0; j < 4; ++j) { bg[j] = a[j]; bg[4 + j] = b[j]; bv[j] = c[j]; bv[4 + j] = d[j]; } }
        const bool first_in_seg = (t0 == 0 || t0 == NCTX), last_in_seg = (t0 + 16 == NCTX || t0 + 16 == LTOK);
        const GAS bf16* ug = (const GAS bf16*)U + (size_t)m0 * DFF2 + c0;
        v4u pg = {0u, 0u, 0u, 0u}, pv = {0u, 0u, 0u, 0u};
        if (!first_in_seg) { pg = *(const GAS v4u*)(ug - DFF2); pv = *(const GAS v4u*)(ug - DFF2 + DFF); }
        v4u cg = *(const GAS v4u*)(ug), cv = *(const GAS v4u*)(ug + DFF);
        for (int r = 0; r < 16; ++r) {
            v4u ng = {0u, 0u, 0u, 0u}, nv = {0u, 0u, 0u, 0u};
            if (r < 15 || !last_in_seg) { ng = *(const GAS v4u*)(ug + (size_t)(r + 1) * DFF2); nv = *(const GAS v4u*)(ug + (size_t)(r + 1) * DFF2 + DFF); }
            float o[8];
#pragma unroll
            for (int q = 0; q < 4; ++q) {
                const unsigned pgw = pg[q], cgw = cg[q], ngw = ng[q], pvw = pv[q], cvw = cv[q], nvw = nv[q];
                const float g0 = bg[2 * q] + wg[0][2 * q] * bflo(pgw) + wg[1][2 * q] * bflo(cgw) + wg[2][2 * q] * bflo(ngw);
                const float g1 = bg[2 * q + 1] + wg[0][2 * q + 1] * bfhi(pgw) + wg[1][2 * q + 1] * bfhi(cgw) + wg[2][2 * q + 1] * bfhi(ngw);
                const float v0 = bv[2 * q] + wv[0][2 * q] * bflo(pvw) + wv[1][2 * q] * bflo(cvw) + wv[2][2 * q] * bflo(nvw);
                const float v1 = bv[2 * q + 1] + wv[0][2 * q + 1] * bfhi(pvw) + wv[1][2 * q + 1] * bfhi(cvw) + wv[2][2 * q + 1] * bfhi(nvw);
                o[2 * q] = siluf_(g0) * v0; o[2 * q + 1] = siluf_(g1) * v1; }
            v4u w; w.x = pk2(o[0], o[1]); w.y = pk2(o[2], o[3]); w.z = pk2(o[4], o[5]); w.w = pk2(o[6], o[7]);
            *(GAS v4u*)(ACT + (size_t)(m0 + r) * DFF + c0) = w;
            pg = cg; pv = cv; cg = ng; cv = nv;
        }
    }
}

template <bool LAT>
__device__ __forceinline__ void ffn_fix_phase(Frame& F, const bf16* UB, bf16* ACT, const float* cw, const float* cb) {
    const int gw = GW(F), NGWv = NGW(F); const int nruns = (LAT ? NLAT : NTOK) / 64; const int nitems = nruns * 11;
    for (int it = gw; it < nitems; it += NGWv) {
        const int cblk = it % 11, rl = it / 11;
        int run; if (LAT) { const int r = rl * 64; run = ((r >> 11) * LTOK + NCTX + (r & 2047)) >> 6; } else run = rl;
        const int m0 = run * 64, t0 = m0 % LTOK;
        const bool seg_first = (t0 == 0 || t0 == NCTX), seg_last = (t0 + 64 == NCTX || t0 + 64 == LTOK);
        const int c0 = cblk * 512 + F.lane * 8; const int uc = (c0 >> 7) * 256 + (c0 & 127);
        const GAS bf16* ub = (const GAS bf16*)UB + (size_t)run * 4 * DFF2 + uc;
        v4u rg[6], rv[6];
#pragma unroll
        for (int q = 0; q < 6; ++q) { const int rq = (q == 0 && seg_first) ? 1 : ((q == 5 && seg_last) ? 4 : q);
            const GAS bf16* rp = ub + (ptrdiff_t)(rq - 1) * DFF2; rg[q] = *(const GAS v4u*)rp; rv[q] = *(const GAS v4u*)(rp + 128); }
        float wg[3][8], wv[3][8], bg[8], bv[8];
#pragma unroll
        for (int k = 0; k < 3; ++k) { const GAS float* wp = (const GAS float*)cw + (size_t)k * DFF2 + c0; const f32x4 a = *(const GAS f32x4*)wp, b = *(const GAS f32x4*)(wp + 4), c = *(const GAS f32x4*)(wp + DFF), d = *(const GAS f32x4*)(wp + DFF + 4);
#pragma unroll
            for (int j = 0; j < 4; ++j) { wg[k][j] = a[j]; wg[k][4 + j] = b[j]; wv[k][j] = c[j]; wv[k][4 + j] = d[j]; } }
        { const GAS float* bp = (const GAS float*)cb + c0; const f32x4 a = *(const GAS f32x4*)bp, b = *(const GAS f32x4*)(bp + 4), c = *(const GAS f32x4*)(bp + DFF), d = *(const GAS f32x4*)(bp + DFF + 4);
#pragma unroll
          for (int j = 0; j < 4; ++j) { bg[j] = a[j]; bg[4 + j] = b[j]; bv[j] = c[j]; bv[4 + j] = d[j]; } }
        const float zf = seg_first ? 0.f : 1.f, zl = seg_last ? 0.f : 1.f;
#pragma unroll
        for (int which = 0; which < 2; ++which) {
            const int ip = which ? 3 : 0, ic = which ? 4 : 1, in_ = which ? 5 : 2; const float mp = which ? 1.f : zf, mn = which ? zl : 1.f;
            float o[8];
#pragma unroll
            for (int q = 0; q < 4; ++q) {
                const unsigned pgw = rg[ip][q], cgw = rg[ic][q], ngw = rg[in_][q], pvw = rv[ip][q], cvw = rv[ic][q], nvw = rv[in_][q];
                const float g0 = bg[2 * q] + wg[0][2 * q] * (bflo(pgw) * mp) + wg[1][2 * q] * bflo(cgw) + wg[2][2 * q] * (bflo(ngw) * mn);
                const float g1 = bg[2 * q + 1] + wg[0][2 * q + 1] * (bfhi(pgw) * mp) + wg[1][2 * q + 1] * bfhi(cgw) + wg[2][2 * q + 1] * (bfhi(ngw) * mn);
                const float v0 = bv[2 * q] + wv[0][2 * q] * (bflo(pvw) * mp) + wv[1][2 * q] * bflo(cvw) + wv[2][2 * q] * (bflo(nvw) * mn);
                const float v1 = bv[2 * q + 1] + wv[0][2 * q + 1] * (bfhi(pvw) * mp) + wv[1][2 * q + 1] * bfhi(cvw) + wv[2][2 * q + 1] * (bfhi(nvw) * mn);
                o[2 * q] = siluf_(g0) * v0; o[2 * q + 1] = siluf_(g1) * v1; }
            v4u w; w.x = pk2(o[0], o[1]); w.y = pk2(o[2], o[3]); w.z = pk2(o[4], o[5]); w.w = pk2(o[6], o[7]);
            *(GAS v4u*)(ACT + (size_t)(m0 + (which ? 63 : 0)) * DFF + c0) = w;
        }
    }
}
__device__ __forceinline__ int flip_tok(int s) { return s < NCTX ? (NCTX - 1 - s) : (LTOK + NCTX - 1 - s); }

__device__ __forceinline__ pg8::f32x4 mma_tile(pg8::f32x4 acc, const LAS bf16* A, int lda, const LAS bf16* Bt, int ldb, int ksteps, int lane) {
    const LAS bf16* ap = A + (lane & 15) * lda + (lane >> 4) * 8; const LAS bf16* bp = Bt + (lane & 15) * ldb + (lane >> 4) * 8;
    for (int k = 0; k < ksteps; ++k) { const bf16x8 a = *(const LAS bf16x8*)(ap + k * 32), b = *(const LAS bf16x8*)(bp + k * 32);
        acc = __builtin_amdgcn_mfma_f32_16x16x32_bf16(a, b, acc, 0, 0, 0); }
    return acc;
}
template <int CTRL> __device__ __forceinline__ float dpp_f(float v) { return __int_as_float(__builtin_amdgcn_update_dpp(0, __float_as_int(v), CTRL, 0xF, 0xF, true)); }
__device__ __forceinline__ float red8(float v) { v += dpp_f<0xB1>(v); v += dpp_f<0x4E>(v); v += dpp_f<0x141>(v); return v; }
__device__ __forceinline__ float red16(float v) { v = red8(v); v += dpp_f<0x140>(v); return v; }
__device__ __forceinline__ void unpack8(const v4u w, float (&f)[8]) { f[0] = bflo(w.x); f[1] = bfhi(w.x); f[2] = bflo(w.y); f[3] = bfhi(w.y); f[4] = bflo(w.z); f[5] = bfhi(w.z); f[6] = bflo(w.w); f[7] = bfhi(w.w); }
__device__ __forceinline__ v4u pack8(const float (&f)[8]) { v4u w; w.x = pk2(f[0], f[1]); w.y = pk2(f[2], f[3]); w.z = pk2(f[4], f[5]); w.w = pk2(f[6], f[7]); return w; }
__device__ __forceinline__ void ld8f(const float* p, float (&f)[8]) { const f32x4 a = *(const f32x4*)p, b = *(const f32x4*)(p + 4); f[0] = a.x; f[1] = a.y; f[2] = a.z; f[3] = a.w; f[4] = b.x; f[5] = b.y; f[6] = b.z; f[7] = b.w; }
__device__ __forceinline__ void l0_xs_phase(Frame& F, const float* x, const float* ctx, const float* mu) {
    const int gw = GW(F), NGWv = NGW(F);
    bf16* XS = (bf16*)(F.ws + L0_XS);
    const int c0 = (gw & 3) * 512 + F.lane * 8;
    float mv[6][8];
#pragma unroll
    for (int n = 0; n < 6; ++n) ld8f(mu + (size_t)n * DM + c0, mv[n]);
    for (int it = gw; it < (NTOK / 8) * 4; it += NGWv) {
        const int strip = it >> 2; const int m0 = strip * 8, b = m0 / LTOK, t0 = m0 % LTOK;
        const float* zr = (t0 < NCTX) ? ctx + ((size_t)b * NCTX + t0) * DM : x + ((size_t)b * SEQ + (t0 - NCTX)) * DM;
        const int seg_end = (t0 < NCTX) ? NCTX : LTOK; const bool first = (t0 == 0 || t0 == NCTX);
        const int bsel = (t0 < NCTX) ? 4 : b;
        f32x4 za[10], zb[10];
#pragma unroll
        for (int q = 0; q < 10; ++q) { const bool ok = (q == 0) ? !first : (t0 + q - 1 < seg_end);
            za[q] = (f32x4){0.f, 0.f, 0.f, 0.f}; zb[q] = za[q];
            if (ok) { const GAS float* rp = (const GAS float*)zr + (ptrdiff_t)(q - 1) * DM + c0; za[q] = *(const GAS f32x4*)rp; zb[q] = *(const GAS f32x4*)(rp + 4); } }
        float s0[8], s1[8], hp[8], hc[8], hn[8];
        { const float* sh = mod_ptr(F.ws, 0, bsel, 0) + c0; const float* sc = mod_ptr(F.ws, 0, bsel, 1) + c0;
          const f32x4 a = *(const GAS f32x4*)sh, a2 = *(const GAS f32x4*)(sh + 4), c = *(const GAS f32x4*)sc, c2 = *(const GAS f32x4*)(sc + 4);
#pragma unroll
          for (int j = 0; j < 4; ++j) { s0[j] = a[j]; s0[4 + j] = a2[j]; s1[j] = c[j] + 1.f; s1[4 + j] = c2[j] + 1.f; } }
#pragma unroll
        for (int j = 0; j < 4; ++j) { hp[j] = first ? 0.f : za[0][j] * s1[j] + s0[j]; hp[4 + j] = first ? 0.f : zb[0][j] * s1[4 + j] + s0[4 + j];
                                      hc[j] = za[1][j] * s1[j] + s0[j]; hc[4 + j] = zb[1][j] * s1[4 + j] + s0[4 + j]; }
#pragma unroll
        for (int r = 0; r < 8; ++r) {
            const bool hasn = (t0 + r + 1 < seg_end);
#pragma unroll
            for (int j = 0; j < 4; ++j) { hn[j] = hasn ? za[r + 2][j] * s1[j] + s0[j] : 0.f; hn[4 + j] = hasn ? zb[r + 2][j] * s1[4 + j] + s0[4 + j] : 0.f; }
            const size_t m = (size_t)(m0 + r);
            float dx[8];
#pragma unroll
            for (int j = 0; j < 8; ++j) dx[j] = (hp[j] + hn[j]) * 0.5f - hc[j];
#pragma unroll
            for (int n = 0; n < 6; ++n) { float o[8];
#pragma unroll
                for (int j = 0; j < 8; ++j) o[j] = hc[j] + dx[j] * mv[n][j];
                *(GAS v4u*)(XS + ((size_t)n * NTOK + m) * DM + c0) = pack8(o); }
#pragma unroll
            for (int j = 0; j < 8; ++j) { hp[j] = hc[j]; hc[j] = hn[j]; }
        }
    }
}
__device__ __forceinline__ void l0_prep_phase(Frame& F, const float* k_k, const float* k_a, const float* r_k) {
    const int gw = GW(F), NGWv = NGW(F); unsigned char* ws = F.ws;
    const bf16* R = (const bf16*)(ws + L0_R); const bf16* K = (const bf16*)(ws + L0_K); const bf16* V = (const bf16*)(ws + L0_V);
    bf16* VEC = (bf16*)(ws + L0_VEC); float* SCAL = (float*)(ws + L0_SCAL); float* BONUS = (float*)(ws + L0_BONUS);
    const int l8 = F.lane & 7;
    for (int it = gw; it < NTOK * 4; it += NGWv) {
        const int m = it >> 2, h = (it & 3) * 8 + (F.lane >> 3), b = m / LTOK, t = m % LTOK; const int c0 = h * 64 + l8 * 8; const size_t e = (size_t)m * DM + c0;
        float r[8], k[8], kk[8], tmp[8], par[8];
        unpack8(*(const GAS v4u*)(R + e), r); unpack8(*(const GAS v4u*)(K + e), k);
        const v4u vraw = *(const GAS v4u*)(V + e);
        ld8f(k_k + c0, par); float ss = 0.f;
#pragma unroll
        for (int j = 0; j < 8; ++j) { kk[j] = k[j] * par[j]; ss += kk[j] * kk[j]; }
        ss = red8(ss); const float inv = 1.0f / sqrtf(ss + 1e-12f);
#pragma unroll
        for (int j = 0; j < 8; ++j) kk[j] *= inv;
        float ka[8], kdsum[8]; ld8f(k_a + c0, ka);
#pragma unroll
        for (int j = 0; j < 8; ++j) kdsum[j] = 0.f;
#pragma unroll
        for (int d = 0; d < 2; ++d) {
            float w[8], ic[8], kd[8];
            unpack8(*(const GAS v4u*)((const bf16*)(ws + (d ? L0_DEC1 : L0_DEC0)) + e), w); unpack8(*(const GAS v4u*)((const bf16*)(ws + (d ? L0_IC1 : L0_IC0)) + e), ic);
            float kr = 0.f, kkar = 0.f;
#pragma unroll
            for (int j = 0; j < 8; ++j) { kd[j] = k[j] * (1.f + (ic[j] - 1.f) * ka[j]); kdsum[j] += kd[j]; kr += kd[j] * r[j]; }
            const int s = d ? flip_tok(t) : t; const size_t sidx = (size_t)((d * NB + b) * 32 + h);
            bf16* vp = VEC + (sidx * LTOK + s) * 384 + l8 * 8;
            *(GAS v4u*)(vp) = pack8(w); *(GAS v4u*)(vp + 64) = pack8(kd); *(GAS v4u*)(vp + 128) = pack8(kk);
#pragma unroll
            for (int j = 0; j < 8; ++j) { tmp[j] = kk[j] * ic[j]; kkar += tmp[j] * r[j]; }
            *(GAS v4u*)(vp + 192) = pack8(tmp);
#pragma unroll
            for (int j = 0; j < 8; ++j) tmp[j] = w[j] * r[j];
            *(GAS v4u*)(vp + 256) = pack8(tmp); *(GAS v4u*)(vp + 320) = vraw;
            kr = red8(kr); kkar = red8(kkar);
            if (l8 == 0) *(GAS f32x2*)(SCAL + (sidx * LTOK + s) * 2) = (f32x2){kr, kkar};
        }
        ld8f(r_k + c0, par); float bon = 0.f;
#pragma unroll
        for (int j = 0; j < 8; ++j) bon += r[j] * kdsum[j] * par[j];
        bon = red8(bon);
        if (l8 == 0) BONUS[m * 32 + h] = bon;
    }
}
constexpr int RW_CS = 32;
__device__ __forceinline__ void l0_scan_phase(Frame& F) {
    unsigned char* ws = F.ws; const bf16* VEC = (const bf16*)(ws + L0_VEC); const float* SCAL = (const float*)(ws + L0_SCAL); float* YS = (float*)(ws + L0_YS);
    LAS float* opb = (LAS float*)(F.lds + RING_OFF);
    LAS float* scl = opb + 2 * RW_CS * 384;
    LAS float* ybuf = scl + 2 * RW_CS * 2;
    const int rp = F.tid >> 4, q = F.tid & 15; constexpr int NCH = LTOK / RW_CS;
    for (int sidx = F.vcu; sidx < 256; sidx += F.G) {
        const int d = sidx >> 7, b = (sidx >> 5) & 3, h = sidx & 31;
        const GAS v4u* src = (const GAS v4u*)(VEC + (size_t)sidx * LTOK * 384); const GAS float* ssrc = (const GAS float*)(SCAL + (size_t)sidx * LTOK * 2);
        f32x2 Sa = {0.f, 0.f}, Sb = {0.f, 0.f}, Sc = {0.f, 0.f}, Sd = {0.f, 0.f};
        v4u pre[3]; float psc = 0.f;
#pragma unroll
        for (int k = 0; k < 3; ++k) pre[k] = src[F.tid + 512 * k];
        if (F.tid < RW_CS * 2) psc = ssrc[F.tid];
        __syncthreads();
#pragma unroll
        for (int k = 0; k < 3; ++k) { LAS float* dst = opb + (size_t)(F.tid + 512 * k) * 8; const v4u w = pre[k];
            *(LAS f32x4*)dst = (f32x4){bflo(w.x), bfhi(w.x), bflo(w.y), bfhi(w.y)}; *(LAS f32x4*)(dst + 4) = (f32x4){bflo(w.z), bfhi(w.z), bflo(w.w), bfhi(w.w)}; }
        if (F.tid < RW_CS * 2) scl[F.tid] = psc;
        __syncthreads();
        for (int ch = 0; ch < NCH; ++ch) {
            const int cur = ch & 1;
            if (ch + 1 < NCH) {
#pragma unroll
                for (int k = 0; k < 3; ++k) pre[k] = src[(size_t)(ch + 1) * (RW_CS * 48) + F.tid + 512 * k];
                if (F.tid < RW_CS * 2) psc = ssrc[(ch + 1) * RW_CS * 2 + F.tid]; }
            const LAS float* ob = opb + cur * RW_CS * 384; const LAS float* sb = scl + cur * RW_CS * 2;
            const LAS float* o0 = ob + q * 4; const LAS float* ov = ob + 320 + 2 * rp;
            f32x4 w4 = *(const LAS f32x4*)(o0), k4 = *(const LAS f32x4*)(o0 + 64), c4 = *(const LAS f32x4*)(o0 + 128), a4 = *(const LAS f32x4*)(o0 + 192), r4 = *(const LAS f32x4*)(o0 + 256);
            f32x2 v2 = *(const LAS f32x2*)(ov), sc2 = *(const LAS f32x2*)(sb);
            LAS float* ydst = (q == 0) ? (ybuf + 2 * rp) : (ybuf + RW_CS * 64 + 2 * F.tid);
            const int ystep = (q == 0) ? 64 : 0;
#pragma unroll 4
            for (int s = 0; s < RW_CS; ++s) {
                const int sn = (s + 1 < RW_CS) ? s + 1 : s;
                const LAS float* o = o0 + sn * 384;
                const f32x4 w4n = *(const LAS f32x4*)(o), k4n = *(const LAS f32x4*)(o + 64), c4n = *(const LAS f32x4*)(o + 128), a4n = *(const LAS f32x4*)(o + 192), r4n = *(const LAS f32x4*)(o + 256);
                const f32x2 v2n = *(const LAS f32x2*)(ov + sn * 384), sc2n = *(const LAS f32x2*)(sb + sn * 2);
                f32x2 sa = Sa * c4.x; sa = Sb * c4.y + sa; sa = Sc * c4.z + sa; sa = Sd * c4.w + sa;
                f32x2 yy = Sa * r4.x; yy = Sb * r4.y + yy; yy = Sc * r4.z + yy; yy = Sd * r4.w + yy;
                float sa0 = sa.x, sa1 = sa.y, y0 = yy.x, y1 = yy.y;
                asm volatile("s_nop 1\n\t"
                    "v_add_f32_dpp %0, %0, %0 quad_perm:[1,0,3,2] row_mask:0xf bank_mask:0xf bound_ctrl:1\n\t" "v_add_f32_dpp %1, %1, %1 quad_perm:[1,0,3,2] row_mask:0xf bank_mask:0xf bound_ctrl:1\n\t"
                    "v_add_f32_dpp %2, %2, %2 quad_perm:[1,0,3,2] row_mask:0xf bank_mask:0xf bound_ctrl:1\n\t" "v_add_f32_dpp %3, %3, %3 quad_perm:[1,0,3,2] row_mask:0xf bank_mask:0xf bound_ctrl:1\n\t"
                    "v_add_f32_dpp %0, %0, %0 quad_perm:[2,3,0,1] row_mask:0xf bank_mask:0xf bound_ctrl:1\n\t" "v_add_f32_dpp %1, %1, %1 quad_perm:[2,3,0,1] row_mask:0xf bank_mask:0xf bound_ctrl:1\n\t"
                    "v_add_f32_dpp %2, %2, %2 quad_perm:[2,3,0,1] row_mask:0xf bank_mask:0xf bound_ctrl:1\n\t" "v_add_f32_dpp %3, %3, %3 quad_perm:[2,3,0,1] row_mask:0xf bank_mask:0xf bound_ctrl:1\n\t"
                    "v_add_f32_dpp %0, %0, %0 row_half_mirror row_mask:0xf bank_mask:0xf bound_ctrl:1\n\t" "v_add_f32_dpp %1, %1, %1 row_half_mirror row_mask:0xf bank_mask:0xf bound_ctrl:1\n\t"
                    "v_add_f32_dpp %2, %2, %2 row_half_mirror row_mask:0xf bank_mask:0xf bound_ctrl:1\n\t" "v_add_f32_dpp %3, %3, %3 row_half_mirror row_mask:0xf bank_mask:0xf bound_ctrl:1\n\t"
                    "v_add_f32_dpp %0, %0, %0 row_mirror row_mask:0xf bank_mask:0xf bound_ctrl:1\n\t" "v_add_f32_dpp %1, %1, %1 row_mirror row_mask:0xf bank_mask:0xf bound_ctrl:1\n\t"
                    "v_add_f32_dpp %2, %2, %2 row_mirror row_mask:0xf bank_mask:0xf bound_ctrl:1\n\t" "v_add_f32_dpp %3, %3, %3 row_mirror row_mask:0xf bank_mask:0xf bound_ctrl:1\n\t"
                    "s_nop 0"
                    : "+v"(sa0), "+v"(sa1), "+v"(y0), "+v"(y1));
                sa = (f32x2){sa0, sa1}; yy = (f32x2){y0, y1};
                yy = yy + (v2 * sc2.x - sa * sc2.y);
                Sa = Sa * w4.x + (v2 * k4.x - sa * a4.x); Sb = Sb * w4.y + (v2 * k4.y - sa * a4.y); Sc = Sc * w4.z + (v2 * k4.z - sa * a4.z); Sd = Sd * w4.w + (v2 * k4.w - sa * a4.w);
                *(LAS f32x2*)(ydst + s * ystep) = yy;
                w4 = w4n; k4 = k4n; c4 = c4n; a4 = a4n; r4 = r4n; v2 = v2n; sc2 = sc2n;
            }
            __syncthreads();
            {
                const int s = F.tid >> 4, i4 = (F.tid & 15) * 4; const int step = ch * RW_CS + s; const int t = d ? flip_tok(step) : step;
                const f32x4 yv = *(const LAS f32x4*)(ybuf + s * 64 + i4);
                *(GAS f32x4*)(YS + ((size_t)d * NTOK + (size_t)b * LTOK + t) * DM + h * 64 + i4) = yv; }
            if (ch + 1 < NCH) {
                LAS float* nb = opb + (cur ^ 1) * RW_CS * 384;
#pragma unroll
                for (int k = 0; k < 3; ++k) { LAS float* dst = nb + (size_t)(F.tid + 512 * k) * 8; const v4u w = pre[k];
                    *(LAS f32x4*)dst = (f32x4){bflo(w.x), bfhi(w.x), bflo(w.y), bfhi(w.y)}; *(LAS f32x4*)(dst + 4) = (f32x4){bflo(w.z), bfhi(w.z), bflo(w.w), bfhi(w.w)}; }
                if (F.tid < RW_CS * 2) scl[(cur ^ 1) * RW_CS * 2 + F.tid] = psc; }
            __syncthreads();
        }
    }
}
__device__ __forceinline__ void l0_cscan_phase(Frame& F, const float* k_k, const float* k_a, const float* r_k) {
    unsigned char* ws = F.ws; float* YS = (float*)(ws + L0_XS); float* BON = (float*)(ws + L0_BONUS);
    constexpr int PA = 72, PB = 40, NCH = LTOK / 16;
    LAS bf16* RAW = (LAS bf16*)(F.lds + RING_OFF);
    LAS bf16* Ah = RAW + 5 * 16 * PA; LAS bf16* Rh = Ah + 16 * PA; LAS bf16* Kh = Rh + 16 * PA; LAS bf16* Bh = Kh + 16 * PA;
    LAS bf16* KBt = Bh + 16 * PA;
    LAS bf16* VSt = KBt + 64 * PB;
    LAS bf16* LKp = VSt + 64 * PB;
    LAS bf16* UKB = LKp + 16 * PB;
    LAS bf16* Sb = UKB + 16 * PB;
    LAS float* LB = (LAS float*)(Sb + 64 * PA);
    LAS float* RH = LB + 16 * 20;
    LAS float* Wend = RH + 16 * 68;
    const int tid = F.tid, lane = F.lane, w = F.wave;
    for (int sidx = F.vcu; sidx < 256; sidx += F.G) {
        const int d = sidx >> 7, b = (sidx >> 5) & 3, h = sidx & 31;
        const GAS bf16* gR = (const GAS bf16*)(ws + L0_R) + (size_t)b * LTOK * DM + h * 64;
        const GAS bf16* gK = (const GAS bf16*)(ws + L0_K) + (size_t)b * LTOK * DM + h * 64;
        const GAS bf16* gV = (const GAS bf16*)(ws + L0_V) + (size_t)b * LTOK * DM + h * 64;
        const GAS bf16* gD = (const GAS bf16*)(ws + (d ? L0_DEC1 : L0_DEC0)) + (size_t)b * LTOK * DM + h * 64;
        const GAS bf16* gI = (const GAS bf16*)(ws + (d ? L0_IC1 : L0_IC0)) + (size_t)b * LTOK * DM + h * 64;
        const int ft = tid >> 5, fpart = tid & 31, fti = fpart >> 3, fc = (fpart & 7) * 8;
        const GAS bf16* fbase = fti == 0 ? gR : (fti == 1 ? gK : (fti == 2 ? gV : gD));
        const int t1 = tid >> 5, jp = tid & 31, j2 = 2 * jp;
        const f32x2 kk2 = *(const f32x2*)(k_k + h * 64 + j2), ka2 = *(const f32x2*)(k_a + h * 64 + j2), rk2 = *(const f32x2*)(r_k + h * 64 + j2);
        __syncthreads();
        for (int i = tid; i < 64 * PA / 2; i += 512) ((LAS unsigned*)Sb)[i] = 0u;
        for (int i = tid; i < 64 * PB / 2; i += 512) ((LAS unsigned*)VSt)[i] = 0u;
        for (int i = tid; i < 16 * PB / 2; i += 512) ((LAS unsigned*)LKp)[i] = 0u;
        pg8::f32x4 ST[2]; ST[0] = (pg8::f32x4){0.f, 0.f, 0.f, 0.f}; ST[1] = ST[0];
        v4u pa, pb = {0u, 0u, 0u, 0u};
#define CS_FETCH(chn) do { { const int step_ = (chn) * 16 + ft; const int tk_ = d ? flip_tok(step_) : step_; pa = *(const GAS v4u*)(fbase + (size_t)tk_ * DM + fc); } \
            if (tid < 128) { const int step_ = (chn) * 16 + (tid >> 3); const int tk_ = d ? flip_tok(step_) : step_; pb = *(const GAS v4u*)(gI + (size_t)tk_ * DM + (tid & 7) * 8); } } while (0)
        CS_FETCH(0);
        for (int ch = 0; ch < NCH; ++ch) {
            *(LAS v4u*)(RAW + (fti * 16 + ft) * PA + fc) = pa;
            if (tid < 128) *(LAS v4u*)(RAW + (4 * 16 + (tid >> 3)) * PA + (tid & 7) * 8) = pb;
            if (ch + 1 < NCH) CS_FETCH(ch + 1);
            LDS_BARRIER();
            {
                const unsigned rw = *(const LAS unsigned*)(RAW + (0 * 16 + t1) * PA + j2), kw = *(const LAS unsigned*)(RAW + (1 * 16 + t1) * PA + j2), vw = *(const LAS unsigned*)(RAW + (2 * 16 + t1) * PA + j2);
                const unsigned iw = *(const LAS unsigned*)(RAW + (4 * 16 + t1) * PA + j2);
                const f32x2 r = {bflo(rw), bfhi(rw)}, k = {bflo(kw), bfhi(kw)}, ic = {bflo(iw), bfhi(iw)};
                f32x2 kkv = k * kk2; float ss = kkv.x * kkv.x + kkv.y * kkv.y; ss = red16(ss); ss += __shfl_xor(ss, 16);
                kkv = kkv * (1.0f / sqrtf(ss + 1e-12f));
                const f32x2 kd = k * ((ic - 1.f) * ka2 + 1.f), kka = kkv * ic;
                float bon = r.x * kd.x * rk2.x + r.y * kd.y * rk2.y; bon = red16(bon); bon += __shfl_xor(bon, 16);
                const int step = ch * 16 + t1; const int tk = d ? flip_tok(step) : step;
                if (jp == 0) BON[((size_t)d * NTOK + (size_t)b * LTOK + tk) * 32 + h] = bon;
                f32x2 Wm = {1.f, 1.f};
#pragma unroll
                for (int u = 0; u < 15; ++u) { const unsigned dw = *(const LAS unsigned*)(RAW + (3 * 16 + u) * PA + j2); if (u < t1) { Wm.x *= bflo(dw); Wm.y *= bfhi(dw); } }
                const unsigned dwt = *(const LAS unsigned*)(RAW + (3 * 16 + t1) * PA + j2);
                const f32x2 Wt = {Wm.x * bflo(dwt), Wm.y * bfhi(dwt)}; const f32x2 iW = {__builtin_amdgcn_rcpf(Wt.x), __builtin_amdgcn_rcpf(Wt.y)};
                const f32x2 ah = kkv * Wm, bh = kka * iW, kh = kd * iW, rh = r * Wt;
                *(LAS unsigned*)(Ah + t1 * PA + j2) = pk2(ah.x, ah.y); *(LAS unsigned*)(Rh + t1 * PA + j2) = pk2(rh.x, rh.y);
                *(LAS unsigned*)(Kh + t1 * PA + j2) = pk2(kh.x, kh.y); *(LAS unsigned*)(Bh + t1 * PA + j2) = pk2(bh.x, bh.y);
                const unsigned khw = pk2(kh.x, kh.y), nbw = pk2(-bh.x, -bh.y);
                KBt[j2 * PB + t1] = (bf16)(khw & 0xffff); KBt[(j2 + 1) * PB + t1] = (bf16)(khw >> 16);
                KBt[j2 * PB + 16 + t1] = (bf16)(nbw & 0xffff); KBt[(j2 + 1) * PB + 16 + t1] = (bf16)(nbw >> 16);
                VSt[j2 * PB + t1] = (bf16)(vw & 0xffff); VSt[(j2 + 1) * PB + t1] = (bf16)(vw >> 16);
                if (t1 == 15) *(LAS f32x2*)(Wend + j2) = Wt;
            }
            LDS_BARRIER();
            pg8::f32x4 accg = {0.f, 0.f, 0.f, 0.f};
            const int tr = (lane >> 4) * 4, uc = lane & 15;
            if (w < 4) {
                pg8::f32x4 a = {0.f, 0.f, 0.f, 0.f};
                a = mma_tile(a, (w < 2) ? Ah : Rh, PA, (w == 0 || w == 3) ? Bh : Kh, PA, 2, lane);
#pragma unroll
                for (int r = 0; r < 4; ++r) { const int t = tr + r; const float x = a[r];
                    if (w == 0) LB[uc * 20 + t] = (uc < t) ? x : 0.f;
                    else if (w == 1) LKp[t * PB + uc] = f2bf((uc < t) ? x : 0.f);
                    else if (w == 2) UKB[t * PB + uc] = f2bf((uc <= t) ? x : 0.f);
                    else UKB[t * PB + 16 + uc] = f2bf((uc <= t) ? -x : 0.f); }
            } else accg = mma_tile(accg, Ah, PA, Sb + (w - 4) * 16 * PA, PA, 2, lane);
            LDS_BARRIER();
            pg8::f32x4 accy = {0.f, 0.f, 0.f, 0.f};
            if (w >= 4) { accg = mma_tile(accg, LKp, PB, VSt + (w - 4) * 16 * PB, PB, 1, lane);
#pragma unroll
                for (int r = 0; r < 4; ++r) RH[(tr + r) * 68 + (w - 4) * 16 + uc] = accg[r]; }
            else accy = mma_tile(accy, Rh, PA, Sb + w * 16 * PA, PA, 2, lane);
            LDS_BARRIER();
            if (w == 7) {
                float sg[16];
#pragma unroll
                for (int t = 0; t < 16; ++t) sg[t] = RH[t * 68 + lane];
#pragma unroll
                for (int u = 0; u < 15; ++u) {
#pragma unroll
                    for (int g4 = (u + 1) / 4; g4 < 4; ++g4) { const pg8::f32x4 l4 = *(const LAS pg8::f32x4*)(LB + u * 20 + g4 * 4);
#pragma unroll
                        for (int r = 0; r < 4; ++r) { const int t = g4 * 4 + r; if (t > u) sg[t] -= l4[r] * sg[u]; } } }
                v4u o; o.x = pk2(sg[0], sg[1]); o.y = pk2(sg[2], sg[3]); o.z = pk2(sg[4], sg[5]); o.w = pk2(sg[6], sg[7]); *(LAS v4u*)(VSt + lane * PB + 16) = o;
                o.x = pk2(sg[8], sg[9]); o.y = pk2(sg[10], sg[11]); o.z = pk2(sg[12], sg[13]); o.w = pk2(sg[14], sg[15]); *(LAS v4u*)(VSt + lane * PB + 24) = o;
            }
            LDS_BARRIER();
            if (w < 4) { accy = mma_tile(accy, UKB, PB, VSt + w * 16 * PB, PB, 1, lane);
#pragma unroll
                for (int r = 0; r < 4; ++r) { const int step = ch * 16 + tr + r; const int tk = d ? flip_tok(step) : step;
                    YS[((size_t)d * NTOK + (size_t)b * LTOK + tk) * DM + h * 64 + w * 16 + uc] = accy[r]; } }
            { const int jb = w >> 1; const pg8::f32x4 we = *(const LAS pg8::f32x4*)(Wend + jb * 16 + tr);
#pragma unroll
              for (int q = 0; q < 2; ++q) { const int ib = (w & 1) * 2 + q;
                  pg8::f32x4 a = mma_tile(ST[q], KBt + jb * 16 * PB, PB, VSt + ib * 16 * PB, PB, 1, lane);
                  a = a * we; ST[q] = a;
                  v2u sw; sw.x = pk2(a[0], a[1]); sw.y = pk2(a[2], a[3]);
                  *(LAS v2u*)(Sb + (ib * 16 + uc) * PA + jb * 16 + tr) = sw; } }
            LDS_BARRIER();
        }
#undef CS_FETCH
    }
}
__device__ __forceinline__ void l0_cscan2_phase(Frame& F, const float* k_k, const float* k_a, const float* r_k) {
    unsigned char* ws = F.ws; bf16* YS = (bf16*)(ws + L0_XS); float* BON = (float*)(ws + L0_BONUS);
    constexpr int PA = 72, PB = 40, NCH = LTOK / 16;
    constexpr int O_AH = 0, O_RH = 16 * PA, O_KH = 32 * PA, O_BH = 48 * PA, O_KBT = 64 * PA, O_VST = O_KBT + 64 * PB, O_LKP = O_VST + 64 * PB, O_UKB = O_LKP + 16 * PB, SETSZ = O_UKB + 16 * PB;
    static_assert(SETSZ % 8 == 0, "set size keeps 16-byte alignment");
    constexpr int FSZ = 320 + 16 * 64;
    LAS bf16* SET = (LAS bf16*)(F.lds + RING_OFF);
    LAS bf16* RAW = SET + 2 * SETSZ;
    LAS bf16* Sb = RAW + 4 * 16 * PA;
    LAS float* FSET = (LAS float*)(Sb + 64 * PA);
    LAS float* RH = FSET + 2 * FSZ;
    const int tid = F.tid, lane = F.lane, w = F.wave;
    const int tr = (lane >> 4) * 4, uc = lane & 15;
    for (int sidx = F.vcu; sidx < 256; sidx += F.G) {
        const int d = sidx >> 7, b = (sidx >> 5) & 3, h = sidx & 31;
        const GAS bf16* gR = (const GAS bf16*)(ws + L0_R) + (size_t)b * LTOK * DM + h * 64;
        const GAS bf16* gK = (const GAS bf16*)(ws + L0_K) + (size_t)b * LTOK * DM + h * 64;
        const GAS bf16* gV = (const GAS bf16*)(ws + L0_V) + (size_t)b * LTOK * DM + h * 64;
        const GAS bf16* gD = (const GAS bf16*)(ws + (d ? L0_DEC1 : L0_DEC0)) + (size_t)b * LTOK * DM + h * 64;
        const GAS bf16* gI = (const GAS bf16*)(ws + (d ? L0_IC1 : L0_IC0)) + (size_t)b * LTOK * DM + h * 64;
        const int ft = tid >> 5, fpart = tid & 31, fti = fpart >> 3, fc = (fpart & 7) * 8;
        const GAS bf16* fbase = fti == 0 ? gR : (fti == 1 ? gK : (fti == 2 ? gV : gI));
        const int t1 = (tid >> 4) & 15, j4 = (tid & 15) * 4;
        const f32x4 kk4 = *(const f32x4*)(k_k + h * 64 + j4), ka4 = *(const f32x4*)(k_a + h * 64 + j4), rk4 = *(const f32x4*)(r_k + h * 64 + j4);
        __syncthreads();
        for (int i = tid; i < 64 * PA / 2; i += 512) ((LAS unsigned*)Sb)[i] = 0u;
        for (int i = tid; i < 2 * SETSZ / 2; i += 512) ((LAS unsigned*)SET)[i] = 0u;
        pg8::f32x4 ST[2]; ST[0] = (pg8::f32x4){0.f, 0.f, 0.f, 0.f}; ST[1] = ST[0];
        v4u pa; bf16 dq[16];
#define CS_FETCH(chn) do { { const int step_ = (chn) * 16 + ft; const int tk_ = d ? flip_tok(step_) : step_; pa = *(const GAS v4u*)(fbase + (size_t)tk_ * DM + fc); } \
            if (w == 4) { _Pragma("unroll") for (int t_ = 0; t_ < 16; ++t_) { const int step_ = (chn) * 16 + t_; const int tk_ = d ? flip_tok(step_) : step_; dq[t_] = gD[(size_t)tk_ * DM + lane]; } } } while (0)
#define CS_RAWWRITE(st) do { *(LAS v4u*)(RAW + (fti * 16 + ft) * PA + fc) = pa; \
            if (w == 4) { float W_ = 1.f; LAS float* wc_ = FSET + (st) * FSZ + 320 + lane; _Pragma("unroll") for (int t_ = 0; t_ < 16; ++t_) { W_ *= bf2f(dq[t_]); wc_[t_ * 64] = W_; } } } while (0)
#define CS_STEP1(chn, st) do { LAS bf16* S_ = SET + (st) * SETSZ; const LAS float* wc_ = FSET + (st) * FSZ + 320; \
            const v2u rw = *(const LAS v2u*)(RAW + (0 * 16 + t1) * PA + j4), kw = *(const LAS v2u*)(RAW + (1 * 16 + t1) * PA + j4), vw = *(const LAS v2u*)(RAW + (2 * 16 + t1) * PA + j4), iw = *(const LAS v2u*)(RAW + (3 * 16 + t1) * PA + j4); \
            const f32x4 r = {bflo(rw.x), bfhi(rw.x), bflo(rw.y), bfhi(rw.y)}, k = {bflo(kw.x), bfhi(kw.x), bflo(kw.y), bfhi(kw.y)}, ic = {bflo(iw.x), bfhi(iw.x), bflo(iw.y), bfhi(iw.y)}; \
            const f32x4 Wt = *(const LAS f32x4*)(wc_ + t1 * 64 + j4); f32x4 Wm = {1.f, 1.f, 1.f, 1.f}; if (t1 > 0) Wm = *(const LAS f32x4*)(wc_ + (t1 - 1) * 64 + j4); \
            f32x4 kkv = k * kk4; float ss = (kkv.x * kkv.x + kkv.y * kkv.y) + (kkv.z * kkv.z + kkv.w * kkv.w); \
            const f32x4 kd = k * ((ic - 1.f) * ka4 + 1.f); const f32x4 bt = r * kd * rk4; float bon = (bt.x + bt.y) + (bt.z + bt.w); \
            ss = red16(ss); bon = red16(bon); \
            kkv = kkv * __builtin_amdgcn_rsqf(ss + 1e-12f); const f32x4 kka = kkv * ic; \
            const int step = (chn) * 16 + t1; const int tk = d ? flip_tok(step) : step; \
            if ((tid & 15) == 0) BON[((size_t)d * NTOK + (size_t)b * LTOK + tk) * 32 + h] = bon; \
            const f32x4 iW = {__builtin_amdgcn_rcpf(Wt.x), __builtin_amdgcn_rcpf(Wt.y), __builtin_amdgcn_rcpf(Wt.z), __builtin_amdgcn_rcpf(Wt.w)}; \
            const f32x4 ah = kkv * Wm, bh = kka * iW, kh = kd * iW, rh = r * Wt; \
            v2u o_; o_.x = pk2(ah.x, ah.y); o_.y = pk2(ah.z, ah.w); *(LAS v2u*)(S_ + O_AH + t1 * PA + j4) = o_; \
            o_.x = pk2(rh.x, rh.y); o_.y = pk2(rh.z, rh.w); *(LAS v2u*)(S_ + O_RH + t1 * PA + j4) = o_; \
            v2u kh_; kh_.x = pk2(kh.x, kh.y); kh_.y = pk2(kh.z, kh.w); *(LAS v2u*)(S_ + O_KH + t1 * PA + j4) = kh_; \
            o_.x = pk2(bh.x, bh.y); o_.y = pk2(bh.z, bh.w); *(LAS v2u*)(S_ + O_BH + t1 * PA + j4) = o_; \
            v2u nb_; nb_.x = pk2(-bh.x, -bh.y); nb_.y = pk2(-bh.z, -bh.w); \
            LAS bf16* kb_ = S_ + O_KBT + j4 * PB + t1; LAS bf16* vs_ = S_ + O_VST + j4 * PB + t1; \
            kb_[0] = (bf16)(kh_.x & 0xffff); kb_[PB] = (bf16)(kh_.x >> 16); kb_[2 * PB] = (bf16)(kh_.y & 0xffff); kb_[3 * PB] = (bf16)(kh_.y >> 16); \
            kb_[16] = (bf16)(nb_.x & 0xffff); kb_[PB + 16] = (bf16)(nb_.x >> 16); kb_[2 * PB + 16] = (bf16)(nb_.y & 0xffff); kb_[3 * PB + 16] = (bf16)(nb_.y >> 16); \
            vs_[0] = (bf16)(vw.x & 0xffff); vs_[PB] = (bf16)(vw.x >> 16); vs_[2 * PB] = (bf16)(vw.y & 0xffff); vs_[3 * PB] = (bf16)(vw.y >> 16); } while (0)
#define CS_STEP2(wq, st) do { LAS bf16* S_ = SET + (st) * SETSZ; LAS float* LB_ = FSET + (st) * FSZ; pg8::f32x4 a = {0.f, 0.f, 0.f, 0.f}; \
            a = mma_tile(a, S_ + (((wq) < 2) ? O_AH : O_RH), PA, S_ + (((wq) == 0 || (wq) == 3) ? O_BH : O_KH), PA, 2, lane); \
            _Pragma("unroll") for (int r = 0; r < 4; ++r) { const int t = tr + r; const float x = a[r]; \
                if ((wq) == 0) LB_[uc * 20 + t] = (uc < t) ? x : 0.f; \
                else if ((wq) == 1) S_[O_LKP + t * PB + uc] = f2bf((uc < t) ? x : 0.f); \
                else if ((wq) == 2) S_[O_UKB + t * PB + uc] = f2bf((uc <= t) ? x : 0.f); \
                else S_[O_UKB + t * PB + 16 + uc] = f2bf((uc <= t) ? -x : 0.f); } } while (0)
        CS_FETCH(0); CS_RAWWRITE(0); CS_FETCH(1);
        LDS_BARRIER();
        if (w < 4) CS_STEP1(0, 0);
        LDS_BARRIER();
        if (w < 4) CS_STEP2(w, 0);
        LDS_BARRIER();
        asm volatile("" : "+v"(pa));
        for (int ch = 0; ch < NCH; ++ch) {
            const int cur = ch & 1, nxt = cur ^ 1; LAS bf16* C_ = SET + cur * SETSZ; LAS float* FC_ = FSET + cur * FSZ;
            if (ch + 1 < NCH) { CS_RAWWRITE(nxt); if (ch + 2 < NCH) CS_FETCH(ch + 2); }
            pg8::f32x4 accy = {0.f, 0.f, 0.f, 0.f};
            if (w >= 4) { pg8::f32x4 accg = {0.f, 0.f, 0.f, 0.f};
                accg = mma_tile(accg, C_ + O_AH, PA, Sb + (w - 4) * 16 * PA, PA, 2, lane);
                accg = mma_tile(accg, C_ + O_LKP, PB, C_ + O_VST + (w - 4) * 16 * PB, PB, 1, lane);
#pragma unroll
                for (int r = 0; r < 4; ++r) RH[(tr + r) * 68 + (w - 4) * 16 + uc] = accg[r]; }
            else accy = mma_tile(accy, C_ + O_RH, PA, Sb + w * 16 * PA, PA, 2, lane);
            LDS_BARRIER();
            if (w == 7) {
                float sg[16];
#pragma unroll
                for (int t = 0; t < 16; ++t) sg[t] = RH[t * 68 + lane];
#pragma unroll
                for (int u = 0; u < 15; ++u) {
#pragma unroll
                    for (int g4 = (u + 1) / 4; g4 < 4; ++g4) { const pg8::f32x4 l4 = *(const LAS pg8::f32x4*)(FC_ + u * 20 + g4 * 4);
#pragma unroll
                        for (int r = 0; r < 4; ++r) { const int t = g4 * 4 + r; if (t > u) sg[t] -= l4[r] * sg[u]; } } }
                v4u o; o.x = pk2(sg[0], sg[1]); o.y = pk2(sg[2], sg[3]); o.z = pk2(sg[4], sg[5]); o.w = pk2(sg[6], sg[7]); *(LAS v4u*)(C_ + O_VST + lane * PB + 16) = o;
                o.x = pk2(sg[8], sg[9]); o.y = pk2(sg[10], sg[11]); o.z = pk2(sg[12], sg[13]); o.w = pk2(sg[14], sg[15]); *(LAS v4u*)(C_ + O_VST + lane * PB + 24) = o;
            } else if (w < 4 && ch + 1 < NCH) CS_STEP1(ch + 1, nxt);
            LDS_BARRIER();
            { const int jb = w >> 1, ib0 = (w & 1) * 2; const pg8::f32x4 we = *(const LAS pg8::f32x4*)(FC_ + 320 + 15 * 64 + jb * 16 + tr);
              if (w < 4) accy = mma_tile(accy, C_ + O_UKB, PB, C_ + O_VST + w * 16 * PB, PB, 1, lane);
              pg8::f32x4 a0 = mma_tile(ST[0], C_ + O_KBT + jb * 16 * PB, PB, C_ + O_VST + ib0 * 16 * PB, PB, 1, lane);
              pg8::f32x4 a1 = mma_tile(ST[1], C_ + O_KBT + jb * 16 * PB, PB, C_ + O_VST + (ib0 + 1) * 16 * PB, PB, 1, lane);
              pg8::f32x4 a2 = {0.f, 0.f, 0.f, 0.f}; const int wq = w - 4; LAS bf16* N_ = SET + nxt * SETSZ; LAS float* LBn = FSET + nxt * FSZ;
              const bool do2 = (w >= 4 && ch + 1 < NCH);
              if (do2) a2 = mma_tile(a2, N_ + ((wq < 2) ? O_AH : O_RH), PA, N_ + ((wq == 0 || wq == 3) ? O_BH : O_KH), PA, 2, lane);
              a0 = a0 * we; a1 = a1 * we; ST[0] = a0; ST[1] = a1;
              asm volatile("" : "+v"(pa));
              if (w < 4) {
#pragma unroll
                  for (int r = 0; r < 4; ++r) { const int step = ch * 16 + tr + r; const int tk = d ? flip_tok(step) : step;
                      YS[((size_t)d * NTOK + (size_t)b * LTOK + tk) * DM + h * 64 + w * 16 + uc] = f2bf(accy[r]); } }
              v2u sw; sw.x = pk2(a0[0], a0[1]); sw.y = pk2(a0[2], a0[3]); *(LAS v2u*)(Sb + (ib0 * 16 + uc) * PA + jb * 16 + tr) = sw;
              sw.x = pk2(a1[0], a1[1]); sw.y = pk2(a1[2], a1[3]); *(LAS v2u*)(Sb + ((ib0 + 1) * 16 + uc) * PA + jb * 16 + tr) = sw;
              if (do2) {
#pragma unroll
                  for (int r = 0; r < 4; ++r) { const int t = tr + r; const float x = a2[r];
                      if (wq == 0) LBn[uc * 20 + t] = (uc < t) ? x : 0.f;
                      else if (wq == 1) N_[O_LKP + t * PB + uc] = f2bf((uc < t) ? x : 0.f);
                      else if (wq == 2) N_[O_UKB + t * PB + uc] = f2bf((uc <= t) ? x : 0.f);
                      else N_[O_UKB + t * PB + 16 + uc] = f2bf((uc <= t) ? -x : 0.f); } } }
            LDS_BARRIER();
        }
#undef CS_FETCH
#undef CS_RAWWRITE
#undef CS_STEP1
#undef CS_STEP2
    }
}
__device__ __forceinline__ void l0_post_phase(Frame& F, const float* gn_g, const float* gn_b) {
    const int gw = GW(F), NGWv = NGW(F); unsigned char* ws = F.ws;
    const bf16* YS = (const bf16*)(ws + L0_XS); const bf16* V = (const bf16*)(ws + L0_V); const bf16* G = (const bf16*)(ws + L0_G); const float* BONUS = (const float*)(ws + L0_BONUS);
    bf16* OUTB = (bf16*)(ws + WS_OUTB); const int l8 = F.lane & 7;
    const int hh = (gw & 3) * 8 + (F.lane >> 3), c0 = hh * 64 + l8 * 8;
    float gg[8], gb[8]; ld8f(gn_g + c0, gg); ld8f(gn_b + c0, gb);
    constexpr int UB = 3;
    for (int it0 = gw; it0 < NTOK * 4; it0 += UB * NGWv) {
        v4u wya[UB], wyb[UB], wv[UB], wg[UB]; float b0[UB], b1[UB];
#pragma unroll
        for (int u = 0; u < UB; ++u) { const int it = it0 + u * NGWv; if (it < NTOK * 4) { const int m = it >> 2; const size_t e = (size_t)m * DM + c0;
            wya[u] = *(const GAS v4u*)(YS + e); wyb[u] = *(const GAS v4u*)(YS + (size_t)NTOK * DM + e); wv[u] = *(const GAS v4u*)(V + e); wg[u] = *(const GAS v4u*)(G + e);
            b0[u] = *(const GAS float*)(BONUS + m * 32 + hh); b1[u] = *(const GAS float*)(BONUS + (size_t)NTOK * 32 + m * 32 + hh); } }
#pragma unroll
        for (int u = 0; u < UB; ++u) { const int it = it0 + u * NGWv; if (it < NTOK * 4) { const int m = it >> 2; const size_t e = (size_t)m * DM + c0;
            float y[8], y2[8], v[8], g[8];
            { float ya[8], yb[8]; unpack8(wya[u], ya); unpack8(wyb[u], yb);
#pragma unroll
              for (int j = 0; j < 8; ++j) y[j] = ya[j] + yb[j]; }
            unpack8(wv[u], v); unpack8(wg[u], g);
            float s = 0.f;
#pragma unroll
            for (int j = 0; j < 8; ++j) s += y[j];
            const float mean = red8(s) * (1.f / 64.f); float q2 = 0.f;
#pragma unroll
            for (int j = 0; j < 8; ++j) { y[j] -= mean; q2 += y[j] * y[j]; }
            const float rstd = 1.0f / sqrtf(red8(q2) * (1.f / 64.f) + 64e-5f);
            const float bon = b0[u] + b1[u];
#pragma unroll
            for (int j = 0; j < 8; ++j) y2[j] = ((y[j] * rstd) * gg[j] + gb[j] + bon * v[j]) * g[j];
            *(GAS v4u*)(OUTB + e) = pack8(y2); } }
    }
}

__device__ __forceinline__ void l1_rope_phase(Frame& F) {
    bf16* QKV = (bf16*)(F.ws + L1_QKV); const float* RT = (const float*)(F.ws + WS_ROPE);
    const size_t total = (size_t)NLAT * 256; const size_t stride = (size_t)F.G * 512;
    for (size_t it = (size_t)F.vcu * 512 + F.tid; it < total; it += stride) {
        const int idx = (int)(it >> 8), sub = (int)(it & 255); const int hd = sub >> 3, ax = (sub >> 2) & 1, g8 = sub & 3;
        const int b = idx >> 11, t = NCTX + (idx & 2047); const size_t m = (size_t)b * LTOK + t;
        bf16* pa = QKV + m * 6144 + hd * 128 + ax * 64 + g8 * 8; bf16* pb = pa + 32;
        const v4u wa = *(const GAS v4u*)pa, wb = *(const GAS v4u*)pb;
        const float* cs = RT + ((size_t)t * 64 + ax * 32 + g8 * 8) * 2;
        float a[8] = {bflo(wa.x), bfhi(wa.x), bflo(wa.y), bfhi(wa.y), bflo(wa.z), bfhi(wa.z), bflo(wa.w), bfhi(wa.w)};
        float bb[8] = {bflo(wb.x), bfhi(wb.x), bflo(wb.y), bfhi(wb.y), bflo(wb.z), bfhi(wb.z), bflo(wb.w), bfhi(wb.w)};
        float oa[8], ob[8];
#pragma unroll
        for (int j = 0; j < 8; ++j) { const f32x2 c = *(const GAS f32x2*)(cs + 2 * j); oa[j] = a[j] * c.x - bb[j] * c.y; ob[j] = bb[j] * c.x + a[j] * c.y; }
        v4u w; w.x = pk2(oa[0], oa[1]); w.y = pk2(oa[2], oa[3]); w.z = pk2(oa[4], oa[5]); w.w = pk2(oa[6], oa[7]); *(GAS v4u*)pa = w;
        w.x = pk2(ob[0], ob[1]); w.y = pk2(ob[2], ob[3]); w.z = pk2(ob[4], ob[5]); w.w = pk2(ob[6], ob[7]); *(GAS v4u*)pb = w;
    }
}
__device__ __forceinline__ void l1_attn_phase(Frame& F, char* lds_generic) {
    const att::bf16* QKV = (const att::bf16*)(F.ws + L1_QKV); bf16* O = (bf16*)(F.ws + L1_O);
    constexpr int NLONG = NB * 16 * 2 * 8, NSHORT = NB * 16 * 2;
    for (int u = F.vcu; u < NLONG + NSHORT; u += F.G) {
        int b, hm, vh, qb, seq;
        if (u < NLONG) { qb = 1 + (u & 7); vh = (u >> 3) & 1; hm = (u >> 4) & 15; b = u >> 8; seq = LTOK; }
        else { const int v = u - NLONG; qb = 0; vh = v & 1; hm = (v >> 1) & 15; b = v >> 5; seq = NCTX; }
        const size_t m0 = (size_t)b * LTOK + (size_t)qb * 256, k0 = (size_t)b * LTOK;
        att::attn_dense_body<att::bf16>(QKV + m0 * 6144 + hm * 128, QKV + k0 * 6144 + 2048 + hm * 128, QKV + k0 * 6144 + 4096 + (hm >> 1) * 256 + vh * 128,
                                        O + m0 * 4096 + hm * 256 + vh * 128, seq, lds_generic);
        __syncthreads();
    }
}
__device__ __forceinline__ void l1_combine_phase(Frame& F, const float* lam_vec, const float* sub_g) {
    const int gw = GW(F), NGWv = NGW(F); const bf16* O = (const bf16*)(F.ws + L1_O); bf16* OUTB = (bf16*)(F.ws + WS_OUTB);
    float d01 = 0.f, d23 = 0.f;
    for (int i = F.lane; i < 128; i += 64) { d01 += lam_vec[i] * lam_vec[128 + i]; d23 += lam_vec[256 + i] * lam_vec[384 + i]; }
    const float lam_init = 0.8f - 0.6f * expf(-0.3f * 1.0f);
    const float lam = expf(wave_sum(d01)) - expf(wave_sum(d23)) + lam_init;
    const int l32 = F.lane & 31, hs = F.lane >> 5;
    float sg[8]; ld8f(sub_g + 8 * l32, sg);
    constexpr int UB = 3;
    for (int it0 = gw; it0 < NTOK * 4; it0 += UB * NGWv) {
        v4u w1[UB], w2[UB];
#pragma unroll
        for (int u = 0; u < UB; ++u) { const int it = it0 + u * NGWv; if (it < NTOK * 4) { const int m = it >> 2, h = (it & 3) * 2 + hs; const GAS bf16* op = (const GAS bf16*)O + (size_t)m * 4096 + h * 512 + 8 * l32;
            w1[u] = *(const GAS v4u*)op; w2[u] = *(const GAS v4u*)(op + 256); } }
#pragma unroll
        for (int u = 0; u < UB; ++u) { const int it = it0 + u * NGWv; if (it < NTOK * 4) { const int m = it >> 2, h = (it & 3) * 2 + hs;
            float o1[8], o2[8], o[8]; unpack8(w1[u], o1); unpack8(w2[u], o2); float ss = 0.f;
#pragma unroll
            for (int j = 0; j < 8; ++j) { o[j] = o1[j] - o2[j] * lam; ss += o[j] * o[j]; }
            ss = red16(ss); ss += __shfl_xor(ss, 16);
            const float rs = (1.0f / sqrtf(ss * (1.f / 256.f) + 1e-5f)) * (1.f - lam_init);
#pragma unroll
            for (int j = 0; j < 8; ++j) o[j] = o[j] * rs * sg[j];
            *(GAS v4u*)(OUTB + (size_t)m * DM + h * 256 + 8 * l32) = pack8(o); } }
    }
}

__device__ __forceinline__ void l2_gla_phase(Frame& F) {
    unsigned char* ws = F.ws; const bf16* HGO = (const bf16*)(ws + L2_HGO); bf16* OG = (bf16*)(ws + L2_OG);
    constexpr int PK = 136, PS = 72;
    LAS bf16* QR = (LAS bf16*)(F.lds + RING_OFF);
    LAS bf16* KR = QR + 64 * PK;
    LAS bf16* VR = KR + 64 * PK;
    LAS bf16* QD = QR; LAS bf16* KD = KR;
    LAS bf16* KEt = VR + 64 * PS;
    LAS bf16* Vt = KEt + 128 * PS;
    LAS bf16* Pm = Vt + 64 * PS;
    LAS bf16* St = Pm + 64 * PS;
    LAS float* tot = (LAS float*)(St + 64 * PK);
    LAS float* dec = tot + 8 * 128;
    const int lane = F.lane, w = F.wave, tid = F.tid;
    constexpr int NCHK = LTOK / 64;
    for (int u = F.vcu; u < 256; u += F.G) {
        const int vh = u & 1, h = (u >> 1) & 15, b = (u >> 5) & 3, d = u >> 7;
        pg8::f32x4 S4[4];
#pragma unroll
        for (int vb = 0; vb < 4; ++vb) S4[vb] = (pg8::f32x4){0.f, 0.f, 0.f, 0.f};
        v4u rq[2], rk[2], rv;
        const GAS bf16* hb = (const GAS bf16*)HGO + (size_t)b * LTOK * 10240;
#define GLA_FETCH(chn) do { \
            _Pragma("unroll") for (int k_ = 0; k_ < 2; ++k_) { const int id_ = tid + 512 * k_, s_ = id_ >> 4, c16_ = id_ & 15; const int step_ = (chn) * 64 + s_; const int t_ = d ? flip_tok(step_) : step_; \
                rq[k_] = *(const GAS v4u*)(hb + (size_t)t_ * 10240 + h * 128 + c16_ * 8); rk[k_] = *(const GAS v4u*)(hb + (size_t)t_ * 10240 + (3 + d) * DM + h * 128 + c16_ * 8); } \
            { const int s_ = tid >> 3, c16_ = tid & 7; const int step_ = (chn) * 64 + s_; const int t_ = d ? flip_tok(step_) : step_; rv = *(const GAS v4u*)(hb + (size_t)t_ * 10240 + DM + h * 128 + vh * 64 + c16_ * 8); } } while (0)
        GLA_FETCH(0);
        asm volatile("" : "+v"(rq[0]), "+v"(rq[1]), "+v"(rk[0]), "+v"(rk[1]), "+v"(rv));
        for (int ch = 0; ch < NCHK; ++ch) {
            LDS_BARRIER();
#pragma unroll
            for (int k = 0; k < 2; ++k) { const int id = tid + 512 * k, s = id >> 4, c16 = id & 15; *(LAS v4u*)(QR + s * PK + c16 * 8) = rq[k]; *(LAS v4u*)(KR + s * PK + c16 * 8) = rk[k]; }
            *(LAS v4u*)(VR + (tid >> 3) * PS + (tid & 7) * 8) = rv;
            if (ch + 1 < NCHK) GLA_FETCH(ch + 1);
            LDS_BARRIER();
            const int cp = tid & 63, sg = tid >> 6, c = 2 * cp;
            float k0[8], k1[8], b0[8], b1[8]; float run0 = 0.f, run1 = 0.f;
#pragma unroll
            for (int s = 0; s < 8; ++s) { const unsigned kw = *(const LAS unsigned*)(KR + (sg * 8 + s) * PK + c); k0[s] = bflo(kw); k1[s] = bfhi(kw);
                run0 += __logf(1.f - k0[s]); run1 += __logf(1.f - k1[s]); b0[s] = run0; b1[s] = run1; }
            *(LAS f32x2*)(tot + sg * 128 + c) = (f32x2){run0, run1};
            { const int v = tid & 63, s8 = (tid >> 6) * 8; unsigned short e[8];
#pragma unroll
              for (int s = 0; s < 8; ++s) e[s] = VR[(s8 + s) * PS + v];
              v4u o; o.x = e[0] | ((unsigned)e[1] << 16); o.y = e[2] | ((unsigned)e[3] << 16); o.z = e[4] | ((unsigned)e[5] << 16); o.w = e[6] | ((unsigned)e[7] << 16);
              *(LAS v4u*)(Vt + v * PS + s8) = o; }
#pragma unroll
            for (int vb = 0; vb < 4; ++vb) { v2u sw; sw.x = pk2(S4[vb][0], S4[vb][1]); sw.y = pk2(S4[vb][2], S4[vb][3]);
                *(LAS v2u*)(St + (vb * 16 + (lane & 15)) * PK + 16 * w + (lane >> 4) * 4) = sw; }
            LDS_BARRIER();
            float off0 = 0.f, off1 = 0.f, bend0 = 0.f, bend1 = 0.f;
#pragma unroll
            for (int g = 0; g < 8; ++g) { const f32x2 tg = *(const LAS f32x2*)(tot + g * 128 + c); if (g < sg) { off0 += tg.x; off1 += tg.y; } bend0 += tg.x; bend1 += tg.y; }
            if (sg == 0) *(LAS f32x2*)(dec + c) = (f32x2){__expf(bend0), __expf(bend1)};
            { const float eb0 = __expf(bend0), eb1 = __expf(bend1); float ke0[8], ke1[8];
#pragma unroll
              for (int s = 0; s < 8; ++s) { const int st = sg * 8 + s; const float e0 = __expf(off0 + b0[s]), e1 = __expf(off1 + b1[s]); const float i0 = __builtin_amdgcn_rcpf(e0), i1 = __builtin_amdgcn_rcpf(e1);
                  const unsigned qw = *(const LAS unsigned*)(QR + st * PK + c);
                  *(LAS unsigned*)(QD + st * PK + c) = pk2(bflo(qw) * e0, bfhi(qw) * e1);
                  const float kd0 = k0[s] * i0, kd1 = k1[s] * i1;
                  *(LAS unsigned*)(KD + st * PK + c) = pk2(kd0, kd1); ke0[s] = kd0 * eb0; ke1[s] = kd1 * eb1; }
              v4u o; o.x = pk2(ke0[0], ke0[1]); o.y = pk2(ke0[2], ke0[3]); o.z = pk2(ke0[4], ke0[5]); o.w = pk2(ke0[6], ke0[7]); *(LAS v4u*)(KEt + c * PS + sg * 8) = o;
              o.x = pk2(ke1[0], ke1[1]); o.y = pk2(ke1[2], ke1[3]); o.z = pk2(ke1[4], ke1[5]); o.w = pk2(ke1[6], ke1[7]); *(LAS v4u*)(KEt + (c + 1) * PS + sg * 8) = o; }
            LDS_BARRIER();
            { const int tb = w >> 1;
#pragma unroll
              for (int q2 = 0; q2 < 2; ++q2) { const int sb = (w & 1) * 2 + q2; pg8::f32x4 a = {0.f, 0.f, 0.f, 0.f};
                  if (sb <= tb) a = mma_tile(a, QD + tb * 16 * PK, PK, KD + sb * 16 * PK, PK, 4, lane);
#pragma unroll
                  for (int j = 0; j < 4; ++j) { const int tt = tb * 16 + (lane >> 4) * 4 + j, ss = sb * 16 + (lane & 15); Pm[tt * PS + ss] = f2bf(ss <= tt ? a[j] : 0.f); } } }
            LDS_BARRIER();
            asm volatile("" : "+v"(rq[0]), "+v"(rq[1]), "+v"(rk[0]), "+v"(rk[1]), "+v"(rv));
            { const int tb = w >> 1;
#pragma unroll
              for (int q2 = 0; q2 < 2; ++q2) { const int vb = (w & 1) * 2 + q2; pg8::f32x4 a = {0.f, 0.f, 0.f, 0.f};
                  a = mma_tile(a, Pm + tb * 16 * PS, PS, Vt + vb * 16 * PS, PS, 2, lane);
                  a = mma_tile(a, QD + tb * 16 * PK, PK, St + vb * 16 * PK, PK, 4, lane);
#pragma unroll
                  for (int j = 0; j < 4; ++j) { const int s = tb * 16 + (lane >> 4) * 4 + j; const int step = ch * 64 + s; const int t = d ? flip_tok(step) : step;
                      OG[((size_t)d * NTOK + (size_t)b * LTOK + t) * DM + h * 128 + vh * 64 + vb * 16 + (lane & 15)] = f2bf(a[j]); } } }
#pragma unroll
            for (int vb = 0; vb < 4; ++vb) { pg8::f32x4 a = S4[vb];
#pragma unroll
                for (int j = 0; j < 4; ++j) a[j] *= dec[16 * w + (lane >> 4) * 4 + j];
                S4[vb] = mma_tile(a, KEt + 16 * w * PS, PS, Vt + vb * 16 * PS, PS, 2, lane); }
        }
#undef GLA_FETCH
    }
}
__device__ __forceinline__ void l2_combine_phase(Frame& F, const float* norm_g) {
    const int gw = GW(F), NGWv = NGW(F); const bf16* OG = (const bf16*)(F.ws + L2_OG); const bf16* HGO = (const bf16*)(F.ws + L2_HGO); bf16* OUTB = (bf16*)(F.ws + WS_OUTB);
    const int l16 = F.lane & 15, hq = F.lane >> 4;
    float ng[8]; ld8f(norm_g + 8 * l16, ng);
    constexpr int UB = 3;
    for (int it0 = gw; it0 < NTOK * 4; it0 += UB * NGWv) {
        v4u wa[UB], wb[UB], wg[UB];
#pragma unroll
        for (int u = 0; u < UB; ++u) { const int it = it0 + u * NGWv; if (it < NTOK * 4) { const int m = it >> 2, col = ((it & 3) * 4 + hq) * 128 + 8 * l16; const size_t e = (size_t)m * DM + col;
            wa[u] = *(const GAS v4u*)(OG + e); wb[u] = *(const GAS v4u*)(OG + (size_t)NTOK * DM + e); wg[u] = *(const GAS v4u*)(HGO + (size_t)m * 10240 + 2 * DM + col); } }
#pragma unroll
        for (int u = 0; u < UB; ++u) { const int it = it0 + u * NGWv; if (it < NTOK * 4) { const int m = it >> 2, col = ((it & 3) * 4 + hq) * 128 + 8 * l16;
            float oa[8], ob[8], g[8], o[8]; unpack8(wa[u], oa); unpack8(wb[u], ob); unpack8(wg[u], g); float ss = 0.f;
#pragma unroll
            for (int j = 0; j < 8; ++j) { o[j] = oa[j] + ob[j]; ss += o[j] * o[j]; }
            ss = red16(ss);
            const float rs = 1.0f / sqrtf(ss * (1.f / 128.f) + 1e-5f);
#pragma unroll
            for (int j = 0; j < 8; ++j) o[j] = o[j] * rs * ng[j] * g[j];
            *(GAS v4u*)(OUTB + (size_t)m * DM + col) = pack8(o); } }
    }
}

__device__ __forceinline__ void l3_conv_phase(Frame& F, const float* cw, const float* cb) {
    const int gw = GW(F), NGWv = NGW(F); const bf16* IN = (const bf16*)(F.ws + L3_IN) + DM; bf16* XB = (bf16*)(F.ws + L3_XB);
    const int c0 = (gw & 3) * 512 + F.lane * 8;
    float wk[4][8], bk[8];
#pragma unroll
    for (int k = 0; k < 4; ++k) ld8f(cw + (size_t)k * DM + c0, wk[k]);
    ld8f(cb + c0, bk);
    for (int it = gw; it < (NTOK / 16) * 4; it += NGWv) {
        const int strip = it >> 2; const int m0 = strip * 16, t0 = m0 % LTOK;
        const int seg_end = (t0 < NCTX) ? NCTX : LTOK; const bool first_in_seg = (t0 == 0 || t0 == NCTX);
        const GAS bf16* xg = (const GAS bf16*)IN + (size_t)m0 * 4096 + c0;
        v4u xr[19];
#pragma unroll
        for (int q = 0; q < 19; ++q) { const bool ok = (q == 0) ? !first_in_seg : (t0 + q - 1 < seg_end);
            xr[q] = (v4u){0u, 0u, 0u, 0u}; if (ok) xr[q] = *(const GAS v4u*)(xg + (ptrdiff_t)(q - 1) * 4096); }
#pragma unroll
        for (int r = 0; r < 16; ++r) {
            const v4u x0 = xr[r], x1 = xr[r + 1], x2 = xr[r + 2], x3 = xr[r + 3];
            float o[8];
#pragma unroll
            for (int q = 0; q < 4; ++q) {
                o[2 * q] = bk[2 * q] + wk[0][2 * q] * bflo(x0[q]) + wk[1][2 * q] * bflo(x1[q]) + wk[2][2 * q] * bflo(x2[q]) + wk[3][2 * q] * bflo(x3[q]);
                o[2 * q + 1] = bk[2 * q + 1] + wk[0][2 * q + 1] * bfhi(x0[q]) + wk[1][2 * q + 1] * bfhi(x1[q]) + wk[2][2 * q + 1] * bfhi(x2[q]) + wk[3][2 * q + 1] * bfhi(x3[q]); }
            *(GAS v4u*)(XB + (size_t)(m0 + r) * DM + c0) = pack8(o);
        }
    }
}
__device__ __forceinline__ void l3_scan_phase(Frame& F) {
    unsigned char* ws = F.ws; LAS float* PA = (LAS float*)(F.lds + RING_OFF); LAS float* PH = PA + 512;
    constexpr int SEGL = LTOK / 8, NBLK = SEGL / 16;
    for (int u = F.vcu; u < 256; u += F.G) {
        const int d = u >> 7, b = (u >> 5) & 3, cg = u & 31; const int ch = cg * 64 + F.lane, seg = F.wave;
        const bf16* LOGA = (const bf16*)(ws + L3_LOGA) + (size_t)d * NTOK * DM + (size_t)b * LTOK * DM + ch;
        const bf16* UU = (const bf16*)(ws + L3_UU) + (size_t)d * NTOK * DM + (size_t)b * LTOK * DM + ch;
        bf16* YS = (bf16*)(ws + L3_YS) + (size_t)d * NTOK * DM + (size_t)b * LTOK * DM + ch;
        bf16 laA[16], luA[16], laB[16], luB[16];
        auto ldblk = [&](const int blk, bf16 (&la)[16], bf16 (&lu)[16]) __attribute__((always_inline)) {
#pragma unroll
            for (int s = 0; s < 16; ++s) { const int step = seg * SEGL + blk * 16 + s; const int t = d ? flip_tok(step) : step; la[s] = LOGA[(size_t)t * DM]; lu[s] = UU[(size_t)t * DM]; } };
        float P = 1.f, Hh = 0.f;
        auto scan1 = [&](const bf16 (&la)[16], const bf16 (&lu)[16]) __attribute__((always_inline)) {
#pragma unroll
            for (int s = 0; s < 16; ++s) { const float a = __expf(bf2f(la[s])); Hh = a * Hh + bf2f(lu[s]); P *= a; } };
        auto scan2 = [&](const int blk, const bf16 (&la)[16], const bf16 (&lu)[16]) __attribute__((always_inline)) {
#pragma unroll
            for (int s = 0; s < 16; ++s) { const int step = seg * SEGL + blk * 16 + s; const int t = d ? flip_tok(step) : step; const float a = __expf(bf2f(la[s])); Hh = a * Hh + bf2f(lu[s]); YS[(size_t)t * DM] = f2bf(Hh); } };
        ldblk(0, laA, luA);
#pragma unroll 1
        for (int blk = 0; blk < NBLK; blk += 2) { ldblk(blk + 1, laB, luB); scan1(laA, luA); ldblk(blk + 2 < NBLK ? blk + 2 : NBLK - 1, laA, luA); scan1(laB, luB); }
        __syncthreads();
        PA[F.tid] = P; PH[F.tid] = Hh;
        __syncthreads();
        float carry = 0.f;
        for (int g = 0; g < seg; ++g) carry = PA[g * 64 + F.lane] * carry + PH[g * 64 + F.lane];
        Hh = carry;
        ldblk(0, laA, luA);
#pragma unroll 1
        for (int blk = 0; blk < NBLK; blk += 2) { ldblk(blk + 1, laB, luB); scan2(blk, laA, luA); ldblk(blk + 2 < NBLK ? blk + 2 : NBLK - 1, laA, luA); scan2(blk + 1, laB, luB); }
    }
}
__device__ __forceinline__ void l3_combine_phase(Frame& F) {
    const bf16* YS = (const bf16*)(F.ws + L3_YS); const bf16* IN = (const bf16*)(F.ws + L3_IN); bf16* OUTB = (bf16*)(F.ws + WS_OUTB);
    const size_t total = (size_t)NTOK * DM / 8; const size_t stride = (size_t)F.G * 512;
    constexpr int UB = 3;
    for (size_t i0 = (size_t)F.vcu * 512 + F.tid; i0 < total; i0 += UB * stride) {
        v4u ya[UB], yb[UB], gg[UB];
#pragma unroll
        for (int u = 0; u < UB; ++u) { const size_t i = i0 + u * stride; if (i < total) { const size_t e = i * 8; const size_t m = e / DM, c = e % DM;
            ya[u] = *(const GAS v4u*)(YS + e); yb[u] = *(const GAS v4u*)(YS + (size_t)NTOK * DM + e); gg[u] = *(const GAS v4u*)(IN + m * 4096 + c); } }
#pragma unroll
        for (int u = 0; u < UB; ++u) { const size_t i = i0 + u * stride; if (i < total) { const size_t e = i * 8;
            float a[8], b[8], g[8], o[8]; unpack8(ya[u], a); unpack8(yb[u], b); unpack8(gg[u], g);
#pragma unroll
            for (int j = 0; j < 8; ++j) o[j] = (a[j] + b[j]) * g[j];
            *(GAS v4u*)(OUTB + e) = pack8(o); } }
    }
}
constexpr int N_PHASE_IDS = 1 + 16 * NLAYER;
struct Args { const float* in[43]; float* out; unsigned char* ws; int ph_lo, ph_hi; };
static_assert(sizeof(Args) == 45 * 8 + 8, "Args has no holes");

#ifdef PROBE_MASK
__device__ __forceinline__ int probe_rep(int k) {
    if (k == 0) return 1;
    return ((PROBE_SEL >> (k - 1)) & 1ull) ? 2 : 1;
}
#endif
__global__ void __launch_bounds__(NWAVES * 64, 2) mega_fwd(Args args) {
    extern __shared__ __attribute__((aligned(16))) unsigned char lds[];
    { const int t0 = threadIdx.x; for (int u = t0; u < (LDS_BYTES - LDSCTL_OFF) / 4; u += NWAVES * 64) ((LAS unsigned*)((LAS unsigned char*)lds + LDSCTL_OFF))[u] = 0u; }
    __syncthreads();
#define MKFRAME() Frame F; { int t_ = threadIdx.x; asm volatile("" : "+v"(t_)); int bx_ = blockIdx.x, g_ = gridDim.x; asm volatile("" : "+s"(bx_), "+s"(g_)); \
        F.lds = (LAS unsigned char*)lds; F.MISC = (volatile LAS unsigned*)(F.lds + MISC_OFF); F.tid = t_; F.lane = t_ & 63; F.wave = __builtin_amdgcn_readfirstlane(t_ >> 6); \
        F.G = g_; F.vcu = (g_ % 8 == 0) ? (bx_ % 8) * (g_ / 8) + bx_ / 8 : bx_; F.bx = bx_; F.ws = (unsigned char*)ldarg(44); F.ctl = (gu32*)(F.ws + WS_CTL); }
    const int lo = args.ph_lo, hi = args.ph_hi;
    const bool multi = (hi - lo) > 1;
    XcdBarrier bar; bar.bar = (unsigned*)((unsigned char*)ldarg(44) + WS_CTL) + CW_BAR; bar.x = 0; bar.st = nullptr;
    if (multi) bar = xcd_barrier_post(bar.bar, (volatile LAS unsigned*)((LAS unsigned char*)lds + MISC_OFF) + 8);
#define IN(k) (lo <= (k) && (k) < hi)
#define RUN_GEMM(EPI, MODE, LAT, NM, NN, LDA_, LDB_, KK_, Aptr, Bptr, Eobj) do { typedef Sched<MODE, LAT, NM, NN, LDA_, LDB_> S_t; S_t S_; S_.init(F.G, F.bx); \
        pg8::gemm_phase<EPI, S_t, LDA_, LDB_, KK_, true, true>(F.lds + RING_OFF, (Aptr), (Bptr), S_, (Eobj)); } while (0)
#define RUN_GEMM_SPLIT(SPLIT, KSUB, LDA_, LDB_, Aptr, Bptr, Eobj) do { typedef SchedSplitHalf<SPLIT, KSUB, LDA_, LDB_> S_t; S_t S_; S_.init(F.G, F.bx); \
        pg8::gemm_phase<EpiPartial, S_t, LDA_, LDB_, KSUB, true, true, true>(F.lds + RING_OFF, (Aptr), (Bptr), S_, (Eobj)); } while (0)
#define RUN_GEMM_HT(EPI, LAT, NM, NN, LMAX, NT, LDA_, LDB_, KK_, Aptr, Bptr, Eobj) do { \
        typedef SchedHT<LAT, NM, NN, LMAX, NT, LDA_, LDB_> S_t; S_t S_; S_.init(F.G, F.bx); pg8::gemm_phase<EPI, S_t, LDA_, LDB_, KK_, true, true, 2>(F.lds + RING_OFF, (Aptr), (Bptr), S_, (Eobj)); } while (0)
#define SEAM(k) do { if ((k) + 1 < hi) xcd_barrier(bar); } while (0)
#ifdef PROBE_MASK
#define PH_OPEN(k) if (IN(k)) { _Pragma("unroll 1") for (int rep_ = 0; rep_ < probe_rep(k); ++rep_) {
#define PH_CLOSE(k) if ((k) + 1 < hi || rep_ + 1 < probe_rep(k)) xcd_barrier(bar); } }
#else
#define PH_OPEN(k) if (IN(k)) {
#define PH_CLOSE(k) SEAM(k); }
#endif
#define WSP ((unsigned char*)ldarg(44))
#define Z ((float*)(WSP + WS_Z))
#define PRE ((bf16*)(WSP + WS_PRE))
#define H ((bf16*)(WSP + WS_H))
#define OUTB ((bf16*)(WSP + WS_OUTB))
#define U ((bf16*)(WSP + WS_U))
#define ACT ((bf16*)(WSP + WS_ACT))

#ifndef DIS_P0
    PH_OPEN(0) MKFRAME(); p0_prologue(F); PH_CLOSE(0)
#endif

    for (int layer = 0; layer < NLAYER; ++layer) {
        const int P = 1 + 16 * layer;
        if (layer == 0) {
#ifndef DIS_L0
            PH_OPEN(P + 0) MKFRAME(); l0_xs_phase(F, INP(0), INP(2), INP(12)); PH_CLOSE(P + 0)
#ifndef DIS_L0_G1
            PH_OPEN(P + 1) MKFRAME();
                EpiBf16Route<1> E{nullptr, 0, WSP, nullptr, nullptr};
                RUN_GEMM(EpiBf16Route<1>, 1, false, 36, 27, DM, DM, DM, (const bf16*)(WSP + L0_XS), (const bf16*)(WSP + WS_WA), E); PH_CLOSE(P + 1)
#endif
#ifndef DIS_L0_G2
            PH_OPEN(P + 2) MKFRAME();
                EpiBf16Route<2> E{nullptr, 0, WSP, INP(14), INP(17)};
                RUN_GEMM(EpiBf16Route<2>, 2, false, 36, 40, 256, 256, 256, (const bf16*)(WSP + L0_HID), (const bf16*)(WSP + WS_WL2), E); PH_CLOSE(P + 2)
#endif
#ifndef DIS_L0_PREP
#endif
#ifndef DIS_L0_SCAN
            PH_OPEN(P + 4) MKFRAME(); l0_cscan2_phase(F, INP(22), INP(23), INP(24)); PH_CLOSE(P + 4)
#endif
            PH_OPEN(P + 5) MKFRAME(); l0_post_phase(F, INP(25), INP(26)); PH_CLOSE(P + 5)
#endif
        } else if (layer == 1) {
#ifndef DIS_L1
            PH_OPEN(P + 0) MKFRAME();
                EpiBf16Route<5> E{(bf16*)(WSP + L1_QKV), 6144, WSP, nullptr, nullptr};
                RUN_GEMM_HT(EpiBf16Route<5>, false, 36, 24, 768, 96, DM, DM, DM, H, (const bf16*)(WSP + WS_WQKV), E); PH_CLOSE(P + 0)
            PH_OPEN(P + 2) MKFRAME(); l1_attn_phase(F, (char*)lds + RING_OFF); PH_CLOSE(P + 2)
            PH_OPEN(P + 3) MKFRAME(); l1_combine_phase(F, INP(29), INP(30)); PH_CLOSE(P + 3)
#endif
        } else if (layer == 2) {
#ifndef DIS_L2
            PH_OPEN(P + 0) MKFRAME();
                EpiBf16Route<3> E{(bf16*)(WSP + L2_HGO), 10240, WSP, (const float*)(WSP + WS_LB), nullptr};
                RUN_GEMM(EpiBf16Route<3>, 0, false, 36, 40, DM, DM, DM, H, (const bf16*)(WSP + WS_WHG), E); PH_CLOSE(P + 0)
            PH_OPEN(P + 1) MKFRAME(); l2_gla_phase(F); PH_CLOSE(P + 1)
            PH_OPEN(P + 2) MKFRAME(); l2_combine_phase(F, INP(34)); PH_CLOSE(P + 2)
#endif
        } else {
#ifndef DIS_L3
            PH_OPEN(P + 0) MKFRAME();
                EpiBf16Route<4> E{(bf16*)(WSP + L3_IN), 4096, WSP, nullptr, nullptr};
                RUN_GEMM_HT(EpiBf16Route<4>, false, 36, 16, 512, 64, DM, DM, DM, H, (const bf16*)(WSP + WS_WLR), E); PH_CLOSE(P + 0)
            PH_OPEN(P + 1) MKFRAME(); l3_conv_phase(F, INP(37), INP(38)); PH_CLOSE(P + 1)
            PH_OPEN(P + 2) MKFRAME();
                EpiGates E{WSP, INP(40), INP(41)};
                RUN_GEMM(EpiGates, 3, false, 36, 32, DM, 256, 256, (const bf16*)(WSP + L3_XB), (const bf16*)(WSP + WS_WGATE), E); PH_CLOSE(P + 2)
            PH_OPEN(P + 3) MKFRAME(); l3_scan_phase(F); PH_CLOSE(P + 3)
            PH_OPEN(P + 4) MKFRAME(); l3_combine_phase(F); PH_CLOSE(P + 4)
#endif
        }
#ifndef DIS_COMMON
        const bool last = (layer == NLAYER - 1);
        const float* lng = INP(6) + (size_t)layer * 2 * DM; const float* lnb = INP(7) + (size_t)layer * 2 * DM;
        PH_OPEN(P + 10) MKFRAME();
            const bf16* wB = (const bf16*)(WSP + WS_WO) + (size_t)layer * DM * DM; EpiResid E{PRE, WSP, layer, 2};
            if (last) RUN_GEMM(EpiResid, 0, true, 32, 8, DM, DM, DM, OUTB, wB, E);
            else { RUN_GEMM(EpiResid, 0, false, 32, 8, DM, DM, DM, OUTB, wB, E); EpiPartial EP{(bf16*)(WSP + WS_U)}; RUN_GEMM_SPLIT(4, 512, DM, DM, OUTB, wB, EP); }
            PH_CLOSE(P + 10)
        PH_OPEN(P + 11) MKFRAME();
            if (last) ln1_phase<true, 0, false>(F, PRE, Z, INP(0), INP(2), H, (float*)(WSP + WS_STAT), lng, lnb, layer, nullptr);
            else if (layer == 0) ln1_phase<false, 4, true>(F, PRE, Z, INP(0), INP(2), H, (float*)(WSP + WS_STAT), lng, lnb, layer, (const bf16*)(WSP + WS_U));
            else ln1_phase<false, 4, false>(F, PRE, Z, INP(0), INP(2), H, (float*)(WSP + WS_STAT), lng, lnb, layer, (const bf16*)(WSP + WS_U));
            PH_CLOSE(P + 11)
        PH_OPEN(P + 12) MKFRAME();
            const bf16* wB = (const bf16*)(WSP + WS_WUP) + (size_t)layer * DFF2 * DM; EpiConvAct E{ACT, (bf16*)(WSP + WS_UB), INP(9) + (size_t)layer * 3 * DFF2, INP(10) + (size_t)layer * DFF2};
            if (last) RUN_GEMM_HT(EpiConvAct, true, 32, 44, 1280, 128, DM, DM, DM, H, wB, E); else RUN_GEMM_HT(EpiConvAct, false, 36, 44, 1536, 48, DM, DM, DM, H, wB, E);
            PH_CLOSE(P + 12)
        PH_OPEN(P + 13) MKFRAME(); const float* cw = INP(9) + (size_t)layer * 3 * DFF2; const float* cb = INP(10) + (size_t)layer * DFF2;
            if (last) ffn_fix_phase<true>(F, (const bf16*)(WSP + WS_UB), ACT, cw, cb); else ffn_fix_phase<false>(F, (const bf16*)(WSP + WS_UB), ACT, cw, cb); PH_CLOSE(P + 13)
        PH_OPEN(P + 14) MKFRAME();
            const bf16* wB = (const bf16*)(WSP + WS_WDN) + (size_t)layer * DM * DFF; EpiResid E{PRE + (size_t)NTOK * DM, WSP, layer, 5};
            if (last) RUN_GEMM(EpiResid, 0, true, 32, 8, DFF, DFF, DFF, ACT, wB, E);
            else { RUN_GEMM(EpiResid, 0, false, 32, 8, DFF, DFF, DFF, ACT, wB, E); EpiPartial EP{(bf16*)(WSP + WS_U)}; RUN_GEMM_SPLIT(4, 1408, DFF, DFF, ACT, wB, EP); }
            PH_CLOSE(P + 14)
        PH_OPEN(P + 15) MKFRAME();
            if (last) ln2_phase<true, true, false, 0, false>(F, PRE, PRE + (size_t)NTOK * DM, Z, INP(0), INP(2), nullptr, (float*)ldarg(43), nullptr, (const float*)(WSP + WS_STAT), lng, lnb, lng + DM, lnb + DM, layer, nullptr);
            else if (layer == 0) ln2_phase<false, false, true, 4, true>(F, PRE, PRE + (size_t)NTOK * DM, Z, INP(0), INP(2), Z, nullptr, H, (const float*)(WSP + WS_STAT), lng, lnb, lng + DM, lnb + DM, layer, (const bf16*)(WSP + WS_U));
            else ln2_phase<false, false, true, 4, false>(F, PRE, PRE + (size_t)NTOK * DM, Z, INP(0), INP(2), Z, nullptr, H, (const float*)(WSP + WS_STAT), lng, lnb, lng + DM, lnb + DM, layer, (const bf16*)(WSP + WS_U));
            PH_CLOSE(P + 15)
#endif
    }
#undef IN
#undef SEAM
#undef Z
#undef PRE
#undef H
#undef OUTB
#undef U
#undef ACT
}

static const bool kPhaseUsed[N_PHASE_IDS] = {
    true,
    true, true, true, false, true, true, false, false, false, false, true, true, true, true, true, true,
    true, false, true, true, false, false, false, false, false, false, true, true, true, true, true, true,
    true, true, true, false, false, false, false, false, false, false, true, true, true, true, true, true,
    true, true, true, true, true, false, false, false, false, false, true, true, true, true, true, true };
extern "C" void kernel_launch(void* const* d_in, const int* in_sizes, int n_in, void* d_out, int out_size, void* d_ws, size_t ws_size, hipStream_t stream) {
    static int grid = 0;
    if (grid == 0) {
        if (n_in != 43 || out_size != NLAT * DM || ws_size < WS_END) { fprintf(stderr, "kernel_launch: unexpected shapes: n_in %d out %d ws %zu (need %zu)\n", n_in, out_size, ws_size, (size_t)WS_END); grid = -1; return; }
        int dev = 0, cus = 0, per_cu = 0;
        if (hipGetDevice(&dev) != hipSuccess || hipDeviceGetAttribute(&cus, hipDeviceAttributeMultiprocessorCount, dev) != hipSuccess) { grid = -1; return; }
        if (hipFuncSetAttribute((const void*)mega_fwd, hipFuncAttributeMaxDynamicSharedMemorySize, LDS_BYTES) != hipSuccess) { fprintf(stderr, "kernel_launch: hipFuncSetAttribute failed\n"); grid = -1; return; }
        if (hipOccupancyMaxActiveBlocksPerMultiprocessor(&per_cu, (const void*)mega_fwd, NWAVES * 64, LDS_BYTES) != hipSuccess || per_cu < 1)
            fprintf(stderr, "kernel_launch: occupancy query reports %d workgroups per CU\n", per_cu);
        (void)hipGetLastError();
        grid = cus;
    }
    if (grid < 0) return;
    if (hipMemsetAsync((char*)d_ws + WS_CTL, 0, ZERO_BYTES, stream) != hipSuccess) { fprintf(stderr, "kernel_launch: memset failed\n"); return; }
    Args a{};
    for (int i = 0; i < 43; ++i) a.in[i] = (const float*)d_in[i];
    a.out = (float*)d_out; a.ws = (unsigned char*)d_ws;
#if MK_N_LAUNCHES == 1
    a.ph_lo = 0; a.ph_hi = N_PHASE_IDS;
    hipLaunchKernelGGL(mega_fwd, dim3(grid), dim3(NWAVES * 64), LDS_BYTES, stream, a);
#else
    for (int p = 0; p < N_PHASE_IDS; ++p) { if (!kPhaseUsed[p]) continue; a.ph_lo = p; a.ph_hi = p + 1;
        hipLaunchKernelGGL(mega_fwd, dim3(grid), dim3(NWAVES * 64), LDS_BYTES, stream, a); }
#endif
    const hipError_t le = hipPeekAtLastError();
    if (le != hipSuccess) fprintf(stderr, "kernel_launch: launch failed: %s\n", hipGetErrorName(le));
}
```

```cpp
#include <hip/hip_runtime.h>
#include <cstdio>
#include <cstdint>

namespace pg8 {
#define PG8_LAS __attribute__((address_space(3)))
typedef unsigned short bf16_t;
typedef short bf16x8 __attribute__((ext_vector_type(8)));
typedef float f32x4 __attribute__((ext_vector_type(4)));
typedef float f32x2 __attribute__((ext_vector_type(2)));
typedef unsigned u32x4 __attribute__((ext_vector_type(4)));
typedef unsigned u32x2 __attribute__((ext_vector_type(2)));
constexpr int BM = 256, BK = 64, HALF = 128, HTB = HALF * BK * 2  , STAGE_BYTES = 8 * HTB, NXCD = 8, WGM = 8;

__host__ __device__ __forceinline__ int lds_byte(int r, int c) { const int st = (r >> 4) * 2 + (c >> 5), rr = r & 15, cc = c & 31, ob = rr * 64 + cc * 2; return st * 1024 + (ob ^ (((ob >> 9) & 1) << 5)); }
__host__ __device__ __forceinline__ void stage_rc(int b, int& R, int& C) { const int st = b / 1024, sb = b % 1024, swz = sb ^ (((sb >> 9) & 1) << 5); R = (st >> 1) * 16 + swz / 64; C = (st & 1) * 32 + (swz % 64) / 2; }
__host__ __device__ __forceinline__ int perm32(int rho) { const int n = rho >> 4, i = rho & 15; return 8 * (i >> 2) + 4 * n + (i & 3); }

struct Unit { int pm, pn; unsigned aoff, boff; int half, seq; };
struct Gemm { const bf16_t* A; const bf16_t* Bt; int lda, ldb, K; };

template <int nM, int nN> struct TileOrder {
    static constexpr int nwg = nM * nN;
    int G, c;
    __device__ void init(int G_, int c_) { G = G_; c = c_; }
    __device__ __forceinline__ bool tile(int i, int& pm, int& pn) const { return tileL(i * G + c, pm, pn); }
    static __device__ __forceinline__ bool tileL(int L, int& pm, int& pn) {
        if (L >= nwg) return false;
        int wgid = L; { constexpr int q = nwg / NXCD, r = nwg % NXCD; const int xcd = wgid % NXCD, off = wgid / NXCD; wgid = (xcd < r ? xcd * (q + 1) : r * (q + 1) + (xcd - r) * q) + off; }
        constexpr int nig = WGM * nN; const int gid = wgid / nig, fm = gid * WGM, gsz = (nM - fm) < WGM ? (nM - fm) : WGM;
        pm = fm + ((wgid % nig) % gsz); pn = (wgid % nig) / gsz; return true;
    }
};

typedef __bf16 bf16x2_hw __attribute__((ext_vector_type(2)));
__device__ __forceinline__ unsigned cvt_pk_bf16(float lo, float hi) { const f32x2 v = {lo, hi}; const bf16x2_hw b = __builtin_convertvector(v, bf16x2_hw); return __builtin_bit_cast(unsigned, b); }

template <class Epi, class Sched, int LDA, int LDB, int KK, bool ALIGN_EPI = false, bool SP2 = false, int HM = 0>
__device__ __forceinline__ void gemm_phase(PG8_LAS unsigned char* lds, const bf16_t* gA, const bf16_t* gBt, const Sched& S, const Epi& E) {
    int tid_ = threadIdx.x; asm volatile("" : "+v"(tid_));
    const int tid = tid_, wid = __builtin_amdgcn_readfirstlane(tid >> 6), lane = tid & 63, wr = wid >> 2, wc = wid & 3, fr = lane & 15, fq = lane >> 4;
    constexpr int nt = KK / BK;
    unsigned voffA[2], voffB[2];
#pragma unroll
    for (int i = 0; i < 2; ++i) { int R, C; stage_rc(tid * 16 + i * 8192, R, C); const int Rb = Epi::PERM ? ((R & ~31) + perm32(R & 31)) : R;
        const int Ra = Epi::PERMA ? ((R & ~63) + 4 * (R & 15) + ((R & 63) >> 4)) : R;
        voffA[i] = (unsigned)(Ra * LDA + C) * 2u; voffB[i] = (unsigned)(Rb * LDB + C) * 2u; }
    constexpr size_t kstep = (size_t)(BK * 2);
    constexpr size_t hstepA = (size_t)HALF * LDA * 2, hstepB = (size_t)HALF * LDB * 2;
    const unsigned ldsw = (unsigned)wid * 1024u;
    const int aoff = lds_byte(wr * 64 + fr, fq * 8), boff = lds_byte(wc * 32 + fr, fq * 8);
#define PG8_SA(b, h) (((b) * 2 + (h)) * HTB)
#define PG8_SB(b, h) ((4 + (b) * 2 + (h)) * HTB)
#define PG8_STAGE(bufoff, gbase, voff) do { _Pragma("unroll") for (int _i = 0; _i < 2; ++_i) \
        __builtin_amdgcn_global_load_lds((const unsigned*)((const char*)(gbase) + (voff)[_i]), (PG8_LAS unsigned*)(lds + (bufoff) + ldsw + _i * 8192), 16, 0, 0); } while (0)
#define PG8_LDA(dst, b, h) do { _Pragma("unroll") for (int m = 0; m < 4; ++m) _Pragma("unroll") for (int k = 0; k < 2; ++k) dst[m][k] = *(const PG8_LAS bf16x8*)(lds + PG8_SA(b, h) + aoff + m * 2048 + k * 1024); } while (0)
#define PG8_LDB(dst, b, h) do { _Pragma("unroll") for (int n = 0; n < 2; ++n) _Pragma("unroll") for (int k = 0; k < 2; ++k) dst[n][k] = *(const PG8_LAS bf16x8*)(lds + PG8_SB(b, h) + boff + n * 2048 + k * 1024); } while (0)
#define PG8_MMA(ai, bj, At, Bt) do { __builtin_amdgcn_s_setprio(1); _Pragma("unroll") for (int m = 0; m < 4; ++m) _Pragma("unroll") for (int n = 0; n < 2; ++n) _Pragma("unroll") for (int k = 0; k < 2; ++k) \
        acc[ai][bj][m][n] = __builtin_amdgcn_mfma_f32_16x16x32_bf16(Bt[n][k], At[m][k], acc[ai][bj][m][n], 0, 0, 0); __builtin_amdgcn_s_setprio(0); } while (0)
#define PG8_WAIT_V(n) asm volatile("s_waitcnt vmcnt(" #n ")" ::: "memory")
#define PG8_WAIT_L(n) asm volatile("s_waitcnt lgkmcnt(" #n ")" ::: "memory")
#define PG8_BAR __builtin_amdgcn_s_barrier()
#define PG8_SCHED __builtin_amdgcn_sched_barrier(0)
    Unit cur, nxt; int ui = 0;
    if (!S.next(0, cur)) return;
    f32x4 acc[2][2][4][2];
#pragma unroll
    for (int a = 0; a < 2; ++a)
#pragma unroll
        for (int b = 0; b < 2; ++b)
#pragma unroll
            for (int m = 0; m < 4; ++m)
#pragma unroll
                for (int n = 0; n < 2; ++n) acc[a][b][m][n] = (f32x4){0.f, 0.f, 0.f, 0.f};
    bf16x8 At[4][2], B0[2][2], B1[2][2];
    const char* cA = (const char*)gA + cur.aoff; const char* cB = (const char*)gBt + cur.boff;
    if (HM == 1 || (HM == 2 && cur.half >= 0)) {
        PG8_STAGE(PG8_SB(0, 0), cB, voffB); PG8_STAGE(PG8_SB(0, 1), cB + hstepB, voffB); PG8_STAGE(PG8_SA(0, 0), cA, voffA);
        if (wr == 1) PG8_BAR;
        PG8_WAIT_V(0); PG8_BAR;
        PG8_STAGE(PG8_SB(1, 0), cB + kstep, voffB); PG8_STAGE(PG8_SA(1, 0), cA + kstep, voffA); PG8_STAGE(PG8_SB(1, 1), cB + hstepB + kstep, voffB);
        PG8_WAIT_V(6); PG8_BAR;
    } else if constexpr (SP2) {
        PG8_STAGE(PG8_SB(0, 0), cB, voffB); PG8_STAGE(PG8_SB(0, 1), cB + hstepB, voffB); PG8_STAGE(PG8_SA(0, 0), cA, voffA); PG8_STAGE(PG8_SA(0, 1), cA + hstepA, voffA);
        if (wr == 1) PG8_BAR;
        PG8_WAIT_V(2); PG8_BAR;
        PG8_STAGE(PG8_SB(1, 0), cB + kstep, voffB); PG8_STAGE(PG8_SA(1, 0), cA + kstep, voffA); PG8_STAGE(PG8_SB(1, 1), cB + hstepB + kstep, voffB);
        PG8_WAIT_V(6); PG8_BAR;
    } else {
        PG8_STAGE(PG8_SB(0, 0), cB, voffB); PG8_STAGE(PG8_SA(0, 0), cA, voffA); PG8_STAGE(PG8_SB(0, 1), cB + hstepB, voffB); PG8_STAGE(PG8_SA(0, 1), cA + hstepA, voffA);
        if (wr == 1) PG8_BAR;
        PG8_WAIT_V(4); PG8_BAR;
        PG8_STAGE(PG8_SB(1, 0), cB + kstep, voffB); PG8_STAGE(PG8_SA(1, 0), cA + kstep, voffA); PG8_STAGE(PG8_SB(1, 1), cB + hstepB + kstep, voffB);
        PG8_WAIT_V(6); PG8_BAR;
    }
    for (;;) {
        const bool has_next = S.next(ui + 1, nxt);
        const char* nA = has_next ? (const char*)gA + nxt.aoff : cA; const char* nB = has_next ? (const char*)gBt + nxt.boff : cB;
        cur.seq = ui & 1;
        if constexpr (Epi::PREFETCH) E.prefetch(cur, lds + STAGE_BYTES + 4096 + (ui & 1) * 4096, tid, wid);
#define PG8_KT_ADDR const bool last = (t == nt - 2); const char* a1 = cA + (size_t)(t + 1) * kstep; \
            const char* a2 = last ? nA : cA + (size_t)(t + 2) * kstep; const char* b2 = last ? nB : cB + (size_t)(t + 2) * kstep; const char* a3 = a2 + kstep; const char* b3 = b2 + kstep;
        if (HM == 1 || (HM == 2 && cur.half >= 0)) {
#pragma unroll 1
          for (int t = 0; t < nt; t += 2) { PG8_KT_ADDR
            PG8_LDB(B0, 0, 0); PG8_LDB(B1, 0, 1); PG8_SCHED; PG8_LDA(At, 0, 0);
            PG8_WAIT_V(6); PG8_WAIT_L(0); PG8_BAR; PG8_MMA(0, 0, At, B0); PG8_MMA(0, 1, At, B1); PG8_BAR; PG8_SCHED;
            PG8_STAGE(PG8_SB(0, 0), b2, voffB); PG8_STAGE(PG8_SB(0, 1), b2 + hstepB, voffB); PG8_STAGE(PG8_SA(0, 0), a2, voffA);
            PG8_WAIT_V(6); PG8_BAR; PG8_BAR; PG8_SCHED;
            PG8_LDB(B0, 1, 0); PG8_LDB(B1, 1, 1); PG8_SCHED; PG8_LDA(At, 1, 0);
            PG8_WAIT_V(6); PG8_WAIT_L(0); PG8_BAR; PG8_MMA(0, 0, At, B0); PG8_MMA(0, 1, At, B1); PG8_BAR; PG8_SCHED;
            PG8_STAGE(PG8_SB(1, 0), b3, voffB); PG8_STAGE(PG8_SB(1, 1), b3 + hstepB, voffB); PG8_STAGE(PG8_SA(1, 0), a3, voffA);
            PG8_WAIT_V(6); PG8_BAR; PG8_BAR; PG8_SCHED;
            (void)a1;
          }
        } else {
#pragma unroll 1
          for (int t = 0; t < nt; t += 2) { PG8_KT_ADDR
            if constexpr (SP2) {
            PG8_LDB(B0, 0, 0); PG8_LDB(B1, 0, 1); PG8_SCHED; PG8_LDA(At, 0, 0); PG8_STAGE(PG8_SA(1, 1), a1 + hstepA, voffA);
            PG8_WAIT_V(8); PG8_WAIT_L(0); PG8_BAR; PG8_MMA(0, 0, At, B0); PG8_MMA(0, 1, At, B1); PG8_BAR; PG8_SCHED;
            PG8_LDA(At, 0, 1); PG8_STAGE(PG8_SB(0, 0), b2, voffB); PG8_STAGE(PG8_SB(0, 1), b2 + hstepB, voffB); PG8_STAGE(PG8_SA(0, 0), a2, voffA);
            PG8_WAIT_V(8); PG8_WAIT_L(0); PG8_BAR; PG8_MMA(1, 0, At, B0); PG8_MMA(1, 1, At, B1); PG8_BAR; PG8_SCHED;
            PG8_LDB(B0, 1, 0); PG8_LDB(B1, 1, 1); PG8_SCHED; PG8_LDA(At, 1, 0); PG8_STAGE(PG8_SA(0, 1), a2 + hstepA, voffA);
            PG8_WAIT_V(8); PG8_WAIT_L(0); PG8_BAR; PG8_MMA(0, 0, At, B0); PG8_MMA(0, 1, At, B1); PG8_BAR; PG8_SCHED;
            PG8_LDA(At, 1, 1); PG8_STAGE(PG8_SB(1, 0), b3, voffB); PG8_STAGE(PG8_SB(1, 1), b3 + hstepB, voffB); PG8_STAGE(PG8_SA(1, 0), a3, voffA);
            PG8_WAIT_V(8); PG8_WAIT_L(0); PG8_BAR; PG8_MMA(1, 0, At, B0); PG8_MMA(1, 1, At, B1); PG8_BAR; PG8_SCHED;
            } else {
            PG8_LDB(B0, 0, 0); PG8_SCHED; PG8_LDA(At, 0, 0); PG8_STAGE(PG8_SA(1, 1), a1 + hstepA, voffA);
            PG8_WAIT_L(8); PG8_BAR; PG8_WAIT_L(0); PG8_MMA(0, 0, At, B0); PG8_BAR; PG8_SCHED;
            PG8_LDB(B1, 0, 1); PG8_STAGE(PG8_SB(0, 0), b2, voffB);
            PG8_BAR; PG8_WAIT_L(0); PG8_MMA(0, 1, At, B1); PG8_BAR;
            PG8_LDA(At, 0, 1); PG8_STAGE(PG8_SA(0, 0), a2, voffA);
            PG8_BAR; PG8_WAIT_L(0); PG8_MMA(1, 0, At, B0); PG8_BAR; PG8_SCHED;
            PG8_STAGE(PG8_SB(0, 1), b2 + hstepB, voffB);
            PG8_WAIT_V(6); PG8_BAR; PG8_MMA(1, 1, At, B1); PG8_BAR;
            PG8_LDB(B0, 1, 0); PG8_SCHED; PG8_LDA(At, 1, 0); PG8_STAGE(PG8_SA(0, 1), a2 + hstepA, voffA);
            PG8_WAIT_L(8); PG8_BAR; PG8_WAIT_L(0); PG8_MMA(0, 0, At, B0); PG8_BAR; PG8_SCHED;
            PG8_LDB(B1, 1, 1); PG8_STAGE(PG8_SB(1, 0), b3, voffB);
            PG8_BAR; PG8_WAIT_L(0); PG8_MMA(0, 1, At, B1); PG8_BAR;
            PG8_LDA(At, 1, 1); PG8_STAGE(PG8_SA(1, 0), a3, voffA);
            PG8_BAR; PG8_WAIT_L(0); PG8_MMA(1, 0, At, B0); PG8_BAR; PG8_SCHED;
            PG8_STAGE(PG8_SB(1, 1), b3 + hstepB, voffB);
            PG8_WAIT_V(6); PG8_BAR; PG8_MMA(1, 1, At, B1); PG8_BAR;
            }
          }
        }
#undef PG8_KT_ADDR
        if constexpr (ALIGN_EPI) { if (wr == 0) PG8_BAR; }
        E(acc, cur, wr, wc, fr, fq);
        if (!has_next) break;
#pragma unroll
        for (int a = 0; a < 2; ++a)
#pragma unroll
            for (int b = 0; b < 2; ++b)
#pragma unroll
                for (int m = 0; m < 4; ++m)
#pragma unroll
                    for (int n = 0; n < 2; ++n) acc[a][b][m][n] = (f32x4){0.f, 0.f, 0.f, 0.f};
        cur = nxt; cA = nA; cB = nB; ++ui;
        if constexpr (ALIGN_EPI) { if (wr == 1) PG8_BAR; }
    }
    PG8_WAIT_V(0);
    if constexpr (!ALIGN_EPI) { if (wr == 0) PG8_BAR; }
    PG8_BAR;
#undef PG8_SA
#undef PG8_SB
#undef PG8_STAGE
#undef PG8_LDA
#undef PG8_LDB
#undef PG8_MMA
#undef PG8_WAIT_V
#undef PG8_WAIT_L
#undef PG8_BAR
#undef PG8_SCHED
}
}
#include <hip/hip_bf16.h>
#include <cmath>
namespace att {
using bf16 = __hip_bfloat16;
constexpr int   D = 128, NW = 8, QBLK = 32, KVBLK = 64;
constexpr float SCALE = 0.088388347648318440f;
constexpr float THR = 8.f;
constexpr int SDEPTH = 2;
constexpr int LDQ = 6144, LDK = 6144, LDO = 4096;
constexpr size_t SHM_V = KVBLK * D * 2, SHM_K = KVBLK * D * 2, SHM_ATTN = 2 * SHM_V + 2 * SHM_K + NW * 64 * 4;
using bf16x8 = __attribute__((ext_vector_type(8))) short;
using s16x4  = __attribute__((ext_vector_type(4))) short;
using f32x16 = __attribute__((ext_vector_type(16))) float;
using f32x8  = __attribute__((ext_vector_type(8))) float;
using u32x4  = __attribute__((ext_vector_type(4))) unsigned;
#define KSWZ(row, colB) ((row) * 256 + ((colB) ^ (((row) & 7) << 4)))
#define SBAR() __builtin_amdgcn_sched_barrier(0)
__device__ __forceinline__ int crow(int r, int hi) { return (r & 3) + 8 * (r >> 2) + 4 * hi; }
__device__ __forceinline__ unsigned cvtpk(float lo, float hi) {
  unsigned r; asm volatile("v_cvt_pk_bf16_f32 %0, %1, %2" : "=v"(r) : "v"(lo), "v"(hi)); return r;
}
template <typename TIn> struct Stage;
template <> struct Stage<bf16>  { using T = bf16x8;
  __device__ static __forceinline__ T ld8(const bf16* p) { return *reinterpret_cast<const bf16x8*>(p); }
  __device__ static __forceinline__ bf16x8 tobf(T x) { return x; } };
template <> struct Stage<float> { using T = f32x8;
  __device__ static __forceinline__ T ld8(const float* p) { return *reinterpret_cast<const f32x8*>(p); }
  __device__ static __forceinline__ bf16x8 tobf(T x) {
    u32x4 w = {cvtpk(x[0], x[1]), cvtpk(x[2], x[3]), cvtpk(x[4], x[5]), cvtpk(x[6], x[7])}; return *reinterpret_cast<bf16x8*>(&w); } };

__device__ __forceinline__ void partialSM(f32x16& p0, f32x16& p1, float& m_reg, float& mn, float& alpha) {
  constexpr float C = SCALE * 1.4426950408889634f;
  float pmax = p0[0]; for (int r = 1; r < 16; ++r) pmax = fmaxf(pmax, p0[r]); for (int r = 0; r < 16; ++r) pmax = fmaxf(pmax, p1[r]);
  { auto rr = __builtin_amdgcn_permlane32_swap(__float_as_uint(pmax), __float_as_uint(pmax), false, false);
    pmax = fmaxf(__uint_as_float(rr[0]), __uint_as_float(rr[1])); }
  if (__builtin_expect(__all(pmax - m_reg <= THR / SCALE), 1)) { mn = m_reg; alpha = 1.f; }
  else { mn = fmaxf(m_reg, pmax); alpha = __builtin_amdgcn_exp2f((m_reg - mn) * C); m_reg = mn; }
  float mnC = -mn * C;
  for (int r = 0; r < 16; ++r) p0[r] = fmaf(p0[r], C, mnC); for (int r = 0; r < 16; ++r) p1[r] = fmaf(p1[r], C, mnC);
  for (int r = 0; r < 16; ++r) p0[r] = __builtin_amdgcn_exp2f(p0[r]);
}
__device__ __forceinline__ void finishSM(f32x16& p0, f32x16& p1, float alpha, float& l_reg, bf16x8& pa0, bf16x8& pa1, bf16x8& pa2, bf16x8& pa3) {
  for (int r = 0; r < 16; ++r) p1[r] = __builtin_amdgcn_exp2f(p1[r]);
  float ps = 0; for (int r = 0; r < 16; ++r) ps += p0[r]; for (int r = 0; r < 16; ++r) ps += p1[r];
  { auto rr = __builtin_amdgcn_permlane32_swap(__float_as_uint(ps), __float_as_uint(ps), false, false);
    ps = __uint_as_float(rr[0]) + __uint_as_float(rr[1]); }
  l_reg = l_reg * alpha + ps;
#define PK4(P, BASE, OUT) do { unsigned a0 = cvtpk(P[BASE + 0], P[BASE + 1]), a1 = cvtpk(P[BASE + 2], P[BASE + 3]);   \
    unsigned b0 = cvtpk(P[BASE + 4], P[BASE + 5]), b1 = cvtpk(P[BASE + 6], P[BASE + 7]);                              \
    auto r0 = __builtin_amdgcn_permlane32_swap(a0, b0, false, false); auto r1 = __builtin_amdgcn_permlane32_swap(a1, b1, false, false); \
    u32x4 w = {r0[0], r1[0], r0[1], r1[1]}; OUT = *reinterpret_cast<bf16x8*>(&w); } while (0)
  PK4(p0, 0, pa0); PK4(p0, 8, pa1); PK4(p1, 0, pa2); PK4(p1, 8, pa3);
#undef PK4
}
__device__ __forceinline__ void qkt(f32x16& p0, f32x16& p1, const bf16* Ks, const bf16x8* qr, int r32, int hi) {
  p0 = f32x16{}; p1 = f32x16{};
  for (int d0 = 0; d0 < 8; ++d0) { int cb = (d0 * 16 + hi * 8) * 2;
    bf16x8 b0 = *reinterpret_cast<const bf16x8*>((const char*)Ks + KSWZ(r32, cb));
    bf16x8 b1 = *reinterpret_cast<const bf16x8*>((const char*)Ks + KSWZ(32 + r32, cb));
    p0 = __builtin_amdgcn_mfma_f32_32x32x16_bf16(b0, qr[d0], p0, 0, 0, 0);
    p1 = __builtin_amdgcn_mfma_f32_32x32x16_bf16(b1, qr[d0], p1, 0, 0, 0); }
}
__device__ __forceinline__ int v_st(int k, int c) { const int kk = (k & ~0xC) | ((k & 4) << 1) | ((k & 8) >> 1); return ((kk >> 3) * 4 + (c >> 5)) * 512 + ((kk & 7) * 32 + (c & 31)) * 2; }
__device__ __forceinline__ int v_rd_base(int lane) { return ((lane & 3) << 3) | (((lane >> 2) & 3) << 6) | (((lane >> 4) & 1) << 5) | (((lane >> 5) & 1) << 8); }
constexpr int v_rd_off(int d0, int ks, int half) { return d0 * 512 + ks * 4096 + half * 2048; }
template <int OFF> __device__ __forceinline__ s16x4 tr_read(int vb) {
  s16x4 r; asm volatile("ds_read_b64_tr_b16 %0, %1 offset:%2" : "=&v"(r) : "v"(vb), "i"(OFF) : "memory"); return r;
}
template <int D0> __device__ __forceinline__ void pv_one(f32x16& od, int vb, bf16x8 pa0, bf16x8 pa1, bf16x8 pa2, bf16x8 pa3) {
  const s16x4 l0 = tr_read<v_rd_off(D0, 0, 0)>(vb), h0 = tr_read<v_rd_off(D0, 0, 1)>(vb), l1 = tr_read<v_rd_off(D0, 1, 0)>(vb), h1 = tr_read<v_rd_off(D0, 1, 1)>(vb);
  const s16x4 l2 = tr_read<v_rd_off(D0, 2, 0)>(vb), h2 = tr_read<v_rd_off(D0, 2, 1)>(vb), l3 = tr_read<v_rd_off(D0, 3, 0)>(vb), h3 = tr_read<v_rd_off(D0, 3, 1)>(vb);
  asm volatile("s_waitcnt lgkmcnt(0)" ::: "memory"); SBAR();
#define PK(L, H) (bf16x8){L[0], L[1], L[2], L[3], H[0], H[1], H[2], H[3]}
  od = __builtin_amdgcn_mfma_f32_32x32x16_bf16(pa0, PK(l0, h0), od, 0, 0, 0);
  od = __builtin_amdgcn_mfma_f32_32x32x16_bf16(pa1, PK(l1, h1), od, 0, 0, 0);
  od = __builtin_amdgcn_mfma_f32_32x32x16_bf16(pa2, PK(l2, h2), od, 0, 0, 0);
  od = __builtin_amdgcn_mfma_f32_32x32x16_bf16(pa3, PK(l3, h3), od, 0, 0, 0);
#undef PK
}
__device__ __forceinline__ void pv_d0(f32x16* o, int vb, bf16x8 pa0, bf16x8 pa1, bf16x8 pa2, bf16x8 pa3) {
  pv_one<0>(o[0], vb, pa0, pa1, pa2, pa3); pv_one<1>(o[1], vb, pa0, pa1, pa2, pa3); pv_one<2>(o[2], vb, pa0, pa1, pa2, pa3); pv_one<3>(o[3], vb, pa0, pa1, pa2, pa3);
}

template <typename TQ>
__device__ __forceinline__ void attn_dense_body(const TQ* __restrict__ Qb, const bf16* __restrict__ Kh, const bf16* __restrict__ Vh,
                                                unsigned short* __restrict__ Ob, int seq, char* lds) {
  using St = Stage<bf16>; using SQ = Stage<TQ>;
  int tid_ = threadIdx.x; asm volatile("" : "+v"(tid_)); const int tid = tid_, wid = tid >> 6, lane = tid & 63, r32 = lane & 31, hi = lane >> 5;
  bf16* V_lds = (bf16*)lds; bf16* K_lds = (bf16*)(lds + 2 * SHM_V);
  float* ws = (float*)(lds + 2 * SHM_V + 2 * SHM_K) + wid * 64; float* li_l = ws; float* al_l = ws + 32;
  float m_reg = -1e30f, l_reg = 0; f32x16 o[4] = {}; bf16x8 qr[8];
  const TQ* Qw = Qb + (long)(wid * QBLK + r32) * LDQ + hi * 8;
#pragma unroll
  for (int d0 = 0; d0 < 8; ++d0) qr[d0] = SQ::tobf(SQ::ld8(Qw + d0 * 16));
  const int sr = tid >> 4, sc = (tid & 15) * 8, vst0 = v_st(sr, sc), vst1 = v_st(32 + sr, sc);
  const int vb0 = (int)(uintptr_t)V_lds + v_rd_base(lane);
  struct { typename St::T vs0, vs1, ks0, ks1; } sr_[SDEPTH];
#define SLOAD(i, k0) do { sr_[i].vs0 = St::ld8(&Vh[(long)((k0) + sr) * LDK + sc]); sr_[i].vs1 = St::ld8(&Vh[(long)((k0) + 32 + sr) * LDK + sc]); \
    sr_[i].ks0 = St::ld8(&Kh[(long)((k0) + sr) * LDK + sc]); sr_[i].ks1 = St::ld8(&Kh[(long)((k0) + 32 + sr) * LDK + sc]); } while (0)
#define SWRITE(b, i) do { *(bf16x8*)((char*)V_lds + (b) * SHM_V + vst0) = St::tobf(sr_[i].vs0);          \
    *(bf16x8*)((char*)V_lds + (b) * SHM_V + vst1) = St::tobf(sr_[i].vs1); int kc = sc * 2;               \
    *(bf16x8*)((char*)K_lds + (b) * SHM_K + KSWZ(sr, kc)) = St::tobf(sr_[i].ks0);                       \
    *(bf16x8*)((char*)K_lds + (b) * SHM_K + KSWZ(32 + sr, kc)) = St::tobf(sr_[i].ks1); } while (0)
#define SWAIT() do { if constexpr (SDEPTH == 2) asm volatile("s_waitcnt vmcnt(4)" ::: "memory"); else asm volatile("s_waitcnt vmcnt(0)" ::: "memory"); } while (0)
#define RESC(a) do { if (__any((a) < 1.f)) { if (hi == 0) al_l[r32] = (a); asm volatile("s_waitcnt lgkmcnt(0)" ::: "memory"); \
    for (int d = 0; d < 4; ++d) for (int r = 0; r < 16; ++r) o[d][r] *= al_l[crow(r, hi)]; } } while (0)
  f32x16 pA0, pA1, pB0, pB1; float mnA, mnB, alA, alB; bf16x8 pa0, pa1, pa2, pa3; const int NT = seq / KVBLK;
  constexpr int SE = 0, SO = SDEPTH - 1;
  SLOAD(SE, 0); asm volatile("s_waitcnt vmcnt(0)" ::: "memory"); SWRITE(0, SE); __syncthreads();
  qkt(pA0, pA1, K_lds, qr, r32, hi); partialSM(pA0, pA1, m_reg, mnA, alA);
  SLOAD(SO, KVBLK); if constexpr (SDEPTH == 2) { if (2 < NT) SLOAD(SE, 2 * KVBLK); }
  SWAIT(); SWRITE(1, SO); __syncthreads();
  for (int j = 1; j + 1 < NT; j += 2) {
    SBAR(); qkt(pB0, pB1, (bf16*)((char*)K_lds + SHM_K), qr, r32, hi);
    finishSM(pA0, pA1, alA, l_reg, pa0, pa1, pa2, pa3); SBAR();
    SLOAD(SO, (j + SDEPTH) * KVBLK); SBAR();
    pv_d0(o, vb0, pa0, pa1, pa2, pa3); partialSM(pB0, pB1, m_reg, mnB, alB);
    __syncthreads(); SWAIT(); SWRITE(0, SE);
    RESC(alB); __syncthreads();
    SBAR(); qkt(pA0, pA1, K_lds, qr, r32, hi);
    finishSM(pB0, pB1, alB, l_reg, pa0, pa1, pa2, pa3); SBAR();
    if (SDEPTH == 1 || j + 3 < NT) SLOAD(SE, (j + 1 + SDEPTH) * KVBLK); SBAR();
    pv_d0(o, vb0 + (int)SHM_V, pa0, pa1, pa2, pa3); partialSM(pA0, pA1, m_reg, mnA, alA);
    __syncthreads(); SWAIT(); SWRITE(1, SO);
    RESC(alA); __syncthreads();
  }
  SBAR(); qkt(pB0, pB1, (bf16*)((char*)K_lds + SHM_K), qr, r32, hi);
  finishSM(pA0, pA1, alA, l_reg, pa0, pa1, pa2, pa3); SBAR();
  pv_d0(o, vb0, pa0, pa1, pa2, pa3); partialSM(pB0, pB1, m_reg, mnB, alB);
  __syncthreads(); RESC(alB);
  finishSM(pB0, pB1, alB, l_reg, pa0, pa1, pa2, pa3); SBAR();
  pv_d0(o, vb0 + (int)SHM_V, pa0, pa1, pa2, pa3);
  if (hi == 0) li_l[r32] = l_reg; asm volatile("s_waitcnt lgkmcnt(0)" ::: "memory");
  float rli[16];
#pragma unroll
  for (int r = 0; r < 16; ++r) rli[r] = __builtin_amdgcn_rcpf(li_l[crow(r, hi)]);
  unsigned short* Ow = Ob + (long)(wid * QBLK) * LDO;
#pragma unroll
  for (int r = 0; r < 16; ++r) { int orow = crow(r, hi);
    for (int d0 = 0; d0 < 4; ++d0) Ow[(long)orow * LDO + d0 * 32 + r32] = (unsigned short)(pg8::cvt_pk_bf16(o[d0][r] * rli[r], 0.f) & 0xffffu); }
#undef SLOAD
#undef SWRITE
#undef SWAIT
#undef RESC
}
}
constexpr int DM = 2048, NB = 4, SEQ = 2048, NCTX = 256, LTOK = 2304, NTOK = NB * LTOK  , NLAT = NB * SEQ  ;
constexpr int DFF = 5632, DFF2 = 2 * DFF;
constexpr int NLAYER = 4, NMOD = 6;
constexpr float DN_ALPHA = 1.6817928305074290f;
constexpr float LN_EPS = 1e-5f;
constexpr int NWAVES = 8;
#ifndef MK_N_LAUNCHES
#define MK_N_LAUNCHES 1
#endif

constexpr size_t MiB = 1u << 20;
constexpr size_t al256(size_t x) { return (x + 255) / 256 * 256; }
constexpr size_t WS_CTL = 0;
constexpr size_t WS_MOD = 1 * MiB;
constexpr size_t ZERO_BYTES = 2 * MiB;
constexpr size_t WS_ROPE = 2 * MiB;
constexpr size_t WS_LB = WS_ROPE + al256((size_t)LTOK * 64 * 2 * 4);
constexpr size_t WS_STAT = WS_LB + 64 * 1024;
constexpr size_t WS_ZS = WS_STAT + 80 * 1024;
constexpr size_t WS_W0 = 4 * MiB;
static_assert(WS_ZS + (size_t)NTOK * 4 <= WS_W0, "small tables fit below the weight copies");
constexpr size_t WS_WA = WS_W0;
constexpr size_t WS_WL2 = WS_WA + (size_t)6912 * 2048 * 2;
constexpr size_t WS_WO = WS_WL2 + (size_t)10240 * 256 * 2;
constexpr size_t WS_WQKV = WS_WO + (size_t)4 * 2048 * 2048 * 2;
constexpr size_t WS_WHG = WS_WQKV + (size_t)6144 * 2048 * 2;
constexpr size_t WS_WLR = WS_WHG + (size_t)10240 * 2048 * 2;
constexpr size_t WS_WGATE = WS_WLR + (size_t)4096 * 2048 * 2;
constexpr size_t WS_WUP = WS_WGATE + (size_t)32 * 256 * 256 * 2;
constexpr size_t WS_WDN = WS_WUP + (size_t)4 * DFF2 * 2048 * 2;
constexpr size_t WS_WEND = WS_WDN + (size_t)4 * 2048 * DFF * 2;
constexpr size_t WS_Z = al256(WS_WEND);
constexpr size_t WS_PRE = WS_Z + (size_t)NTOK * DM * 4;
constexpr size_t WS_H = WS_PRE + (size_t)NTOK * DM * 4;
constexpr size_t WS_OUTB = WS_H + (size_t)NTOK * DM * 2;
constexpr size_t WS_POOL = WS_OUTB + (size_t)NTOK * DM * 2;
constexpr size_t SLOT = (size_t)NTOK * DM * 2;
constexpr size_t WS_U = WS_POOL;
constexpr size_t WS_ACT = WS_U + (size_t)NTOK * DFF2 * 2;
constexpr size_t WS_UB = WS_U + (size_t)32 * MiB;
constexpr size_t WS_RKV = WS_POOL;
constexpr size_t L0_R = WS_RKV, L0_K = WS_RKV + SLOT, L0_DEC0 = WS_RKV + 2 * SLOT, L0_DEC1 = WS_RKV + 3 * SLOT, L0_IC0 = WS_RKV + 4 * SLOT, L0_IC1 = WS_RKV + 5 * SLOT, L0_V = WS_RKV + 6 * SLOT, L0_G = WS_RKV + 7 * SLOT;
constexpr size_t L0_YS = WS_RKV;
constexpr size_t L0_HID = WS_RKV + 8 * SLOT;
constexpr size_t L0_BONUS = L0_HID + (size_t)3 * NTOK * 256 * 2;
constexpr size_t L0_SCAL = L0_BONUS + (size_t)NTOK * 32 * 4;
constexpr size_t L0_XS = al256(L0_SCAL + (size_t)256 * LTOK * 2 * 4);
constexpr size_t L0_VEC = L0_XS;
constexpr size_t L0_END = L0_VEC + (size_t)256 * LTOK * 6 * 64 * 2;
constexpr size_t L1_QKV = WS_POOL;
constexpr size_t L1_O = L1_QKV + (size_t)NTOK * 6144 * 2;
constexpr size_t L2_HGO = WS_POOL;
constexpr size_t L2_OG = L2_HGO + (size_t)NTOK * 10240 * 2;
constexpr size_t L3_IN = WS_POOL;
constexpr size_t L3_XB = L3_IN + 2 * SLOT;
constexpr size_t L3_LOGA = L3_XB + SLOT;
constexpr size_t L3_UU = L3_LOGA + 2 * SLOT;
constexpr size_t L3_YS = L3_UU + 2 * SLOT;
constexpr size_t WS_END = L0_END;
static_assert(WS_ACT + (size_t)NTOK * DFF * 2 <= WS_END && L3_YS + 4 * SLOT <= WS_END && L2_OG + 4 * SLOT <= WS_END && L1_O + (size_t)NTOK * 4096 * 4 <= WS_END, "pool");
static_assert(WS_END <= (size_t)1536 * MiB, "d_ws map must fit 4 x the largest input");

constexpr int CW_BAR = 4096;
constexpr int RING_OFF = 0, RING_BYTES = 131072;
constexpr int LDSCTL_OFF = RING_BYTES, MISC_OFF = LDSCTL_OFF + 320;
constexpr int LDS_BYTES = 147456;

#define GAS __attribute__((address_space(1)))
#define LAS __attribute__((address_space(3)))
typedef unsigned short bf16;
typedef unsigned v4u __attribute__((ext_vector_type(4)));
typedef unsigned v2u __attribute__((ext_vector_type(2)));
typedef float f32x4 __attribute__((ext_vector_type(4)));
typedef float f32x2 __attribute__((ext_vector_type(2)));
typedef short bf16x8 __attribute__((ext_vector_type(8)));
typedef GAS unsigned gu32;
#define RLX_AGENT __ATOMIC_RELAXED, __HIP_MEMORY_SCOPE_AGENT
#define LDS_WAIT() asm volatile("s_waitcnt lgkmcnt(0)" ::: "memory")
#define VM_WAIT() asm volatile("s_waitcnt vmcnt(0)" ::: "memory")
#define LDS_BARRIER() do { asm volatile("s_waitcnt lgkmcnt(0)" ::: "memory"); __builtin_amdgcn_s_barrier(); asm volatile("" ::: "memory"); } while (0)
__device__ __forceinline__ unsigned pk2(float lo, float hi) { return pg8::cvt_pk_bf16(lo, hi); }
__device__ __forceinline__ float bflo(unsigned w) { return __uint_as_float(w << 16); }
__device__ __forceinline__ float bfhi(unsigned w) { return __uint_as_float(w & 0xffff0000u); }
__device__ __forceinline__ float bf2f(bf16 x) { return __uint_as_float(((unsigned)x) << 16); }
__device__ __forceinline__ bf16 f2bf(float f) { return (bf16)(pk2(f, 0.f) & 0xffffu); }
__device__ __forceinline__ int vzero() { int z; asm volatile("v_mov_b32 %0, 0" : "=v"(z)); return z; }
__device__ __forceinline__ float sigmoidf_(float x) { return __builtin_amdgcn_rcpf(1.f + __expf(-x)); }
__device__ __forceinline__ float siluf_(float x) { return x * sigmoidf_(x); }
__device__ __forceinline__ float tanhf_(float x) { const float e = __expf(2.f * x); return 1.f - 2.f * __builtin_amdgcn_rcpf(e + 1.f); }
__device__ __forceinline__ float gelu_tanh_(float x) { const float u = 0.7978845608028654f * (x + 0.044715f * x * x * x); return 0.5f * x * (1.f + tanhf_(u)); }

#define XB_TMO      128
#define XB_XCNT(j)  (256  + 64 * (j))
#define XB_XSUB(j)  (1280 + 64 * (j))
#define XB_XGEN(j)  (2304 + 64 * (j))
#define XB_TOP      3328
#define XB_TOPGEN   3392
#define XCD_BAR_WORDS 3456
#define XB_SPIN_CAP (1u << 18)
__device__ __forceinline__ unsigned xb_ld(unsigned* p)              { return __hip_atomic_load(p, __ATOMIC_RELAXED, __HIP_MEMORY_SCOPE_AGENT); }
__device__ __forceinline__ unsigned xb_add(unsigned* p, unsigned v) { return __hip_atomic_fetch_add(p, v, __ATOMIC_RELAXED, __HIP_MEMORY_SCOPE_AGENT); }
__device__ __forceinline__ unsigned xb_xcc_id() { return (unsigned)__builtin_amdgcn_s_getreg((3 << 11) | 20) & 0xFu; }
#define XB_SPIN(cond, bar) do { unsigned _sp = 0; while (cond) { __builtin_amdgcn_s_sleep(1); \
    if ((++_sp & 255u) == 0u) { if (xb_ld(&(bar)[XB_TMO])) break; if (_sp > XB_SPIN_CAP) { atomicAdd(&(bar)[XB_TMO], 1u); break; } } } } while (0)
struct XcdBarrier { unsigned* bar; unsigned x; volatile LAS unsigned* st; };
__device__ __forceinline__ XcdBarrier xcd_barrier_post(unsigned* bar, volatile LAS unsigned* st) {
    XcdBarrier b; b.bar = bar; b.x = xb_xcc_id(); b.st = st;
    if (threadIdx.x == 0) (void)xb_add(&bar[XB_XCNT(b.x)], 1u);
    return b;
}
__device__ __forceinline__ void xcd_barrier_complete(unsigned* bar, unsigned x, unsigned& nloc, unsigned& nx) {
    const unsigned G = gridDim.x * gridDim.y * gridDim.z;
    unsigned sum, cnt, mine, sp = 0u;
    for (;;) {
        sum = 0u; cnt = 0u; mine = 0u;
#pragma unroll
        for (unsigned j = 0; j < 16; ++j) { const unsigned c = xb_ld(&bar[XB_XCNT(j)]); sum += c; cnt += (c > 0u) ? 1u : 0u; mine = (j == x) ? c : mine; }
        if (sum == G) break;
        __builtin_amdgcn_s_sleep(1);
        if ((++sp & 255u) == 0u) { if (xb_ld(&bar[XB_TMO])) break; if (sp > XB_SPIN_CAP) { atomicAdd(&bar[XB_TMO], 1u); break; } }
    }
    nloc = mine > 0u ? mine : 1u; nx = cnt > 0u ? cnt : 1u;
}
__device__ __forceinline__ void xcd_barrier(const XcdBarrier& b) {
    asm volatile("s_waitcnt vmcnt(0)" ::: "memory");
    __syncthreads();
    if (threadIdx.x == 0) {
        unsigned* bar = b.bar;
        __builtin_amdgcn_s_waitcnt(0);
        unsigned nloc = b.st[0], nx = b.st[1];
        if (nloc == 0u) { xcd_barrier_complete(bar, b.x, nloc, nx); b.st[0] = nloc; b.st[1] = nx; }
        const unsigned old = xb_add(&bar[XB_XSUB(b.x)], 1u);
        const unsigned gen = old / nloc;
        if (old + 1u == (gen + 1u) * nloc) {
            __builtin_amdgcn_fence(__ATOMIC_RELEASE, "agent");
            asm volatile("s_waitcnt vmcnt(0)" ::: "memory");
            const unsigned og = xb_add(&bar[XB_TOP], 1u);
            const unsigned tg = og / nx;
            if (og + 1u == (tg + 1u) * nx) xb_add(&bar[XB_TOPGEN], 1u);
            else XB_SPIN(xb_ld(&bar[XB_TOPGEN]) == tg, bar);
            __builtin_amdgcn_fence(__ATOMIC_ACQUIRE, "agent");
            xb_add(&bar[XB_XGEN(b.x)], 1u);
            asm volatile("s_waitcnt vmcnt(0)" ::: "memory");
        } else {
            XB_SPIN(xb_ld(&bar[XB_XGEN(b.x)]) == gen, bar);
            __builtin_amdgcn_fence(__ATOMIC_ACQUIRE, "agent");
            asm volatile("s_waitcnt vmcnt(0)" ::: "memory");
        }
    }
    __syncthreads();
}

#define CAS __attribute__((address_space(4)))
__device__ __forceinline__ const void* ldarg(int k) { const CAS char* ka = (const CAS char*)__builtin_amdgcn_kernarg_segment_ptr(); return *(const void* const volatile CAS*)(ka + 8 * k); }
#define INP(k) ((const float*)ldarg(k))
__device__ __forceinline__ float wave_max(float v) {
#pragma unroll
    for (int o = 1; o < 64; o <<= 1) v = fmaxf(v, __shfl_xor(v, o));
    return v;
}
__device__ __forceinline__ float wave_sum(float v) {
#pragma unroll
    for (int o = 1; o < 64; o <<= 1) v += __shfl_xor(v, o);
    return v;
}
struct Frame {
    LAS unsigned char* lds;
    volatile LAS unsigned* MISC;
    gu32* ctl;
    int tid, lane, wave;
    int vcu, G, bx;
    unsigned char* ws;
};
#define GW(F) ((F).vcu * NWAVES + (F).wave)
#define NGW(F) ((F).G * NWAVES)
struct ItemIter { int base, step, lim; };
__device__ __forceinline__ ItemIter item_iter(const Frame& F, int N) {
    ItemIter I;
    I.base = GW(F); I.step = NGW(F); I.lim = N;
    return I;
}

__device__ __forceinline__ void transpose_item(const float* W, int ldw, int Ksrc, int koff, int dstK, int N, bf16* WT, int row_off, LAS float* scr, int item, int lane) {
    const int nblk = N / 32, kb = item / nblk, nb = item % nblk, k0 = 64 * kb, n0 = 32 * nb;
    float tv[32];
#pragma unroll
    for (int i = 0; i < 32; ++i) { const int kk = 2 * i + (lane >> 5); const int ks = k0 + kk - koff;
        tv[i] = 0.f; if (ks >= 0 && ks < Ksrc) tv[i] = W[(size_t)ks * ldw + n0 + (lane & 31)]; }
#pragma unroll
    for (int i = 0; i < 32; ++i) scr[(2 * i + (lane >> 5)) * 33 + (lane & 31)] = tv[i];
    LDS_WAIT(); asm volatile("" ::: "memory");
    const int c = lane & 7;
#pragma unroll
    for (int j = 0; j < 4; ++j) { const int n = (lane >> 3) + 8 * j; const LAS float* s = scr + (8 * c) * 33 + n;
        v4u o; o.x = pk2(s[0 * 33], s[1 * 33]); o.y = pk2(s[2 * 33], s[3 * 33]); o.z = pk2(s[4 * 33], s[5 * 33]); o.w = pk2(s[6 * 33], s[7 * 33]);
        *(GAS v4u*)(WT + (size_t)(row_off + n0 + n) * dstK + k0 + 8 * c) = o; }
    LDS_WAIT(); asm volatile("" ::: "memory");
}
#define TR_RUN(W, ldw, Ksrc, koff, dstK, N, WT, row_off) do { const int _n = ((dstK) / 64) * ((N) / 32); \
    for (int _it = (gw + NGWv - (int)(tr_base % NGWv)) % NGWv; _it < _n; _it += NGWv) transpose_item((W), (ldw), (Ksrc), (koff), (dstK), (N), (WT), (row_off), scr, _it, F.lane); \
    tr_base += _n; } while (0)

__device__ __forceinline__ void p0_prologue(Frame& F) {
    LAS float* scr = (LAS float*)(F.lds + RING_OFF + F.wave * 16384);
    const int gw = GW(F), NGWv = NGW(F);
    unsigned char* ws = F.ws;
    long tr_base = 0;
#if defined(PROBE_MASK) && ((PROBE_MASK >> 10) & 1)
    for (int prep_ = 0; prep_ < 2; ++prep_) {
#else
    {
#endif
    bf16* WA = (bf16*)(ws + WS_WA);
    for (int n = 0; n < 3; ++n) TR_RUN(INP(13) + (size_t)n * DM * DM, DM, DM, 0, DM, DM, WA, n * DM);
    for (int d = 0; d < 2; ++d) TR_RUN(INP(15) + (size_t)d * DM * 96, 96, DM, 0, DM, 96, WA, 6144 + d * 96);
    for (int d = 0; d < 2; ++d) TR_RUN(INP(18) + (size_t)d * DM * 64, 64, DM, 0, DM, 64, WA, 6144 + 256 + d * 64);
    TR_RUN(INP(20), 256, DM, 0, DM, 256, WA, 6144 + 512);
    {
        const size_t nvec = (size_t)(64 + 128) * DM / 8;
        for (size_t i = (size_t)gw * 64 + F.lane; i < nvec; i += (size_t)NGWv * 64) {
            const size_t e = i * 8; const size_t row = e / DM, col = e % DM; const size_t r = row < 64 ? 6144 + 192 + row : 6144 + 256 + 128 + (row - 64);
            *(GAS v4u*)(WA + r * DM + col) = (v4u){0u, 0u, 0u, 0u}; }
    }
    bf16* WL2 = (bf16*)(ws + WS_WL2);
    for (int d = 0; d < 2; ++d) TR_RUN(INP(16) + (size_t)d * 96 * DM, DM, 96, d * 96, 256, DM, WL2, d * DM);
    for (int d = 0; d < 2; ++d) TR_RUN(INP(19) + (size_t)d * 64 * DM, DM, 64, d * 64, 256, DM, WL2, (2 + d) * DM);
    TR_RUN(INP(21), DM, 256, 0, 256, DM, WL2, 4 * DM);
    bf16* WO = (bf16*)(ws + WS_WO);
    TR_RUN(INP(27), DM, DM, 0, DM, DM, WO, 0); TR_RUN(INP(31), DM, DM, 0, DM, DM, WO, DM); TR_RUN(INP(35), DM, DM, 0, DM, DM, WO, 2 * DM); TR_RUN(INP(42), DM, DM, 0, DM, DM, WO, 3 * DM);
    {
        bf16* WQ = (bf16*)(ws + WS_WQKV); const float* Wsrc = INP(28);
        const int nkb = DM / 64, nit = nkb * 128;
        for (int it = (gw + NGWv - (int)(tr_base % NGWv)) % NGWv; it < nit; it += NGWv) { const int kb = it / 128, cb = it % 128; const int tile = cb >> 3, hl = (cb & 7) >> 2, qtr = cb & 3;
            const int db = tile * 8 + (qtr & 1) * 4 + hl * 2 + (qtr >> 1);
            transpose_item(Wsrc + cb * 32, 3 * DM, DM, 0, DM, 32, WQ, db * 32, scr, kb, F.lane); }
        tr_base += nit;
        TR_RUN(Wsrc + 2 * DM, 3 * DM, DM, 0, DM, DM, WQ, 2 * DM);
    }
    TR_RUN(INP(32), 5 * DM, DM, 0, DM, 5 * DM, (bf16*)(ws + WS_WHG), 0);
    TR_RUN(INP(36), 2 * DM, DM, 0, DM, 2 * DM, (bf16*)(ws + WS_WLR), 0);
    {
        bf16* WG = (bf16*)(ws + WS_WGATE);
        for (int q = 0; q < 64; ++q) { const int d = q >> 5, g = (q >> 4) & 1, n = (q >> 1) & 7, hf = q & 1;
            TR_RUN(INP(39) + ((size_t)((d * 2 + g) * 8 + n) * 256) * 256 + hf * 128, 256, 256, 0, 256, 128, WG, ((d * 8 + n) * 2 + hf) * 256 + g * 128); }
    }
    {
        const int nit = (DM / 64) * 352;
        for (int l = 0; l < NLAYER; ++l) { const float* Wsrc = INP(8) + (size_t)l * DM * DFF2;
            for (int it = (gw + NGWv - (int)(tr_base % NGWv)) % NGWv; it < nit; it += NGWv) { const int kb = it / 352, cb = it % 352; const int bj = cb / 176, rem = cb % 176;
                const int db = (rem >> 2) * 8 + bj * 4 + (rem & 3);
                transpose_item(Wsrc + cb * 32, DFF2, DM, 0, DM, 32, (bf16*)(ws + WS_WUP), l * DFF2 + db * 32, scr, kb, F.lane); }
            tr_base += nit; }
    }
    for (int l = 0; l < NLAYER; ++l) TR_RUN(INP(11) + (size_t)l * DFF * DM, DM, DFF, 0, DFF, DM, (bf16*)(ws + WS_WDN), l * DM);
    }
    { float* RT = (float*)(ws + WS_ROPE);
      for (int i = gw * 64 + F.lane; i < LTOK * 64; i += NGWv * 64) { const int t = i >> 6, f = i & 63; float ang = 0.f;
          if (t >= NCTX) { const int p = t - NCTX; const float pos = (float)((f < 32) ? (p >> 6) : (p & 63)); const float invf = powf(10000.0f, -(float)(f & 31) / 32.0f); ang = pos * invf; }
          RT[2 * i] = cosf(ang); RT[2 * i + 1] = sinf(ang); } }
    { float* LB = (float*)(ws + WS_LB); const float* lower = INP(33);
      for (int i = gw * 64 + F.lane; i < 2 * DM; i += NGWv * 64) { const int d = i / DM, c = i % DM; float v[4], mx = -1e30f;
          for (int l = 0; l < 4; ++l) { v[l] = lower[(size_t)(d * 4 + l) * DM + c]; mx = fmaxf(mx, v[l]); }
          float s = 0.f; for (int l = 0; l < 4; ++l) { v[l] = expf(v[l] - mx); s += v[l]; }
          LB[i] = (v[1] + v[2]) / s; } }
    {
        __syncthreads();
        LAS float* cv = (LAS float*)(F.lds + RING_OFF);
        LAS float* red = (LAS float*)(F.lds + RING_OFF + 5 * DM * 4);
        { f32x4 xv[5];
#pragma unroll
          for (int r = 0; r < 5; ++r) xv[r] = ((const GAS f32x4*)((r < 4) ? INP(1) + r * DM : INP(3)))[F.tid];
#pragma unroll
          for (int r = 0; r < 5; ++r) { f32x4 o; o.x = xv[r].x / (1.f + expf(-xv[r].x)); o.y = xv[r].y / (1.f + expf(-xv[r].y)); o.z = xv[r].z / (1.f + expf(-xv[r].z)); o.w = xv[r].w / (1.f + expf(-xv[r].w));
              ((LAS f32x4*)cv)[r * (DM / 4) + F.tid] = o; } }
        __syncthreads();
        float* MOD = (float*)(ws + WS_MOD);
        const int NIT = NLAYER * 96 * 2;
        for (int it = F.vcu; it < NIT; it += F.G) {
            const int l = it / 192, rem = it % 192, cb = rem >> 1, kh = rem & 1;
            const float* Wl = INP(4) + (size_t)l * DM * (NMOD * DM) + cb * 128 + 2 * F.lane;
            const int kbeg = kh * 1024 + F.wave * 128;
            float a0[5], a1[5];
#pragma unroll
            for (int r = 0; r < 5; ++r) { a0[r] = 0.f; a1[r] = 0.f; }
#pragma unroll 4
            for (int kk = 0; kk < 128; ++kk) { const int k = kbeg + kk; const f32x2 w = *(const f32x2*)(Wl + (size_t)k * (NMOD * DM));
#pragma unroll
                for (int r = 0; r < 5; ++r) { const float c = cv[r * DM + k]; a0[r] += c * w.x; a1[r] += c * w.y; } }
#pragma unroll
            for (int r = 0; r < 5; ++r) { red[(F.wave * 5 + r) * 128 + 2 * F.lane] = a0[r]; red[(F.wave * 5 + r) * 128 + 2 * F.lane + 1] = a1[r]; }
            __syncthreads();
            for (int o = F.tid; o < 5 * 128; o += NWAVES * 64) { const int r = o / 128, c = o % 128; float s = 0.f;
#pragma unroll
                for (int w = 0; w < 8; ++w) s += red[(w * 5 + r) * 128 + c];
                const int n = cb * 128 + c; if (kh == 0) s += INP(5)[(size_t)l * NMOD * DM + n];
                atomicAdd(MOD + ((size_t)(l * 5 + r) * NMOD * DM + n), s); }
            __syncthreads();
        }
    }
}

__device__ __forceinline__ const float* mod_ptr(const unsigned char* ws, int layer, int bsel, int j) { return (const float*)(ws + WS_MOD) + ((size_t)((layer * 5 + bsel) * NMOD + j)) * DM; }

template <int MODE, bool LAT, int NM, int NN, int LDA, int LDB> struct Sched {
    pg8::TileOrder<NM, NN> T;
    static constexpr unsigned a_tile = 256u * LDA * 2u, b_tile = 256u * LDB * 2u;
    __device__ void init(int G, int c) { T.init(G, c); }
    __device__ __forceinline__ bool next(int i, pg8::Unit& u) const {
        int pm, pn; if (!T.tile(i, pm, pn)) return false;
        if (LAT) pm = (pm >> 3) * 9 + 1 + (pm & 7);
        u.pm = pm; u.pn = pn; u.half = -1;
        if (MODE == 0) { u.aoff = (unsigned)pm * a_tile; u.boff = (unsigned)pn * b_tile; }
        else if (MODE == 1) { const int grp = pn < 24 ? (pn >> 3) : (pn - 21); u.aoff = ((unsigned)grp * 36u + pm) * a_tile; u.boff = (unsigned)pn * b_tile; }
        else if (MODE == 2) { const int g = pn >> 3, hg = (g == 4) ? 2 : (g >> 1); u.aoff = ((unsigned)hg * 36u + pm) * a_tile; u.boff = (unsigned)pn * b_tile; }
        else { const int n = (pn >> 1) & 7; u.aoff = (unsigned)pm * a_tile + (unsigned)n * 512u; u.boff = (unsigned)pn * b_tile; }
        return true;
    }
};
template <int SPLIT, int KSUB, int LDA, int LDB> struct SchedSplit {
    int G, c;
    __device__ void init(int G_, int c_) { G = G_; c = c_; }
    __device__ __forceinline__ bool next(int i, pg8::Unit& u) const {
        const int L = i * G + c; if (L >= 32 * SPLIT) return false;
        const int tile = L / SPLIT, ks = L % SPLIT; const int pm = 32 + (tile & 3), pn = tile >> 2;
        u.pm = pm; u.pn = pn | (ks << 8); u.half = -1;
        u.aoff = (unsigned)pm * (256u * LDA * 2u) + (unsigned)ks * (KSUB * 2u); u.boff = (unsigned)pn * (256u * LDB * 2u) + (unsigned)ks * (KSUB * 2u);
        return true;
    }
};

template <int SPLIT, int KSUB, int LDA, int LDB> struct SchedSplitHalf {
    int G, c;
    __device__ void init(int G_, int c_) { G = G_; c = c_; }
    __device__ __forceinline__ bool next(int i, pg8::Unit& u) const {
        const int L = i * G + c; if (L >= 64 * SPLIT) return false;
        const int h = L & 1, Lq = L >> 1; const int tile = Lq / SPLIT, ks = Lq % SPLIT; const int pm = 32 + (tile & 3), pn = tile >> 2;
        u.pm = pm; u.pn = pn | (ks << 8); u.half = h;
        u.aoff = (unsigned)pm * (256u * LDA * 2u) + (unsigned)h * (128u * LDA * 2u) + (unsigned)ks * (KSUB * 2u); u.boff = (unsigned)pn * (256u * LDB * 2u) + (unsigned)ks * (KSUB * 2u);
        return true;
    }
};
template <bool LAT, int NM, int NN, int LMAX, int LDA, int LDB> struct SchedHead {
    int G, c;
    __device__ void init(int G_, int c_) { G = G_; c = c_; }
    __device__ __forceinline__ bool next(int i, pg8::Unit& u) const {
        const int L = i * G + c; if (L >= LMAX) return false;
        int pm, pn; pg8::TileOrder<NM, NN>::tileL(L, pm, pn);
        if (LAT) pm = (pm >> 3) * 9 + 1 + (pm & 7);
        u.pm = pm; u.pn = pn; u.half = -1; u.aoff = (unsigned)pm * (256u * LDA * 2u); u.boff = (unsigned)pn * (256u * LDB * 2u);
        return true;
    }
};
template <bool LAT, int NM, int NN, int LMAX, int NT, int LDA, int LDB> struct SchedHT {
    int G, c;
    __device__ void init(int G_, int c_) { G = G_; c = c_; }
    __device__ __forceinline__ bool next(int i, pg8::Unit& u) const {
        const int L = i * G + c; if (L >= LMAX + 2 * NT) return false;
        const bool whole = L < LMAX; const int Lp = L - LMAX; const int h = whole ? 0 : (Lp & 1);
        int pm, pn; pg8::TileOrder<NM, NN>::tileL(whole ? L : LMAX + (Lp >> 1), pm, pn);
        if (LAT) pm = (pm >> 3) * 9 + 1 + (pm & 7);
        u.pm = pm; u.pn = pn; u.half = whole ? -1 : h; u.aoff = (unsigned)pm * (256u * LDA * 2u) + (unsigned)h * (128u * LDA * 2u); u.boff = (unsigned)pn * (256u * LDB * 2u);
        return true;
    }
};
template <bool LAT, int NM, int NN, int L0, int NT, int LDA, int LDB> struct SchedTailHalf {
    int G, c;
    __device__ void init(int G_, int c_) { G = G_; c = c_; }
    __device__ __forceinline__ bool next(int i, pg8::Unit& u) const {
        const int Lp = i * G + c; if (Lp >= 2 * NT) return false;
        const int tu = Lp >> 1, h = Lp & 1;
        int pm, pn; pg8::TileOrder<NM, NN>::tileL(L0 + tu, pm, pn);
        if (LAT) pm = (pm >> 3) * 9 + 1 + (pm & 7);
        u.pm = pm; u.pn = pn; u.half = h; u.aoff = (unsigned)pm * (256u * LDA * 2u) + (unsigned)h * (128u * LDA * 2u); u.boff = (unsigned)pn * (256u * LDB * 2u);
        return true;
    }
};

template <int kind> struct EpiBf16Route {
    static constexpr bool PERM = true; static constexpr bool PERMA = false; static constexpr bool PREFETCH = false;
    bf16* O; int ldc;
    unsigned char* ws; const float* p0; const float* p1;
    static __device__ __forceinline__ float act(int mode, float x, float p) {
        if (kind == 0 || kind == 5) return x;
        if (kind == 1) { const float e = __expf(mode == 1 ? 2.f * x : -x); const float r = __builtin_amdgcn_rcpf(e + 1.f); return mode == 0 ? x : (mode == 1 ? 1.f - 2.f * r : r); }
        if (kind == 2) { const float s = sigmoidf_(x + p); const float dcy = __expf(-0.606531f * s); return mode == 4 ? dcy : (mode == 2 ? s : x); }
        if (kind == 3) { const float s = sigmoidf_(mode == 6 ? -x : x); return mode == 0 ? x : (mode == 3 ? x * s : (1.f - p) * s); }
        return mode == 5 ? gelu_tanh_(x) : x;
    }
    __device__ __forceinline__ void operator()(const pg8::f32x4 (&acc)[2][2][4][2], const pg8::Unit& u, int wr, int wc, int fr, int fq) const {
        bf16* base = O; int ld = ldc, colt = u.pn * 256, mode = 0; const float* par = nullptr;
        if (kind == 1) { if (u.pn < 24) { const int g = u.pn >> 3; base = (bf16*)(ws + (g == 0 ? L0_R : (g == 1 ? L0_K : L0_V))); ld = DM; colt = (u.pn & 7) * 256; }
                         else { const int hg = u.pn - 24; base = (bf16*)(ws + L0_HID) + (size_t)hg * NTOK * 256; ld = 256; colt = 0; mode = hg == 0 ? 1 : (hg == 1 ? 0 : 2); } }
        else if (kind == 2) { const int g = u.pn >> 3; colt = (u.pn & 7) * 256; ld = DM;
                         base = (bf16*)(ws + (g == 0 ? L0_DEC0 : g == 1 ? L0_DEC1 : g == 2 ? L0_IC0 : g == 3 ? L0_IC1 : L0_G));
                         if (g < 2) { mode = 4; par = p0 + g * DM + colt; } else if (g < 4) { mode = 2; par = p1 + (g - 2) * DM + colt; } }
        else if (kind == 3) { const int g = u.pn >> 3; if (g == 0 || g == 2) mode = 3; else if (g >= 3) { mode = 6; par = p0 + (g - 3) * DM + (u.pn & 7) * 256; } }
        else if (kind == 4) { if (u.pn < 8) mode = 5; }
        const int row0 = u.pm * 256 + wr * 64 + fr, col0 = colt + wc * 32 + 8 * fq, pc0 = wc * 32 + 8 * fq;
        const int ai0 = u.half < 0 ? 0 : u.half, nai = u.half < 0 ? 2 : 1;
        if (kind == 5 && u.pn < 16) {
            const int x = wc * 32 + 8 * fq, hl = x >> 6, y = x & 63; const int ncol = u.pn * 256 + hl * 128 + (y < 32 ? y : y + 32);
            const float* RT = (const float*)(ws + WS_ROPE);
#pragma unroll
            for (int ai = 0; ai < 2; ++ai) if (ai < nai)
#pragma unroll
                for (int m = 0; m < 4; ++m) { const int row = row0 + (ai0 + ai) * 128 + m * 16; const int t = row % LTOK;
                    const GAS pg8::f32x4* cs = (const GAS pg8::f32x4*)(RT + ((size_t)t * 64 + y) * 2);
                    const pg8::f32x4 c0 = cs[0], c1 = cs[1], c2 = cs[2], c3 = cs[3];
                    const pg8::f32x4 a0 = acc[ai][0][m][0], a1 = acc[ai][0][m][1], b0 = acc[ai][1][m][0], b1 = acc[ai][1][m][1];
                    pg8::u32x4 wa, wb;
                    wa.x = pk2(a0[0] * c0[0] - b0[0] * c0[1], a0[1] * c0[2] - b0[1] * c0[3]); wa.y = pk2(a0[2] * c1[0] - b0[2] * c1[1], a0[3] * c1[2] - b0[3] * c1[3]);
                    wa.z = pk2(a1[0] * c2[0] - b1[0] * c2[1], a1[1] * c2[2] - b1[1] * c2[3]); wa.w = pk2(a1[2] * c3[0] - b1[2] * c3[1], a1[3] * c3[2] - b1[3] * c3[3]);
                    wb.x = pk2(b0[0] * c0[0] + a0[0] * c0[1], b0[1] * c0[2] + a0[1] * c0[3]); wb.y = pk2(b0[2] * c1[0] + a0[2] * c1[1], b0[3] * c1[2] + a0[3] * c1[3]);
                    wb.z = pk2(b1[0] * c2[0] + a1[0] * c2[1], b1[1] * c2[2] + a1[1] * c2[3]); wb.w = pk2(b1[2] * c3[0] + a1[2] * c3[1], b1[3] * c3[2] + a1[3] * c3[3]);
                    bf16* rp_ = base + (size_t)row * ld + ncol;
                    *(pg8::u32x4*)rp_ = wa; *(pg8::u32x4*)(rp_ + 32) = wb; }
            return;
        }
#pragma unroll
        for (int bj = 0; bj < 2; ++bj) {
            pg8::f32x4 pa = {0.f, 0.f, 0.f, 0.f}, pb = {0.f, 0.f, 0.f, 0.f};
            if ((kind == 2 || kind == 3) && par) { pa = *(const GAS pg8::f32x4*)(par + pc0 + bj * 128); pb = *(const GAS pg8::f32x4*)(par + pc0 + bj * 128 + 4); }
#pragma unroll
            for (int ai = 0; ai < 2; ++ai) if (ai < nai)
#pragma unroll
                for (int m = 0; m < 4; ++m) { bf16* rowp = base + (size_t)(row0 + (ai0 + ai) * 128 + m * 16) * ld + col0 + bj * 128;
                    pg8::f32x4 v0 = acc[ai][bj][m][0], v1 = acc[ai][bj][m][1];
                    if (kind != 0 && kind != 5) {
#pragma unroll
                        for (int j = 0; j < 4; ++j) { v0[j] = act(mode, v0[j], pa[j]); v1[j] = act(mode, v1[j], pb[j]); } }
                    pg8::u32x4 w; w.x = pk2(v0[0], v0[1]); w.y = pk2(v0[2], v0[3]); w.z = pk2(v1[0], v1[1]); w.w = pk2(v1[2], v1[3]);
                    *(pg8::u32x4*)rowp = w; }
        }
    }
};
template <int CTRL> __device__ __forceinline__ float dppz(float v) { return __int_as_float(__builtin_amdgcn_update_dpp(0, __float_as_int(v), CTRL, 0xF, 0xF, true)); }
struct EpiConvAct {
    static constexpr bool PERM = true; static constexpr bool PERMA = true;
    static constexpr bool PREFETCH = true;
    bf16* A; bf16* UB; const float* cw; const float* cb; LAS unsigned char* wlds;
    __device__ __forceinline__ void prefetch(const pg8::Unit& u, PG8_LAS unsigned char* wl, int tid, int wid) const {
        if (wid < 4) { const int r8 = tid >> 5, piece = tid & 31; const float* src = ((r8 & 3) < 3 ? cw + (size_t)(r8 & 3) * DFF2 : cb) + (r8 >> 2) * DFF + u.pn * 128 + 4 * piece;
            __builtin_amdgcn_global_load_lds((const unsigned*)src, (PG8_LAS unsigned*)(wl + wid * 1024), 16, 0, 0); }
    }
    __device__ __forceinline__ void operator()(const pg8::f32x4 (&acc)[2][2][4][2], const pg8::Unit& u, int wr, int wc, int fr, int fq) const {
        const int pc = wc * 32 + 8 * fq, cn = u.pn * 128 + pc;
        const int rowb = u.pm * 256 + wr * 64 + 4 * fr;
        const int ai0 = u.half < 0 ? 0 : u.half, nai = u.half < 0 ? 2 : 1;
        if (fr == 0 || fr == 15) {
            const bool lo = fr == 0; const int run = u.pm * 4 + wr + 2 * ai0;
#pragma unroll
            for (int ai = 0; ai < 2; ++ai) if (ai < nai)
#pragma unroll
                for (int bj = 0; bj < 2; ++bj)
#pragma unroll
                    for (int s = 0; s < 2; ++s) { const pg8::f32x4 a0 = lo ? acc[ai][bj][s][0] : acc[ai][bj][2 + s][0], a1 = lo ? acc[ai][bj][s][1] : acc[ai][bj][2 + s][1];
                        pg8::u32x4 w; w.x = pk2(a0[0], a0[1]); w.y = pk2(a0[2], a0[3]); w.z = pk2(a1[0], a1[1]); w.w = pk2(a1[2], a1[3]);
                        *(pg8::u32x4*)(UB + (size_t)((run + 2 * ai) * 4 + (lo ? s : 2 + s)) * DFF2 + u.pn * 256 + bj * 128 + pc) = w; }
        }
        pg8::u32x2 r0[2][4];
#pragma unroll
        for (int h = 0; h < 2; ++h) {
            const LAS float* wq = (const LAS float*)(wlds + u.seq * 4096) + pc + 4 * h;
            const pg8::f32x4 g0 = *(const LAS pg8::f32x4*)wq, g1 = *(const LAS pg8::f32x4*)(wq + 128), g2 = *(const LAS pg8::f32x4*)(wq + 256), gb = *(const LAS pg8::f32x4*)(wq + 384);
            const pg8::f32x4 v0 = *(const LAS pg8::f32x4*)(wq + 512), v1 = *(const LAS pg8::f32x4*)(wq + 640), v2 = *(const LAS pg8::f32x4*)(wq + 768), vb = *(const LAS pg8::f32x4*)(wq + 896);
#pragma unroll
            for (int ai = 0; ai < 2; ++ai) if (ai < nai) {
                __builtin_amdgcn_sched_barrier(0);
                float o[4][4];
#pragma unroll
                for (int j = 0; j < 4; ++j) {
                    const float xg0 = acc[ai][0][0][h][j], xg1 = acc[ai][0][1][h][j], xg2 = acc[ai][0][2][h][j], xg3 = acc[ai][0][3][h][j];
                    const float xv0 = acc[ai][1][0][h][j], xv1 = acc[ai][1][1][h][j], xv2 = acc[ai][1][2][h][j], xv3 = acc[ai][1][3][h][j];
                    const float pg = dppz<0x111>(xg3), ng = dppz<0x101>(xg0), pv = dppz<0x111>(xv3), nv = dppz<0x101>(xv0);
                    const float og0 = gb[j] + g0[j] * pg + g1[j] * xg0 + g2[j] * xg1, ov0 = vb[j] + v0[j] * pv + v1[j] * xv0 + v2[j] * xv1;
                    const float og1 = gb[j] + g0[j] * xg0 + g1[j] * xg1 + g2[j] * xg2, ov1 = vb[j] + v0[j] * xv0 + v1[j] * xv1 + v2[j] * xv2;
                    const float og2 = gb[j] + g0[j] * xg1 + g1[j] * xg2 + g2[j] * xg3, ov2 = vb[j] + v0[j] * xv1 + v1[j] * xv2 + v2[j] * xv3;
                    const float og3 = gb[j] + g0[j] * xg2 + g1[j] * xg3 + g2[j] * ng, ov3 = vb[j] + v0[j] * xv2 + v1[j] * xv3 + v2[j] * nv;
                    o[0][j] = siluf_(og0) * ov0; o[1][j] = siluf_(og1) * ov1; o[2][j] = siluf_(og2) * ov2; o[3][j] = siluf_(og3) * ov3; }
#pragma unroll
                for (int m = 0; m < 4; ++m) { pg8::u32x2 w; w.x = pk2(o[m][0], o[m][1]); w.y = pk2(o[m][2], o[m][3]);
                    if (h == 0) r0[ai][m] = w;
                    else { pg8::u32x4 w4; w4.x = r0[ai][m].x; w4.y = r0[ai][m].y; w4.z = w.x; w4.w = w.y; *(pg8::u32x4*)(A + (size_t)(rowb + (ai0 + ai) * 128 + m) * DFF + cn) = w4; } }
            }
            __builtin_amdgcn_sched_barrier(0);
        }
    }
};
struct EpiResid {
    static constexpr bool PERM = true; static constexpr bool PERMA = false; static constexpr bool PREFETCH = false;
    bf16* DELTA; const unsigned char* ws; int layer, j;
    __device__ __forceinline__ void operator()(const pg8::f32x4 (&acc)[2][2][4][2], const pg8::Unit& u, int wr, int wc, int fr, int fq) const {
        const int bsel = (u.pm % 9 == 0) ? 4 : (u.pm / 9);
        const float* gate = mod_ptr(ws, layer, bsel, j);
        const int row0 = u.pm * 256 + wr * 64 + fr, col0 = u.pn * 256 + wc * 32 + 8 * fq;
#pragma unroll
        for (int bj = 0; bj < 2; ++bj) {
            const pg8::f32x4 ga = *(const GAS pg8::f32x4*)(gate + col0 + bj * 128), gb = *(const GAS pg8::f32x4*)(gate + col0 + bj * 128 + 4);
#pragma unroll
            for (int ai = 0; ai < 2; ++ai)
#pragma unroll
                for (int m = 0; m < 4; ++m) { const pg8::f32x4 v0 = acc[ai][bj][m][0] * ga, v1 = acc[ai][bj][m][1] * gb;
                    pg8::u32x4 w; w.x = pk2(v0[0], v0[1]); w.y = pk2(v0[2], v0[3]); w.z = pk2(v1[0], v1[1]); w.w = pk2(v1[2], v1[3]);
                    *(pg8::u32x4*)(DELTA + (size_t)(row0 + ai * 128 + m * 16) * DM + col0 + bj * 128) = w; }
        }
    }
};
struct EpiPartial {
    static constexpr bool PERM = true; static constexpr bool PERMA = false; static constexpr bool PREFETCH = false;
    bf16* PART;
    __device__ __forceinline__ void operator()(const pg8::f32x4 (&acc)[2][2][4][2], const pg8::Unit& u, int wr, int wc, int fr, int fq) const {
        const int ks = u.pn >> 8, pn = u.pn & 255;
        bf16* base = PART + (size_t)ks * 1024 * DM; const int row0 = (u.pm - 32) * 256 + wr * 64 + fr, col0 = pn * 256 + wc * 32 + 8 * fq;
        const int ai0 = u.half < 0 ? 0 : u.half, nai = u.half < 0 ? 2 : 1;
#pragma unroll
        for (int ai = 0; ai < 2; ++ai) if (ai < nai)
#pragma unroll
            for (int m = 0; m < 4; ++m)
#pragma unroll
                for (int bj = 0; bj < 2; ++bj) { const pg8::f32x4 v0 = acc[ai][bj][m][0], v1 = acc[ai][bj][m][1];
                    pg8::u32x4 w; w.x = pk2(v0[0], v0[1]); w.y = pk2(v0[2], v0[3]); w.z = pk2(v1[0], v1[1]); w.w = pk2(v1[2], v1[3]);
                    *(pg8::u32x4*)(base + (size_t)(row0 + (ai0 + ai) * 128 + m * 16) * DM + col0 + bj * 128) = w; }
    }
};
struct EpiGates {
    static constexpr bool PERM = true; static constexpr bool PERMA = false; static constexpr bool PREFETCH = false;
    unsigned char* ws; const float* b_gate; const float* lam;
    __device__ __forceinline__ void operator()(const pg8::f32x4 (&acc)[2][2][4][2], const pg8::Unit& u, int wr, int wc, int fr, int fq) const {
        const int d = u.pn >> 4, nb = (u.pn >> 1) & 7, hf = u.pn & 1;
        const int c0 = nb * 256 + hf * 128 + wc * 32 + 8 * fq;
        const int row0 = u.pm * 256 + wr * 64 + fr;
        const bf16* XB = (const bf16*)(ws + L3_XB);
        bf16* LOGA = (bf16*)(ws + L3_LOGA) + (size_t)d * NTOK * DM; bf16* UU = (bf16*)(ws + L3_UU) + (size_t)d * NTOK * DM;
        v4u xw[2][4];
#pragma unroll
        for (int ai = 0; ai < 2; ++ai)
#pragma unroll
            for (int m = 0; m < 4; ++m) xw[ai][m] = *(const GAS v4u*)(XB + (size_t)(row0 + ai * 128 + m * 16) * DM + c0);
        v2u kla[2][4], kuu[2][4];
#pragma unroll
        for (int n = 0; n < 2; ++n) {
            const int c4 = c0 + 4 * n;
            const pg8::f32x4 br = *(const pg8::f32x4*)(b_gate + (size_t)(d * 2 + 0) * DM + c4), bi = *(const pg8::f32x4*)(b_gate + (size_t)(d * 2 + 1) * DM + c4);
            const pg8::f32x4 lm = *(const pg8::f32x4*)(lam + (size_t)d * DM + c4); pg8::f32x4 sp;
#pragma unroll
            for (int j = 0; j < 4; ++j) sp[j] = __logf(1.f + __expf(-lm[j]));
#pragma unroll
            for (int ai = 0; ai < 2; ++ai)
#pragma unroll
                for (int m = 0; m < 4; ++m) { const size_t off = (size_t)(row0 + ai * 128 + m * 16) * DM + c0;
                    const unsigned x01 = n ? xw[ai][m].z : xw[ai][m].x, x23 = n ? xw[ai][m].w : xw[ai][m].y;
                    float xb[4]; xb[0] = bflo(x01); xb[1] = bfhi(x01); xb[2] = bflo(x23); xb[3] = bfhi(x23);
                    float la[4], uu[4];
#pragma unroll
                    for (int j = 0; j < 4; ++j) { const float rg = sigmoidf_(acc[ai][0][m][n][j] + br[j]), ig = sigmoidf_(acc[ai][1][m][n][j] + bi[j]);
                        const float lg = -8.0f * rg * sp[j]; la[j] = lg;
                        uu[j] = __builtin_amdgcn_sqrtf(fmaxf(1.f - __expf(2.f * lg), 0.f)) * ig * xb[j]; }
                    v2u wl; wl.x = pk2(la[0], la[1]); wl.y = pk2(la[2], la[3]); v2u wu; wu.x = pk2(uu[0], uu[1]); wu.y = pk2(uu[2], uu[3]);
                    if (n == 0) { kla[ai][m] = wl; kuu[ai][m] = wu; }
                    else { v4u o1; o1.x = kla[ai][m].x; o1.y = kla[ai][m].y; o1.z = wl.x; o1.w = wl.y; *(GAS v4u*)(LOGA + off) = o1;
                           v4u o2; o2.x = kuu[ai][m].x; o2.y = kuu[ai][m].y; o2.z = wu.x; o2.w = wu.y; *(GAS v4u*)(UU + off) = o2; } }
        }
    }
};

template <bool LAT, bool TO_OUT, bool WITH_H, int NSPLIT>
__device__ __forceinline__ void ln_phase(Frame& F, const bf16* DELTA, const float* Zin, float* Zout, float* dout, bf16* H, const float* gam, const float* bet, int mlayer, int jshift, const bf16* PART, int glayer, int jgate) {
    const int gw = GW(F), NGWv = NGW(F); const int nrows = LAT ? NLAT : NTOK;
    for (int idx = gw; idx < nrows; idx += NGWv) {
        int m, b, t; if (LAT) { b = idx >> 11; t = NCTX + (idx & 2047); m = b * LTOK + t; } else { m = idx; b = m / LTOK; t = m % LTOK; }
        const int bsel = (t < NCTX) ? 4 : b;
        f32x4 v[8]; float s = 0.f;
        if (NSPLIT > 0 && m >= 8192) {
            const GAS f32x4* zr = (const GAS f32x4*)(Zin + (size_t)m * DM) + F.lane; const GAS f32x4* gr = (const GAS f32x4*)mod_ptr(F.ws, glayer, bsel, jgate) + F.lane;
            const GAS v2u* pr = (const GAS v2u*)(PART + (size_t)(m - 8192) * DM) + F.lane;
#pragma unroll
            for (int j = 0; j < 8; ++j) { f32x4 a = {0.f, 0.f, 0.f, 0.f};
#pragma unroll
                for (int p = 0; p < NSPLIT; ++p) { const v2u pw = pr[(size_t)p * (1024 * DM / 4) + 64 * j]; a += (f32x4){bflo(pw.x), bfhi(pw.x), bflo(pw.y), bfhi(pw.y)}; }
                v[j] = zr[64 * j] * DN_ALPHA + gr[64 * j] * a; s += (v[j].x + v[j].y) + (v[j].z + v[j].w); }
        } else {
            const GAS f32x4* zr = (const GAS f32x4*)(Zin + (size_t)m * DM) + F.lane; const GAS v2u* dr = (const GAS v2u*)(DELTA + (size_t)m * DM) + F.lane;
#pragma unroll
            for (int j = 0; j < 8; ++j) { const v2u dw = dr[64 * j]; const f32x4 dl = {bflo(dw.x), bfhi(dw.x), bflo(dw.y), bfhi(dw.y)};
                v[j] = zr[64 * j] * DN_ALPHA + dl; s += (v[j].x + v[j].y) + (v[j].z + v[j].w); }
        }
        const float mean = wave_sum(s) * (1.f / DM); float s2 = 0.f;
#pragma unroll
        for (int j = 0; j < 8; ++j) { v[j] = v[j] - mean; s2 += (v[j].x * v[j].x + v[j].y * v[j].y) + (v[j].z * v[j].z + v[j].w * v[j].w); }
        const float rstd = 1.f / sqrtf(wave_sum(s2) * (1.f / DM) + LN_EPS);
        const float* sh = WITH_H ? mod_ptr(F.ws, mlayer, bsel, jshift) : nullptr; const float* sc = WITH_H ? mod_ptr(F.ws, mlayer, bsel, jshift + 1) : nullptr;
        float* zo = TO_OUT ? dout + ((size_t)b * SEQ + (t - NCTX)) * DM : Zout + (size_t)m * DM;
#pragma unroll
        for (int j = 0; j < 8; ++j) { const int col = 256 * j + 4 * F.lane;
            const f32x4 g = *(const f32x4*)(gam + col), be = *(const f32x4*)(bet + col);
            const f32x4 z = v[j] * rstd * g + be;
            *(GAS f32x4*)(zo + col) = z;
            if (WITH_H) { const f32x4 s1 = *(const GAS f32x4*)(sc + col), s0 = *(const GAS f32x4*)(sh + col); const f32x4 h = z * (s1 + 1.f) + s0;
                v2u w; w.x = pk2(h.x, h.y); w.y = pk2(h.z, h.w); *(GAS v2u*)(H + (size_t)m * DM + col) = w; } }
    }
}
__device__ __forceinline__ const float* z0_row(const float* Zb, const float* xin, const float* cin, bool z0in, int m, int b, int t) {
    return z0in ? ((t < NCTX) ? cin + ((size_t)b * NCTX + t) * DM : xin + ((size_t)b * SEQ + (t - NCTX)) * DM) : Zb + (size_t)m * DM;
}
#define LN_ROWINFO(idx_, m_, b_, t_) do { if (LAT) { b_ = (idx_) >> 11; t_ = NCTX + ((idx_) & 2047); m_ = b_ * LTOK + t_; } else { m_ = (idx_); b_ = m_ / LTOK; t_ = m_ % LTOK; } } while (0)
#define LNI(j_) (128 * ((j_) >> 1) + 2 * F.lane + ((j_) & 1))
#define LN_SPLIT_D(dst, PARTp, gatep, m_) do { const GAS v2u* pr_ = (const GAS v2u*)((PARTp) + (size_t)((m_) - 8192) * DM); const GAS f32x4* gr_ = (const GAS f32x4*)(gatep); \
        _Pragma("unroll") for (int j_ = 0; j_ < 8; ++j_) { f32x4 a_ = {0.f, 0.f, 0.f, 0.f}; \
            _Pragma("unroll") for (int p_ = 0; p_ < NSPLIT; ++p_) { const v2u pw_ = pr_[(size_t)p_ * (1024 * DM / 4) + LNI(j_)]; a_ += (f32x4){bflo(pw_.x), bfhi(pw_.x), bflo(pw_.y), bfhi(pw_.y)}; } \
            a_ = a_ * gr_[LNI(j_)]; dst[j_].x = pk2(a_.x, a_.y); dst[j_].y = pk2(a_.z, a_.w); } } while (0)
__device__ __forceinline__ f32x4 zq_decode(const f32x4 raw, float sc) { const int a = __float_as_int(raw.x), b = __float_as_int(raw.y);
    return (f32x4){(float)(short)(a & 0xffff), (float)(a >> 16), (float)(short)(b & 0xffff), (float)(b >> 16)} * sc; }
#define ZQ_ROW(Zb_, m_) ((const GAS v4u*)((const unsigned short*)(Zb_) + (size_t)(m_) * DM) + F.lane)
template <bool LAT, int NSPLIT, bool Z0IN>
__device__ __forceinline__ void ln1_phase(Frame& F, bf16* D1, const float* Zb, const float* xin, const float* cin, bf16* H, float* STAT, const float* gam, const float* bet, int layer, const bf16* PART) {
    const int gw = GW(F), NGWv = NGW(F); const int nrows = LAT ? NLAT : NTOK; const int nmain = NSPLIT > 0 ? 8192 : nrows;
    LAS float* Lg = (LAS float*)(F.lds + RING_OFF); LAS float* Lb = Lg + DM; LAS float* Lm = Lb + DM;
    f32x4 zA[8], zB[8]; v2u dA[8], dB[8]; float sA = 1.f, sB = 1.f;
    auto loadz = [&](const int idx, f32x4 (&zz)[8], float& zs) __attribute__((always_inline)) {
        int m, b, t; LN_ROWINFO(idx, m, b, t);
        if (Z0IN) { const GAS f32x4* zr = (const GAS f32x4*)z0_row(Zb, xin, cin, true, m, b, t);
#pragma unroll
            for (int j = 0; j < 8; ++j) zz[j] = zr[LNI(j)]; }
        else { const GAS v4u* qr = ZQ_ROW(Zb, m); zs = *(const GAS float*)((const float*)(F.ws + WS_ZS) + m);
#pragma unroll
            for (int k = 0; k < 4; ++k) { const v4u pw = qr[64 * k]; zz[2 * k].x = __uint_as_float(pw.x); zz[2 * k].y = __uint_as_float(pw.y); zz[2 * k + 1].x = __uint_as_float(pw.z); zz[2 * k + 1].y = __uint_as_float(pw.w); } } };
    auto loadd = [&](const int idx, v2u (&dd)[8]) __attribute__((always_inline)) {
        int m, b, t; LN_ROWINFO(idx, m, b, t); const GAS v4u* dr = (const GAS v4u*)(D1 + (size_t)m * DM) + F.lane;
#pragma unroll
        for (int k = 0; k < 4; ++k) { const v4u pw = dr[64 * k]; dd[2 * k] = (v2u){pw.x, pw.y}; dd[2 * k + 1] = (v2u){pw.z, pw.w}; } };
    auto row1 = [&](f32x4 (&zc)[8], v2u (&dc)[8], const float zsc, const int idx) __attribute__((always_inline)) {
        int m, b, t; LN_ROWINFO(idx, m, b, t); const int bsel = (t < NCTX) ? 4 : b;
        float s = 0.f;
#pragma unroll
        for (int j = 0; j < 8; ++j) { const f32x4 dl = {bflo(dc[j].x), bfhi(dc[j].x), bflo(dc[j].y), bfhi(dc[j].y)}; const f32x4 z0v = Z0IN ? zc[j] : zq_decode(zc[j], zsc);
            zc[j] = z0v * DN_ALPHA + dl; s += (zc[j].x + zc[j].y) + (zc[j].z + zc[j].w); }
        const float mean = wave_sum(s) * (1.f / DM); float s2 = 0.f;
#pragma unroll
        for (int j = 0; j < 8; ++j) { zc[j] = zc[j] - mean; s2 += (zc[j].x * zc[j].x + zc[j].y * zc[j].y) + (zc[j].z * zc[j].z + zc[j].w * zc[j].w); }
        const float rstd = 1.f / sqrtf(wave_sum(s2) * (1.f / DM) + LN_EPS);
        if (F.lane == 0) *(GAS f32x2*)(STAT + (size_t)m * 2) = (f32x2){mean, rstd};
        const LAS float* sh = Lm + bsel * 2 * DM; const LAS float* sc = sh + DM; v2u hw = {0u, 0u};
#pragma unroll
        for (int j = 0; j < 8; ++j) { const int col = 4 * LNI(j);
            const f32x4 z = zc[j] * rstd * *(const LAS f32x4*)(Lg + col) + *(const LAS f32x4*)(Lb + col);
            const f32x4 h = z * (*(const LAS f32x4*)(sc + col) + 1.f) + *(const LAS f32x4*)(sh + col);
            v2u w; w.x = pk2(h.x, h.y); w.y = pk2(h.z, h.w);
            if (j & 1) *(GAS v4u*)(H + (size_t)m * DM + col - 4) = (v4u){hw.x, hw.y, w.x, w.y}; else hw = w; } };
    int idx = gw; bool have = idx < nmain;
    if (have) { loadz(idx, zA, sA); loadd(idx, dA); }
    {
        f32x4 pv[12];
        pv[0] = ((const GAS f32x4*)gam)[F.tid]; pv[1] = ((const GAS f32x4*)bet)[F.tid];
#pragma unroll
        for (int k = 0; k < 10; ++k) { const int v = F.tid + NWAVES * 64 * k, bs = v >> 10, r4 = v & 1023; pv[2 + k] = ((const GAS f32x4*)mod_ptr(F.ws, layer, bs, 3))[r4]; }
        ((LAS f32x4*)Lg)[F.tid] = pv[0]; ((LAS f32x4*)Lb)[F.tid] = pv[1];
#pragma unroll
        for (int k = 0; k < 10; ++k) ((LAS f32x4*)Lm)[F.tid + NWAVES * 64 * k] = pv[2 + k];
    }
    __syncthreads();
    while (have) {
        const int nidx = idx + NGWv; const bool hasn = nidx < nmain;
        if (hasn) { loadz(nidx, zB, sB); loadd(nidx, dB); }
        asm volatile("" ::: "memory");
        row1(zA, dA, sA, idx);
        if (!hasn) break;
        const int fidx = nidx + NGWv; const bool hasf = fidx < nmain;
        if (hasf) { loadz(fidx, zA, sA); loadd(fidx, dA); }
        asm volatile("" ::: "memory");
        row1(zB, dB, sB, nidx);
        idx = fidx; have = hasf;
    }
    if (NSPLIT > 0) {
        for (int ti = 8192 + gw; ti < nrows; ti += NGWv) {
            int m, b, t; LN_ROWINFO(ti, m, b, t);
            loadz(ti, zA, sA); LN_SPLIT_D(dA, PART, mod_ptr(F.ws, layer, (t < NCTX) ? 4 : b, 2), m);
#pragma unroll
            for (int k = 0; k < 4; ++k) { v4u o; o.x = dA[2 * k].x; o.y = dA[2 * k].y; o.z = dA[2 * k + 1].x; o.w = dA[2 * k + 1].y; *((GAS v4u*)(D1 + (size_t)m * DM) + 64 * k + F.lane) = o; }
            asm volatile("" ::: "memory");
            row1(zA, dA, sA, ti);
        }
    }
}
template <bool LAT, bool TO_OUT, bool WITH_H, int NSPLIT, bool Z0IN>
__device__ __forceinline__ void ln2_phase(Frame& F, const bf16* D1, const bf16* D2, const float* Zb, const float* xin, const float* cin, float* Zout, float* dout, bf16* H, const float* STAT,
                                          const float* gam1, const float* bet1, const float* gam2, const float* bet2, int layer, const bf16* PART) {
    const int gw = GW(F), NGWv = NGW(F); const int nrows = LAT ? NLAT : NTOK; const int nmain = NSPLIT > 0 ? 8192 : nrows;
    LAS float* Lg1 = (LAS float*)(F.lds + RING_OFF); LAS float* Lb1 = Lg1 + DM; LAS float* Lg2 = Lb1 + DM; LAS float* Lb2 = Lg2 + DM; LAS float* Lm = Lb2 + DM;
    f32x4 zA[8], zB[8]; v2u d1A[8], d1B[8], d2A[8], d2B[8]; f32x2 stA = {0.f, 0.f}, stB = {0.f, 0.f}; float sA = 1.f, sB = 1.f;
    auto loadz = [&](const int idx, f32x4 (&zz)[8], v2u (&dd1)[8], f32x2& st, float& zs) __attribute__((always_inline)) {
        int m, b, t; LN_ROWINFO(idx, m, b, t);
        if (Z0IN) { const GAS f32x4* zr = (const GAS f32x4*)z0_row(Zb, xin, cin, true, m, b, t);
#pragma unroll
            for (int j = 0; j < 8; ++j) zz[j] = zr[LNI(j)]; }
        else { const GAS v4u* qr = ZQ_ROW(Zb, m); zs = *(const GAS float*)((const float*)(F.ws + WS_ZS) + m);
#pragma unroll
            for (int k = 0; k < 4; ++k) { const v4u pw = qr[64 * k]; zz[2 * k].x = __uint_as_float(pw.x); zz[2 * k].y = __uint_as_float(pw.y); zz[2 * k + 1].x = __uint_as_float(pw.z); zz[2 * k + 1].y = __uint_as_float(pw.w); } }
        const GAS v4u* dr = (const GAS v4u*)(D1 + (size_t)m * DM) + F.lane;
#pragma unroll
        for (int k = 0; k < 4; ++k) { const v4u pw = dr[64 * k]; dd1[2 * k] = (v2u){pw.x, pw.y}; dd1[2 * k + 1] = (v2u){pw.z, pw.w}; }
        st = *(const GAS f32x2*)(STAT + (size_t)m * 2); };
    auto loadd2 = [&](const int idx, v2u (&dd2)[8]) __attribute__((always_inline)) {
        int m, b, t; LN_ROWINFO(idx, m, b, t); const GAS v4u* dr = (const GAS v4u*)(D2 + (size_t)m * DM) + F.lane;
#pragma unroll
        for (int k = 0; k < 4; ++k) { const v4u pw = dr[64 * k]; dd2[2 * k] = (v2u){pw.x, pw.y}; dd2[2 * k + 1] = (v2u){pw.z, pw.w}; } };
    auto row2 = [&](f32x4 (&zc)[8], v2u (&d1c)[8], v2u (&d2c)[8], const f32x2 stc, const float zsc, const int idx) __attribute__((always_inline)) {
        int m, b, t; LN_ROWINFO(idx, m, b, t); const int bsel = (t < NCTX) ? 4 : b;
        float s = 0.f;
#pragma unroll
        for (int j = 0; j < 8; ++j) { const int col = 4 * LNI(j);
            const f32x4 dl1 = {bflo(d1c[j].x), bfhi(d1c[j].x), bflo(d1c[j].y), bfhi(d1c[j].y)}, dl2 = {bflo(d2c[j].x), bfhi(d2c[j].x), bflo(d2c[j].y), bfhi(d2c[j].y)};
            const f32x4 z0v = Z0IN ? zc[j] : zq_decode(zc[j], zsc);
            const f32x4 z1 = ((z0v * DN_ALPHA + dl1) - stc.x) * stc.y * *(const LAS f32x4*)(Lg1 + col) + *(const LAS f32x4*)(Lb1 + col);
            zc[j] = z1 * DN_ALPHA + dl2; s += (zc[j].x + zc[j].y) + (zc[j].z + zc[j].w); }
        const float mean = wave_sum(s) * (1.f / DM); float s2 = 0.f;
#pragma unroll
        for (int j = 0; j < 8; ++j) { zc[j] = zc[j] - mean; s2 += (zc[j].x * zc[j].x + zc[j].y * zc[j].y) + (zc[j].z * zc[j].z + zc[j].w * zc[j].w); }
        const float rstd = 1.f / sqrtf(wave_sum(s2) * (1.f / DM) + LN_EPS);
        const LAS float* sh = Lm + bsel * 2 * DM; const LAS float* sc = sh + DM;
        float* zo = TO_OUT ? dout + ((size_t)b * SEQ + (t - NCTX)) * DM : nullptr;
        float qinv = 1.f; v2u qw = {0u, 0u}, hw = {0u, 0u};
        if (!TO_OUT) {
            float am = 0.f;
#pragma unroll
            for (int j = 0; j < 8; ++j) { const int col = 4 * LNI(j);
                const f32x4 z = zc[j] * rstd * *(const LAS f32x4*)(Lg2 + col) + *(const LAS f32x4*)(Lb2 + col);
                am = fmaxf(am, fmaxf(fmaxf(fabsf(z.x), fabsf(z.y)), fmaxf(fabsf(z.z), fabsf(z.w)))); }
            am = wave_max(am); const float scq = am > 0.f ? am * (1.f / 32767.f) : 1.f; qinv = am > 0.f ? 32767.f / am : 1.f;
            if (F.lane == 0) *(GAS float*)((float*)(F.ws + WS_ZS) + m) = scq;
        }
#pragma unroll
        for (int j = 0; j < 8; ++j) { const int col = 4 * LNI(j);
            const f32x4 z = zc[j] * rstd * *(const LAS f32x4*)(Lg2 + col) + *(const LAS f32x4*)(Lb2 + col);
            if (TO_OUT) *(GAS f32x4*)(zo + col) = z;
            else { const int q0 = __float2int_rn(z.x * qinv), q1 = __float2int_rn(z.y * qinv), q2 = __float2int_rn(z.z * qinv), q3 = __float2int_rn(z.w * qinv);
                v2u pw; pw.x = ((unsigned)q0 & 0xffffu) | ((unsigned)q1 << 16); pw.y = ((unsigned)q2 & 0xffffu) | ((unsigned)q3 << 16);
                if (j & 1) *(GAS v4u*)((unsigned short*)Zout + (size_t)m * DM + col - 4) = (v4u){qw.x, qw.y, pw.x, pw.y}; else qw = pw; }
            if (WITH_H) { const f32x4 h = z * (*(const LAS f32x4*)(sc + col) + 1.f) + *(const LAS f32x4*)(sh + col);
                v2u w; w.x = pk2(h.x, h.y); w.y = pk2(h.z, h.w);
                if (j & 1) *(GAS v4u*)(H + (size_t)m * DM + col - 4) = (v4u){hw.x, hw.y, w.x, w.y}; else hw = w; } } };
    int idx = gw; bool have = idx < nmain;
    if (have) { loadz(idx, zA, d1A, stA, sA); loadd2(idx, d2A); }
    {
        f32x4 pv[14];
        pv[0] = ((const GAS f32x4*)gam1)[F.tid]; pv[1] = ((const GAS f32x4*)bet1)[F.tid]; pv[2] = ((const GAS f32x4*)gam2)[F.tid]; pv[3] = ((const GAS f32x4*)bet2)[F.tid];
        if (WITH_H) {
#pragma unroll
            for (int k = 0; k < 10; ++k) { const int v = F.tid + NWAVES * 64 * k, bs = v >> 10, r4 = v & 1023; pv[4 + k] = ((const GAS f32x4*)mod_ptr(F.ws, layer + 1, bs, 0))[r4]; }
        }
        ((LAS f32x4*)Lg1)[F.tid] = pv[0]; ((LAS f32x4*)Lb1)[F.tid] = pv[1]; ((LAS f32x4*)Lg2)[F.tid] = pv[2]; ((LAS f32x4*)Lb2)[F.tid] = pv[3];
        if (WITH_H) {
#pragma unroll
            for (int k = 0; k < 10; ++k) ((LAS f32x4*)Lm)[F.tid + NWAVES * 64 * k] = pv[4 + k];
        }
    }
    __syncthreads();
    while (have) {
        const int nidx = idx + NGWv; const bool hasn = nidx < nmain;
        if (hasn) { loadz(nidx, zB, d1B, stB, sB); loadd2(nidx, d2B); }
        asm volatile("" ::: "memory");
        row2(zA, d1A, d2A, stA, sA, idx);
        if (!hasn) break;
        const int fidx = nidx + NGWv; const bool hasf = fidx < nmain;
        if (hasf) { loadz(fidx, zA, d1A, stA, sA); loadd2(fidx, d2A); }
        asm volatile("" ::: "memory");
        row2(zB, d1B, d2B, stB, sB, nidx);
        idx = fidx; have = hasf;
    }
    if (NSPLIT > 0) {
        for (int ti = 8192 + gw; ti < nrows; ti += NGWv) {
            int m, b, t; LN_ROWINFO(ti, m, b, t);
            loadz(ti, zA, d1A, stA, sA); LN_SPLIT_D(d2A, PART, mod_ptr(F.ws, layer, (t < NCTX) ? 4 : b, 5), m);
            asm volatile("" ::: "memory");
            row2(zA, d1A, d2A, stA, sA, ti);
        }
    }
}
template <bool LAT>
__device__ __forceinline__ void ffn_conv_phase(Frame& F, const bf16* U, bf16* ACT, const float* cw, const float* cb) {
    const int gw = GW(F), NGWv = NGW(F); const int nstrips = (LAT ? NLAT : NTOK) / 16; const int nitems = nstrips * 11;
    for (int it = gw; it < nitems; it += NGWv) {
        const int strip = it / 11, cblk = it % 11; const int c0 = cblk * 512 + F.lane * 8;
        int m0; if (LAT) { const int r = strip * 16; m0 = (r >> 11) * LTOK + NCTX + (r & 2047); } else m0 = strip * 16;
        const int t0 = m0 % LTOK;
        float wg[3][8], wv[3][8], bg[8], bv[8];
#pragma unroll
        for (int k = 0; k < 3; ++k) { const f32x4 a = *(const f32x4*)(cw + (size_t)k * DFF2 + c0), b = *(const f32x4*)(cw + (size_t)k * DFF2 + c0 + 4), c = *(const f32x4*)(cw + (size_t)k * DFF2 + DFF + c0), d = *(const f32x4*)(cw + (size_t)k * DFF2 + DFF + c0 + 4);
#pragma unroll
            for (int j = 0; j < 4; ++j) { wg[k][j] = a[j]; wg[k][4 + j] = b[j]; wv[k][j] = c[j]; wv[k][4 + j] = d[j]; } }
        { const f32x4 a = *(const f32x4*)(cb + c0), b = *(const f32x4*)(cb + c0 + 4), c = *(const f32x4*)(cb + DFF + c0), d = *(const f32x4*)(cb + DFF + c0 + 4);
#pragma unroll
          for (int j = 0; j < 4; ++j) { bg[j] = a[j]; bg[4 + j] = b[j]; bv[j] = c[j]; bv[4 + j] = d[j]; } }
        const bool first_in_seg = (t0 == 0 || t0 == NCTX), last_in_seg = (t0 + 16 == NCTX || t0 + 16 == LTOK);
        const GAS bf16* ug = (const GAS bf16*)U + (size_t)m0 * DFF2 + c0;
        v4u pg = {0u, 0u, 0u, 0u}, pv = {0u, 0u, 0u, 0u};
        if (!first_in_seg) { pg = *(const GAS v4u*)(ug - DFF2); pv = *(const GAS v4u*)(ug - DFF2 + DFF); }
        v4u cg = *(const GAS v4u*)(ug), cv = *(const GAS v4u*)(ug + DFF);
        for (int r = 0; r < 16; ++r) {
            v4u ng = {0u, 0u, 0u, 0u}, nv = {0u, 0u, 0u, 0u};
            if (r < 15 || !last_in_seg) { ng = *(const GAS v4u*)(ug + (size_t)(r + 1) * DFF2); nv = *(const GAS v4u*)(ug + (size_t)(r + 1) * DFF2 + DFF); }
            float o[8];
#pragma unroll
            for (int q = 0; q < 4; ++q) {
                const unsigned pgw = pg[q], cgw = cg[q], ngw = ng[q], pvw = pv[q], cvw = cv[q], nvw = nv[q];
                const float g0 = bg[2 * q] + wg[0][2 * q] * bflo(pgw) + wg[1][2 * q] * bflo(cgw) + wg[2][2 * q] * bflo(ngw);
                const float g1 = bg[2 * q + 1] + wg[0][2 * q + 1] * bfhi(pgw) + wg[1][2 * q + 1] * bfhi(cgw) + wg[2][2 * q + 1] * bfhi(ngw);
                const float v0 = bv[2 * q] + wv[0][2 * q] * bflo(pvw) + wv[1][2 * q] * bflo(cvw) + wv[2][2 * q] * bflo(nvw);
                const float v1 = bv[2 * q + 1] + wv[0][2 * q + 1] * bfhi(pvw) + wv[1][2 * q + 1] * bfhi(cvw) + wv[2][2 * q + 1] * bfhi(nvw);
                o[2 * q] = siluf_(g0) * v0; o[2 * q + 1] = siluf_(g1) * v1; }
            v4u w; w.x = pk2(o[0], o[1]); w.y = pk2(o[2], o[3]); w.z = pk2(o[4], o[5]); w.w = pk2(o[6], o[7]);
            *(GAS v4u*)(ACT + (size_t)(m0 + r) * DFF + c0) = w;
            pg = cg; pv = cv; cg = ng; cv = nv;
        }
    }
}

template <bool LAT>
__device__ __forceinline__ void ffn_fix_phase(Frame& F, const bf16* UB, bf16* ACT, const float* cw, const float* cb) {
    const int gw = GW(F), NGWv = NGW(F); const int nruns = (LAT ? NLAT : NTOK) / 64; const int nitems = nruns * 11;
    for (int it = gw; it < nitems; it += NGWv) {
        const int cblk = it % 11, rl = it / 11;
        int run; if (LAT) { const int r = rl * 64; run = ((r >> 11) * LTOK + NCTX + (r & 2047)) >> 6; } else run = rl;
        const int m0 = run * 64, t0 = m0 % LTOK;
        const bool seg_first = (t0 == 0 || t0 == NCTX), seg_last = (t0 + 64 == NCTX || t0 + 64 == LTOK);
        const int c0 = cblk * 512 + F.lane * 8; const int uc = (c0 >> 7) * 256 + (c0 & 127);
        const GAS bf16* ub = (const GAS bf16*)UB + (size_t)run * 4 * DFF2 + uc;
        v4u rg[6], rv[6];
#pragma unroll
        for (int q = 0; q < 6; ++q) { const int rq = (q == 0 && seg_first) ? 1 : ((q == 5 && seg_last) ? 4 : q);
            const GAS bf16* rp = ub + (ptrdiff_t)(rq - 1) * DFF2; rg[q] = *(const GAS v4u*)rp; rv[q] = *(const GAS v4u*)(rp + 128); }
        float wg[3][8], wv[3][8], bg[8], bv[8];
#pragma unroll
        for (int k = 0; k < 3; ++k) { const GAS float* wp = (const GAS float*)cw + (size_t)k * DFF2 + c0; const f32x4 a = *(const GAS f32x4*)wp, b = *(const GAS f32x4*)(wp + 4), c = *(const GAS f32x4*)(wp + DFF), d = *(const GAS f32x4*)(wp + DFF + 4);
#pragma unroll
            for (int j = 0; j < 4; ++j) { wg[k][j] = a[j]; wg[k][4 + j] = b[j]; wv[k][j] = c[j]; wv[k][4 + j] = d[j]; } }
        { const GAS float* bp = (const GAS float*)cb + c0; const f32x4 a = *(const GAS f32x4*)bp, b = *(const GAS f32x4*)(bp + 4), c = *(const GAS f32x4*)(bp + DFF), d = *(const GAS f32x4*)(bp + DFF + 4);
#pragma unroll
          for (int j = 0; j < 4; ++j) { bg[j] = a[j]; bg[4 + j] = b[j]; bv[j] = c[j]; bv[4 + j] = d[j]; } }
        const float zf = seg_first ? 0.f : 1.f, zl = seg_last ? 0.f : 1.f;
#pragma unroll
        for (int which = 0; which < 2; ++which) {
            const int ip = which ? 3 : 0, ic = which ? 4 : 1, in_ = which ? 5 : 2; const float mp = which ? 1.f : zf, mn = which ? zl : 1.f;
            float o[8];
#pragma unroll
            for (int q = 0; q < 4; ++q) {
                const unsigned pgw = rg[ip][q], cgw = rg[ic][q], ngw = rg[in_][q], pvw = rv[ip][q], cvw = rv[ic][q], nvw = rv[in_][q];
                const float g0 = bg[2 * q] + wg[0][2 * q] * (bflo(pgw) * mp) + wg[1][2 * q] * bflo(cgw) + wg[2][2 * q] * (bflo(ngw) * mn);
                const float g1 = bg[2 * q + 1] + wg[0][2 * q + 1] * (bfhi(pgw) * mp) + wg[1][2 * q + 1] * bfhi(cgw) + wg[2][2 * q + 1] * (bfhi(ngw) * mn);
                const float v0 = bv[2 * q] + wv[0][2 * q] * (bflo(pvw) * mp) + wv[1][2 * q] * bflo(cvw) + wv[2][2 * q] * (bflo(nvw) * mn);
                const float v1 = bv[2 * q + 1] + wv[0][2 * q + 1] * (bfhi(pvw) * mp) + wv[1][2 * q + 1] * bfhi(cvw) + wv[2][2 * q + 1] * (bfhi(nvw) * mn);
                o[2 * q] = siluf_(g0) * v0; o[2 * q + 1] = siluf_(g1) * v1; }
            v4u w; w.x = pk2(o[0], o[1]); w.y = pk2(o[2], o[3]); w.z = pk2(o[4], o[5]); w.w = pk2(o[6], o[7]);
            *(GAS v4u*)(ACT + (size_t)(m0 + (which ? 63 : 0)) * DFF + c0) = w;
        }
    }
}
__device__ __forceinline__ int flip_tok(int s) { return s < NCTX ? (NCTX - 1 - s) : (LTOK + NCTX - 1 - s); }

__device__ __forceinline__ pg8::f32x4 mma_tile(pg8::f32x4 acc, const LAS bf16* A, int lda, const LAS bf16* Bt, int ldb, int ksteps, int lane) {
    const LAS bf16* ap = A + (lane & 15) * lda + (lane >> 4) * 8; const LAS bf16* bp = Bt + (lane & 15) * ldb + (lane >> 4) * 8;
    for (int k = 0; k < ksteps; ++k) { const bf16x8 a = *(const LAS bf16x8*)(ap + k * 32), b = *(const LAS bf16x8*)(bp + k * 32);
        acc = __builtin_amdgcn_mfma_f32_16x16x32_bf16(a, b, acc, 0, 0, 0); }
    return acc;
}
template <int CTRL> __device__ __forceinline__ float dpp_f(float v) { return __int_as_float(__builtin_amdgcn_update_dpp(0, __float_as_int(v), CTRL, 0xF, 0xF, true)); }
__device__ __forceinline__ float red8(float v) { v += dpp_f<0xB1>(v); v += dpp_f<0x4E>(v); v += dpp_f<0x141>(v); return v; }
__device__ __forceinline__ float red16(float v) { v = red8(v); v += dpp_f<0x140>(v); return v; }
__device__ __forceinline__ void unpack8(const v4u w, float (&f)[8]) { f[0] = bflo(w.x); f[1] = bfhi(w.x); f[2] = bflo(w.y); f[3] = bfhi(w.y); f[4] = bflo(w.z); f[5] = bfhi(w.z); f[6] = bflo(w.w); f[7] = bfhi(w.w); }
__device__ __forceinline__ v4u pack8(const float (&f)[8]) { v4u w; w.x = pk2(f[0], f[1]); w.y = pk2(f[2], f[3]); w.z = pk2(f[4], f[5]); w.w = pk2(f[6], f[7]); return w; }
__device__ __forceinline__ void ld8f(const float* p, float (&f)[8]) { const f32x4 a = *(const f32x4*)p, b = *(const f32x4*)(p + 4); f[0] = a.x; f[1] = a.y; f[2] = a.z; f[3] = a.w; f[4] = b.x; f[5] = b.y; f[6] = b.z; f[7] = b.w; }
__device__ __forceinline__ void l0_xs_phase(Frame& F, const float* x, const float* ctx, const float* mu) {
    const int gw = GW(F), NGWv = NGW(F);
    bf16* XS = (bf16*)(F.ws + L0_XS);
    const int c0 = (gw & 3) * 512 + F.lane * 8;
    float mv[6][8];
#pragma unroll
    for (int n = 0; n < 6; ++n) ld8f(mu + (size_t)n * DM + c0, mv[n]);
    for (int it = gw; it < (NTOK / 8) * 4; it += NGWv) {
        const int strip = it >> 2; const int m0 = strip * 8, b = m0 / LTOK, t0 = m0 % LTOK;
        const float* zr = (t0 < NCTX) ? ctx + ((size_t)b * NCTX + t0) * DM : x + ((size_t)b * SEQ + (t0 - NCTX)) * DM;
        const int seg_end = (t0 < NCTX) ? NCTX : LTOK; const bool first = (t0 == 0 || t0 == NCTX);
        const int bsel = (t0 < NCTX) ? 4 : b;
        f32x4 za[10], zb[10];
#pragma unroll
        for (int q = 0; q < 10; ++q) { const bool ok = (q == 0) ? !first : (t0 + q - 1 < seg_end);
            za[q] = (f32x4){0.f, 0.f, 0.f, 0.f}; zb[q] = za[q];
            if (ok) { const GAS float* rp = (const GAS float*)zr + (ptrdiff_t)(q - 1) * DM + c0; za[q] = *(const GAS f32x4*)rp; zb[q] = *(const GAS f32x4*)(rp + 4); } }
        float s0[8], s1[8], hp[8], hc[8], hn[8];
        { const float* sh = mod_ptr(F.ws, 0, bsel, 0) + c0; const float* sc = mod_ptr(F.ws, 0, bsel, 1) + c0;
          const f32x4 a = *(const GAS f32x4*)sh, a2 = *(const GAS f32x4*)(sh + 4), c = *(const GAS f32x4*)sc, c2 = *(const GAS f32x4*)(sc + 4);
#pragma unroll
          for (int j = 0; j < 4; ++j) { s0[j] = a[j]; s0[4 + j] = a2[j]; s1[j] = c[j] + 1.f; s1[4 + j] = c2[j] + 1.f; } }
#pragma unroll
        for (int j = 0; j < 4; ++j) { hp[j] = first ? 0.f : za[0][j] * s1[j] + s0[j]; hp[4 + j] = first ? 0.f : zb[0][j] * s1[4 + j] + s0[4 + j];
                                      hc[j] = za[1][j] * s1[j] + s0[j]; hc[4 + j] = zb[1][j] * s1[4 + j] + s0[4 + j]; }
#pragma unroll
        for (int r = 0; r < 8; ++r) {
            const bool hasn = (t0 + r + 1 < seg_end);
#pragma unroll
            for (int j = 0; j < 4; ++j) { hn[j] = hasn ? za[r + 2][j] * s1[j] + s0[j] : 0.f; hn[4 + j] = hasn ? zb[r + 2][j] * s1[4 + j] + s0[4 + j] : 0.f; }
            const size_t m = (size_t)(m0 + r);
            float dx[8];
#pragma unroll
            for (int j = 0; j < 8; ++j) dx[j] = (hp[j] + hn[j]) * 0.5f - hc[j];
#pragma unroll
            for (int n = 0; n < 6; ++n) { float o[8];
#pragma unroll
                for (int j = 0; j < 8; ++j) o[j] = hc[j] + dx[j] * mv[n][j];
                *(GAS v4u*)(XS + ((size_t)n * NTOK + m) * DM + c0) = pack8(o); }
#pragma unroll
            for (int j = 0; j < 8; ++j) { hp[j] = hc[j]; hc[j] = hn[j]; }
        }
    }
}
__device__ __forceinline__ void l0_prep_phase(Frame& F, const float* k_k, const float* k_a, const float* r_k) {
    const int gw = GW(F), NGWv = NGW(F); unsigned char* ws = F.ws;
    const bf16* R = (const bf16*)(ws + L0_R); const bf16* K = (const bf16*)(ws + L0_K); const bf16* V = (const bf16*)(ws + L0_V);
    bf16* VEC = (bf16*)(ws + L0_VEC); float* SCAL = (float*)(ws + L0_SCAL); float* BONUS = (float*)(ws + L0_BONUS);
    const int l8 = F.lane & 7;
    for (int it = gw; it < NTOK * 4; it += NGWv) {
        const int m = it >> 2, h = (it & 3) * 8 + (F.lane >> 3), b = m / LTOK, t = m % LTOK; const int c0 = h * 64 + l8 * 8; const size_t e = (size_t)m * DM + c0;
        float r[8], k[8], kk[8], tmp[8], par[8];
        unpack8(*(const GAS v4u*)(R + e), r); unpack8(*(const GAS v4u*)(K + e), k);
        const v4u vraw = *(const GAS v4u*)(V + e);
        ld8f(k_k + c0, par); float ss = 0.f;
#pragma unroll
        for (int j = 0; j < 8; ++j) { kk[j] = k[j] * par[j]; ss += kk[j] * kk[j]; }
        ss = red8(ss); const float inv = 1.0f / sqrtf(ss + 1e-12f);
#pragma unroll
        for (int j = 0; j < 8; ++j) kk[j] *= inv;
        float ka[8], kdsum[8]; ld8f(k_a + c0, ka);
#pragma unroll
        for (int j = 0; j < 8; ++j) kdsum[j] = 0.f;
#pragma unroll
        for (int d = 0; d < 2; ++d) {
            float w[8], ic[8], kd[8];
            unpack8(*(const GAS v4u*)((const bf16*)(ws + (d ? L0_DEC1 : L0_DEC0)) + e), w); unpack8(*(const GAS v4u*)((const bf16*)(ws + (d ? L0_IC1 : L0_IC0)) + e), ic);
            float kr = 0.f, kkar = 0.f;
#pragma unroll
            for (int j = 0; j < 8; ++j) { kd[j] = k[j] * (1.f + (ic[j] - 1.f) * ka[j]); kdsum[j] += kd[j]; kr += kd[j] * r[j]; }
            const int s = d ? flip_tok(t) : t; const size_t sidx = (size_t)((d * NB + b) * 32 + h);
            bf16* vp = VEC + (sidx * LTOK + s) * 384 + l8 * 8;
            *(GAS v4u*)(vp) = pack8(w); *(GAS v4u*)(vp + 64) = pack8(kd); *(GAS v4u*)(vp + 128) = pack8(kk);
#pragma unroll
            for (int j = 0; j < 8; ++j) { tmp[j] = kk[j] * ic[j]; kkar += tmp[j] * r[j]; }
            *(GAS v4u*)(vp + 192) = pack8(tmp);
#pragma unroll
            for (int j = 0; j < 8; ++j) tmp[j] = w[j] * r[j];
            *(GAS v4u*)(vp + 256) = pack8(tmp); *(GAS v4u*)(vp + 320) = vraw;
            kr = red8(kr); kkar = red8(kkar);
            if (l8 == 0) *(GAS f32x2*)(SCAL + (sidx * LTOK + s) * 2) = (f32x2){kr, kkar};
        }
        ld8f(r_k + c0, par); float bon = 0.f;
#pragma unroll
        for (int j = 0; j < 8; ++j) bon += r[j] * kdsum[j] * par[j];
        bon = red8(bon);
        if (l8 == 0) BONUS[m * 32 + h] = bon;
    }
}
constexpr int RW_CS = 32;
__device__ __forceinline__ void l0_scan_phase(Frame& F) {
    unsigned char* ws = F.ws; const bf16* VEC = (const bf16*)(ws + L0_VEC); const float* SCAL = (const float*)(ws + L0_SCAL); float* YS = (float*)(ws + L0_YS);
    LAS float* opb = (LAS float*)(F.lds + RING_OFF);
    LAS float* scl = opb + 2 * RW_CS * 384;
    LAS float* ybuf = scl + 2 * RW_CS * 2;
    const int rp = F.tid >> 4, q = F.tid & 15; constexpr int NCH = LTOK / RW_CS;
    for (int sidx = F.vcu; sidx < 256; sidx += F.G) {
        const int d = sidx >> 7, b = (sidx >> 5) & 3, h = sidx & 31;
        const GAS v4u* src = (const GAS v4u*)(VEC + (size_t)sidx * LTOK * 384); const GAS float* ssrc = (const GAS float*)(SCAL + (size_t)sidx * LTOK * 2);
        f32x2 Sa = {0.f, 0.f}, Sb = {0.f, 0.f}, Sc = {0.f, 0.f}, Sd = {0.f, 0.f};
        v4u pre[3]; float psc = 0.f;
#pragma unroll
        for (int k = 0; k < 3; ++k) pre[k] = src[F.tid + 512 * k];
        if (F.tid < RW_CS * 2) psc = ssrc[F.tid];
        __syncthreads();
#pragma unroll
        for (int k = 0; k < 3; ++k) { LAS float* dst = opb + (size_t)(F.tid + 512 * k) * 8; const v4u w = pre[k];
            *(LAS f32x4*)dst = (f32x4){bflo(w.x), bfhi(w.x), bflo(w.y), bfhi(w.y)}; *(LAS f32x4*)(dst + 4) = (f32x4){bflo(w.z), bfhi(w.z), bflo(w.w), bfhi(w.w)}; }
        if (F.tid < RW_CS * 2) scl[F.tid] = psc;
        __syncthreads();
        for (int ch = 0; ch < NCH; ++ch) {
            const int cur = ch & 1;
            if (ch + 1 < NCH) {
#pragma unroll
                for (int k = 0; k < 3; ++k) pre[k] = src[(size_t)(ch + 1) * (RW_CS * 48) + F.tid + 512 * k];
                if (F.tid < RW_CS * 2) psc = ssrc[(ch + 1) * RW_CS * 2 + F.tid]; }
            const LAS float* ob = opb + cur * RW_CS * 384; const LAS float* sb = scl + cur * RW_CS * 2;
            const LAS float* o0 = ob + q * 4; const LAS float* ov = ob + 320 + 2 * rp;
            f32x4 w4 = *(const LAS f32x4*)(o0), k4 = *(const LAS f32x4*)(o0 + 64), c4 = *(const LAS f32x4*)(o0 + 128), a4 = *(const LAS f32x4*)(o0 + 192), r4 = *(const LAS f32x4*)(o0 + 256);
            f32x2 v2 = *(const LAS f32x2*)(ov), sc2 = *(const LAS f32x2*)(sb);
            LAS float* ydst = (q == 0) ? (ybuf + 2 * rp) : (ybuf + RW_CS * 64 + 2 * F.tid);
            const int ystep = (q == 0) ? 64 : 0;
#pragma unroll 4
            for (int s = 0; s < RW_CS; ++s) {
                const int sn = (s + 1 < RW_CS) ? s + 1 : s;
                const LAS float* o = o0 + sn * 384;
                const f32x4 w4n = *(const LAS f32x4*)(o), k4n = *(const LAS f32x4*)(o + 64), c4n = *(const LAS f32x4*)(o + 128), a4n = *(const LAS f32x4*)(o + 192), r4n = *(const LAS f32x4*)(o + 256);
                const f32x2 v2n = *(const LAS f32x2*)(ov + sn * 384), sc2n = *(const LAS f32x2*)(sb + sn * 2);
                f32x2 sa = Sa * c4.x; sa = Sb * c4.y + sa; sa = Sc * c4.z + sa; sa = Sd * c4.w + sa;
                f32x2 yy = Sa * r4.x; yy = Sb * r4.y + yy; yy = Sc * r4.z + yy; yy = Sd * r4.w + yy;
                float sa0 = sa.x, sa1 = sa.y, y0 = yy.x, y1 = yy.y;
                asm volatile("s_nop 1\n\t"
                    "v_add_f32_dpp %0, %0, %0 quad_perm:[1,0,3,2] row_mask:0xf bank_mask:0xf bound_ctrl:1\n\t" "v_add_f32_dpp %1, %1, %1 quad_perm:[1,0,3,2] row_mask:0xf bank_mask:0xf bound_ctrl:1\n\t"
                    "v_add_f32_dpp %2, %2, %2 quad_perm:[1,0,3,2] row_mask:0xf bank_mask:0xf bound_ctrl:1\n\t" "v_add_f32_dpp %3, %3, %3 quad_perm:[1,0,3,2] row_mask:0xf bank_mask:0xf bound_ctrl:1\n\t"
                    "v_add_f32_dpp %0, %0, %0 quad_perm:[2,3,0,1] row_mask:0xf bank_mask:0xf bound_ctrl:1\n\t" "v_add_f32_dpp %1, %1, %1 quad_perm:[2,3,0,1] row_mask:0xf bank_mask:0xf bound_ctrl:1\n\t"
                    "v_add_f32_dpp %2, %2, %2 quad_perm:[2,3,0,1] row_mask:0xf bank_mask:0xf bound_ctrl:1\n\t" "v_add_f32_dpp %3, %3, %3 quad_perm:[2,3,0,1] row_mask:0xf bank_mask:0xf bound_ctrl:1\n\t"
                    "v_add_f32_dpp %0, %0, %0 row_half_mirror row_mask:0xf bank_mask:0xf bound_ctrl:1\n\t" "v_add_f32_dpp %1, %1, %1 row_half_mirror row_mask:0xf bank_mask:0xf bound_ctrl:1\n\t"
                    "v_add_f32_dpp %2, %2, %2 row_half_mirror row_mask:0xf bank_mask:0xf bound_ctrl:1\n\t" "v_add_f32_dpp %3, %3, %3 row_half_mirror row_mask:0xf bank_mask:0xf bound_ctrl:1\n\t"
                    "v_add_f32_dpp %0, %0, %0 row_mirror row_mask:0xf bank_mask:0xf bound_ctrl:1\n\t" "v_add_f32_dpp %1, %1, %1 row_mirror row_mask:0xf bank_mask:0xf bound_ctrl:1\n\t"
                    "v_add_f32_dpp %2, %2, %2 row_mirror row_mask:0xf bank_mask:0xf bound_ctrl:1\n\t" "v_add_f32_dpp %3, %3, %3 row_mirror row_mask:0xf bank_mask:0xf bound_ctrl:1\n\t"
                    "s_nop 0"
                    : "+v"(sa0), "+v"(sa1), "+v"(y0), "+v"(y1));
                sa = (f32x2){sa0, sa1}; yy = (f32x2){y0, y1};
                yy = yy + (v2 * sc2.x - sa * sc2.y);
                Sa = Sa * w4.x + (v2 * k4.x - sa * a4.x); Sb = Sb * w4.y + (v2 * k4.y - sa * a4.y); Sc = Sc * w4.z + (v2 * k4.z - sa * a4.z); Sd = Sd * w4.w + (v2 * k4.w - sa * a4.w);
                *(LAS f32x2*)(ydst + s * ystep) = yy;
                w4 = w4n; k4 = k4n; c4 = c4n; a4 = a4n; r4 = r4n; v2 = v2n; sc2 = sc2n;
            }
            __syncthreads();
            {
                const int s = F.tid >> 4, i4 = (F.tid & 15) * 4; const int step = ch * RW_CS + s; const int t = d ? flip_tok(step) : step;
                const f32x4 yv = *(const LAS f32x4*)(ybuf + s * 64 + i4);
                *(GAS f32x4*)(YS + ((size_t)d * NTOK + (size_t)b * LTOK + t) * DM + h * 64 + i4) = yv; }
            if (ch + 1 < NCH) {
                LAS float* nb = opb + (cur ^ 1) * RW_CS * 384;
#pragma unroll
                for (int k = 0; k < 3; ++k) { LAS float* dst = nb + (size_t)(F.tid + 512 * k) * 8; const v4u w = pre[k];
                    *(LAS f32x4*)dst = (f32x4){bflo(w.x), bfhi(w.x), bflo(w.y), bfhi(w.y)}; *(LAS f32x4*)(dst + 4) = (f32x4){bflo(w.z), bfhi(w.z), bflo(w.w), bfhi(w.w)}; }
                if (F.tid < RW_CS * 2) scl[(cur ^ 1) * RW_CS * 2 + F.tid] = psc; }
            __syncthreads();
        }
    }
}
__device__ __forceinline__ void l0_cscan_phase(Frame& F, const float* k_k, const float* k_a, const float* r_k) {
    unsigned char* ws = F.ws; float* YS = (float*)(ws + L0_XS); float* BON = (float*)(ws + L0_BONUS);
    constexpr int PA = 72, PB = 40, NCH = LTOK / 16;
    LAS bf16* RAW = (LAS bf16*)(F.lds + RING_OFF);
    LAS bf16* Ah = RAW + 5 * 16 * PA; LAS bf16* Rh = Ah + 16 * PA; LAS bf16* Kh = Rh + 16 * PA; LAS bf16* Bh = Kh + 16 * PA;
    LAS bf16* KBt = Bh + 16 * PA;
    LAS bf16* VSt = KBt + 64 * PB;
    LAS bf16* LKp = VSt + 64 * PB;
    LAS bf16* UKB = LKp + 16 * PB;
    LAS bf16* Sb = UKB + 16 * PB;
    LAS float* LB = (LAS float*)(Sb + 64 * PA);
    LAS float* RH = LB + 16 * 20;
    LAS float* Wend = RH + 16 * 68;
    const int tid = F.tid, lane = F.lane, w = F.wave;
    for (int sidx = F.vcu; sidx < 256; sidx += F.G) {
        const int d = sidx >> 7, b = (sidx >> 5) & 3, h = sidx & 31;
        const GAS bf16* gR = (const GAS bf16*)(ws + L0_R) + (size_t)b * LTOK * DM + h * 64;
        const GAS bf16* gK = (const GAS bf16*)(ws + L0_K) + (size_t)b * LTOK * DM + h * 64;
        const GAS bf16* gV = (const GAS bf16*)(ws + L0_V) + (size_t)b * LTOK * DM + h * 64;
        const GAS bf16* gD = (const GAS bf16*)(ws + (d ? L0_DEC1 : L0_DEC0)) + (size_t)b * LTOK * DM + h * 64;
        const GAS bf16* gI = (const GAS bf16*)(ws + (d ? L0_IC1 : L0_IC0)) + (size_t)b * LTOK * DM + h * 64;
        const int ft = tid >> 5, fpart = tid & 31, fti = fpart >> 3, fc = (fpart & 7) * 8;
        const GAS bf16* fbase = fti == 0 ? gR : (fti == 1 ? gK : (fti == 2 ? gV : gD));
        const int t1 = tid >> 5, jp = tid & 31, j2 = 2 * jp;
        const f32x2 kk2 = *(const f32x2*)(k_k + h * 64 + j2), ka2 = *(const f32x2*)(k_a + h * 64 + j2), rk2 = *(const f32x2*)(r_k + h * 64 + j2);
        __syncthreads();
        for (int i = tid; i < 64 * PA / 2; i += 512) ((LAS unsigned*)Sb)[i] = 0u;
        for (int i = tid; i < 64 * PB / 2; i += 512) ((LAS unsigned*)VSt)[i] = 0u;
        for (int i = tid; i < 16 * PB / 2; i += 512) ((LAS unsigned*)LKp)[i] = 0u;
        pg8::f32x4 ST[2]; ST[0] = (pg8::f32x4){0.f, 0.f, 0.f, 0.f}; ST[1] = ST[0];
        v4u pa, pb = {0u, 0u, 0u, 0u};
#define CS_FETCH(chn) do { { const int step_ = (chn) * 16 + ft; const int tk_ = d ? flip_tok(step_) : step_; pa = *(const GAS v4u*)(fbase + (size_t)tk_ * DM + fc); } \
            if (tid < 128) { const int step_ = (chn) * 16 + (tid >> 3); const int tk_ = d ? flip_tok(step_) : step_; pb = *(const GAS v4u*)(gI + (size_t)tk_ * DM + (tid & 7) * 8); } } while (0)
        CS_FETCH(0);
        for (int ch = 0; ch < NCH; ++ch) {
            *(LAS v4u*)(RAW + (fti * 16 + ft) * PA + fc) = pa;
            if (tid < 128) *(LAS v4u*)(RAW + (4 * 16 + (tid >> 3)) * PA + (tid & 7) * 8) = pb;
            if (ch + 1 < NCH) CS_FETCH(ch + 1);
            LDS_BARRIER();
            {
                const unsigned rw = *(const LAS unsigned*)(RAW + (0 * 16 + t1) * PA + j2), kw = *(const LAS unsigned*)(RAW + (1 * 16 + t1) * PA + j2), vw = *(const LAS unsigned*)(RAW + (2 * 16 + t1) * PA + j2);
                const unsigned iw = *(const LAS unsigned*)(RAW + (4 * 16 + t1) * PA + j2);
                const f32x2 r = {bflo(rw), bfhi(rw)}, k = {bflo(kw), bfhi(kw)}, ic = {bflo(iw), bfhi(iw)};
                f32x2 kkv = k * kk2; float ss = kkv.x * kkv.x + kkv.y * kkv.y; ss = red16(ss); ss += __shfl_xor(ss, 16);
                kkv = kkv * (1.0f / sqrtf(ss + 1e-12f));
                const f32x2 kd = k * ((ic - 1.f) * ka2 + 1.f), kka = kkv * ic;
                float bon = r.x * kd.x * rk2.x + r.y * kd.y * rk2.y; bon = red16(bon); bon += __shfl_xor(bon, 16);
                const int step = ch * 16 + t1; const int tk = d ? flip_tok(step) : step;
                if (jp == 0) BON[((size_t)d * NTOK + (size_t)b * LTOK + tk) * 32 + h] = bon;
                f32x2 Wm = {1.f, 1.f};
#pragma unroll
                for (int u = 0; u < 15; ++u) { const unsigned dw = *(const LAS unsigned*)(RAW + (3 * 16 + u) * PA + j2); if (u < t1) { Wm.x *= bflo(dw); Wm.y *= bfhi(dw); } }
                const unsigned dwt = *(const LAS unsigned*)(RAW + (3 * 16 + t1) * PA + j2);
                const f32x2 Wt = {Wm.x * bflo(dwt), Wm.y * bfhi(dwt)}; const f32x2 iW = {__builtin_amdgcn_rcpf(Wt.x), __builtin_amdgcn_rcpf(Wt.y)};
                const f32x2 ah = kkv * Wm, bh = kka * iW, kh = kd * iW, rh = r * Wt;
                *(LAS unsigned*)(Ah + t1 * PA + j2) = pk2(ah.x, ah.y); *(LAS unsigned*)(Rh + t1 * PA + j2) = pk2(rh.x, rh.y);
                *(LAS unsigned*)(Kh + t1 * PA + j2) = pk2(kh.x, kh.y); *(LAS unsigned*)(Bh + t1 * PA + j2) = pk2(bh.x, bh.y);
                const unsigned khw = pk2(kh.x, kh.y), nbw = pk2(-bh.x, -bh.y);
                KBt[j2 * PB + t1] = (bf16)(khw & 0xffff); KBt[(j2 + 1) * PB + t1] = (bf16)(khw >> 16);
                KBt[j2 * PB + 16 + t1] = (bf16)(nbw & 0xffff); KBt[(j2 + 1) * PB + 16 + t1] = (bf16)(nbw >> 16);
                VSt[j2 * PB + t1] = (bf16)(vw & 0xffff); VSt[(j2 + 1) * PB + t1] = (bf16)(vw >> 16);
                if (t1 == 15) *(LAS f32x2*)(Wend + j2) = Wt;
            }
            LDS_BARRIER();
            pg8::f32x4 accg = {0.f, 0.f, 0.f, 0.f};
            const int tr = (lane >> 4) * 4, uc = lane & 15;
            if (w < 4) {
                pg8::f32x4 a = {0.f, 0.f, 0.f, 0.f};
                a = mma_tile(a, (w < 2) ? Ah : Rh, PA, (w == 0 || w == 3) ? Bh : Kh, PA, 2, lane);
#pragma unroll
                for (int r = 0; r < 4; ++r) { const int t = tr + r; const float x = a[r];
                    if (w == 0) LB[uc * 20 + t] = (uc < t) ? x : 0.f;
                    else if (w == 1) LKp[t * PB + uc] = f2bf((uc < t) ? x : 0.f);
                    else if (w == 2) UKB[t * PB + uc] = f2bf((uc <= t) ? x : 0.f);
                    else UKB[t * PB + 16 + uc] = f2bf((uc <= t) ? -x : 0.f); }
            } else accg = mma_tile(accg, Ah, PA, Sb + (w - 4) * 16 * PA, PA, 2, lane);
            LDS_BARRIER();
            pg8::f32x4 accy = {0.f, 0.f, 0.f, 0.f};
            if (w >= 4) { accg = mma_tile(accg, LKp, PB, VSt + (w - 4) * 16 * PB, PB, 1, lane);
#pragma unroll
                for (int r = 0; r < 4; ++r) RH[(tr + r) * 68 + (w - 4) * 16 + uc] = accg[r]; }
            else accy = mma_tile(accy, Rh, PA, Sb + w * 16 * PA, PA, 2, lane);
            LDS_BARRIER();
            if (w == 7) {
                float sg[16];
#pragma unroll
                for (int t = 0; t < 16; ++t) sg[t] = RH[t * 68 + lane];
#pragma unroll
                for (int u = 0; u < 15; ++u) {
#pragma unroll
                    for (int g4 = (u + 1) / 4; g4 < 4; ++g4) { const pg8::f32x4 l4 = *(const LAS pg8::f32x4*)(LB + u * 20 + g4 * 4);
#pragma unroll
                        for (int r = 0; r < 4; ++r) { const int t = g4 * 4 + r; if (t > u) sg[t] -= l4[r] * sg[u]; } } }
                v4u o; o.x = pk2(sg[0], sg[1]); o.y = pk2(sg[2], sg[3]); o.z = pk2(sg[4], sg[5]); o.w = pk2(sg[6], sg[7]); *(LAS v4u*)(VSt + lane * PB + 16) = o;
                o.x = pk2(sg[8], sg[9]); o.y = pk2(sg[10], sg[11]); o.z = pk2(sg[12], sg[13]); o.w = pk2(sg[14], sg[15]); *(LAS v4u*)(VSt + lane * PB + 24) = o;
            }
            LDS_BARRIER();
            if (w < 4) { accy = mma_tile(accy, UKB, PB, VSt + w * 16 * PB, PB, 1, lane);
#pragma unroll
                for (int r = 0; r < 4; ++r) { const int step = ch * 16 + tr + r; const int tk = d ? flip_tok(step) : step;
                    YS[((size_t)d * NTOK + (size_t)b * LTOK + tk) * DM + h * 64 + w * 16 + uc] = accy[r]; } }
            { const int jb = w >> 1; const pg8::f32x4 we = *(const LAS pg8::f32x4*)(Wend + jb * 16 + tr);
#pragma unroll
              for (int q = 0; q < 2; ++q) { const int ib = (w & 1) * 2 + q;
                  pg8::f32x4 a = mma_tile(ST[q], KBt + jb * 16 * PB, PB, VSt + ib * 16 * PB, PB, 1, lane);
                  a = a * we; ST[q] = a;
                  v2u sw; sw.x = pk2(a[0], a[1]); sw.y = pk2(a[2], a[3]);
                  *(LAS v2u*)(Sb + (ib * 16 + uc) * PA + jb * 16 + tr) = sw; } }
            LDS_BARRIER();
        }
#undef CS_FETCH
    }
}
__device__ __forceinline__ void l0_cscan2_phase(Frame& F, const float* k_k, const float* k_a, const float* r_k) {
    unsigned char* ws = F.ws; bf16* YS = (bf16*)(ws + L0_XS); float* BON = (float*)(ws + L0_BONUS);
    constexpr int PA = 72, PB = 40, NCH = LTOK / 16;
    constexpr int O_AH = 0, O_RH = 16 * PA, O_KH = 32 * PA, O_BH = 48 * PA, O_KBT = 64 * PA, O_VST = O_KBT + 64 * PB, O_LKP = O_VST + 64 * PB, O_UKB = O_LKP + 16 * PB, SETSZ = O_UKB + 16 * PB;
    static_assert(SETSZ % 8 == 0, "set size keeps 16-byte alignment");
    constexpr int FSZ = 320 + 16 * 64;
    LAS bf16* SET = (LAS bf16*)(F.lds + RING_OFF);
    LAS bf16* RAW = SET + 2 * SETSZ;
    LAS bf16* Sb = RAW + 4 * 16 * PA;
    LAS float* FSET = (LAS float*)(Sb + 64 * PA);
    LAS float* RH = FSET + 2 * FSZ;
    const int tid = F.tid, lane = F.lane, w = F.wave;
    const int tr = (lane >> 4) * 4, uc = lane & 15;
    for (int sidx = F.vcu; sidx < 256; sidx += F.G) {
        const int d = sidx >> 7, b = (sidx >> 5) & 3, h = sidx & 31;
        const GAS bf16* gR = (const GAS bf16*)(ws + L0_R) + (size_t)b * LTOK * DM + h * 64;
        const GAS bf16* gK = (const GAS bf16*)(ws + L0_K) + (size_t)b * LTOK * DM + h * 64;
        const GAS bf16* gV = (const GAS bf16*)(ws + L0_V) + (size_t)b * LTOK * DM + h * 64;
        const GAS bf16* gD = (const GAS bf16*)(ws + (d ? L0_DEC1 : L0_DEC0)) + (size_t)b * LTOK * DM + h * 64;
        const GAS bf16* gI = (const GAS bf16*)(ws + (d ? L0_IC1 : L0_IC0)) + (size_t)b * LTOK * DM + h * 64;
        const int ft = tid >> 5, fpart = tid & 31, fti = fpart >> 3, fc = (fpart & 7) * 8;
        const GAS bf16* fbase = fti == 0 ? gR : (fti == 1 ? gK : (fti == 2 ? gV : gI));
        const int t1 = (tid >> 4) & 15, j4 = (tid & 15) * 4;
        const f32x4 kk4 = *(const f32x4*)(k_k + h * 64 + j4), ka4 = *(const f32x4*)(k_a + h * 64 + j4), rk4 = *(const f32x4*)(r_k + h * 64 + j4);
        __syncthreads();
        for (int i = tid; i < 64 * PA / 2; i += 512) ((LAS unsigned*)Sb)[i] = 0u;
        for (int i = tid; i < 2 * SETSZ / 2; i += 512) ((LAS unsigned*)SET)[i] = 0u;
        pg8::f32x4 ST[2]; ST[0] = (pg8::f32x4){0.f, 0.f, 0.f, 0.f}; ST[1] = ST[0];
        v4u pa; bf16 dq[16];
#define CS_FETCH(chn) do { { const int step_ = (chn) * 16 + ft; const int tk_ = d ? flip_tok(step_) : step_; pa = *(const GAS v4u*)(fbase + (size_t)tk_ * DM + fc); } \
            if (w == 4) { _Pragma("unroll") for (int t_ = 0; t_ < 16; ++t_) { const int step_ = (chn) * 16 + t_; const int tk_ = d ? flip_tok(step_) : step_; dq[t_] = gD[(size_t)tk_ * DM + lane]; } } } while (0)
#define CS_RAWWRITE(st) do { *(LAS v4u*)(RAW + (fti * 16 + ft) * PA + fc) = pa; \
            if (w == 4) { float W_ = 1.f; LAS float* wc_ = FSET + (st) * FSZ + 320 + lane; _Pragma("unroll") for (int t_ = 0; t_ < 16; ++t_) { W_ *= bf2f(dq[t_]); wc_[t_ * 64] = W_; } } } while (0)
#define CS_STEP1(chn, st) do { LAS bf16* S_ = SET + (st) * SETSZ; const LAS float* wc_ = FSET + (st) * FSZ + 320; \
            const v2u rw = *(const LAS v2u*)(RAW + (0 * 16 + t1) * PA + j4), kw = *(const LAS v2u*)(RAW + (1 * 16 + t1) * PA + j4), vw = *(const LAS v2u*)(RAW + (2 * 16 + t1) * PA + j4), iw = *(const LAS v2u*)(RAW + (3 * 16 + t1) * PA + j4); \
            const f32x4 r = {bflo(rw.x), bfhi(rw.x), bflo(rw.y), bfhi(rw.y)}, k = {bflo(kw.x), bfhi(kw.x), bflo(kw.y), bfhi(kw.y)}, ic = {bflo(iw.x), bfhi(iw.x), bflo(iw.y), bfhi(iw.y)}; \
            const f32x4 Wt = *(const LAS f32x4*)(wc_ + t1 * 64 + j4); f32x4 Wm = {1.f, 1.f, 1.f, 1.f}; if (t1 > 0) Wm = *(const LAS f32x4*)(wc_ + (t1 - 1) * 64 + j4); \
            f32x4 kkv = k * kk4; float ss = (kkv.x * kkv.x + kkv.y * kkv.y) + (kkv.z * kkv.z + kkv.w * kkv.w); \
            const f32x4 kd = k * ((ic - 1.f) * ka4 + 1.f); const f32x4 bt = r * kd * rk4; float bon = (bt.x + bt.y) + (bt.z + bt.w); \
            ss = red16(ss); bon = red16(bon); \
            kkv = kkv * __builtin_amdgcn_rsqf(ss + 1e-12f); const f32x4 kka = kkv * ic; \
            const int step = (chn) * 16 + t1; const int tk = d ? flip_tok(step) : step; \
            if ((tid & 15) == 0) BON[((size_t)d * NTOK + (size_t)b * LTOK + tk) * 32 + h] = bon; \
            const f32x4 iW = {__builtin_amdgcn_rcpf(Wt.x), __builtin_amdgcn_rcpf(Wt.y), __builtin_amdgcn_rcpf(Wt.z), __builtin_amdgcn_rcpf(Wt.w)}; \
            const f32x4 ah = kkv * Wm, bh = kka * iW, kh = kd * iW, rh = r * Wt; \
            v2u o_; o_.x = pk2(ah.x, ah.y); o_.y = pk2(ah.z, ah.w); *(LAS v2u*)(S_ + O_AH + t1 * PA + j4) = o_; \
            o_.x = pk2(rh.x, rh.y); o_.y = pk2(rh.z, rh.w); *(LAS v2u*)(S_ + O_RH + t1 * PA + j4) = o_; \
            v2u kh_; kh_.x = pk2(kh.x, kh.y); kh_.y = pk2(kh.z, kh.w); *(LAS v2u*)(S_ + O_KH + t1 * PA + j4) = kh_; \
            o_.x = pk2(bh.x, bh.y); o_.y = pk2(bh.z, bh.w); *(LAS v2u*)(S_ + O_BH + t1 * PA + j4) = o_; \
            v2u nb_; nb_.x = pk2(-bh.x, -bh.y); nb_.y = pk2(-bh.z, -bh.w); \
            LAS bf16* kb_ = S_ + O_KBT + j4 * PB + t1; LAS bf16* vs_ = S_ + O_VST + j4 * PB + t1; \
            kb_[0] = (bf16)(kh_.x & 0xffff); kb_[PB] = (bf16)(kh_.x >> 16); kb_[2 * PB] = (bf16)(kh_.y & 0xffff); kb_[3 * PB] = (bf16)(kh_.y >> 16); \
            kb_[16] = (bf16)(nb_.x & 0xffff); kb_[PB + 16] = (bf16)(nb_.x >> 16); kb_[2 * PB + 16] = (bf16)(nb_.y & 0xffff); kb_[3 * PB + 16] = (bf16)(nb_.y >> 16); \
            vs_[0] = (bf16)(vw.x & 0xffff); vs_[PB] = (bf16)(vw.x >> 16); vs_[2 * PB] = (bf16)(vw.y & 0xffff); vs_[3 * PB] = (bf16)(vw.y >> 16); } while (0)
#define CS_STEP2(wq, st) do { LAS bf16* S_ = SET + (st) * SETSZ; LAS float* LB_ = FSET + (st) * FSZ; pg8::f32x4 a = {0.f, 0.f, 0.f, 0.f}; \
            a = mma_tile(a, S_ + (((wq) < 2) ? O_AH : O_RH), PA, S_ + (((wq) == 0 || (wq) == 3) ? O_BH : O_KH), PA, 2, lane); \
            _Pragma("unroll") for (int r = 0; r < 4; ++r) { const int t = tr + r; const float x = a[r]; \
                if ((wq) == 0) LB_[uc * 20 + t] = (uc < t) ? x : 0.f; \
                else if ((wq) == 1) S_[O_LKP + t * PB + uc] = f2bf((uc < t) ? x : 0.f); \
                else if ((wq) == 2) S_[O_UKB + t * PB + uc] = f2bf((uc <= t) ? x : 0.f); \
                else S_[O_UKB + t * PB + 16 + uc] = f2bf((uc <= t) ? -x : 0.f); } } while (0)
        CS_FETCH(0); CS_RAWWRITE(0); CS_FETCH(1);
        LDS_BARRIER();
        if (w < 4) CS_STEP1(0, 0);
        LDS_BARRIER();
        if (w < 4) CS_STEP2(w, 0);
        LDS_BARRIER();
        asm volatile("" : "+v"(pa));
        for (int ch = 0; ch < NCH; ++ch) {
            const int cur = ch & 1, nxt = cur ^ 1; LAS bf16* C_ = SET + cur * SETSZ; LAS float* FC_ = FSET + cur * FSZ;
            if (ch + 1 < NCH) { CS_RAWWRITE(nxt); if (ch + 2 < NCH) CS_FETCH(ch + 2); }
            pg8::f32x4 accy = {0.f, 0.f, 0.f, 0.f};
            if (w >= 4) { pg8::f32x4 accg = {0.f, 0.f, 0.f, 0.f};
                accg = mma_tile(accg, C_ + O_AH, PA, Sb + (w - 4) * 16 * PA, PA, 2, lane);
                accg = mma_tile(accg, C_ + O_LKP, PB, C_ + O_VST + (w - 4) * 16 * PB, PB, 1, lane);
#pragma unroll
                for (int r = 0; r < 4; ++r) RH[(tr + r) * 68 + (w - 4) * 16 + uc] = accg[r]; }
            else accy = mma_tile(accy, C_ + O_RH, PA, Sb + w * 16 * PA, PA, 2, lane);
            LDS_BARRIER();
            if (w == 7) {
                float sg[16];
#pragma unroll
                for (int t = 0; t < 16; ++t) sg[t] = RH[t * 68 + lane];
#pragma unroll
                for (int u = 0; u < 15; ++u) {
#pragma unroll
                    for (int g4 = (u + 1) / 4; g4 < 4; ++g4) { const pg8::f32x4 l4 = *(const LAS pg8::f32x4*)(FC_ + u * 20 + g4 * 4);
#pragma unroll
                        for (int r = 0; r < 4; ++r) { const int t = g4 * 4 + r; if (t > u) sg[t] -= l4[r] * sg[u]; } } }
                v4u o; o.x = pk2(sg[0], sg[1]); o.y = pk2(sg[2], sg[3]); o.z = pk2(sg[4], sg[5]); o.w = pk2(sg[6], sg[7]); *(LAS v4u*)(C_ + O_VST + lane * PB + 16) = o;
                o.x = pk2(sg[8], sg[9]); o.y = pk2(sg[10], sg[11]); o.z = pk2(sg[12], sg[13]); o.w = pk2(sg[14], sg[15]); *(LAS v4u*)(C_ + O_VST + lane * PB + 24) = o;
            } else if (w < 4 && ch + 1 < NCH) CS_STEP1(ch + 1, nxt);
            LDS_BARRIER();
            { const int jb = w >> 1, ib0 = (w & 1) * 2; const pg8::f32x4 we = *(const LAS pg8::f32x4*)(FC_ + 320 + 15 * 64 + jb * 16 + tr);
              if (w < 4) accy = mma_tile(accy, C_ + O_UKB, PB, C_ + O_VST + w * 16 * PB, PB, 1, lane);
              pg8::f32x4 a0 = mma_tile(ST[0], C_ + O_KBT + jb * 16 * PB, PB, C_ + O_VST + ib0 * 16 * PB, PB, 1, lane);
              pg8::f32x4 a1 = mma_tile(ST[1], C_ + O_KBT + jb * 16 * PB, PB, C_ + O_VST + (ib0 + 1) * 16 * PB, PB, 1, lane);
              pg8::f32x4 a2 = {0.f, 0.f, 0.f, 0.f}; const int wq = w - 4; LAS bf16* N_ = SET + nxt * SETSZ; LAS float* LBn = FSET + nxt * FSZ;
              const bool do2 = (w >= 4 && ch + 1 < NCH);
              if (do2) a2 = mma_tile(a2, N_ + ((wq < 2) ? O_AH : O_RH), PA, N_ + ((wq == 0 || wq == 3) ? O_BH : O_KH), PA, 2, lane);
              a0 = a0 * we; a1 = a1 * we; ST[0] = a0; ST[1] = a1;
              asm volatile("" : "+v"(pa));
              if (w < 4) {
#pragma unroll
                  for (int r = 0; r < 4; ++r) { const int step = ch * 16 + tr + r; const int tk = d ? flip_tok(step) : step;
                      YS[((size_t)d * NTOK + (size_t)b * LTOK + tk) * DM + h * 64 + w * 16 + uc] = f2bf(accy[r]); } }
              v2u sw; sw.x = pk2(a0[0], a0[1]); sw.y = pk2(a0[2], a0[3]); *(LAS v2u*)(Sb + (ib0 * 16 + uc) * PA + jb * 16 + tr) = sw;
              sw.x = pk2(a1[0], a1[1]); sw.y = pk2(a1[2], a1[3]); *(LAS v2u*)(Sb + ((ib0 + 1) * 16 + uc) * PA + jb * 16 + tr) = sw;
              if (do2) {
#pragma unroll
                  for (int r = 0; r < 4; ++r) { const int t = tr + r; const float x = a2[r];
                      if (wq == 0) LBn[uc * 20 + t] = (uc < t) ? x : 0.f;
                      else if (wq == 1) N_[O_LKP + t * PB + uc] = f2bf((uc < t) ? x : 0.f);
                      else if (wq == 2) N_[O_UKB + t * PB + uc] = f2bf((uc <= t) ? x : 0.f);
                      else N_[O_UKB + t * PB + 16 + uc] = f2bf((uc <= t) ? -x : 0.f); } } }
            LDS_BARRIER();
        }
#undef CS_FETCH
#undef CS_RAWWRITE
#undef CS_STEP1
#undef CS_STEP2
    }
}
__device__ __forceinline__ void l0_post_phase(Frame& F, const float* gn_g, const float* gn_b) {
    const int gw = GW(F), NGWv = NGW(F); unsigned char* ws = F.ws;
    const bf16* YS = (const bf16*)(ws + L0_XS); const bf16* V = (const bf16*)(ws + L0_V); const bf16* G = (const bf16*)(ws + L0_G); const float* BONUS = (const float*)(ws + L0_BONUS);
    bf16* OUTB = (bf16*)(ws + WS_OUTB); const int l8 = F.lane & 7;
    const int hh = (gw & 3) * 8 + (F.lane >> 3), c0 = hh * 64 + l8 * 8;
    float gg[8], gb[8]; ld8f(gn_g + c0, gg); ld8f(gn_b + c0, gb);
    constexpr int UB = 3;
    for (int it0 = gw; it0 < NTOK * 4; it0 += UB * NGWv) {
        v4u wya[UB], wyb[UB], wv[UB], wg[UB]; float b0[UB], b1[UB];
#pragma unroll
        for (int u = 0; u < UB; ++u) { const int it = it0 + u * NGWv; if (it < NTOK * 4) { const int m = it >> 2; const size_t e = (size_t)m * DM + c0;
            wya[u] = *(const GAS v4u*)(YS + e); wyb[u] = *(const GAS v4u*)(YS + (size_t)NTOK * DM + e); wv[u] = *(const GAS v4u*)(V + e); wg[u] = *(const GAS v4u*)(G + e);
            b0[u] = *(const GAS float*)(BONUS + m * 32 + hh); b1[u] = *(const GAS float*)(BONUS + (size_t)NTOK * 32 + m * 32 + hh); } }
#pragma unroll
        for (int u = 0; u < UB; ++u) { const int it = it0 + u * NGWv; if (it < NTOK * 4) { const int m = it >> 2; const size_t e = (size_t)m * DM + c0;
            float y[8], y2[8], v[8], g[8];
            { float ya[8], yb[8]; unpack8(wya[u], ya); unpack8(wyb[u], yb);
#pragma unroll
              for (int j = 0; j < 8; ++j) y[j] = ya[j] + yb[j]; }
            unpack8(wv[u], v); unpack8(wg[u], g);
            float s = 0.f;
#pragma unroll
            for (int j = 0; j < 8; ++j) s += y[j];
            const float mean = red8(s) * (1.f / 64.f); float q2 = 0.f;
#pragma unroll
            for (int j = 0; j < 8; ++j) { y[j] -= mean; q2 += y[j] * y[j]; }
            const float rstd = 1.0f / sqrtf(red8(q2) * (1.f / 64.f) + 64e-5f);
            const float bon = b0[u] + b1[u];
#pragma unroll
            for (int j = 0; j < 8; ++j) y2[j] = ((y[j] * rstd) * gg[j] + gb[j] + bon * v[j]) * g[j];
            *(GAS v4u*)(OUTB + e) = pack8(y2); } }
    }
}

__device__ __forceinline__ void l1_rope_phase(Frame& F) {
    bf16* QKV = (bf16*)(F.ws + L1_QKV); const float* RT = (const float*)(F.ws + WS_ROPE);
    const size_t total = (size_t)NLAT * 256; const size_t stride = (size_t)F.G * 512;
    for (size_t it = (size_t)F.vcu * 512 + F.tid; it < total; it += stride) {
        const int idx = (int)(it >> 8), sub = (int)(it & 255); const int hd = sub >> 3, ax = (sub >> 2) & 1, g8 = sub & 3;
        const int b = idx >> 11, t = NCTX + (idx & 2047); const size_t m = (size_t)b * LTOK + t;
        bf16* pa = QKV + m * 6144 + hd * 128 + ax * 64 + g8 * 8; bf16* pb = pa + 32;
        const v4u wa = *(const GAS v4u*)pa, wb = *(const GAS v4u*)pb;
        const float* cs = RT + ((size_t)t * 64 + ax * 32 + g8 * 8) * 2;
        float a[8] = {bflo(wa.x), bfhi(wa.x), bflo(wa.y), bfhi(wa.y), bflo(wa.z), bfhi(wa.z), bflo(wa.w), bfhi(wa.w)};
        float bb[8] = {bflo(wb.x), bfhi(wb.x), bflo(wb.y), bfhi(wb.y), bflo(wb.z), bfhi(wb.z), bflo(wb.w), bfhi(wb.w)};
        float oa[8], ob[8];
#pragma unroll
        for (int j = 0; j < 8; ++j) { const f32x2 c = *(const GAS f32x2*)(cs + 2 * j); oa[j] = a[j] * c.x - bb[j] * c.y; ob[j] = bb[j] * c.x + a[j] * c.y; }
        v4u w; w.x = pk2(oa[0], oa[1]); w.y = pk2(oa[2], oa[3]); w.z = pk2(oa[4], oa[5]); w.w = pk2(oa[6], oa[7]); *(GAS v4u*)pa = w;
        w.x = pk2(ob[0], ob[1]); w.y = pk2(ob[2], ob[3]); w.z = pk2(ob[4], ob[5]); w.w = pk2(ob[6], ob[7]); *(GAS v4u*)pb = w;
    }
}
__device__ __forceinline__ void l1_attn_phase(Frame& F, char* lds_generic) {
    const att::bf16* QKV = (const att::bf16*)(F.ws + L1_QKV); bf16* O = (bf16*)(F.ws + L1_O);
    constexpr int NLONG = NB * 16 * 2 * 8, NSHORT = NB * 16 * 2;
    for (int u = F.vcu; u < NLONG + NSHORT; u += F.G) {
        int b, hm, vh, qb, seq;
        if (u < NLONG) { qb = 1 + (u & 7); vh = (u >> 3) & 1; hm = (u >> 4) & 15; b = u >> 8; seq = LTOK; }
        else { const int v = u - NLONG; qb = 0; vh = v & 1; hm = (v >> 1) & 15; b = v >> 5; seq = NCTX; }
        const size_t m0 = (size_t)b * LTOK + (size_t)qb * 256, k0 = (size_t)b * LTOK;
        att::attn_dense_body<att::bf16>(QKV + m0 * 6144 + hm * 128, QKV + k0 * 6144 + 2048 + hm * 128, QKV + k0 * 6144 + 4096 + (hm >> 1) * 256 + vh * 128,
                                        O + m0 * 4096 + hm * 256 + vh * 128, seq, lds_generic);
        __syncthreads();
    }
}
__device__ __forceinline__ void l1_combine_phase(Frame& F, const float* lam_vec, const float* sub_g) {
    const int gw = GW(F), NGWv = NGW(F); const bf16* O = (const bf16*)(F.ws + L1_O); bf16* OUTB = (bf16*)(F.ws + WS_OUTB);
    float d01 = 0.f, d23 = 0.f;
    for (int i = F.lane; i < 128; i += 64) { d01 += lam_vec[i] * lam_vec[128 + i]; d23 += lam_vec[256 + i] * lam_vec[384 + i]; }
    const float lam_init = 0.8f - 0.6f * expf(-0.3f * 1.0f);
    const float lam = expf(wave_sum(d01)) - expf(wave_sum(d23)) + lam_init;
    const int l32 = F.lane & 31, hs = F.lane >> 5;
    float sg[8]; ld8f(sub_g + 8 * l32, sg);
    constexpr int UB = 3;
    for (int it0 = gw; it0 < NTOK * 4; it0 += UB * NGWv) {
        v4u w1[UB], w2[UB];
#pragma unroll
        for (int u = 0; u < UB; ++u) { const int it = it0 + u * NGWv; if (it < NTOK * 4) { const int m = it >> 2, h = (it & 3) * 2 + hs; const GAS bf16* op = (const GAS bf16*)O + (size_t)m * 4096 + h * 512 + 8 * l32;
            w1[u] = *(const GAS v4u*)op; w2[u] = *(const GAS v4u*)(op + 256); } }
#pragma unroll
        for (int u = 0; u < UB; ++u) { const int it = it0 + u * NGWv; if (it < NTOK * 4) { const int m = it >> 2, h = (it & 3) * 2 + hs;
            float o1[8], o2[8], o[8]; unpack8(w1[u], o1); unpack8(w2[u], o2); float ss = 0.f;
#pragma unroll
            for (int j = 0; j < 8; ++j) { o[j] = o1[j] - o2[j] * lam; ss += o[j] * o[j]; }
            ss = red16(ss); ss += __shfl_xor(ss, 16);
            const float rs = (1.0f / sqrtf(ss * (1.f / 256.f) + 1e-5f)) * (1.f - lam_init);
#pragma unroll
            for (int j = 0; j < 8; ++j) o[j] = o[j] * rs * sg[j];
            *(GAS v4u*)(OUTB + (size_t)m * DM + h * 256 + 8 * l32) = pack8(o); } }
    }
}

__device__ __forceinline__ void l2_gla_phase(Frame& F) {
    unsigned char* ws = F.ws; const bf16* HGO = (const bf16*)(ws + L2_HGO); bf16* OG = (bf16*)(ws + L2_OG);
    constexpr int PK = 136, PS = 72;
    LAS bf16* QR = (LAS bf16*)(F.lds + RING_OFF);
    LAS bf16* KR = QR + 64 * PK;
    LAS bf16* VR = KR + 64 * PK;
    LAS bf16* QD = QR; LAS bf16* KD = KR;
    LAS bf16* KEt = VR + 64 * PS;
    LAS bf16* Vt = KEt + 128 * PS;
    LAS bf16* Pm = Vt + 64 * PS;
    LAS bf16* St = Pm + 64 * PS;
    LAS float* tot = (LAS float*)(St + 64 * PK);
    LAS float* dec = tot + 8 * 128;
    const int lane = F.lane, w = F.wave, tid = F.tid;
    constexpr int NCHK = LTOK / 64;
    for (int u = F.vcu; u < 256; u += F.G) {
        const int vh = u & 1, h = (u >> 1) & 15, b = (u >> 5) & 3, d = u >> 7;
        pg8::f32x4 S4[4];
#pragma unroll
        for (int vb = 0; vb < 4; ++vb) S4[vb] = (pg8::f32x4){0.f, 0.f, 0.f, 0.f};
        v4u rq[2], rk[2], rv;
        const GAS bf16* hb = (const GAS bf16*)HGO + (size_t)b * LTOK * 10240;
#define GLA_FETCH(chn) do { \
            _Pragma("unroll") for (int k_ = 0; k_ < 2; ++k_) { const int id_ = tid + 512 * k_, s_ = id_ >> 4, c16_ = id_ & 15; const int step_ = (chn) * 64 + s_; const int t_ = d ? flip_tok(step_) : step_; \
                rq[k_] = *(const GAS v4u*)(hb + (size_t)t_ * 10240 + h * 128 + c16_ * 8); rk[k_] = *(const GAS v4u*)(hb + (size_t)t_ * 10240 + (3 + d) * DM + h * 128 + c16_ * 8); } \
            { const int s_ = tid >> 3, c16_ = tid & 7; const int step_ = (chn) * 64 + s_; const int t_ = d ? flip_tok(step_) : step_; rv = *(const GAS v4u*)(hb + (size_t)t_ * 10240 + DM + h * 128 + vh * 64 + c16_ * 8); } } while (0)
        GLA_FETCH(0);
        asm volatile("" : "+v"(rq[0]), "+v"(rq[1]), "+v"(rk[0]), "+v"(rk[1]), "+v"(rv));
        for (int ch = 0; ch < NCHK; ++ch) {
            LDS_BARRIER();
#pragma unroll
            for (int k = 0; k < 2; ++k) { const int id = tid + 512 * k, s = id >> 4, c16 = id & 15; *(LAS v4u*)(QR + s * PK + c16 * 8) = rq[k]; *(LAS v4u*)(KR + s * PK + c16 * 8) = rk[k]; }
            *(LAS v4u*)(VR + (tid >> 3) * PS + (tid & 7) * 8) = rv;
            if (ch + 1 < NCHK) GLA_FETCH(ch + 1);
            LDS_BARRIER();
            const int cp = tid & 63, sg = tid >> 6, c = 2 * cp;
            float k0[8], k1[8], b0[8], b1[8]; float run0 = 0.f, run1 = 0.f;
#pragma unroll
            for (int s = 0; s < 8; ++s) { const unsigned kw = *(const LAS unsigned*)(KR + (sg * 8 + s) * PK + c); k0[s] = bflo(kw); k1[s] = bfhi(kw);
                run0 += __logf(1.f - k0[s]); run1 += __logf(1.f - k1[s]); b0[s] = run0; b1[s] = run1; }
            *(LAS f32x2*)(tot + sg * 128 + c) = (f32x2){run0, run1};
            { const int v = tid & 63, s8 = (tid >> 6) * 8; unsigned short e[8];
#pragma unroll
              for (int s = 0; s < 8; ++s) e[s] = VR[(s8 + s) * PS + v];
              v4u o; o.x = e[0] | ((unsigned)e[1] << 16); o.y = e[2] | ((unsigned)e[3] << 16); o.z = e[4] | ((unsigned)e[5] << 16); o.w = e[6] | ((unsigned)e[7] << 16);
              *(LAS v4u*)(Vt + v * PS + s8) = o; }
#pragma unroll
            for (int vb = 0; vb < 4; ++vb) { v2u sw; sw.x = pk2(S4[vb][0], S4[vb][1]); sw.y = pk2(S4[vb][2], S4[vb][3]);
                *(LAS v2u*)(St + (vb * 16 + (lane & 15)) * PK + 16 * w + (lane >> 4) * 4) = sw; }
            LDS_BARRIER();
            float off0 = 0.f, off1 = 0.f, bend0 = 0.f, bend1 = 0.f;
#pragma unroll
            for (int g = 0; g < 8; ++g) { const f32x2 tg = *(const LAS f32x2*)(tot + g * 128 + c); if (g < sg) { off0 += tg.x; off1 += tg.y; } bend0 += tg.x; bend1 += tg.y; }
            if (sg == 0) *(LAS f32x2*)(dec + c) = (f32x2){__expf(bend0), __expf(bend1)};
            { const float eb0 = __expf(bend0), eb1 = __expf(bend1); float ke0[8], ke1[8];
#pragma unroll
              for (int s = 0; s < 8; ++s) { const int st = sg * 8 + s; const float e0 = __expf(off0 + b0[s]), e1 = __expf(off1 + b1[s]); const float i0 = __builtin_amdgcn_rcpf(e0), i1 = __builtin_amdgcn_rcpf(e1);
                  const unsigned qw = *(const LAS unsigned*)(QR + st * PK + c);
                  *(LAS unsigned*)(QD + st * PK + c) = pk2(bflo(qw) * e0, bfhi(qw) * e1);
                  const float kd0 = k0[s] * i0, kd1 = k1[s] * i1;
                  *(LAS unsigned*)(KD + st * PK + c) = pk2(kd0, kd1); ke0[s] = kd0 * eb0; ke1[s] = kd1 * eb1; }
              v4u o; o.x = pk2(ke0[0], ke0[1]); o.y = pk2(ke0[2], ke0[3]); o.z = pk2(ke0[4], ke0[5]); o.w = pk2(ke0[6], ke0[7]); *(LAS v4u*)(KEt + c * PS + sg * 8) = o;
              o.x = pk2(ke1[0], ke1[1]); o.y = pk2(ke1[2], ke1[3]); o.z = pk2(ke1[4], ke1[5]); o.w = pk2(ke1[6], ke1[7]); *(LAS v4u*)(KEt + (c + 1) * PS + sg * 8) = o; }
            LDS_BARRIER();
            { const int tb = w >> 1;
#pragma unroll
              for (int q2 = 0; q2 < 2; ++q2) { const int sb = (w & 1) * 2 + q2; pg8::f32x4 a = {0.f, 0.f, 0.f, 0.f};
                  if (sb <= tb) a = mma_tile(a, QD + tb * 16 * PK, PK, KD + sb * 16 * PK, PK, 4, lane);
#pragma unroll
                  for (int j = 0; j < 4; ++j) { const int tt = tb * 16 + (lane >> 4) * 4 + j, ss = sb * 16 + (lane & 15); Pm[tt * PS + ss] = f2bf(ss <= tt ? a[j] : 0.f); } } }
            LDS_BARRIER();
            asm volatile("" : "+v"(rq[0]), "+v"(rq[1]), "+v"(rk[0]), "+v"(rk[1]), "+v"(rv));
            { const int tb = w >> 1;
#pragma unroll
              for (int q2 = 0; q2 < 2; ++q2) { const int vb = (w & 1) * 2 + q2; pg8::f32x4 a = {0.f, 0.f, 0.f, 0.f};
                  a = mma_tile(a, Pm + tb * 16 * PS, PS, Vt + vb * 16 * PS, PS, 2, lane);
                  a = mma_tile(a, QD + tb * 16 * PK, PK, St + vb * 16 * PK, PK, 4, lane);
#pragma unroll
                  for (int j = 0; j < 4; ++j) { const int s = tb * 16 + (lane >> 4) * 4 + j; const int step = ch * 64 + s; const int t = d ? flip_tok(step) : step;
                      OG[((size_t)d * NTOK + (size_t)b * LTOK + t) * DM + h * 128 + vh * 64 + vb * 16 + (lane & 15)] = f2bf(a[j]); } } }
#pragma unroll
            for (int vb = 0; vb < 4; ++vb) { pg8::f32x4 a = S4[vb];
#pragma unroll
                for (int j = 0; j < 4; ++j) a[j] *= dec[16 * w + (lane >> 4) * 4 + j];
                S4[vb] = mma_tile(a, KEt + 16 * w * PS, PS, Vt + vb * 16 * PS, PS, 2, lane); }
        }
#undef GLA_FETCH
    }
}
__device__ __forceinline__ void l2_combine_phase(Frame& F, const float* norm_g) {
    const int gw = GW(F), NGWv = NGW(F); const bf16* OG = (const bf16*)(F.ws + L2_OG); const bf16* HGO = (const bf16*)(F.ws + L2_HGO); bf16* OUTB = (bf16*)(F.ws + WS_OUTB);
    const int l16 = F.lane & 15, hq = F.lane >> 4;
    float ng[8]; ld8f(norm_g + 8 * l16, ng);
    constexpr int UB = 3;
    for (int it0 = gw; it0 < NTOK * 4; it0 += UB * NGWv) {
        v4u wa[UB], wb[UB], wg[UB];
#pragma unroll
        for (int u = 0; u < UB; ++u) { const int it = it0 + u * NGWv; if (it < NTOK * 4) { const int m = it >> 2, col = ((it & 3) * 4 + hq) * 128 + 8 * l16; const size_t e = (size_t)m * DM + col;
            wa[u] = *(const GAS v4u*)(OG + e); wb[u] = *(const GAS v4u*)(OG + (size_t)NTOK * DM + e); wg[u] = *(const GAS v4u*)(HGO + (size_t)m * 10240 + 2 * DM + col); } }
#pragma unroll
        for (int u = 0; u < UB; ++u) { const int it = it0 + u * NGWv; if (it < NTOK * 4) { const int m = it >> 2, col = ((it & 3) * 4 + hq) * 128 + 8 * l16;
            float oa[8], ob[8], g[8], o[8]; unpack8(wa[u], oa); unpack8(wb[u], ob); unpack8(wg[u], g); float ss = 0.f;
#pragma unroll
            for (int j = 0; j < 8; ++j) { o[j] = oa[j] + ob[j]; ss += o[j] * o[j]; }
            ss = red16(ss);
            const float rs = 1.0f / sqrtf(ss * (1.f / 128.f) + 1e-5f);
#pragma unroll
            for (int j = 0; j < 8; ++j) o[j] = o[j] * rs * ng[j] * g[j];
            *(GAS v4u*)(OUTB + (size_t)m * DM + col) = pack8(o); } }
    }
}

__device__ __forceinline__ void l3_conv_phase(Frame& F, const float* cw, const float* cb) {
    const int gw = GW(F), NGWv = NGW(F); const bf16* IN = (const bf16*)(F.ws + L3_IN) + DM; bf16* XB = (bf16*)(F.ws + L3_XB);
    const int c0 = (gw & 3) * 512 + F.lane * 8;
    float wk[4][8], bk[8];
#pragma unroll
    for (int k = 0; k < 4; ++k) ld8f(cw + (size_t)k * DM + c0, wk[k]);
    ld8f(cb + c0, bk);
    for (int it = gw; it < (NTOK / 16) * 4; it += NGWv) {
        const int strip = it >> 2; const int m0 = strip * 16, t0 = m0 % LTOK;
        const int seg_end = (t0 < NCTX) ? NCTX : LTOK; const bool first_in_seg = (t0 == 0 || t0 == NCTX);
        const GAS bf16* xg = (const GAS bf16*)IN + (size_t)m0 * 4096 + c0;
        v4u xr[19];
#pragma unroll
        for (int q = 0; q < 19; ++q) { const bool ok = (q == 0) ? !first_in_seg : (t0 + q - 1 < seg_end);
            xr[q] = (v4u){0u, 0u, 0u, 0u}; if (ok) xr[q] = *(const GAS v4u*)(xg + (ptrdiff_t)(q - 1) * 4096); }
#pragma unroll
        for (int r = 0; r < 16; ++r) {
            const v4u x0 = xr[r], x1 = xr[r + 1], x2 = xr[r + 2], x3 = xr[r + 3];
            float o[8];
#pragma unroll
            for (int q = 0; q < 4; ++q) {
                o[2 * q] = bk[2 * q] + wk[0][2 * q] * bflo(x0[q]) + wk[1][2 * q] * bflo(x1[q]) + wk[2][2 * q] * bflo(x2[q]) + wk[3][2 * q] * bflo(x3[q]);
                o[2 * q + 1] = bk[2 * q + 1] + wk[0][2 * q + 1] * bfhi(x0[q]) + wk[1][2 * q + 1] * bfhi(x1[q]) + wk[2][2 * q + 1] * bfhi(x2[q]) + wk[3][2 * q + 1] * bfhi(x3[q]); }
            *(GAS v4u*)(XB + (size_t)(m0 + r) * DM + c0) = pack8(o);
        }
    }
}
__device__ __forceinline__ void l3_scan_phase(Frame& F) {
    unsigned char* ws = F.ws; LAS float* PA = (LAS float*)(F.lds + RING_OFF); LAS float* PH = PA + 512;
    constexpr int SEGL = LTOK / 8, NBLK = SEGL / 16;
    for (int u = F.vcu; u < 256; u += F.G) {
        const int d = u >> 7, b = (u >> 5) & 3, cg = u & 31; const int ch = cg * 64 + F.lane, seg = F.wave;
        const bf16* LOGA = (const bf16*)(ws + L3_LOGA) + (size_t)d * NTOK * DM + (size_t)b * LTOK * DM + ch;
        const bf16* UU = (const bf16*)(ws + L3_UU) + (size_t)d * NTOK * DM + (size_t)b * LTOK * DM + ch;
        bf16* YS = (bf16*)(ws + L3_YS) + (size_t)d * NTOK * DM + (size_t)b * LTOK * DM + ch;
        bf16 laA[16], luA[16], laB[16], luB[16];
        auto ldblk = [&](const int blk, bf16 (&la)[16], bf16 (&lu)[16]) __attribute__((always_inline)) {
#pragma unroll
            for (int s = 0; s < 16; ++s) { const int step = seg * SEGL + blk * 16 + s; const int t = d ? flip_tok(step) : step; la[s] = LOGA[(size_t)t * DM]; lu[s] = UU[(size_t)t * DM]; } };
        float P = 1.f, Hh = 0.f;
        auto scan1 = [&](const bf16 (&la)[16], const bf16 (&lu)[16]) __attribute__((always_inline)) {
#pragma unroll
            for (int s = 0; s < 16; ++s) { const float a = __expf(bf2f(la[s])); Hh = a * Hh + bf2f(lu[s]); P *= a; } };
        auto scan2 = [&](const int blk, const bf16 (&la)[16], const bf16 (&lu)[16]) __attribute__((always_inline)) {
#pragma unroll
            for (int s = 0; s < 16; ++s) { const int step = seg * SEGL + blk * 16 + s; const int t = d ? flip_tok(step) : step; const float a = __expf(bf2f(la[s])); Hh = a * Hh + bf2f(lu[s]); YS[(size_t)t * DM] = f2bf(Hh); } };
        ldblk(0, laA, luA);
#pragma unroll 1
        for (int blk = 0; blk < NBLK; blk += 2) { ldblk(blk + 1, laB, luB); scan1(laA, luA); ldblk(blk + 2 < NBLK ? blk + 2 : NBLK - 1, laA, luA); scan1(laB, luB); }
        __syncthreads();
        PA[F.tid] = P; PH[F.tid] = Hh;
        __syncthreads();
        float carry = 0.f;
        for (int g = 0; g < seg; ++g) carry = PA[g * 64 + F.lane] * carry + PH[g * 64 + F.lane];
        Hh = carry;
        ldblk(0, laA, luA);
#pragma unroll 1
        for (int blk = 0; blk < NBLK; blk += 2) { ldblk(blk + 1, laB, luB); scan2(blk, laA, luA); ldblk(blk + 2 < NBLK ? blk + 2 : NBLK - 1, laA, luA); scan2(blk + 1, laB, luB); }
    }
}
__device__ __forceinline__ void l3_combine_phase(Frame& F) {
    const bf16* YS = (const bf16*)(F.ws + L3_YS); const bf16* IN = (const bf16*)(F.ws + L3_IN); bf16* OUTB = (bf16*)(F.ws + WS_OUTB);
    const size_t total = (size_t)NTOK * DM / 8; const size_t stride = (size_t)F.G * 512;
    constexpr int UB = 3;
    for (size_t i0 = (size_t)F.vcu * 512 + F.tid; i0 < total; i0 += UB * stride) {
        v4u ya[UB], yb[UB], gg[UB];
#pragma unroll
        for (int u = 0; u < UB; ++u) { const size_t i = i0 + u * stride; if (i < total) { const size_t e = i * 8; const size_t m = e / DM, c = e % DM;
            ya[u] = *(const GAS v4u*)(YS + e); yb[u] = *(const GAS v4u*)(YS + (size_t)NTOK * DM + e); gg[u] = *(const GAS v4u*)(IN + m * 4096 + c); } }
#pragma unroll
        for (int u = 0; u < UB; ++u) { const size_t i = i0 + u * stride; if (i < total) { const size_t e = i * 8;
            float a[8], b[8], g[8], o[8]; unpack8(ya[u], a); unpack8(yb[u], b); unpack8(gg[u], g);
#pragma unroll
            for (int j = 0; j < 8; ++j) o[j] = (a[j] + b[j]) * g[j];
            *(GAS v4u*)(OUTB + e) = pack8(o); } }
    }
}
constexpr int N_PHASE_IDS = 1 + 16 * NLAYER;
struct Args { const float* in[43]; float* out; unsigned char* ws; int ph_lo, ph_hi; };
static_assert(sizeof(Args) == 45 * 8 + 8, "Args has no holes");

#ifdef PROBE_MASK
__device__ __forceinline__ int probe_rep(int k) {
    if (k == 0) return 1;
    return ((PROBE_SEL >> (k - 1)) & 1ull) ? 2 : 1;
}
#endif
__global__ void __launch_bounds__(NWAVES * 64, 2) mega_fwd(Args args) {
    extern __shared__ __attribute__((aligned(16))) unsigned char lds[];
    { const int t0 = threadIdx.x; for (int u = t0; u < (LDS_BYTES - LDSCTL_OFF) / 4; u += NWAVES * 64) ((LAS unsigned*)((LAS unsigned char*)lds + LDSCTL_OFF))[u] = 0u; }
    __syncthreads();
#define MKFRAME() Frame F; { int t_ = threadIdx.x; asm volatile("" : "+v"(t_)); int bx_ = blockIdx.x, g_ = gridDim.x; asm volatile("" : "+s"(bx_), "+s"(g_)); \
        F.lds = (LAS unsigned char*)lds; F.MISC = (volatile LAS unsigned*)(F.lds + MISC_OFF); F.tid = t_; F.lane = t_ & 63; F.wave = __builtin_amdgcn_readfirstlane(t_ >> 6); \
        F.G = g_; F.vcu = (g_ % 8 == 0) ? (bx_ % 8) * (g_ / 8) + bx_ / 8 : bx_; F.bx = bx_; F.ws = (unsigned char*)ldarg(44); F.ctl = (gu32*)(F.ws + WS_CTL); }
    const int lo = args.ph_lo, hi = args.ph_hi;
    const bool multi = (hi - lo) > 1;
    XcdBarrier bar; bar.bar = (unsigned*)((unsigned char*)ldarg(44) + WS_CTL) + CW_BAR; bar.x = 0; bar.st = nullptr;
    if (multi) bar = xcd_barrier_post(bar.bar, (volatile LAS unsigned*)((LAS unsigned char*)lds + MISC_OFF) + 8);
#define IN(k) (lo <= (k) && (k) < hi)
#define RUN_GEMM(EPI, MODE, LAT, NM, NN, LDA_, LDB_, KK_, Aptr, Bptr, Eobj) do { typedef Sched<MODE, LAT, NM, NN, LDA_, LDB_> S_t; S_t S_; S_.init(F.G, F.bx); \
        pg8::gemm_phase<EPI, S_t, LDA_, LDB_, KK_, true, true>(F.lds + RING_OFF, (Aptr), (Bptr), S_, (Eobj)); } while (0)
#define RUN_GEMM_SPLIT(SPLIT, KSUB, LDA_, LDB_, Aptr, Bptr, Eobj) do { typedef SchedSplitHalf<SPLIT, KSUB, LDA_, LDB_> S_t; S_t S_; S_.init(F.G, F.bx); \
        pg8::gemm_phase<EpiPartial, S_t, LDA_, LDB_, KSUB, true, true, true>(F.lds + RING_OFF, (Aptr), (Bptr), S_, (Eobj)); } while (0)
#define RUN_GEMM_HT(EPI, LAT, NM, NN, LMAX, NT, LDA_, LDB_, KK_, Aptr, Bptr, Eobj) do { \
        typedef SchedHT<LAT, NM, NN, LMAX, NT, LDA_, LDB_> S_t; S_t S_; S_.init(F.G, F.bx); pg8::gemm_phase<EPI, S_t, LDA_, LDB_, KK_, true, true, 2>(F.lds + RING_OFF, (Aptr), (Bptr), S_, (Eobj)); } while (0)
#define SEAM(k) do { if ((k) + 1 < hi) xcd_barrier(bar); } while (0)
#ifdef PROBE_MASK
#define PH_OPEN(k) if (IN(k)) { _Pragma("unroll 1") for (int rep_ = 0; rep_ < probe_rep(k); ++rep_) {
#define PH_CLOSE(k) if ((k) + 1 < hi || rep_ + 1 < probe_rep(k)) xcd_barrier(bar); } }
#else
#define PH_OPEN(k) if (IN(k)) {
#define PH_CLOSE(k) SEAM(k); }
#endif
#define WSP ((unsigned char*)ldarg(44))
#define Z ((float*)(WSP + WS_Z))
#define PRE ((bf16*)(WSP + WS_PRE))
#define H ((bf16*)(WSP + WS_H))
#define OUTB ((bf16*)(WSP + WS_OUTB))
#define U ((bf16*)(WSP + WS_U))
#define ACT ((bf16*)(WSP + WS_ACT))

#ifndef DIS_P0
    PH_OPEN(0) MKFRAME(); p0_prologue(F); PH_CLOSE(0)
#endif

    for (int layer = 0; layer < NLAYER; ++layer) {
        const int P = 1 + 16 * layer;
        if (layer == 0) {
#ifndef DIS_L0
            PH_OPEN(P + 0) MKFRAME(); l0_xs_phase(F, INP(0), INP(2), INP(12)); PH_CLOSE(P + 0)
#ifndef DIS_L0_G1
            PH_OPEN(P + 1) MKFRAME();
                EpiBf16Route<1> E{nullptr, 0, WSP, nullptr, nullptr};
                RUN_GEMM(EpiBf16Route<1>, 1, false, 36, 27, DM, DM, DM, (const bf16*)(WSP + L0_XS), (const bf16*)(WSP + WS_WA), E); PH_CLOSE(P + 1)
#endif
#ifndef DIS_L0_G2
            PH_OPEN(P + 2) MKFRAME();
                EpiBf16Route<2> E{nullptr, 0, WSP, INP(14), INP(17)};
                RUN_GEMM(EpiBf16Route<2>, 2, false, 36, 40, 256, 256, 256, (const bf16*)(WSP + L0_HID), (const bf16*)(WSP + WS_WL2), E); PH_CLOSE(P + 2)
#endif
#ifndef DIS_L0_PREP
#endif
#ifndef DIS_L0_SCAN
            PH_OPEN(P + 4) MKFRAME(); l0_cscan2_phase(F, INP(22), INP(23), INP(24)); PH_CLOSE(P + 4)
#endif
            PH_OPEN(P + 5) MKFRAME(); l0_post_phase(F, INP(25), INP(26)); PH_CLOSE(P + 5)
#endif
        } else if (layer == 1) {
#ifndef DIS_L1
            PH_OPEN(P + 0) MKFRAME();
                EpiBf16Route<5> E{(bf16*)(WSP + L1_QKV), 6144, WSP, nullptr, nullptr};
                RUN_GEMM_HT(EpiBf16Route<5>, false, 36, 24, 768, 96, DM, DM, DM, H, (const bf16*)(WSP + WS_WQKV), E); PH_CLOSE(P + 0)
            PH_OPEN(P + 2) MKFRAME(); l1_attn_phase(F, (char*)lds + RING_OFF); PH_CLOSE(P + 2)
            PH_OPEN(P + 3) MKFRAME(); l1_combine_phase(F, INP(29), INP(30)); PH_CLOSE(P + 3)
#endif
        } else if (layer == 2) {
#ifndef DIS_L2
            PH_OPEN(P + 0) MKFRAME();
                EpiBf16Route<3> E{(bf16*)(WSP + L2_HGO), 10240, WSP, (const float*)(WSP + WS_LB), nullptr};
                RUN_GEMM(EpiBf16Route<3>, 0, false, 36, 40, DM, DM, DM, H, (const bf16*)(WSP + WS_WHG), E); PH_CLOSE(P + 0)
            PH_OPEN(P + 1) MKFRAME(); l2_gla_phase(F); PH_CLOSE(P + 1)
            PH_OPEN(P + 2) MKFRAME(); l2_combine_phase(F, INP(34)); PH_CLOSE(P + 2)
#endif
        } else {
#ifndef DIS_L3
            PH_OPEN(P + 0) MKFRAME();
                EpiBf16Route<4> E{(bf16*)(WSP + L3_IN), 4096, WSP, nullptr, nullptr};
                RUN_GEMM_HT(EpiBf16Route<4>, false, 36, 16, 512, 64, DM, DM, DM, H, (const bf16*)(WSP + WS_WLR), E); PH_CLOSE(P + 0)
            PH_OPEN(P + 1) MKFRAME(); l3_conv_phase(F, INP(37), INP(38)); PH_CLOSE(P + 1)
            PH_OPEN(P + 2) MKFRAME();
                EpiGates E{WSP, INP(40), INP(41)};
                RUN_GEMM(EpiGates, 3, false, 36, 32, DM, 256, 256, (const bf16*)(WSP + L3_XB), (const bf16*)(WSP + WS_WGATE), E); PH_CLOSE(P + 2)
            PH_OPEN(P + 3) MKFRAME(); l3_scan_phase(F); PH_CLOSE(P + 3)
            PH_OPEN(P + 4) MKFRAME(); l3_combine_phase(F); PH_CLOSE(P + 4)
#endif
        }
#ifndef DIS_COMMON
        const bool last = (layer == NLAYER - 1);
        const float* lng = INP(6) + (size_t)layer * 2 * DM; const float* lnb = INP(7) + (size_t)layer * 2 * DM;
        PH_OPEN(P + 10) MKFRAME();
            const bf16* wB = (const bf16*)(WSP + WS_WO) + (size_t)layer * DM * DM; EpiResid E{PRE, WSP, layer, 2};
            if (last) RUN_GEMM(EpiResid, 0, true, 32, 8, DM, DM, DM, OUTB, wB, E);
            else { RUN_GEMM(EpiResid, 0, false, 32, 8, DM, DM, DM, OUTB, wB, E); EpiPartial EP{(bf16*)(WSP + WS_U)}; RUN_GEMM_SPLIT(4, 512, DM, DM, OUTB, wB, EP); }
            PH_CLOSE(P + 10)
        PH_OPEN(P + 11) MKFRAME();
            if (last) ln1_phase<true, 0, false>(F, PRE, Z, INP(0), INP(2), H, (float*)(WSP + WS_STAT), lng, lnb, layer, nullptr);
            else if (layer == 0) ln1_phase<false, 4, true>(F, PRE, Z, INP(0), INP(2), H, (float*)(WSP + WS_STAT), lng, lnb, layer, (const bf16*)(WSP + WS_U));
            else ln1_phase<false, 4, false>(F, PRE, Z, INP(0), INP(2), H, (float*)(WSP + WS_STAT), lng, lnb, layer, (const bf16*)(WSP + WS_U));
            PH_CLOSE(P + 11)
        PH_OPEN(P + 12) MKFRAME();
            const bf16* wB = (const bf16*)(WSP + WS_WUP) + (size_t)layer * DFF2 * DM; EpiConvAct E{ACT, (bf16*)(WSP + WS_UB), INP(9) + (size_t)layer * 3 * DFF2, INP(10) + (size_t)layer * DFF2, F.lds + RING_OFF + RING_BYTES + 4096};
            if (last) RUN_GEMM_HT(EpiConvAct, true, 32, 44, 1280, 128, DM, DM, DM, H, wB, E); else RUN_GEMM_HT(EpiConvAct, false, 36, 44, 1536, 48, DM, DM, DM, H, wB, E);
            PH_CLOSE(P + 12)
        PH_OPEN(P + 13) MKFRAME(); const float* cw = INP(9) + (size_t)layer * 3 * DFF2; const float* cb = INP(10) + (size_t)layer * DFF2;
            if (last) ffn_fix_phase<true>(F, (const bf16*)(WSP + WS_UB), ACT, cw, cb); else ffn_fix_phase<false>(F, (const bf16*)(WSP + WS_UB), ACT, cw, cb); PH_CLOSE(P + 13)
        PH_OPEN(P + 14) MKFRAME();
            const bf16* wB = (const bf16*)(WSP + WS_WDN) + (size_t)layer * DM * DFF; EpiResid E{PRE + (size_t)NTOK * DM, WSP, layer, 5};
            if (last) RUN_GEMM(EpiResid, 0, true, 32, 8, DFF, DFF, DFF, ACT, wB, E);
            else { RUN_GEMM(EpiResid, 0, false, 32, 8, DFF, DFF, DFF, ACT, wB, E); EpiPartial EP{(bf16*)(WSP + WS_U)}; RUN_GEMM_SPLIT(4, 1408, DFF, DFF, ACT, wB, EP); }
            PH_CLOSE(P + 14)
        PH_OPEN(P + 15) MKFRAME();
            if (last) ln2_phase<true, true, false, 0, false>(F, PRE, PRE + (size_t)NTOK * DM, Z, INP(0), INP(2), nullptr, (float*)ldarg(43), nullptr, (const float*)(WSP + WS_STAT), lng, lnb, lng + DM, lnb + DM, layer, nullptr);
            else if (layer == 0) ln2_phase<false, false, true, 4, true>(F, PRE, PRE + (size_t)NTOK * DM, Z, INP(0), INP(2), Z, nullptr, H, (const float*)(WSP + WS_STAT), lng, lnb, lng + DM, lnb + DM, layer, (const bf16*)(WSP + WS_U));
            else ln2_phase<false, false, true, 4, false>(F, PRE, PRE + (size_t)NTOK * DM, Z, INP(0), INP(2), Z, nullptr, H, (const float*)(WSP + WS_STAT), lng, lnb, lng + DM, lnb + DM, layer, (const bf16*)(WSP + WS_U));
            PH_CLOSE(P + 15)
#endif
    }
#undef IN
#undef SEAM
#undef Z
#undef PRE
#undef H
#undef OUTB
#undef U
#undef ACT
}

static const bool kPhaseUsed[N_PHASE_IDS] = {
    true,
    true, true, true, false, true, true, false, false, false, false, true, true, true, true, true, true,
    true, false, true, true, false, false, false, false, false, false, true, true, true, true, true, true,
    true, true, true, false, false, false, false, false, false, false, true, true, true, true, true, true,
    true, true, true, true, true, false, false, false, false, false, true, true, true, true, true, true };
extern "C" void kernel_launch(void* const* d_in, const int* in_sizes, int n_in, void* d_out, int out_size, void* d_ws, size_t ws_size, hipStream_t stream) {
    static int grid = 0;
    if (grid == 0) {
        if (n_in != 43 || out_size != NLAT * DM || ws_size < WS_END) { fprintf(stderr, "kernel_launch: unexpected shapes: n_in %d out %d ws %zu (need %zu)\n", n_in, out_size, ws_size, (size_t)WS_END); grid = -1; return; }
        int dev = 0, cus = 0, per_cu = 0;
        if (hipGetDevice(&dev) != hipSuccess || hipDeviceGetAttribute(&cus, hipDeviceAttributeMultiprocessorCount, dev) != hipSuccess) { grid = -1; return; }
        if (hipFuncSetAttribute((const void*)mega_fwd, hipFuncAttributeMaxDynamicSharedMemorySize, LDS_BYTES) != hipSuccess) { fprintf(stderr, "kernel_launch: hipFuncSetAttribute failed\n"); grid = -1; return; }
        if (hipOccupancyMaxActiveBlocksPerMultiprocessor(&per_cu, (const void*)mega_fwd, NWAVES * 64, LDS_BYTES) != hipSuccess || per_cu < 1)
            fprintf(stderr, "kernel_launch: occupancy query reports %d workgroups per CU\n", per_cu);
        (void)hipGetLastError();
        grid = cus;
    }
    if (grid < 0) return;
    if (hipMemsetAsync((char*)d_ws + WS_CTL, 0, ZERO_BYTES, stream) != hipSuccess) { fprintf(stderr, "kernel_launch: memset failed\n"); return; }
    Args a{};
    for (int i = 0; i < 43; ++i) a.in[i] = (const float*)d_in[i];
    a.out = (float*)d_out; a.ws = (unsigned char*)d_ws;
#if MK_N_LAUNCHES == 1
    a.ph_lo = 0; a.ph_hi = N_PHASE_IDS;
    hipLaunchKernelGGL(mega_fwd, dim3(grid), dim3(NWAVES * 64), LDS_BYTES, stream, a);
#else
    for (int p = 0; p < N_PHASE_IDS; ++p) { if (!kPhaseUsed[p]) continue; a.ph_lo = p; a.ph_hi = p + 1;
        hipLaunchKernelGGL(mega_fwd, dim3(grid), dim3(NWAVES * 64), LDS_BYTES, stream, a); }
#endif
    const hipError_t le = hipPeekAtLastError();
    if (le != hipSuccess) fprintf(stderr, "kernel_launch: launch failed: %s\n", hipGetErrorName(le));
}
```
